# Optimizing an MI355X kernel written in HIP

```python
import math
import jax, jax.numpy as jnp
from jax import lax
import numpy as np

D_MODEL = 1024
BATCH = 2
SEQ = 8192
DEPTH = 1
DEC_BATCH = 8
DEC_SEQ = 16
PAST_LEN = 2048

CHUNK = 64
MIX_WIDTH = D_MODEL
SSD_WIDTH = MIX_WIDTH // 2
SSD_HEAD_DIM = 64
SSD_HEADS = SSD_WIDTH // SSD_HEAD_DIM
SSD_GROUPS = 2
SSD_REP = SSD_HEADS // SSD_GROUPS
SSD_STATE = 128
SSD_CONV = 4
SSD_BLOCK = 64
SSD_XBC = SSD_WIDTH + 2 * SSD_GROUPS * SSD_STATE
SSD_NORM_GROUP = SSD_WIDTH // SSD_GROUPS
SSD_NORM_EPS = 1e-5
ATT_WIDTH = MIX_WIDTH - SSD_WIDTH
ATT_HEAD_DIM = 64
ATT_HEADS = ATT_WIDTH // (2 * ATT_HEAD_DIM)
ATT_V_DIM = 2 * ATT_HEAD_DIM
ATT_NORM_EPS = 1e-5
Q_BLOCK = 128
ROPE_THETA = 10000.0
MEM_LEN = 256
MEM_HEADS = 4
MEM_HEAD_DIM = D_MODEL // MEM_HEADS
FFN_HIDDEN = -(-8 * D_MODEL // (3 * 256)) * 256
NORM_EPS = 1e-6
IN_COLS = SSD_WIDTH + SSD_XBC + SSD_HEADS + 3 * ATT_WIDTH
IN_SPLITS = [SSD_WIDTH, SSD_WIDTH + SSD_XBC, SSD_WIDTH + SSD_XBC + SSD_HEADS,
             SSD_WIDTH + SSD_XBC + SSD_HEADS + ATT_WIDTH,
             SSD_WIDTH + SSD_XBC + SSD_HEADS + 2 * ATT_WIDTH]

kernel_name = 'hybrid_ssd_diffattn_stream_step'


def rms_norm(x, g, eps=NORM_EPS):
    xf = x.astype(jnp.float32)
    y = xf * lax.rsqrt(jnp.mean(xf * xf, axis=-1, keepdims=True) + eps)
    return (y * g.astype(jnp.float32)).astype(x.dtype)


def rope(x, pos):
    d = x.shape[-1]
    inv = jnp.power(ROPE_THETA, -jnp.arange(0, d, 2, dtype=jnp.float32) / d)
    ang = pos[:, None] * inv[None, :]
    cos = jnp.cos(ang)[None, :, None, None, :]
    sin = jnp.sin(ang)[None, :, None, None, :]
    xf = x.astype(jnp.float32)
    x1, x2 = xf[..., : d // 2], xf[..., d // 2:]
    return jnp.concatenate([x1 * cos - x2 * sin, x2 * cos + x1 * sin], axis=-1).astype(x.dtype)


def causal_conv(buf, u, w, b):
    ext = jnp.concatenate([buf.astype(u.dtype), u], axis=1)
    y = lax.conv_general_dilated(ext, w[:, None, :].astype(u.dtype), window_strides=(1,), padding='VALID',
                                 dimension_numbers=('NWC', 'WIO', 'NWC'), feature_group_count=u.shape[-1])
    return y + b.astype(u.dtype), ext[:, -(SSD_CONV - 1):]


def ssd_scan(x, dt, a, bmat, cmat, h0, blk):
    bsz, l, _, p = x.shape
    nc = l // blk
    xdt = (x * dt[..., None]).reshape(bsz, nc, blk, SSD_GROUPS, SSD_REP, p)
    bm = bmat.reshape(bsz, nc, blk, SSD_GROUPS, SSD_STATE)
    cm = cmat.reshape(bsz, nc, blk, SSD_GROUPS, SSD_STATE)
    ad = (dt * a).reshape(bsz, nc, blk, SSD_GROUPS, SSD_REP).transpose(0, 3, 4, 1, 2)
    acum = jnp.cumsum(ad, axis=-1)
    tri = jnp.tril(jnp.ones((blk, blk), dtype=bool))
    lmat = jnp.exp(jnp.where(tri, acum[..., :, None] - acum[..., None, :], -jnp.inf))
    cb = jnp.einsum('bclgn,bcsgn->bgcls', cm, bm)
    y_diag = jnp.einsum('bgrcls,bcsgrp->bclgrp', cb[:, :, None] * lmat, xdt)
    decay_in = jnp.exp(acum[..., -1:] - acum)
    chunk_states = jnp.einsum('bclgn,bgrcl,bclgrp->bcgrpn', bm, decay_in, xdt)
    chunk_decay = jnp.exp(acum[..., -1])

    def step(s, inp):
        st, dc = inp
        return s * dc[..., None, None] + st, s

    h0g = h0.reshape(bsz, SSD_GROUPS, SSD_REP, p, SSD_STATE)
    final, prev = lax.scan(step, h0g, (jnp.moveaxis(chunk_states, 1, 0), jnp.moveaxis(chunk_decay, -1, 0)))
    prev = jnp.moveaxis(prev, 0, 1)
    y_off = jnp.einsum('bclgn,bcgrpn,bgrcl->bclgrp', cm, prev, jnp.exp(acum))
    y = (y_diag + y_off).reshape(bsz, l, SSD_HEADS, p)
    return y, final.reshape(bsz, SSD_HEADS, p, SSD_STATE)


def diff_attn_block(q, k, v, qpos, kpos, lam):
    s = jnp.einsum('bqhcd,bkhcd->bhcqk', q.astype(jnp.float32), k.astype(jnp.float32)) / math.sqrt(ATT_HEAD_DIM)
    visible = (kpos[None, :] // CHUNK) <= (qpos[:, None] // CHUNK)
    p = jax.nn.softmax(jnp.where(visible, s, -jnp.inf), axis=-1)
    att = p[:, :, 0] - lam * p[:, :, 1]
    return jnp.einsum('bhqk,bkhe->bqhe', att, v.astype(jnp.float32))


def diff_attention(q, k, v, qpos, kpos, lam):
    bsz, sq = q.shape[0], q.shape[1]
    if sq % Q_BLOCK != 0:
        return diff_attn_block(q, k, v, qpos, kpos, lam)
    nb = sq // Q_BLOCK
    qb = jnp.moveaxis(q.reshape(bsz, nb, Q_BLOCK, ATT_HEADS, 2, ATT_HEAD_DIM), 1, 0)
    pb = qpos.reshape(nb, Q_BLOCK)
    out = lax.map(lambda t: diff_attn_block(t[0], k, v, t[1], kpos, lam), (qb, pb))
    return jnp.moveaxis(out, 0, 1).reshape(bsz, sq, ATT_HEADS, ATT_V_DIM)


def memory_kv(mem, g_mem, wk_x, wv_x):
    mn = rms_norm(mem, g_mem)
    b = mem.shape[0]
    mk = (mn @ wk_x).reshape(b, MEM_LEN, MEM_HEADS, MEM_HEAD_DIM)
    mv = (mn @ wv_x).reshape(b, MEM_LEN, MEM_HEADS, MEM_HEAD_DIM)
    return mk, mv


def layer_step(x, conv_buf, ssm0, k_past, v_past, mem_k, mem_v, lam_init,
               w_in, conv_w, conv_b, dt_bias, a_log, d_skip, ssm_norm_w,
               lam_q1, lam_k1, lam_q2, lam_k2, subln_w, w_out, wq_x, wo_x,
               g_pre_mix, g_post_mix, g_pre_x, g_post_x, g_pre_ffn, g_post_ffn,
               w_gate, w_up, w_down):
    f32 = jnp.float32
    bsz, l, _ = x.shape
    dtype = x.dtype
    past = k_past.shape[1]
    pos = past + jnp.arange(l, dtype=jnp.int32)

    hn = rms_norm(x, g_pre_mix)
    z, xbc, dt_raw, q, k, v = jnp.split(hn @ w_in, IN_SPLITS, axis=-1)

    xbc, conv_new = causal_conv(conv_buf, xbc, conv_w, conv_b)
    xbc = jax.nn.silu(xbc.astype(f32))
    xs, bm, cm = jnp.split(xbc, [SSD_WIDTH, SSD_WIDTH + SSD_GROUPS * SSD_STATE], axis=-1)
    dt = jax.nn.softplus(dt_raw.astype(f32) + dt_bias.astype(f32))
    a = -jnp.exp(a_log.astype(f32))
    blk = SSD_BLOCK if l % SSD_BLOCK == 0 else l
    xh = xs.reshape(bsz, l, SSD_HEADS, SSD_HEAD_DIM)
    y, ssm_new = ssd_scan(xh, dt, a, bm.reshape(bsz, l, SSD_GROUPS, SSD_STATE),
                          cm.reshape(bsz, l, SSD_GROUPS, SSD_STATE), ssm0.astype(f32), blk)
    y = y + d_skip.astype(f32)[:, None] * xh
    y = y.reshape(bsz, l, SSD_WIDTH) * jax.nn.silu(z.astype(f32))
    yg = y.reshape(bsz, l, SSD_GROUPS, SSD_NORM_GROUP)
    yg = yg * lax.rsqrt(jnp.mean(yg * yg, axis=-1, keepdims=True) + SSD_NORM_EPS)
    y_ssd = (yg.reshape(bsz, l, SSD_WIDTH) * ssm_norm_w.astype(f32)).astype(dtype)

    posf = pos.astype(f32)
    q = rope(q.reshape(bsz, l, ATT_HEADS, 2, ATT_HEAD_DIM), posf)
    k = rope(k.reshape(bsz, l, ATT_HEADS, 2, ATT_HEAD_DIM), posf)
    v = v.reshape(bsz, l, ATT_HEADS, ATT_V_DIM)
    k_all = jnp.concatenate([k_past.astype(dtype), k], axis=1)
    v_all = jnp.concatenate([v_past.astype(dtype), v], axis=1)
    kpos = jnp.arange(past + l, dtype=jnp.int32)
    lam = (jnp.exp(jnp.sum(lam_q1.astype(f32) * lam_k1.astype(f32)))
           - jnp.exp(jnp.sum(lam_q2.astype(f32) * lam_k2.astype(f32))) + lam_init)
    o = diff_attention(q, k_all, v_all, pos, kpos, lam)
    o = o * lax.rsqrt(jnp.mean(o * o, axis=-1, keepdims=True) + ATT_NORM_EPS) * subln_w.astype(f32) * (1.0 - lam_init)
    y_att = o.reshape(bsz, l, ATT_WIDTH).astype(dtype)

    mix = jnp.concatenate([y_ssd, y_att], axis=-1) @ w_out
    h = x + rms_norm(mix, g_post_mix)

    qx = (rms_norm(h, g_pre_x) @ wq_x).reshape(bsz, l, MEM_HEADS, MEM_HEAD_DIM)
    s = jnp.einsum('bqhd,bmhd->bhqm', qx.astype(f32), mem_k.astype(f32)) / math.sqrt(MEM_HEAD_DIM)
    p = jax.nn.softmax(s, axis=-1)
    ox = jnp.einsum('bhqm,bmhd->bqhd', p, mem_v.astype(f32)).reshape(bsz, l, D_MODEL).astype(dtype)
    h = h + rms_norm(ox @ wo_x, g_post_x)

    hn = rms_norm(h, g_pre_ffn)
    f = (jax.nn.silu(hn @ w_gate) * (hn @ w_up)) @ w_down
    h = h + rms_norm(f, g_post_ffn)
    return h, k, v, ssm_new.astype(dtype), conv_new


def setup_inputs(seed: int = 0) -> dict:
    key = jax.random.key(seed)
    ks = iter(jax.random.split(key, 48))
    L = DEPTH

    def nrm(shape, scale):
        return jax.random.normal(next(ks), shape, jnp.float32) * scale

    def gain(n):
        return 1.0 + nrm((L, n), 0.05)

    dt0 = jnp.exp(jax.random.uniform(next(ks), (L, SSD_HEADS), jnp.float32,
                                     minval=math.log(1e-3), maxval=math.log(1e-1)))
    return {
        'x_prompt': nrm((BATCH, SEQ, D_MODEL), 1.0),
        'x_sample': nrm((DEC_BATCH, DEC_SEQ, D_MODEL), 1.0),
        'cache_attn_k': nrm((L, DEC_BATCH, PAST_LEN, ATT_HEADS, 2, ATT_HEAD_DIM), 1.0),
        'cache_attn_v': nrm((L, DEC_BATCH, PAST_LEN, ATT_HEADS, ATT_V_DIM), 1.0),
        'state_ssm': nrm((L, DEC_BATCH, SSD_HEADS, SSD_HEAD_DIM, SSD_STATE), 0.1),
        'state_conv': nrm((L, DEC_BATCH, SSD_CONV - 1, SSD_XBC), 1.0),
        'cache_mem_k': nrm((L, DEC_BATCH, MEM_LEN, MEM_HEADS, MEM_HEAD_DIM), 1.0),
        'cache_mem_v': nrm((L, DEC_BATCH, MEM_LEN, MEM_HEADS, MEM_HEAD_DIM), 1.0),
        'mem_prompt': nrm((BATCH, MEM_LEN, D_MODEL), 1.0),
        'w_in': nrm((L, D_MODEL, IN_COLS), D_MODEL ** -0.5),
        'conv_w': nrm((L, SSD_CONV, SSD_XBC), SSD_CONV ** -0.5),
        'conv_b': nrm((L, SSD_XBC), 0.02),
        'dt_bias': dt0 + jnp.log(-jnp.expm1(-dt0)),
        'a_log': jnp.log(jax.random.uniform(next(ks), (L, SSD_HEADS), jnp.float32, minval=1.0, maxval=16.0)),
        'd_skip': 1.0 + nrm((L, SSD_HEADS), 0.1),
        'ssm_norm_w': gain(SSD_WIDTH),
        'lam_q1': nrm((L, ATT_HEAD_DIM), 0.1),
        'lam_k1': nrm((L, ATT_HEAD_DIM), 0.1),
        'lam_q2': nrm((L, ATT_HEAD_DIM), 0.1),
        'lam_k2': nrm((L, ATT_HEAD_DIM), 0.1),
        'subln_w': gain(ATT_V_DIM),
        'w_out': nrm((L, MIX_WIDTH, D_MODEL), MIX_WIDTH ** -0.5),
        'g_mem': gain(D_MODEL),
        'wq_x': nrm((L, D_MODEL, D_MODEL), D_MODEL ** -0.5),
        'wk_x': nrm((L, D_MODEL, D_MODEL), D_MODEL ** -0.5),
        'wv_x': nrm((L, D_MODEL, D_MODEL), D_MODEL ** -0.5),
        'wo_x': nrm((L, D_MODEL, D_MODEL), D_MODEL ** -0.5),
        'g_pre_mix': gain(D_MODEL),
        'g_post_mix': gain(D_MODEL),
        'g_pre_x': gain(D_MODEL),
        'g_post_x': gain(D_MODEL),
        'g_pre_ffn': gain(D_MODEL),
        'g_post_ffn': gain(D_MODEL),
        'w_gate': nrm((L, D_MODEL, FFN_HIDDEN), D_MODEL ** -0.5),
        'w_up': nrm((L, D_MODEL, FFN_HIDDEN), D_MODEL ** -0.5),
        'w_down': nrm((L, FFN_HIDDEN, D_MODEL), FFN_HIDDEN ** -0.5),
    }


def reference(x_prompt, x_sample, cache_attn_k, cache_attn_v, state_ssm, state_conv, cache_mem_k, cache_mem_v,
              mem_prompt, w_in, conv_w, conv_b, dt_bias, a_log, d_skip, ssm_norm_w,
              lam_q1, lam_k1, lam_q2, lam_k2, subln_w, w_out, g_mem, wq_x, wk_x, wv_x, wo_x,
              g_pre_mix, g_post_mix, g_pre_x, g_post_x, g_pre_ffn, g_post_ffn, w_gate, w_up, w_down):
    dtype = x_prompt.dtype
    bp = x_prompt.shape[0]
    hp, hs = x_prompt, x_sample
    pk, pv, pssm, pconv, pmk, pmv, sk, sv, sssm, sconv = ([] for _ in range(10))
    for i in range(DEPTH):
        lam_init = 0.8 - 0.6 * math.exp(-0.3 * i)
        lw = (w_in[i], conv_w[i], conv_b[i], dt_bias[i], a_log[i], d_skip[i], ssm_norm_w[i],
              lam_q1[i], lam_k1[i], lam_q2[i], lam_k2[i], subln_w[i], w_out[i], wq_x[i], wo_x[i],
              g_pre_mix[i], g_post_mix[i], g_pre_x[i], g_post_x[i], g_pre_ffn[i], g_post_ffn[i],
              w_gate[i], w_up[i], w_down[i])
        mk, mv = memory_kv(mem_prompt, g_mem[i], wk_x[i], wv_x[i])
        hp, k_new, v_new, ssm_new, conv_new = layer_step(
            hp,
            jnp.zeros((bp, SSD_CONV - 1, SSD_XBC), dtype),
            jnp.zeros((bp, SSD_HEADS, SSD_HEAD_DIM, SSD_STATE), jnp.float32),
            jnp.zeros((bp, 0, ATT_HEADS, 2, ATT_HEAD_DIM), dtype),
            jnp.zeros((bp, 0, ATT_HEADS, ATT_V_DIM), dtype),
            mk, mv, lam_init, *lw)
        pk.append(k_new); pv.append(v_new); pssm.append(ssm_new); pconv.append(conv_new)
        pmk.append(mk); pmv.append(mv)
        hs, k_new, v_new, ssm_new, conv_new = layer_step(
            hs, state_conv[i], state_ssm[i], cache_attn_k[i], cache_attn_v[i],
            cache_mem_k[i], cache_mem_v[i], lam_init, *lw)
        sk.append(k_new); sv.append(v_new); sssm.append(ssm_new); sconv.append(conv_new)
    return (hp, hs,
            jnp.stack(pk), jnp.stack(pv), jnp.stack(pssm), jnp.stack(pconv), jnp.stack(pmk), jnp.stack(pmv),
            jnp.stack(sk), jnp.stack(sv), jnp.stack(sssm), jnp.stack(sconv))
```

```cpp
#include <hip/hip_runtime.h>
#include <cstdint>
#include <cstdio>

#define DEV static __device__ __forceinline__
#define WAVE_SYNC() asm volatile("s_waitcnt lgkmcnt(0)" ::: "memory")

DEV float wave_sum(float v) {
#pragma unroll
    for (int o = 32; o > 0; o >>= 1) v += __shfl_xor(v, o);
    return v;
}
DEV float wave_max(float v) {
#pragma unroll
    for (int o = 32; o > 0; o >>= 1) v = fmaxf(v, __shfl_xor(v, o));
    return v;
}
DEV float silu_f(float x) { return x / (1.f + expf(-x)); }

__global__ void __launch_bounds__(512) k_rmsnorm(const float* x, const float* g, const float* res, float* out, int M, float eps) {
    const int wid = threadIdx.x >> 6, lane = threadIdx.x & 63, wpb = blockDim.x >> 6;
    for (int r = blockIdx.x * wpb + wid; r < M; r += gridDim.x * wpb) {
        const float4* xr = (const float4*)(x + (size_t)r * 1024);
        float4 v[4]; float s = 0.f;
#pragma unroll
        for (int j = 0; j < 4; ++j) { v[j] = xr[lane + 64 * j]; s += v[j].x * v[j].x + v[j].y * v[j].y + v[j].z * v[j].z + v[j].w * v[j].w; }
        s = wave_sum(s);
        const float rs = rsqrtf(s * (1.f / 1024.f) + eps);
#pragma unroll
        for (int j = 0; j < 4; ++j) {
            const float4 gg = ((const float4*)g)[lane + 64 * j];
            float4 o; o.x = v[j].x * rs * gg.x; o.y = v[j].y * rs * gg.y; o.z = v[j].z * rs * gg.z; o.w = v[j].w * rs * gg.w;
            if (res) { const float4 rr = ((const float4*)(res + (size_t)r * 1024))[lane + 64 * j]; o.x += rr.x; o.y += rr.y; o.z += rr.z; o.w += rr.w; }
            ((float4*)(out + (size_t)r * 1024))[lane + 64 * j] = o;
        }
    }
}

__global__ void __launch_bounds__(512) k_gemm(const float* A, int lda, const float* W, int ldw, float* C, int ldc, int M, int N, int K) {
    __shared__ float As[16][132];
    __shared__ float Ws[16][64];
    const int tid = threadIdx.x, ty = tid >> 4, tx = tid & 15;
    const int tilesN = (N + 63) / 64, tilesM = M / 128;
    for (int tile = blockIdx.x; tile < tilesM * tilesN; tile += gridDim.x) {
        const int tm = tile / tilesN, tn = tile % tilesN, m0 = tm * 128, n0 = tn * 64;
        float acc[4][4];
#pragma unroll
        for (int i = 0; i < 4; ++i)
#pragma unroll
            for (int j = 0; j < 4; ++j) acc[i][j] = 0.f;
        for (int k0 = 0; k0 < K; k0 += 16) {
            {
                const int r = tid >> 2, kq = (tid & 3) * 4;
                const float4 a = *(const float4*)(A + (size_t)(m0 + r) * lda + k0 + kq);
                As[kq + 0][r] = a.x; As[kq + 1][r] = a.y; As[kq + 2][r] = a.z; As[kq + 3][r] = a.w;
            }
            {
                const int kk = tid >> 5, n2 = (tid & 31) * 2, n = n0 + n2;
                const float* wp = W + (size_t)(k0 + kk) * ldw + n;
                Ws[kk][n2] = (n < N) ? wp[0] : 0.f; Ws[kk][n2 + 1] = (n + 1 < N) ? wp[1] : 0.f;
            }
            __syncthreads();
#pragma unroll
            for (int kk = 0; kk < 16; ++kk) {
                const float4 a = *(const float4*)&As[kk][ty * 4];
                const float4 b = *(const float4*)&Ws[kk][tx * 4];
                const float av[4] = {a.x, a.y, a.z, a.w}, bv[4] = {b.x, b.y, b.z, b.w};
#pragma unroll
                for (int i = 0; i < 4; ++i)
#pragma unroll
                    for (int j = 0; j < 4; ++j) acc[i][j] += av[i] * bv[j];
            }
            __syncthreads();
        }
#pragma unroll
        for (int i = 0; i < 4; ++i)
#pragma unroll
            for (int j = 0; j < 4; ++j) { const int col = n0 + tx * 4 + j; if (col < N) C[(size_t)(m0 + ty * 4 + i) * ldc + col] = acc[i][j]; }
    }
}

__global__ void __launch_bounds__(512) k_conv(const float* raw, const float* buf, const float* cw, const float* cb, float* act, float* conv_new, int B, int L) {
    const size_t total = (size_t)B * L * 1024;
    for (size_t i = (size_t)blockIdx.x * blockDim.x + threadIdx.x; i < total; i += (size_t)gridDim.x * blockDim.x) {
        const int c = (int)(i & 1023); const size_t bt = i >> 10; const int t = (int)(bt % L), b = (int)(bt / L);
        float acc = cb[c];
#pragma unroll
        for (int j = 0; j < 4; ++j) {
            const int tt = t - 3 + j;
            const float u = (tt >= 0) ? raw[((size_t)b * L + tt) * 1024 + c] : (buf ? buf[(size_t)(b * 3 + (tt + 3)) * 1024 + c] : 0.f);
            acc += cw[j * 1024 + c] * u;
        }
        act[i] = silu_f(acc);
        if (t >= L - 3) conv_new[(size_t)(b * 3 + (t - (L - 3))) * 1024 + c] = raw[i];
    }
}

__global__ void __launch_bounds__(512) k_dt(const float* dt_raw, const float* dt_bias, float* dt, int n) {
    for (int i = blockIdx.x * blockDim.x + threadIdx.x; i < n; i += gridDim.x * blockDim.x) {
        const float x = dt_raw[i] + dt_bias[i & 7];
        dt[i] = (x > 20.f) ? x : log1pf(expf(x));
    }
}

__global__ void __launch_bounds__(512) k_ssd(const float* act, const float* dtv, const float* z, const float* a_log, const float* d_skip,
                                             const float* ssm0, float* ypre, float* ssm_new, int B, int L) {
    const int tid = threadIdx.x, p = tid >> 3, seg = tid & 7;
    for (int item = blockIdx.x; item < B * 8; item += gridDim.x) {
        const int b = item >> 3, h = item & 7, g = h >> 2;
        float hs[16];
        const size_t sbase = ((size_t)(b * 8 + h) * 64 + p) * 128 + seg * 16;
#pragma unroll
        for (int i = 0; i < 16; ++i) hs[i] = ssm0 ? ssm0[sbase + i] : 0.f;
        const float a = -expf(a_log[h]), D = d_skip[h];
        for (int t = 0; t < L; ++t) {
            const size_t row = (size_t)b * L + t;
            const float dt = dtv[row * 8 + h];
            const float x = act[row * 1024 + h * 64 + p];
            const float4* Bp = (const float4*)(act + row * 1024 + 512 + g * 128 + seg * 16);
            const float4* Cp = (const float4*)(act + row * 1024 + 768 + g * 128 + seg * 16);
            const float dA = expf(dt * a), coef = dt * x;
            float y = 0.f;
#pragma unroll
            for (int q4 = 0; q4 < 4; ++q4) {
                const float4 bv = Bp[q4], cv = Cp[q4];
                hs[4 * q4 + 0] = dA * hs[4 * q4 + 0] + coef * bv.x; y += cv.x * hs[4 * q4 + 0];
                hs[4 * q4 + 1] = dA * hs[4 * q4 + 1] + coef * bv.y; y += cv.y * hs[4 * q4 + 1];
                hs[4 * q4 + 2] = dA * hs[4 * q4 + 2] + coef * bv.z; y += cv.z * hs[4 * q4 + 2];
                hs[4 * q4 + 3] = dA * hs[4 * q4 + 3] + coef * bv.w; y += cv.w * hs[4 * q4 + 3];
            }
            y += __shfl_xor(y, 1); y += __shfl_xor(y, 2); y += __shfl_xor(y, 4);
            if (seg == 0) { const float zz = z[row * 512 + h * 64 + p]; ypre[row * 512 + h * 64 + p] = (y + D * x) * silu_f(zz); }
        }
#pragma unroll
        for (int i = 0; i < 16; ++i) ssm_new[sbase + i] = hs[i];
    }
}

__global__ void __launch_bounds__(512) k_ssd_norm(const float* ypre, const float* w, float* cat, int M) {
    const int wid = threadIdx.x >> 6, lane = threadIdx.x & 63, wpb = blockDim.x >> 6;
    for (int it = blockIdx.x * wpb + wid; it < M * 2; it += gridDim.x * wpb) {
        const int row = it >> 1, g = it & 1;
        const float4 v = ((const float4*)(ypre + (size_t)row * 512 + g * 256))[lane];
        const float s = wave_sum(v.x * v.x + v.y * v.y + v.z * v.z + v.w * v.w);
        const float rs = rsqrtf(s * (1.f / 256.f) + 1e-5f);
        const float4 ww = ((const float4*)(w + g * 256))[lane];
        float4 o; o.x = v.x * rs * ww.x; o.y = v.y * rs * ww.y; o.z = v.z * rs * ww.z; o.w = v.w * rs * ww.w;
        ((float4*)(cat + (size_t)row * 1024 + g * 256))[lane] = o;
    }
}

__global__ void __launch_bounds__(512) k_rope(float* x, int B, int L, int P) {
    const size_t total = (size_t)B * L * 8 * 32;
    for (size_t i = (size_t)blockIdx.x * blockDim.x + threadIdx.x; i < total; i += (size_t)gridDim.x * blockDim.x) {
        const int d = (int)(i & 31), u = (int)((i >> 5) & 7); const size_t bt = i >> 8; const int t = (int)(bt % L);
        const float pos = (float)(P + t);
        const float inv = exp2f(-(float)d * (13.287712379549449f / 32.f));
        const float ang = pos * inv;
        float rev = ang * 0.15915494309189535f; rev -= floorf(rev);
        const float sn = __builtin_amdgcn_sinf(rev), cs = __builtin_amdgcn_cosf(rev);
        float* p = x + bt * 512 + u * 64 + d;
        const float x1 = p[0], x2 = p[32];
        p[0] = x1 * cs - x2 * sn; p[32] = x2 * cs + x1 * sn;
    }
}

__global__ void __launch_bounds__(512) k_attn(const float* q, const float* kn, const float* vn, const float* kp, const float* vp, int B, int L, int P,
                                              const float* lq1, const float* lk1, const float* lq2, const float* lk2, const float* subln, float lam_init, float* cat) {
    __shared__ float qs[8][4][128];
    __shared__ float ps[8][2][4][64];
    const int wid = threadIdx.x >> 6, lane = threadIdx.x & 63;
    const float lam = expf(wave_sum(lq1[lane] * lk1[lane])) - expf(wave_sum(lq2[lane] * lk2[lane])) + lam_init;
    const int ngrp = L / 4, nitems = B * 4 * ngrp;
    for (int it = blockIdx.x * 8 + wid; it < nitems; it += gridDim.x * 8) {
        const int qg = it % ngrp, bh = it / ngrp, h = bh & 3, b = bh >> 2, t0 = qg * 4;
        int nvis = ((P + t0) / 64 + 1) * 64; if (nvis > P + L) nvis = P + L;
        WAVE_SYNC();
#pragma unroll
        for (int i = 0; i < 8; ++i) { const int idx = lane + 64 * i, qi = idx >> 7, j = idx & 127; qs[wid][qi][j] = q[(((size_t)b * L + t0 + qi) * 4 + h) * 128 + j]; }
        WAVE_SYNC();
        float m[4][2], l[4][2], O[4][2][2];
#pragma unroll
        for (int qi = 0; qi < 4; ++qi)
#pragma unroll
            for (int c = 0; c < 2; ++c) { m[qi][c] = -1e30f; l[qi][c] = 0.f; O[qi][c][0] = 0.f; O[qi][c][1] = 0.f; }
        const int ntiles = (nvis + 63) / 64;
        for (int tile = 0; tile < ntiles; ++tile) {
            const int kk = tile * 64 + lane; const bool valid = kk < nvis; const int kc = valid ? kk : nvis - 1;
            const float* krow = (kc < P) ? kp + (((size_t)b * P + kc) * 4 + h) * 128 : kn + (((size_t)b * L + (kc - P)) * 4 + h) * 128;
            float s[4][2];
#pragma unroll
            for (int qi = 0; qi < 4; ++qi) { s[qi][0] = 0.f; s[qi][1] = 0.f; }
#pragma unroll
            for (int c = 0; c < 2; ++c)
#pragma unroll 4
                for (int d4 = 0; d4 < 16; ++d4) {
                    const float4 kv = ((const float4*)krow)[c * 16 + d4];
#pragma unroll
                    for (int qi = 0; qi < 4; ++qi) { const float4 qv = *(const float4*)&qs[wid][qi][c * 64 + d4 * 4]; s[qi][c] += kv.x * qv.x + kv.y * qv.y + kv.z * qv.z + kv.w * qv.w; }
                }
#pragma unroll
            for (int qi = 0; qi < 4; ++qi)
#pragma unroll
                for (int c = 0; c < 2; ++c) {
                    const float sv = valid ? s[qi][c] * 0.125f : -1e30f;
                    const float mt = wave_max(sv), mn = fmaxf(m[qi][c], mt), alpha = expf(m[qi][c] - mn);
                    const float pp = valid ? expf(sv - mn) : 0.f;
                    l[qi][c] = l[qi][c] * alpha + wave_sum(pp); O[qi][c][0] *= alpha; O[qi][c][1] *= alpha; m[qi][c] = mn;
                    ps[wid][c][qi][lane] = pp;
                }
            WAVE_SYNC();
            int nk = nvis - tile * 64; if (nk > 64) nk = 64;
            for (int j = 0; j < nk; ++j) {
                const int kj = tile * 64 + j;
                const float* vrow = (kj < P) ? vp + (((size_t)b * P + kj) * 4 + h) * 128 : vn + (((size_t)b * L + (kj - P)) * 4 + h) * 128;
                const float2 v = ((const float2*)vrow)[lane];
#pragma unroll
                for (int qi = 0; qi < 4; ++qi)
#pragma unroll
                    for (int c = 0; c < 2; ++c) { const float pv = ps[wid][c][qi][j]; O[qi][c][0] += pv * v.x; O[qi][c][1] += pv * v.y; }
            }
            WAVE_SYNC();
        }
        const float2 w = ((const float2*)subln)[lane];
#pragma unroll
        for (int qi = 0; qi < 4; ++qi) {
            const float ox = O[qi][0][0] / l[qi][0] - lam * O[qi][1][0] / l[qi][1];
            const float oy = O[qi][0][1] / l[qi][0] - lam * O[qi][1][1] / l[qi][1];
            const float ms = wave_sum(ox * ox + oy * oy) * (1.f / 128.f);
            const float r = rsqrtf(ms + 1e-5f) * (1.f - lam_init);
            float2 o; o.x = ox * r * w.x; o.y = oy * r * w.y;
            ((float2*)(cat + ((size_t)b * L + t0 + qi) * 1024 + 512 + h * 128))[lane] = o;
        }
    }
}

__global__ void __launch_bounds__(512) k_xattn(const float* qx, const float* mk, const float* mv, float* ox, int B, int L) {
    __shared__ float qs[8][4][256];
    __shared__ float ps[8][4][64];
    const int wid = threadIdx.x >> 6, lane = threadIdx.x & 63;
    const int ngrp = L / 4, nitems = B * 4 * ngrp;
    for (int it = blockIdx.x * 8 + wid; it < nitems; it += gridDim.x * 8) {
        const int qg = it % ngrp, bh = it / ngrp, h = bh & 3, b = bh >> 2, t0 = qg * 4;
        WAVE_SYNC();
#pragma unroll
        for (int i = 0; i < 16; ++i) { const int idx = lane + 64 * i, qi = idx >> 8, j = idx & 255; qs[wid][qi][j] = qx[((size_t)b * L + t0 + qi) * 1024 + h * 256 + j]; }
        WAVE_SYNC();
        float m[4], l[4], O[4][4];
#pragma unroll
        for (int qi = 0; qi < 4; ++qi) { m[qi] = -1e30f; l[qi] = 0.f; O[qi][0] = O[qi][1] = O[qi][2] = O[qi][3] = 0.f; }
        for (int tile = 0; tile < 4; ++tile) {
            const int kk = tile * 64 + lane;
            const float* krow = mk + (((size_t)b * 256 + kk) * 4 + h) * 256;
            float s[4] = {0.f, 0.f, 0.f, 0.f};
#pragma unroll 4
            for (int d4 = 0; d4 < 64; ++d4) {
                const float4 kv = ((const float4*)krow)[d4];
#pragma unroll
                for (int qi = 0; qi < 4; ++qi) { const float4 qv = *(const float4*)&qs[wid][qi][d4 * 4]; s[qi] += kv.x * qv.x + kv.y * qv.y + kv.z * qv.z + kv.w * qv.w; }
            }
#pragma unroll
            for (int qi = 0; qi < 4; ++qi) {
                const float sv = s[qi] * 0.0625f;
                const float mt = wave_max(sv), mn = fmaxf(m[qi], mt), alpha = expf(m[qi] - mn), pp = expf(sv - mn);
                l[qi] = l[qi] * alpha + wave_sum(pp); O[qi][0] *= alpha; O[qi][1] *= alpha; O[qi][2] *= alpha; O[qi][3] *= alpha; m[qi] = mn;
                ps[wid][qi][lane] = pp;
            }
            WAVE_SYNC();
            for (int j = 0; j < 64; ++j) {
                const float4 v = ((const float4*)(mv + (((size_t)b * 256 + tile * 64 + j) * 4 + h) * 256))[lane];
#pragma unroll
                for (int qi = 0; qi < 4; ++qi) { const float pv = ps[wid][qi][j]; O[qi][0] += pv * v.x; O[qi][1] += pv * v.y; O[qi][2] += pv * v.z; O[qi][3] += pv * v.w; }
            }
            WAVE_SYNC();
        }
#pragma unroll
        for (int qi = 0; qi < 4; ++qi) {
            const float il = 1.f / l[qi];
            float4 o; o.x = O[qi][0] * il; o.y = O[qi][1] * il; o.z = O[qi][2] * il; o.w = O[qi][3] * il;
            ((float4*)(ox + ((size_t)b * L + t0 + qi) * 1024 + h * 256))[lane] = o;
        }
    }
}

__global__ void __launch_bounds__(512) k_silu_mul(float* g, const float* u, size_t n) {
    for (size_t i = (size_t)blockIdx.x * blockDim.x + threadIdx.x; i < n; i += (size_t)gridDim.x * blockDim.x) g[i] = silu_f(g[i]) * u[i];
}

struct Weights {
    const float *w_in, *conv_w, *conv_b, *dt_bias, *a_log, *d_skip, *ssm_norm_w, *lq1, *lk1, *lq2, *lk2, *subln, *w_out, *wq, *wo;
    const float *g_pre_mix, *g_post_mix, *g_pre_x, *g_post_x, *g_pre_ffn, *g_post_ffn, *w_gate, *w_up, *w_down;
};

static void gemm(hipStream_t s, const float* A, int lda, const float* W, int ldw, float* C, int ldc, int M, int N, int K) {
    const int tiles = (M / 128) * ((N + 63) / 64);
    hipLaunchKernelGGL(k_gemm, dim3(tiles < 4096 ? tiles : 4096), dim3(512), 0, s, A, lda, W, ldw, C, ldc, M, N, K);
}

static void layer_step(hipStream_t s, const Weights& w, const float* x, int B, int L, int P, const float* conv_buf, const float* ssm0, const float* k_past, const float* v_past,
                       const float* mem_k, const float* mem_v, float* y, float* k_out, float* v_out, float* ssm_out, float* conv_out, float* ws) {
    const int M = B * L;
    float* hn = ws;
    float* z = hn + (size_t)M * 1024;
    float* raw = z + (size_t)M * 512;
    float* act = raw + (size_t)M * 1024;
    float* q = act + (size_t)M * 1024;
    float* dtr = q + (size_t)M * 512;
    float* dtv = dtr + (size_t)M * 8;
    float* ypre = dtv + (size_t)M * 8;
    float* cat = ypre + (size_t)M * 512;
    float* mix = cat + (size_t)M * 1024;
    const float lam_init = 0.2f;
    const int EG = 2048;
    hipLaunchKernelGGL(k_rmsnorm, dim3(EG), dim3(512), 0, s, x, w.g_pre_mix, (const float*)nullptr, hn, M, 1e-6f);
    gemm(s, hn, 1024, w.w_in + 0, 3080, z, 512, M, 512, 1024);
    gemm(s, hn, 1024, w.w_in + 512, 3080, raw, 1024, M, 1024, 1024);
    gemm(s, hn, 1024, w.w_in + 1536, 3080, dtr, 8, M, 8, 1024);
    gemm(s, hn, 1024, w.w_in + 1544, 3080, q, 512, M, 512, 1024);
    gemm(s, hn, 1024, w.w_in + 2056, 3080, k_out, 512, M, 512, 1024);
    gemm(s, hn, 1024, w.w_in + 2568, 3080, v_out, 512, M, 512, 1024);
    hipLaunchKernelGGL(k_conv, dim3(EG), dim3(512), 0, s, raw, conv_buf, w.conv_w, w.conv_b, act, conv_out, B, L);
    hipLaunchKernelGGL(k_dt, dim3(64), dim3(512), 0, s, dtr, w.dt_bias, dtv, M * 8);
    hipLaunchKernelGGL(k_ssd, dim3(B * 8), dim3(512), 0, s, act, dtv, z, w.a_log, w.d_skip, ssm0, ypre, ssm_out, B, L);
    hipLaunchKernelGGL(k_ssd_norm, dim3(EG), dim3(512), 0, s, ypre, w.ssm_norm_w, cat, M);
    hipLaunchKernelGGL(k_rope, dim3(EG), dim3(512), 0, s, q, B, L, P);
    hipLaunchKernelGGL(k_rope, dim3(EG), dim3(512), 0, s, k_out, B, L, P);
    hipLaunchKernelGGL(k_attn, dim3(EG), dim3(512), 0, s, q, k_out, v_out, k_past, v_past, B, L, P, w.lq1, w.lk1, w.lq2, w.lk2, w.subln, lam_init, cat);
    gemm(s, cat, 1024, w.w_out, 1024, mix, 1024, M, 1024, 1024);
    hipLaunchKernelGGL(k_rmsnorm, dim3(EG), dim3(512), 0, s, mix, w.g_post_mix, x, y, M, 1e-6f);
    hipLaunchKernelGGL(k_rmsnorm, dim3(EG), dim3(512), 0, s, y, w.g_pre_x, (const float*)nullptr, hn, M, 1e-6f);
    float* qx = raw; float* ox = act;
    gemm(s, hn, 1024, w.wq, 1024, qx, 1024, M, 1024, 1024);
    hipLaunchKernelGGL(k_xattn, dim3(EG), dim3(512), 0, s, qx, mem_k, mem_v, ox, B, L);
    gemm(s, ox, 1024, w.wo, 1024, mix, 1024, M, 1024, 1024);
    hipLaunchKernelGGL(k_rmsnorm, dim3(EG), dim3(512), 0, s, mix, w.g_post_x, y, y, M, 1e-6f);
    hipLaunchKernelGGL(k_rmsnorm, dim3(EG), dim3(512), 0, s, y, w.g_pre_ffn, (const float*)nullptr, hn, M, 1e-6f);
    const int CH = (M < 2048) ? M : 2048;
    float* G = mix + (size_t)M * 1024; float* U = G + (size_t)CH * 2816;
    for (int r0 = 0; r0 < M; r0 += CH) {
        gemm(s, hn + (size_t)r0 * 1024, 1024, w.w_gate, 2816, G, 2816, CH, 2816, 1024);
        gemm(s, hn + (size_t)r0 * 1024, 1024, w.w_up, 2816, U, 2816, CH, 2816, 1024);
        hipLaunchKernelGGL(k_silu_mul, dim3(EG), dim3(512), 0, s, G, U, (size_t)CH * 2816);
        gemm(s, G, 2816, w.w_down, 1024, mix + (size_t)r0 * 1024, 1024, CH, 1024, 2816);
    }
    hipLaunchKernelGGL(k_rmsnorm, dim3(EG), dim3(512), 0, s, mix, w.g_post_ffn, y, y, M, 1e-6f);
}

extern "C" void kernel_launch(void* const* d_in, const int* in_sizes, int n_in, void* d_out, int out_size, void* d_ws, size_t ws_size, hipStream_t stream) {
    const float* const* in = (const float* const*)d_in;
    const float *x_prompt = in[0], *x_sample = in[1], *cache_k = in[2], *cache_v = in[3], *state_ssm = in[4], *state_conv = in[5], *cache_mk = in[6], *cache_mv = in[7], *mem_prompt = in[8];
    Weights w;
    w.w_in = in[9]; w.conv_w = in[10]; w.conv_b = in[11]; w.dt_bias = in[12]; w.a_log = in[13]; w.d_skip = in[14]; w.ssm_norm_w = in[15];
    w.lq1 = in[16]; w.lk1 = in[17]; w.lq2 = in[18]; w.lk2 = in[19]; w.subln = in[20]; w.w_out = in[21];
    const float* g_mem = in[22]; w.wq = in[23]; const float* wk = in[24]; const float* wv = in[25]; w.wo = in[26];
    w.g_pre_mix = in[27]; w.g_post_mix = in[28]; w.g_pre_x = in[29]; w.g_post_x = in[30]; w.g_pre_ffn = in[31]; w.g_post_ffn = in[32];
    w.w_gate = in[33]; w.w_up = in[34]; w.w_down = in[35];
    float* out = (float*)d_out;
    float* y_prompt = out;
    float* y_sample = out + 16777216;
    float* p_attn_k = out + 16908288;
    float* p_attn_v = out + 25296896;
    float* p_ssm = out + 33685504;
    float* p_conv = out + 33816576;
    float* p_mem_k = out + 33822720;
    float* p_mem_v = out + 34347008;
    float* s_attn_k = out + 34871296;
    float* s_attn_v = out + 34936832;
    float* s_ssm = out + 35002368;
    float* s_conv = out + 35526656;
    float* ws = (float*)d_ws;
    float* mn = ws;
    hipLaunchKernelGGL(k_rmsnorm, dim3(64), dim3(512), 0, stream, mem_prompt, g_mem, (const float*)nullptr, mn, 512, 1e-6f);
    gemm(stream, mn, 1024, wk, 1024, p_mem_k, 1024, 512, 1024, 1024);
    gemm(stream, mn, 1024, wv, 1024, p_mem_v, 1024, 512, 1024, 1024);
    for (int b = 0; b < 2; ++b) {
        layer_step(stream, w, x_prompt + (size_t)b * 8192 * 1024, 1, 8192, 0, nullptr, nullptr, nullptr, nullptr,
                   p_mem_k + (size_t)b * 256 * 1024, p_mem_v + (size_t)b * 256 * 1024,
                   y_prompt + (size_t)b * 8192 * 1024, p_attn_k + (size_t)b * 8192 * 512, p_attn_v + (size_t)b * 8192 * 512,
                   p_ssm + (size_t)b * 65536, p_conv + (size_t)b * 3072, ws);
    }
    layer_step(stream, w, x_sample, 8, 16, 2048, state_conv, state_ssm, cache_k, cache_v, cache_mk, cache_mv, y_sample, s_attn_k, s_attn_v, s_ssm, s_conv, ws);
}
```

```cpp
#include <hip/hip_runtime.h>
#include <cstdint>
#include <cstdio>
#include <hip/hip_cooperative_groups.h>

#define DEV static __device__ __forceinline__
#define WAVE_SYNC() asm volatile("s_waitcnt lgkmcnt(0)" ::: "memory")

DEV float wave_sum(float v) {
#pragma unroll
    for (int o = 32; o > 0; o >>= 1) v += __shfl_xor(v, o);
    return v;
}
DEV float wave_max(float v) {
#pragma unroll
    for (int o = 32; o > 0; o >>= 1) v = fmaxf(v, __shfl_xor(v, o));
    return v;
}
DEV float silu_f(float x) { return x / (1.f + expf(-x)); }

__global__ void __launch_bounds__(512) k_rmsnorm(const float* x, const float* g, const float* res, float* out, int M, float eps) {
    const int wid = threadIdx.x >> 6, lane = threadIdx.x & 63, wpb = blockDim.x >> 6;
    for (int r = blockIdx.x * wpb + wid; r < M; r += gridDim.x * wpb) {
        const float4* xr = (const float4*)(x + (size_t)r * 1024);
        float4 v[4]; float s = 0.f;
#pragma unroll
        for (int j = 0; j < 4; ++j) { v[j] = xr[lane + 64 * j]; s += v[j].x * v[j].x + v[j].y * v[j].y + v[j].z * v[j].z + v[j].w * v[j].w; }
        s = wave_sum(s);
        const float rs = rsqrtf(s * (1.f / 1024.f) + eps);
#pragma unroll
        for (int j = 0; j < 4; ++j) {
            const float4 gg = ((const float4*)g)[lane + 64 * j];
            float4 o; o.x = v[j].x * rs * gg.x; o.y = v[j].y * rs * gg.y; o.z = v[j].z * rs * gg.z; o.w = v[j].w * rs * gg.w;
            if (res) { const float4 rr = ((const float4*)(res + (size_t)r * 1024))[lane + 64 * j]; o.x += rr.x; o.y += rr.y; o.z += rr.z; o.w += rr.w; }
            ((float4*)(out + (size_t)r * 1024))[lane + 64 * j] = o;
        }
    }
}

__global__ void __launch_bounds__(512) k_gemm(const float* A, int lda, const float* W, int ldw, float* C, int ldc, int M, int N, int K) {
    __shared__ float As[16][132];
    __shared__ float Ws[16][64];
    const int tid = threadIdx.x, ty = tid >> 4, tx = tid & 15;
    const int tilesN = (N + 63) / 64, tilesM = M / 128;
    for (int tile = blockIdx.x; tile < tilesM * tilesN; tile += gridDim.x) {
        const int tm = tile / tilesN, tn = tile % tilesN, m0 = tm * 128, n0 = tn * 64;
        float acc[4][4];
#pragma unroll
        for (int i = 0; i < 4; ++i)
#pragma unroll
            for (int j = 0; j < 4; ++j) acc[i][j] = 0.f;
        for (int k0 = 0; k0 < K; k0 += 16) {
            {
                const int r = tid >> 2, kq = (tid & 3) * 4;
                const float4 a = *(const float4*)(A + (size_t)(m0 + r) * lda + k0 + kq);
                As[kq + 0][r] = a.x; As[kq + 1][r] = a.y; As[kq + 2][r] = a.z; As[kq + 3][r] = a.w;
            }
            {
                const int kk = tid >> 5, n2 = (tid & 31) * 2, n = n0 + n2;
                const float* wp = W + (size_t)(k0 + kk) * ldw + n;
                Ws[kk][n2] = (n < N) ? wp[0] : 0.f; Ws[kk][n2 + 1] = (n + 1 < N) ? wp[1] : 0.f;
            }
            __syncthreads();
#pragma unroll
            for (int kk = 0; kk < 16; ++kk) {
                const float4 a = *(const float4*)&As[kk][ty * 4];
                const float4 b = *(const float4*)&Ws[kk][tx * 4];
                const float av[4] = {a.x, a.y, a.z, a.w}, bv[4] = {b.x, b.y, b.z, b.w};
#pragma unroll
                for (int i = 0; i < 4; ++i)
#pragma unroll
                    for (int j = 0; j < 4; ++j) acc[i][j] += av[i] * bv[j];
            }
            __syncthreads();
        }
#pragma unroll
        for (int i = 0; i < 4; ++i)
#pragma unroll
            for (int j = 0; j < 4; ++j) { const int col = n0 + tx * 4 + j; if (col < N) C[(size_t)(m0 + ty * 4 + i) * ldc + col] = acc[i][j]; }
    }
}

__global__ void __launch_bounds__(512) k_conv(const float* raw, const float* buf, const float* cw, const float* cb, float* act, float* conv_new, int B, int L) {
    const size_t total = (size_t)B * L * 1024;
    for (size_t i = (size_t)blockIdx.x * blockDim.x + threadIdx.x; i < total; i += (size_t)gridDim.x * blockDim.x) {
        const int c = (int)(i & 1023); const size_t bt = i >> 10; const int t = (int)(bt % L), b = (int)(bt / L);
        float acc = cb[c];
#pragma unroll
        for (int j = 0; j < 4; ++j) {
            const int tt = t - 3 + j;
            const float u = (tt >= 0) ? raw[((size_t)b * L + tt) * 1024 + c] : (buf ? buf[(size_t)(b * 3 + (tt + 3)) * 1024 + c] : 0.f);
            acc += cw[j * 1024 + c] * u;
        }
        act[i] = silu_f(acc);
        if (t >= L - 3) conv_new[(size_t)(b * 3 + (t - (L - 3))) * 1024 + c] = raw[i];
    }
}

__global__ void __launch_bounds__(512) k_dt(const float* dt_raw, const float* dt_bias, float* dt, int n) {
    for (int i = blockIdx.x * blockDim.x + threadIdx.x; i < n; i += gridDim.x * blockDim.x) {
        const float x = dt_raw[i] + dt_bias[i & 7];
        dt[i] = (x > 20.f) ? x : log1pf(expf(x));
    }
}

__global__ void __launch_bounds__(512) k_ssd(const float* act, const float* dtv, const float* z, const float* a_log, const float* d_skip,
                                             const float* ssm0, float* ypre, float* ssm_new, int B, int L) {
    const int tid = threadIdx.x, p = tid >> 3, seg = tid & 7;
    for (int item = blockIdx.x; item < B * 8; item += gridDim.x) {
        const int b = item >> 3, h = item & 7, g = h >> 2;
        float hs[16];
        const size_t sbase = ((size_t)(b * 8 + h) * 64 + p) * 128 + seg * 16;
#pragma unroll
        for (int i = 0; i < 16; ++i) hs[i] = ssm0 ? ssm0[sbase + i] : 0.f;
        const float a = -expf(a_log[h]), D = d_skip[h];
        for (int t = 0; t < L; ++t) {
            const size_t row = (size_t)b * L + t;
            const float dt = dtv[row * 8 + h];
            const float x = act[row * 1024 + h * 64 + p];
            const float4* Bp = (const float4*)(act + row * 1024 + 512 + g * 128 + seg * 16);
            const float4* Cp = (const float4*)(act + row * 1024 + 768 + g * 128 + seg * 16);
            const float dA = expf(dt * a), coef = dt * x;
            float y = 0.f;
#pragma unroll
            for (int q4 = 0; q4 < 4; ++q4) {
                const float4 bv = Bp[q4], cv = Cp[q4];
                hs[4 * q4 + 0] = dA * hs[4 * q4 + 0] + coef * bv.x; y += cv.x * hs[4 * q4 + 0];
                hs[4 * q4 + 1] = dA * hs[4 * q4 + 1] + coef * bv.y; y += cv.y * hs[4 * q4 + 1];
                hs[4 * q4 + 2] = dA * hs[4 * q4 + 2] + coef * bv.z; y += cv.z * hs[4 * q4 + 2];
                hs[4 * q4 + 3] = dA * hs[4 * q4 + 3] + coef * bv.w; y += cv.w * hs[4 * q4 + 3];
            }
            y += __shfl_xor(y, 1); y += __shfl_xor(y, 2); y += __shfl_xor(y, 4);
            if (seg == 0) { const float zz = z[row * 512 + h * 64 + p]; ypre[row * 512 + h * 64 + p] = (y + D * x) * silu_f(zz); }
        }
#pragma unroll
        for (int i = 0; i < 16; ++i) ssm_new[sbase + i] = hs[i];
    }
}

__global__ void __launch_bounds__(512) k_ssd_norm(const float* ypre, const float* w, float* cat, int M) {
    const int wid = threadIdx.x >> 6, lane = threadIdx.x & 63, wpb = blockDim.x >> 6;
    for (int it = blockIdx.x * wpb + wid; it < M * 2; it += gridDim.x * wpb) {
        const int row = it >> 1, g = it & 1;
        const float4 v = ((const float4*)(ypre + (size_t)row * 512 + g * 256))[lane];
        const float s = wave_sum(v.x * v.x + v.y * v.y + v.z * v.z + v.w * v.w);
        const float rs = rsqrtf(s * (1.f / 256.f) + 1e-5f);
        const float4 ww = ((const float4*)(w + g * 256))[lane];
        float4 o; o.x = v.x * rs * ww.x; o.y = v.y * rs * ww.y; o.z = v.z * rs * ww.z; o.w = v.w * rs * ww.w;
        ((float4*)(cat + (size_t)row * 1024 + g * 256))[lane] = o;
    }
}

__global__ void __launch_bounds__(512) k_rope(float* x, int B, int L, int P) {
    const size_t total = (size_t)B * L * 8 * 32;
    for (size_t i = (size_t)blockIdx.x * blockDim.x + threadIdx.x; i < total; i += (size_t)gridDim.x * blockDim.x) {
        const int d = (int)(i & 31), u = (int)((i >> 5) & 7); const size_t bt = i >> 8; const int t = (int)(bt % L);
        const float pos = (float)(P + t);
        const float inv = exp2f(-(float)d * (13.287712379549449f / 32.f));
        const float ang = pos * inv;
        float rev = ang * 0.15915494309189535f; rev -= floorf(rev);
        const float sn = __builtin_amdgcn_sinf(rev), cs = __builtin_amdgcn_cosf(rev);
        float* p = x + bt * 512 + u * 64 + d;
        const float x1 = p[0], x2 = p[32];
        p[0] = x1 * cs - x2 * sn; p[32] = x2 * cs + x1 * sn;
    }
}

__global__ void __launch_bounds__(512) k_attn(const float* q, const float* kn, const float* vn, const float* kp, const float* vp, int B, int L, int P,
                                              const float* lq1, const float* lk1, const float* lq2, const float* lk2, const float* subln, float lam_init, float* cat) {
    __shared__ float qs[8][4][128];
    __shared__ float ps[8][2][4][64];
    const int wid = threadIdx.x >> 6, lane = threadIdx.x & 63;
    const float lam = expf(wave_sum(lq1[lane] * lk1[lane])) - expf(wave_sum(lq2[lane] * lk2[lane])) + lam_init;
    const int ngrp = L / 4, nitems = B * 4 * ngrp;
    for (int it = blockIdx.x * 8 + wid; it < nitems; it += gridDim.x * 8) {
        const int qg = it % ngrp, bh = it / ngrp, h = bh & 3, b = bh >> 2, t0 = qg * 4;
        int nvis = ((P + t0) / 64 + 1) * 64; if (nvis > P + L) nvis = P + L;
        WAVE_SYNC();
#pragma unroll
        for (int i = 0; i < 8; ++i) { const int idx = lane + 64 * i, qi = idx >> 7, j = idx & 127; qs[wid][qi][j] = q[(((size_t)b * L + t0 + qi) * 4 + h) * 128 + j]; }
        WAVE_SYNC();
        float m[4][2], l[4][2], O[4][2][2];
#pragma unroll
        for (int qi = 0; qi < 4; ++qi)
#pragma unroll
            for (int c = 0; c < 2; ++c) { m[qi][c] = -1e30f; l[qi][c] = 0.f; O[qi][c][0] = 0.f; O[qi][c][1] = 0.f; }
        const int ntiles = (nvis + 63) / 64;
        for (int tile = 0; tile < ntiles; ++tile) {
            const int kk = tile * 64 + lane; const bool valid = kk < nvis; const int kc = valid ? kk : nvis - 1;
            const float* krow = (kc < P) ? kp + (((size_t)b * P + kc) * 4 + h) * 128 : kn + (((size_t)b * L + (kc - P)) * 4 + h) * 128;
            float s[4][2];
#pragma unroll
            for (int qi = 0; qi < 4; ++qi) { s[qi][0] = 0.f; s[qi][1] = 0.f; }
#pragma unroll
            for (int c = 0; c < 2; ++c)
#pragma unroll 4
                for (int d4 = 0; d4 < 16; ++d4) {
                    const float4 kv = ((const float4*)krow)[c * 16 + d4];
#pragma unroll
                    for (int qi = 0; qi < 4; ++qi) { const float4 qv = *(const float4*)&qs[wid][qi][c * 64 + d4 * 4]; s[qi][c] += kv.x * qv.x + kv.y * qv.y + kv.z * qv.z + kv.w * qv.w; }
                }
#pragma unroll
            for (int qi = 0; qi < 4; ++qi)
#pragma unroll
                for (int c = 0; c < 2; ++c) {
                    const float sv = valid ? s[qi][c] * 0.125f : -1e30f;
                    const float mt = wave_max(sv), mn = fmaxf(m[qi][c], mt), alpha = expf(m[qi][c] - mn);
                    const float pp = valid ? expf(sv - mn) : 0.f;
                    l[qi][c] = l[qi][c] * alpha + wave_sum(pp); O[qi][c][0] *= alpha; O[qi][c][1] *= alpha; m[qi][c] = mn;
                    ps[wid][c][qi][lane] = pp;
                }
            WAVE_SYNC();
            int nk = nvis - tile * 64; if (nk > 64) nk = 64;
            for (int j = 0; j < nk; ++j) {
                const int kj = tile * 64 + j;
                const float* vrow = (kj < P) ? vp + (((size_t)b * P + kj) * 4 + h) * 128 : vn + (((size_t)b * L + (kj - P)) * 4 + h) * 128;
                const float2 v = ((const float2*)vrow)[lane];
#pragma unroll
                for (int qi = 0; qi < 4; ++qi)
#pragma unroll
                    for (int c = 0; c < 2; ++c) { const float pv = ps[wid][c][qi][j]; O[qi][c][0] += pv * v.x; O[qi][c][1] += pv * v.y; }
            }
            WAVE_SYNC();
        }
        const float2 w = ((const float2*)subln)[lane];
#pragma unroll
        for (int qi = 0; qi < 4; ++qi) {
            const float ox = O[qi][0][0] / l[qi][0] - lam * O[qi][1][0] / l[qi][1];
            const float oy = O[qi][0][1] / l[qi][0] - lam * O[qi][1][1] / l[qi][1];
            const float ms = wave_sum(ox * ox + oy * oy) * (1.f / 128.f);
            const float r = rsqrtf(ms + 1e-5f) * (1.f - lam_init);
            float2 o; o.x = ox * r * w.x; o.y = oy * r * w.y;
            ((float2*)(cat + ((size_t)b * L + t0 + qi) * 1024 + 512 + h * 128))[lane] = o;
        }
    }
}

__global__ void __launch_bounds__(512) k_xattn(const float* qx, const float* mk, const float* mv, float* ox, int B, int L) {
    __shared__ float qs[8][4][256];
    __shared__ float ps[8][4][64];
    const int wid = threadIdx.x >> 6, lane = threadIdx.x & 63;
    const int ngrp = L / 4, nitems = B * 4 * ngrp;
    for (int it = blockIdx.x * 8 + wid; it < nitems; it += gridDim.x * 8) {
        const int qg = it % ngrp, bh = it / ngrp, h = bh & 3, b = bh >> 2, t0 = qg * 4;
        WAVE_SYNC();
#pragma unroll
        for (int i = 0; i < 16; ++i) { const int idx = lane + 64 * i, qi = idx >> 8, j = idx & 255; qs[wid][qi][j] = qx[((size_t)b * L + t0 + qi) * 1024 + h * 256 + j]; }
        WAVE_SYNC();
        float m[4], l[4], O[4][4];
#pragma unroll
        for (int qi = 0; qi < 4; ++qi) { m[qi] = -1e30f; l[qi] = 0.f; O[qi][0] = O[qi][1] = O[qi][2] = O[qi][3] = 0.f; }
        for (int tile = 0; tile < 4; ++tile) {
            const int kk = tile * 64 + lane;
            const float* krow = mk + (((size_t)b * 256 + kk) * 4 + h) * 256;
            float s[4] = {0.f, 0.f, 0.f, 0.f};
#pragma unroll 4
            for (int d4 = 0; d4 < 64; ++d4) {
                const float4 kv = ((const float4*)krow)[d4];
#pragma unroll
                for (int qi = 0; qi < 4; ++qi) { const float4 qv = *(const float4*)&qs[wid][qi][d4 * 4]; s[qi] += kv.x * qv.x + kv.y * qv.y + kv.z * qv.z + kv.w * qv.w; }
            }
#pragma unroll
            for (int qi = 0; qi < 4; ++qi) {
                const float sv = s[qi] * 0.0625f;
                const float mt = wave_max(sv), mn = fmaxf(m[qi], mt), alpha = expf(m[qi] - mn), pp = expf(sv - mn);
                l[qi] = l[qi] * alpha + wave_sum(pp); O[qi][0] *= alpha; O[qi][1] *= alpha; O[qi][2] *= alpha; O[qi][3] *= alpha; m[qi] = mn;
                ps[wid][qi][lane] = pp;
            }
            WAVE_SYNC();
            for (int j = 0; j < 64; ++j) {
                const float4 v = ((const float4*)(mv + (((size_t)b * 256 + tile * 64 + j) * 4 + h) * 256))[lane];
#pragma unroll
                for (int qi = 0; qi < 4; ++qi) { const float pv = ps[wid][qi][j]; O[qi][0] += pv * v.x; O[qi][1] += pv * v.y; O[qi][2] += pv * v.z; O[qi][3] += pv * v.w; }
            }
            WAVE_SYNC();
        }
#pragma unroll
        for (int qi = 0; qi < 4; ++qi) {
            const float il = 1.f / l[qi];
            float4 o; o.x = O[qi][0] * il; o.y = O[qi][1] * il; o.z = O[qi][2] * il; o.w = O[qi][3] * il;
            ((float4*)(ox + ((size_t)b * L + t0 + qi) * 1024 + h * 256))[lane] = o;
        }
    }
}

__global__ void __launch_bounds__(512) k_silu_mul(float* g, const float* u, size_t n) {
    for (size_t i = (size_t)blockIdx.x * blockDim.x + threadIdx.x; i < n; i += (size_t)gridDim.x * blockDim.x) g[i] = silu_f(g[i]) * u[i];
}


#define LAS __attribute__((address_space(3)))
typedef unsigned short bf16_t;
typedef float f32x4 __attribute__((ext_vector_type(4)));
typedef float f32x16 __attribute__((ext_vector_type(16)));
typedef short bf16x8 __attribute__((ext_vector_type(8)));
typedef short s16x4 __attribute__((ext_vector_type(4)));
typedef unsigned u32x4 __attribute__((ext_vector_type(4)));
typedef unsigned u32x2 __attribute__((ext_vector_type(2)));

constexpr size_t MiB = 1u << 20;
constexpr size_t WS_W_IN = 0, WS_W_OUT = 6 * MiB, WS_W_Q = 8 * MiB, WS_W_KV = 10 * MiB, WS_W_O = 14 * MiB, WS_W_GU = 16 * MiB, WS_W_DOWN = 27 * MiB;
constexpr size_t WS_CTL = 33 * MiB, WS_DTV = 34 * MiB, WS_CDEC = 34 * MiB + 512 * 1024, WS_MN = 35 * MiB;
constexpr size_t WS_XN = 36 * MiB, WS_CAT = 68 * MiB, WS_QX = 68 * MiB, WS_Q = 100 * MiB, WS_K = 116 * MiB, WS_RAW = 100 * MiB;
constexpr size_t WS_ZX = 132 * MiB, WS_OX = 132 * MiB, WS_V = 180 * MiB, WS_ST = 196 * MiB, WS_HID = 132 * MiB, WS_KM = 228 * MiB, WS_VM = 229 * MiB, WS_SMP = 230 * MiB;
constexpr int MP = 16384;
constexpr int LDS_BYTES = 147456;

DEV unsigned f2bf(float f) { unsigned u = __builtin_bit_cast(unsigned, f); return (u + 0x7fffu + ((u >> 16) & 1u)) >> 16; }
DEV unsigned pk2(float lo, float hi) { return f2bf(lo) | (f2bf(hi) << 16); }
DEV float bflo(unsigned w) { return __builtin_bit_cast(float, w << 16); }
DEV float bfhi(unsigned w) { return __builtin_bit_cast(float, w & 0xffff0000u); }
DEV float fast_silu(float x) { return x * __builtin_amdgcn_rcpf(1.f + __builtin_amdgcn_exp2f(-1.4426950408889634f * x)); }

struct FP {
    const float* in[36];
    float* out;
    unsigned char* ws;
};

template <class RowMap>
DEV void transpose_item(const float* W, int K, int N, bf16_t* WT, int item, LAS float* scr, int lane, RowMap rm) {
    const int nblk = (N + 31) / 32, kb = item / nblk, nb = item % nblk, k0 = 64 * kb, n0 = 32 * nb;
    const int ncol = n0 + (lane & 31);
#pragma unroll 8
    for (int i = 0; i < 32; ++i) { const int kk = 2 * i + (lane >> 5); scr[kk * 33 + (lane & 31)] = (ncol < N) ? W[(size_t)(k0 + kk) * N + ncol] : 0.f; }
    WAVE_SYNC();
    const int c = lane & 7;
#pragma unroll
    for (int j = 0; j < 4; ++j) {
        const int n = (lane >> 3) + 8 * j; const LAS float* s = scr + (8 * c) * 33 + n;
        const int src = n0 + n; const int dst = (src < N) ? rm(src) : -1;
        u32x4 o; o.x = pk2(s[0 * 33], s[1 * 33]); o.y = pk2(s[2 * 33], s[3 * 33]); o.z = pk2(s[4 * 33], s[5 * 33]); o.w = pk2(s[6 * 33], s[7 * 33]);
        if (dst >= 0) *(u32x4*)(WT + (size_t)dst * K + k0 + 8 * c) = o;
    }
    WAVE_SYNC();
}
struct RmPlain { int off; __device__ __forceinline__ int operator()(int n) const { return off + n; } };
struct RmGU { int up; __device__ __forceinline__ int operator()(int n) const { return 32 * (n >> 4) + 16 * up + (n & 15); } };
struct RmIn {
    __device__ __forceinline__ int operator()(int n) const {
        if (n < 1536) return n;
        if (n < 1544) return -1;
        const int m = n - 1544;
        if (m < 1024) { const int u = m >> 6, d = m & 63; return 1536 + 64 * u + 32 * ((d & 31) >> 4) + 16 * (d >> 5) + (d & 15); }
        return 1536 + m;
    }
};

DEV void row_phase(const bf16_t* raw, const float* hin, const float* gpost, float* hout, const float* gpre, bf16_t* xn, int M, int gw, int ngw, int lane) {
    for (int r = gw; r < M; r += ngw) {
        f32x4 h[4];
#pragma unroll
        for (int j = 0; j < 4; ++j) h[j] = ((const f32x4*)(hin + (size_t)r * 1024))[lane + 64 * j];
        if (raw) {
            f32x4 v[4]; float ss = 0.f;
#pragma unroll
            for (int j = 0; j < 4; ++j) {
                const u32x2 w = ((const u32x2*)(raw + (size_t)r * 1024))[lane + 64 * j];
                v[j] = (f32x4){bflo(w.x), bfhi(w.x), bflo(w.y), bfhi(w.y)};
                ss += v[j].x * v[j].x + v[j].y * v[j].y + v[j].z * v[j].z + v[j].w * v[j].w;
            }
            const float rs = rsqrtf(wave_sum(ss) * (1.f / 1024.f) + 1e-6f);
#pragma unroll
            for (int j = 0; j < 4; ++j) { const f32x4 g = ((const f32x4*)gpost)[lane + 64 * j]; h[j] += v[j] * rs * g; }
        }
        if (hout) {
#pragma unroll
            for (int j = 0; j < 4; ++j) ((f32x4*)(hout + (size_t)r * 1024))[lane + 64 * j] = h[j];
        }
        if (gpre) {
            float ss = 0.f;
#pragma unroll
            for (int j = 0; j < 4; ++j) ss += h[j].x * h[j].x + h[j].y * h[j].y + h[j].z * h[j].z + h[j].w * h[j].w;
            const float rs = rsqrtf(wave_sum(ss) * (1.f / 1024.f) + 1e-6f);
#pragma unroll
            for (int j = 0; j < 4; ++j) {
                const f32x4 g = ((const f32x4*)gpre)[lane + 64 * j]; const f32x4 o = h[j] * rs * g;
                u32x2 w; w.x = pk2(o.x, o.y); w.y = pk2(o.z, o.w);
                ((u32x2*)(xn + (size_t)r * 1024))[lane + 64 * j] = w;
            }
        }
    }
}
namespace pg8 {
#define PG8_LAS __attribute__((address_space(3)))
typedef unsigned short bf16_t;
typedef short bf16x8 __attribute__((ext_vector_type(8)));
typedef float f32x4 __attribute__((ext_vector_type(4)));
typedef unsigned u32x4 __attribute__((ext_vector_type(4)));
constexpr int BM = 256, BK = 64, HALF = 128, HTB = HALF * BK * 2  , STAGE_BYTES = 8 * HTB, NXCD = 8, WGM = 8;

__host__ __device__ __forceinline__ int lds_byte(int r, int c) { const int st = (r >> 4) * 2 + (c >> 5), rr = r & 15, cc = c & 31, ob = rr * 64 + cc * 2; return st * 1024 + (ob ^ (((ob >> 9) & 1) << 5)); }
__host__ __device__ __forceinline__ void stage_rc(int b, int& R, int& C) { const int st = b / 1024, sb = b % 1024, swz = sb ^ (((sb >> 9) & 1) << 5); R = (st >> 1) * 16 + swz / 64; C = (st & 1) * 32 + (swz % 64) / 2; }
__host__ __device__ __forceinline__ int perm32(int rho) { const int n = rho >> 4, i = rho & 15; return 8 * (i >> 2) + 4 * n + (i & 3); }

struct Unit { int pm, pn; };
struct Gemm { const bf16_t* A; const bf16_t* Bt; int M, N, K; };

struct StaticOrder {
    int nM, nN, nwg, G, c;
    __host__ __device__ void init(int M, int N, int G_, int c_) { nM = M / BM; nN = N / BM; nwg = nM * nN; G = G_; c = c_; }
    __host__ __device__ bool next(int i, Unit& u) const {
        const long L = (long)i * G + c; if (L >= nwg) return false;
        int wgid = (int)L; { const int q = nwg / NXCD, r = nwg % NXCD, xcd = wgid % NXCD, off = wgid / NXCD; wgid = (xcd < r ? xcd * (q + 1) : r * (q + 1) + (xcd - r) * q) + off; }
        const int nig = WGM * nN, gid = wgid / nig, fm = gid * WGM, gsz = (nM - fm) < WGM ? (nM - fm) : WGM;
        u.pm = fm + ((wgid % nig) % gsz); u.pn = (wgid % nig) / gsz; return true;
    }
    __device__ __forceinline__ void a_ready(const Unit&) const {}
    __device__ __forceinline__ void done(const Unit&) const {}
};

__device__ __forceinline__ unsigned cvt_pk_bf16(float lo, float hi) { unsigned r; asm volatile("v_cvt_pk_bf16_f32 %0, %1, %2" : "=v"(r) : "v"(lo), "v"(hi)); return r; }
typedef float f32x2 __attribute__((ext_vector_type(2)));
__device__ __forceinline__ f32x2 gelu_pk(f32x2 v) {
    const f32x2 av = __builtin_elementwise_abs(v), d = av * 0.2316418882f + 1.0f;
    f32x2 t; t.x = __builtin_amdgcn_rcpf(d.x); t.y = __builtin_amdgcn_rcpf(d.y);
    f32x2 q = t * 0.5307027145f + (-0.7265760135f); q = q * t + 0.7107068705f; q = q * t + (-0.142248368f); q = q * t + 0.127414796f; q = q * t;
    const f32x2 s = (v * v) * (-0.72134752044f);
    f32x2 e; e.x = __builtin_amdgcn_exp2f(s.x); e.y = __builtin_amdgcn_exp2f(s.y);
    const f32x2 m = v * (q * e), r = v - m;
    f32x2 o; o.x = v.x < 0.f ? m.x : r.x; o.y = v.y < 0.f ? m.y : r.y; return o;
}

template <int ACT  > struct EpiBf16 {
    static constexpr bool PERM = true, AFTER_DRAIN = false; static_assert(ACT == 0 || ACT == 1, "EpiBf16: ACT is 0 (none) or 1 (gelu_pk)");
    bf16_t* O; int ldc; const float* bias; int split_cols; size_t split_stride; float scale0;
    __device__ __forceinline__ void operator()(const f32x4 (&acc)[2][2][4][2], const Unit& u, int wr, int wc, int fr, int fq) const {
        const int row0 = u.pm * BM + wr * 64 + fr; int colt = u.pn * BM; bf16_t* base = O;
        float sc = 1.f; if (split_cols) { const int t = colt / split_cols; base += (size_t)t * split_stride; colt -= t * split_cols; if (t == 0) sc = scale0; }
        const int col0 = colt + wc * 32 + 8 * fq, bcol0 = u.pn * BM + wc * 32 + 8 * fq;
        f32x4 bv[2][2];
#pragma unroll
        for (int bj = 0; bj < 2; ++bj)
#pragma unroll
            for (int n = 0; n < 2; ++n) bv[bj][n] = bias ? *(const f32x4*)(bias + bcol0 + bj * HALF + 4 * n) : (f32x4){0.f, 0.f, 0.f, 0.f};
#pragma unroll
        for (int ai = 0; ai < 2; ++ai)
#pragma unroll
            for (int m = 0; m < 4; ++m) { bf16_t* rowp = base + (size_t)(row0 + ai * HALF + m * 16) * ldc + col0;
#pragma unroll
                for (int bj = 0; bj < 2; ++bj) { f32x4 v0 = acc[ai][bj][m][0] + bv[bj][0], v1 = acc[ai][bj][m][1] + bv[bj][1];
                    if (ACT == 1) { f32x2 a = gelu_pk((f32x2){v0[0], v0[1]}), b = gelu_pk((f32x2){v0[2], v0[3]}), c = gelu_pk((f32x2){v1[0], v1[1]}), d = gelu_pk((f32x2){v1[2], v1[3]});
                        v0 = (f32x4){a.x, a.y, b.x, b.y}; v1 = (f32x4){c.x, c.y, d.x, d.y}; }
                    v0 = v0 * sc; v1 = v1 * sc; u32x4 w; w.x = cvt_pk_bf16(v0[0], v0[1]); w.y = cvt_pk_bf16(v0[2], v0[3]); w.z = cvt_pk_bf16(v1[0], v1[1]); w.w = cvt_pk_bf16(v1[2], v1[3]);
                    *(u32x4*)(rowp + bj * HALF) = w; } }
    }
};
template <class Epi, class Sched, bool ALIGN_EPI = false, bool SP2 = false>
__device__ __forceinline__ void gemm_phase(PG8_LAS unsigned char* lds, const Gemm g, const Sched& S, const Epi& E) {
    const int tid = threadIdx.x, wid = __builtin_amdgcn_readfirstlane(tid >> 6), lane = tid & 63, wr = wid >> 2, wc = wid & 3, fr = lane & 15, fq = lane >> 4;
    const int K = g.K, nt = K / BK;
    unsigned voffA[2], voffB[2];
#pragma unroll
    for (int i = 0; i < 2; ++i) { int R, C; stage_rc(tid * 16 + i * 8192, R, C); const int Rb = Epi::PERM ? ((R & ~31) + perm32(R & 31)) : R;
        voffA[i] = (unsigned)(R * K + C) * 2u; voffB[i] = (unsigned)(Rb * K + C) * 2u; }
    const size_t kstep = (size_t)(BK * 2);
    const size_t hstep = (size_t)HALF * K * 2;
    const size_t tstep = 2 * hstep;
    const unsigned ldsw = (unsigned)wid * 1024u;
    const int aoff = lds_byte(wr * 64 + fr, fq * 8), boff = lds_byte(wc * 32 + fr, fq * 8);
#define PG8_SA(b, h) (((b) * 2 + (h)) * HTB)
#define PG8_SB(b, h) ((4 + (b) * 2 + (h)) * HTB)
#define PG8_STAGE(bufoff, gbase, voff) do { _Pragma("unroll") for (int _i = 0; _i < 2; ++_i) \
        __builtin_amdgcn_global_load_lds((const unsigned*)((const char*)(gbase) + (voff)[_i]), (PG8_LAS unsigned*)(lds + (bufoff) + ldsw + _i * 8192), 16, 0, 0); } while (0)
#define PG8_LDA(dst, b, h) do { _Pragma("unroll") for (int m = 0; m < 4; ++m) _Pragma("unroll") for (int k = 0; k < 2; ++k) dst[m][k] = *(const PG8_LAS bf16x8*)(lds + PG8_SA(b, h) + aoff + m * 2048 + k * 1024); } while (0)
#define PG8_LDB(dst, b, h) do { _Pragma("unroll") for (int n = 0; n < 2; ++n) _Pragma("unroll") for (int k = 0; k < 2; ++k) dst[n][k] = *(const PG8_LAS bf16x8*)(lds + PG8_SB(b, h) + boff + n * 2048 + k * 1024); } while (0)
#define PG8_MMA(ai, bj, At, Bt) do { __builtin_amdgcn_s_setprio(1); _Pragma("unroll") for (int m = 0; m < 4; ++m) _Pragma("unroll") for (int n = 0; n < 2; ++n) _Pragma("unroll") for (int k = 0; k < 2; ++k) \
        acc[ai][bj][m][n] = __builtin_amdgcn_mfma_f32_16x16x32_bf16(Bt[n][k], At[m][k], acc[ai][bj][m][n], 0, 0, 0); __builtin_amdgcn_s_setprio(0); } while (0)
#define PG8_WAIT_V(n) asm volatile("s_waitcnt vmcnt(" #n ")" ::: "memory")
#define PG8_WAIT_L(n) asm volatile("s_waitcnt lgkmcnt(" #n ")" ::: "memory")
#define PG8_BAR __builtin_amdgcn_s_barrier()
#define PG8_SCHED __builtin_amdgcn_sched_barrier(0)
    Unit cur, nxt; int ui = 0;
    if (!S.next(0, cur)) return;
    f32x4 acc[2][2][4][2];
#pragma unroll
    for (int a = 0; a < 2; ++a)
#pragma unroll
        for (int b = 0; b < 2; ++b)
#pragma unroll
            for (int m = 0; m < 4; ++m)
#pragma unroll
                for (int n = 0; n < 2; ++n) acc[a][b][m][n] = (f32x4){0.f, 0.f, 0.f, 0.f};
    bf16x8 At[4][2], B0[2][2], B1[2][2];
    const char* cA = (const char*)g.A + (size_t)cur.pm * tstep; const char* cB = (const char*)g.Bt + (size_t)cur.pn * tstep;
    S.a_ready(cur);
    if constexpr (SP2) {
        PG8_STAGE(PG8_SB(0, 0), cB, voffB); PG8_STAGE(PG8_SB(0, 1), cB + hstep, voffB); PG8_STAGE(PG8_SA(0, 0), cA, voffA); PG8_STAGE(PG8_SA(0, 1), cA + hstep, voffA);
        if (wr == 1) PG8_BAR;
        PG8_WAIT_V(2); PG8_BAR;
        PG8_STAGE(PG8_SB(1, 0), cB + kstep, voffB); PG8_STAGE(PG8_SA(1, 0), cA + kstep, voffA); PG8_STAGE(PG8_SB(1, 1), cB + hstep + kstep, voffB);
        PG8_WAIT_V(6); PG8_BAR;
    } else {
        PG8_STAGE(PG8_SB(0, 0), cB, voffB); PG8_STAGE(PG8_SA(0, 0), cA, voffA); PG8_STAGE(PG8_SB(0, 1), cB + hstep, voffB); PG8_STAGE(PG8_SA(0, 1), cA + hstep, voffA);
        if (wr == 1) PG8_BAR;
        PG8_WAIT_V(4); PG8_BAR;
        PG8_STAGE(PG8_SB(1, 0), cB + kstep, voffB); PG8_STAGE(PG8_SA(1, 0), cA + kstep, voffA); PG8_STAGE(PG8_SB(1, 1), cB + hstep + kstep, voffB);
        PG8_WAIT_V(6); PG8_BAR;
    }
    for (;;) {
        const bool has_next = S.next(ui + 1, nxt);
        const char* nA = has_next ? (const char*)g.A + (size_t)nxt.pm * tstep : cA; const char* nB = has_next ? (const char*)g.Bt + (size_t)nxt.pn * tstep : cB;
        for (int t = 0; t < nt; t += 2) {
            const bool last = (t == nt - 2);
            const char* a1 = cA + (size_t)(t + 1) * kstep;
            const char* a2 = last ? nA : cA + (size_t)(t + 2) * kstep; const char* b2 = last ? nB : cB + (size_t)(t + 2) * kstep;
            const char* a3 = a2 + kstep; const char* b3 = b2 + kstep;
            if (last && has_next) S.a_ready(nxt);
            if constexpr (SP2) {
            PG8_LDB(B0, 0, 0); PG8_LDB(B1, 0, 1); PG8_SCHED; PG8_LDA(At, 0, 0); PG8_STAGE(PG8_SA(1, 1), a1 + hstep, voffA);
            PG8_WAIT_V(8); PG8_WAIT_L(0); PG8_BAR; PG8_MMA(0, 0, At, B0); PG8_MMA(0, 1, At, B1); PG8_BAR; PG8_SCHED;
            PG8_LDA(At, 0, 1); PG8_STAGE(PG8_SB(0, 0), b2, voffB); PG8_STAGE(PG8_SB(0, 1), b2 + hstep, voffB); PG8_STAGE(PG8_SA(0, 0), a2, voffA);
            PG8_WAIT_V(8); PG8_WAIT_L(0); PG8_BAR; PG8_MMA(1, 0, At, B0); PG8_MMA(1, 1, At, B1); PG8_BAR; PG8_SCHED;
            PG8_LDB(B0, 1, 0); PG8_LDB(B1, 1, 1); PG8_SCHED; PG8_LDA(At, 1, 0); PG8_STAGE(PG8_SA(0, 1), a2 + hstep, voffA);
            PG8_WAIT_V(8); PG8_WAIT_L(0); PG8_BAR; PG8_MMA(0, 0, At, B0); PG8_MMA(0, 1, At, B1); PG8_BAR; PG8_SCHED;
            PG8_LDA(At, 1, 1); PG8_STAGE(PG8_SB(1, 0), b3, voffB); PG8_STAGE(PG8_SB(1, 1), b3 + hstep, voffB); PG8_STAGE(PG8_SA(1, 0), a3, voffA);
            PG8_WAIT_V(8); PG8_WAIT_L(0); PG8_BAR; PG8_MMA(1, 0, At, B0); PG8_MMA(1, 1, At, B1); PG8_BAR; PG8_SCHED;
            } else {
            PG8_LDB(B0, 0, 0); PG8_SCHED; PG8_LDA(At, 0, 0); PG8_STAGE(PG8_SA(1, 1), a1 + hstep, voffA);
            PG8_WAIT_L(8); PG8_BAR; PG8_WAIT_L(0); PG8_MMA(0, 0, At, B0); PG8_BAR; PG8_SCHED;
            PG8_LDB(B1, 0, 1); PG8_STAGE(PG8_SB(0, 0), b2, voffB);
            PG8_BAR; PG8_WAIT_L(0); PG8_MMA(0, 1, At, B1); PG8_BAR;
            PG8_LDA(At, 0, 1); PG8_STAGE(PG8_SA(0, 0), a2, voffA);
            PG8_BAR; PG8_WAIT_L(0); PG8_MMA(1, 0, At, B0); PG8_BAR; PG8_SCHED;
            PG8_STAGE(PG8_SB(0, 1), b2 + hstep, voffB);
            PG8_WAIT_V(6); PG8_BAR; PG8_MMA(1, 1, At, B1); PG8_BAR;
            PG8_LDB(B0, 1, 0); PG8_SCHED; PG8_LDA(At, 1, 0); PG8_STAGE(PG8_SA(0, 1), a2 + hstep, voffA);
            PG8_WAIT_L(8); PG8_BAR; PG8_WAIT_L(0); PG8_MMA(0, 0, At, B0); PG8_BAR; PG8_SCHED;
            PG8_LDB(B1, 1, 1); PG8_STAGE(PG8_SB(1, 0), b3, voffB);
            PG8_BAR; PG8_WAIT_L(0); PG8_MMA(0, 1, At, B1); PG8_BAR;
            PG8_LDA(At, 1, 1); PG8_STAGE(PG8_SA(1, 0), a3, voffA);
            PG8_BAR; PG8_WAIT_L(0); PG8_MMA(1, 0, At, B0); PG8_BAR; PG8_SCHED;
            PG8_STAGE(PG8_SB(1, 1), b3 + hstep, voffB);
            PG8_WAIT_V(6); PG8_BAR; PG8_MMA(1, 1, At, B1); PG8_BAR;
            }
        }
        if constexpr (ALIGN_EPI) { if (wr == 0) PG8_BAR; }
        if constexpr (!Epi::AFTER_DRAIN) { E(acc, cur, wr, wc, fr, fq); S.done(cur); }
        if (!has_next) break;
#pragma unroll
        for (int a = 0; a < 2; ++a)
#pragma unroll
            for (int b = 0; b < 2; ++b)
#pragma unroll
                for (int m = 0; m < 4; ++m)
#pragma unroll
                    for (int n = 0; n < 2; ++n) acc[a][b][m][n] = (f32x4){0.f, 0.f, 0.f, 0.f};
        cur = nxt; cA = nA; cB = nB; ++ui;
        if constexpr (ALIGN_EPI) { if (wr == 1) PG8_BAR; }
    }
    PG8_WAIT_V(0);
    if constexpr (!ALIGN_EPI) { if (wr == 0) PG8_BAR; }
    PG8_BAR;
    if constexpr (Epi::AFTER_DRAIN) { E.fused(acc, cur, wr, wc, fr, fq, lds, wid, lane); S.done(cur); }
#undef PG8_SA
#undef PG8_SB
#undef PG8_STAGE
#undef PG8_LDA
#undef PG8_LDB
#undef PG8_MMA
#undef PG8_WAIT_V
#undef PG8_WAIT_L
#undef PG8_BAR
#undef PG8_SCHED
}
}

namespace pg8 {
struct EpiSwiglu {
    static constexpr bool PERM = false, AFTER_DRAIN = false;
    bf16_t* O; int ldo;
    __device__ __forceinline__ void operator()(const f32x4 (&acc)[2][2][4][2], const Unit& u, int wr, int wc, int fr, int fq) const {
        const int row0 = u.pm * BM + wr * 64 + fr;
#pragma unroll
        for (int ai = 0; ai < 2; ++ai)
#pragma unroll
            for (int m = 0; m < 4; ++m) {
                bf16_t* rowp = O + (size_t)(row0 + ai * HALF + m * 16) * ldo;
#pragma unroll
                for (int bj = 0; bj < 2; ++bj) {
                    const int grp = u.pn * 8 + bj * 4 + wc;
                    const f32x4 g = acc[ai][bj][m][0], up = acc[ai][bj][m][1];
                    const float h0 = fast_silu(g[0]) * up[0], h1 = fast_silu(g[1]) * up[1], h2 = fast_silu(g[2]) * up[2], h3 = fast_silu(g[3]) * up[3];
                    u32x2 w; w.x = cvt_pk_bf16(h0, h1); w.y = cvt_pk_bf16(h2, h3);
                    *(u32x2*)(rowp + grp * 16 + 4 * fq) = w;
                }
            }
    }
};
}

DEV void phase_prep_ffn(const FP& p, LAS unsigned char* lds, int gw, int ngw, int wave, int lane) {
    LAS float* scr = (LAS float*)(lds + wave * 16384);
    const float *wg = p.in[33], *wu = p.in[34], *wd = p.in[35];
    bf16_t* GU = (bf16_t*)(p.ws + WS_W_GU); bf16_t* DN = (bf16_t*)(p.ws + WS_W_DOWN);
    constexpr int I_G = 16 * 88, I_D = 44 * 32;
    for (int it = gw; it < 2 * I_G + I_D; it += ngw) {
        int r = it;
        if (r < I_G) { transpose_item(wg, 1024, 2816, GU, r, scr, lane, RmGU{0}); continue; } r -= I_G;
        if (r < I_G) { transpose_item(wu, 1024, 2816, GU, r, scr, lane, RmGU{1}); continue; } r -= I_G;
        transpose_item(wd, 2816, 1024, DN, r, scr, lane, RmPlain{0});
    }
}
DEV void phase_ffn_gu(const FP& p, LAS unsigned char* lds, int G, int bid) {
    pg8::Gemm g{(const bf16_t*)(p.ws + WS_XN), (const bf16_t*)(p.ws + WS_W_GU), MP, 5632, 1024};
    pg8::StaticOrder S; S.init(MP, 5632, G, bid);
    pg8::EpiSwiglu E{(bf16_t*)(p.ws + WS_HID), 2816};
    pg8::gemm_phase<pg8::EpiSwiglu, pg8::StaticOrder, true, true>(lds, g, S, E);
}
DEV void phase_ffn_down(const FP& p, LAS unsigned char* lds, int G, int bid) {
    pg8::Gemm g{(const bf16_t*)(p.ws + WS_HID), (const bf16_t*)(p.ws + WS_W_DOWN), MP, 1024, 2816};
    pg8::StaticOrder S; S.init(MP, 1024, G, bid);
    pg8::EpiBf16<0> E{(bf16_t*)(p.ws + WS_RAW), 1024, nullptr, 0, 0, 1.f};
    pg8::gemm_phase<pg8::EpiBf16<0>, pg8::StaticOrder, true, true>(lds, g, S, E);
}

typedef short v4i16_t __attribute__((ext_vector_type(4)));
typedef float f32x2_t __attribute__((ext_vector_type(2)));
typedef __bf16 bf16x2_t __attribute__((ext_vector_type(2)));
DEV unsigned cvtpk(float lo, float hi) { f32x2_t v = {lo, hi}; bf16x2_t b = __builtin_convertvector(v, bf16x2_t); return __builtin_bit_cast(unsigned, b); }
DEV f32x16 mfma32(bf16x8 a, bf16x8 b, f32x16 c) { return __builtin_amdgcn_mfma_f32_32x32x16_bf16(a, b, c, 0, 0, 0); }
DEV s16x4 tr_read(LAS const unsigned char* p) { return __builtin_bit_cast(s16x4, __builtin_amdgcn_ds_read_tr16_b64_v4i16((LAS v4i16_t*)p)); }
DEV bf16x8 cat8(s16x4 lo, s16x4 hi) { return (bf16x8){lo[0], lo[1], lo[2], lo[3], hi[0], hi[1], hi[2], hi[3]}; }
DEV float half_max(float v) { auto rr = __builtin_amdgcn_permlane32_swap(__float_as_uint(v), __float_as_uint(v), false, false); return fmaxf(__uint_as_float(rr[0]), __uint_as_float(rr[1])); }
DEV float half_sum(float v) { auto rr = __builtin_amdgcn_permlane32_swap(__float_as_uint(v), __float_as_uint(v), false, false); return __uint_as_float(rr[0]) + __uint_as_float(rr[1]); }
DEV bf16x8 pfrag(const f32x16& S, int s) {
    u32x4 w;
    if (s == 0) { w.x = cvtpk(S[0], S[1]); w.y = cvtpk(S[2], S[3]); w.z = cvtpk(S[4], S[5]); w.w = cvtpk(S[6], S[7]); }
    else { w.x = cvtpk(S[8], S[9]); w.y = cvtpk(S[10], S[11]); w.z = cvtpk(S[12], S[13]); w.w = cvtpk(S[14], S[15]); }
    return __builtin_bit_cast(bf16x8, w);
}
DEV float max16(const f32x16& S) {
    float a = fmaxf(fmaxf(S[0], S[1]), fmaxf(S[2], S[3])), b = fmaxf(fmaxf(S[4], S[5]), fmaxf(S[6], S[7]));
    float c = fmaxf(fmaxf(S[8], S[9]), fmaxf(S[10], S[11])), d = fmaxf(fmaxf(S[12], S[13]), fmaxf(S[14], S[15]));
    return fmaxf(fmaxf(a, b), fmaxf(c, d));
}

namespace pg8 {
struct EpiMemKV {
    static constexpr bool PERM = false, AFTER_DRAIN = false;
    float* ok; float* ov; bf16_t* bk; bf16_t* bv;
    __device__ __forceinline__ void operator()(const f32x4 (&acc)[2][2][4][2], const Unit& u, int wr, int wc, int fr, int fq) const {
        const int row0 = u.pm * BM + wr * 64 + fr; const bool isv = u.pn >= 4; const int colt = (u.pn & 3) * BM + wc * 32 + 4 * fq;
        float* of = isv ? ov : ok; bf16_t* ob = isv ? bv : bk;
#pragma unroll
        for (int ai = 0; ai < 2; ++ai)
#pragma unroll
            for (int m = 0; m < 4; ++m) {
                const size_t ro = (size_t)(row0 + ai * HALF + m * 16) * 1024;
#pragma unroll
                for (int bj = 0; bj < 2; ++bj)
#pragma unroll
                    for (int n = 0; n < 2; ++n) {
                        const f32x4 v = acc[ai][bj][m][n]; const int col = colt + bj * HALF + n * 16;
                        *(f32x4*)(of + ro + col) = v;
                        u32x2 w; w.x = cvt_pk_bf16(v[0], v[1]); w.y = cvt_pk_bf16(v[2], v[3]);
                        *(u32x2*)(ob + ro + col) = w;
                    }
            }
    }
};
}

DEV void phase_prep_x(const FP& p, LAS unsigned char* lds, int gw, int ngw, int wave, int lane) {
    LAS float* scr = (LAS float*)(lds + wave * 16384);
    constexpr int I_S = 16 * 32;
    for (int it = gw; it < 4 * I_S; it += ngw) {
        int r = it;
        if (r < I_S) { transpose_item(p.in[23], 1024, 1024, (bf16_t*)(p.ws + WS_W_Q), r, scr, lane, RmPlain{0}); continue; } r -= I_S;
        if (r < I_S) { transpose_item(p.in[24], 1024, 1024, (bf16_t*)(p.ws + WS_W_KV), r, scr, lane, RmPlain{0}); continue; } r -= I_S;
        if (r < I_S) { transpose_item(p.in[25], 1024, 1024, (bf16_t*)(p.ws + WS_W_KV), r, scr, lane, RmPlain{1024}); continue; } r -= I_S;
        transpose_item(p.in[26], 1024, 1024, (bf16_t*)(p.ws + WS_W_O), r, scr, lane, RmPlain{0});
    }
    row_phase(nullptr, p.in[8], nullptr, nullptr, p.in[22], (bf16_t*)(p.ws + WS_MN), 512, gw, ngw, lane);
}
DEV void phase_memkv(const FP& p, LAS unsigned char* lds, int G, int bid) {
    pg8::Gemm g{(const bf16_t*)(p.ws + WS_MN), (const bf16_t*)(p.ws + WS_W_KV), 512, 2048, 1024};
    pg8::StaticOrder S; S.init(512, 2048, G, bid);
    pg8::EpiMemKV E{p.out + 33822720, p.out + 34347008, (bf16_t*)(p.ws + WS_KM), (bf16_t*)(p.ws + WS_VM)};
    pg8::gemm_phase<pg8::EpiMemKV, pg8::StaticOrder, true, true>(lds, g, S, E);
}
DEV void phase_wq(const FP& p, LAS unsigned char* lds, int G, int bid) {
    pg8::Gemm g{(const bf16_t*)(p.ws + WS_XN), (const bf16_t*)(p.ws + WS_W_Q), MP, 1024, 1024};
    pg8::StaticOrder S; S.init(MP, 1024, G, bid);
    pg8::EpiBf16<0> E{(bf16_t*)(p.ws + WS_QX), 1024, nullptr, 1024, 0, 0.0625f * 1.4426950408889634f};
    pg8::gemm_phase<pg8::EpiBf16<0>, pg8::StaticOrder, true, true>(lds, g, S, E);
}
DEV void phase_wo(const FP& p, LAS unsigned char* lds, int G, int bid) {
    pg8::Gemm g{(const bf16_t*)(p.ws + WS_OX), (const bf16_t*)(p.ws + WS_W_O), MP, 1024, 1024};
    pg8::StaticOrder S; S.init(MP, 1024, G, bid);
    pg8::EpiBf16<0> E{(bf16_t*)(p.ws + WS_RAW), 1024, nullptr, 0, 0, 1.f};
    pg8::gemm_phase<pg8::EpiBf16<0>, pg8::StaticOrder, true, true>(lds, g, S, E);
}

DEV void phase_xattn(const FP& p, LAS unsigned char* lds, int G, int bid) {
    const int tid = threadIdx.x, lane = tid & 63, wave = __builtin_amdgcn_readfirstlane(tid >> 6), r = lane & 31, hh = lane >> 5, qb = wave & 3, eh = wave >> 2;
    const bf16_t* QX = (const bf16_t*)(p.ws + WS_QX); const bf16_t* KM = (const bf16_t*)(p.ws + WS_KM); const bf16_t* VM = (const bf16_t*)(p.ws + WS_VM);
    bf16_t* OX = (bf16_t*)(p.ws + WS_OX);
    constexpr int QOFF = 0, KOFF = 65536, VOFF = 98304;
    const int vlane = (4 * hh + ((lane & 15) >> 2)) * 64 + 32 * ((lane >> 4) & 1) + 8 * (lane & 3);
    for (int u = bid; u < 512; u += G) {
        const int bh = u & 7, b = bh >> 2, h = bh & 3, qblk = u >> 3;
        const size_t qrow0 = (size_t)b * 8192 + (size_t)qblk * 128;
#pragma unroll
        for (int j = 0; j < 8; ++j) {
            const int id = tid + 512 * j, row = id >> 5, ch = id & 31;
            const u32x4 v = *(const u32x4*)(QX + (qrow0 + row) * 1024 + h * 256 + ch * 8);
            *(LAS u32x4*)(lds + QOFF + row * 512 + ((ch ^ (row & 15)) << 4)) = v;
        }
        u32x4 kr[2], vr[2];
#pragma unroll
        for (int j = 0; j < 2; ++j) {
            const int id = tid + 512 * j, key = id >> 5, ch = id & 31;
            kr[j] = *(const u32x4*)(KM + ((size_t)b * 256 + key) * 1024 + h * 256 + ch * 8);
            vr[j] = *(const u32x4*)(VM + ((size_t)b * 256 + key) * 1024 + h * 256 + ch * 8);
        }
#pragma unroll
        for (int j = 0; j < 2; ++j) {
            const int id = tid + 512 * j, key = id >> 5, ch = id & 31;
            *(LAS u32x4*)(lds + KOFF + key * 512 + ((ch ^ (key & 15)) << 4)) = kr[j];
            *(LAS u32x4*)(lds + VOFF + (ch >> 2) * 2048 + key * 64 + (ch & 3) * 16) = vr[j];
        }
        __syncthreads();
        f32x16 O[4];
#pragma unroll
        for (int e = 0; e < 4; ++e)
#pragma unroll
            for (int i = 0; i < 16; ++i) O[e][i] = 0.f;
        float mrun = -1e30f, lsum = 0.f;
        const LAS unsigned char* qp = lds + QOFF + (32 * qb + r) * 512;
        for (int t = 0; t < 8; ++t) {
            const int buf = t & 1;
            if (t + 1 < 8) {
#pragma unroll
                for (int j = 0; j < 2; ++j) {
                    const int id = tid + 512 * j, key = id >> 5, ch = id & 31;
                    kr[j] = *(const u32x4*)(KM + ((size_t)b * 256 + 32 * (t + 1) + key) * 1024 + h * 256 + ch * 8);
                    vr[j] = *(const u32x4*)(VM + ((size_t)b * 256 + 32 * (t + 1) + key) * 1024 + h * 256 + ch * 8);
                }
            }
            const LAS unsigned char* kp = lds + KOFF + buf * 16384 + r * 512;
            const LAS unsigned char* vp = lds + VOFF + buf * 16384 + (4 * eh) * 2048 + vlane;
            f32x16 S;
#pragma unroll
            for (int i = 0; i < 16; ++i) S[i] = 0.f;
#pragma unroll
            for (int ks = 0; ks < 16; ++ks) {
                const int sl = ((2 * ks + hh) ^ (r & 15)) << 4;
                const bf16x8 a = *(const LAS bf16x8*)(kp + sl);
                const bf16x8 q = *(const LAS bf16x8*)(qp + sl);
                S = mfma32(a, q, S);
            }
            const float mx = half_max(max16(S));
            const float mnew = fmaxf(mrun, mx), alpha = __builtin_amdgcn_exp2f(mrun - mnew);
            mrun = mnew;
            float ps = 0.f;
#pragma unroll
            for (int i = 0; i < 16; ++i) { S[i] = __builtin_amdgcn_exp2f(S[i] - mnew); ps += S[i]; }
            lsum = lsum * alpha + ps;
#pragma unroll
            for (int e = 0; e < 4; ++e)
#pragma unroll
                for (int i = 0; i < 16; ++i) O[e][i] *= alpha;
            const bf16x8 P0 = pfrag(S, 0), P1 = pfrag(S, 1);
#pragma unroll
            for (int e = 0; e < 4; ++e) {
                const bf16x8 v0 = cat8(tr_read(vp + e * 2048), tr_read(vp + e * 2048 + 512));
                const bf16x8 v1 = cat8(tr_read(vp + e * 2048 + 1024), tr_read(vp + e * 2048 + 1536));
                O[e] = mfma32(v0, P0, O[e]);
                O[e] = mfma32(v1, P1, O[e]);
            }
            if (t + 1 < 8) {
#pragma unroll
                for (int j = 0; j < 2; ++j) {
                    const int id = tid + 512 * j, key = id >> 5, ch = id & 31;
                    *(LAS u32x4*)(lds + KOFF + (buf ^ 1) * 16384 + key * 512 + ((ch ^ (key & 15)) << 4)) = kr[j];
                    *(LAS u32x4*)(lds + VOFF + (buf ^ 1) * 16384 + (ch >> 2) * 2048 + key * 64 + (ch & 3) * 16) = vr[j];
                }
            }
            __syncthreads();
        }
        const float inv = 1.f / half_sum(lsum);
        LAS unsigned char* stg = lds + wave * 16384;
#pragma unroll
        for (int e = 0; e < 4; ++e)
#pragma unroll
            for (int g4 = 0; g4 < 4; ++g4) {
                u32x2 w; w.x = cvtpk(O[e][4 * g4 + 0] * inv, O[e][4 * g4 + 1] * inv); w.y = cvtpk(O[e][4 * g4 + 2] * inv, O[e][4 * g4 + 3] * inv);
                *(LAS u32x2*)(stg + r * 272 + (32 * e + 8 * g4 + 4 * hh) * 2) = w;
            }
        WAVE_SYNC();
#pragma unroll
        for (int i = 0; i < 8; ++i) {
            const int row = i * 4 + (lane >> 4), ch = lane & 15;
            const u32x4 v = *(const LAS u32x4*)(stg + row * 272 + ch * 16);
            *(u32x4*)(OX + (qrow0 + 32 * qb + row) * 1024 + h * 256 + 128 * eh + ch * 8) = v;
        }
        __syncthreads();
    }
}

constexpr float QSCALE = 0.125f * 1.4426950408889634f;
namespace pg8 {
struct EpiIn {
    static constexpr bool PERM = false, AFTER_DRAIN = false;
    bf16_t* ZX; bf16_t* Qb; bf16_t* Kb; bf16_t* Vb; float* okf; float* ovf; float* oconv;
    __device__ __forceinline__ void operator()(const f32x4 (&acc)[2][2][4][2], const Unit& u, int wr, int wc, int fr, int fq) const {
        const int row0 = u.pm * BM + wr * 64 + fr, pn = u.pn;
        if (pn < 6) {
#pragma unroll
            for (int ai = 0; ai < 2; ++ai)
#pragma unroll
                for (int m = 0; m < 4; ++m) {
                    const int row = row0 + ai * HALF + m * 16; const int t = row & 8191;
#pragma unroll
                    for (int bj = 0; bj < 2; ++bj)
#pragma unroll
                        for (int n = 0; n < 2; ++n) {
                            const f32x4 v = acc[ai][bj][m][n]; const int col = pn * BM + bj * HALF + wc * 32 + n * 16 + 4 * fq;
                            u32x2 w; w.x = cvt_pk_bf16(v[0], v[1]); w.y = cvt_pk_bf16(v[2], v[3]);
                            *(u32x2*)(ZX + (size_t)row * 1536 + col) = w;
                            if (pn >= 2 && t >= 8189) *(f32x4*)(oconv + (size_t)((row >> 13) * 3 + (t - 8189)) * 1024 + (col - 512)) = v;
                        }
                }
        } else if (pn < 10) {
            const bool isk = pn >= 8;
            const int g = wc & 1;
            float inv[4];
#pragma unroll
            for (int i = 0; i < 4; ++i) inv[i] = __builtin_amdgcn_exp2f(-(float)(16 * g + 4 * fq + i) * (13.287712379549449f / 32.f)) * 0.15915494309189535f;
#pragma unroll
            for (int ai = 0; ai < 2; ++ai)
#pragma unroll
                for (int m = 0; m < 4; ++m) {
                    const int row = row0 + ai * HALF + m * 16; const float pos = (float)(row & 8191);
                    float cs[4], sn[4];
#pragma unroll
                    for (int i = 0; i < 4; ++i) { float rev = pos * inv[i]; rev -= floorf(rev); sn[i] = __builtin_amdgcn_sinf(rev); cs[i] = __builtin_amdgcn_cosf(rev); }
#pragma unroll
                    for (int bj = 0; bj < 2; ++bj) {
                        const int cl = (pn & 1) * BM + bj * HALF + wc * 32;
                        const f32x4 x1 = acc[ai][bj][m][0], x2 = acc[ai][bj][m][1];
                        f32x4 o1, o2;
#pragma unroll
                        for (int i = 0; i < 4; ++i) { o1[i] = x1[i] * cs[i] - x2[i] * sn[i]; o2[i] = x2[i] * cs[i] + x1[i] * sn[i]; }
                        if (isk) {
                            float* kf = okf + (size_t)row * 512 + (cl >> 6) * 64 + 16 * g + 4 * fq;
                            *(f32x4*)kf = o1; *(f32x4*)(kf + 32) = o2;
                            u32x2 w; w.x = cvt_pk_bf16(o1[0], o1[1]); w.y = cvt_pk_bf16(o1[2], o1[3]);
                            *(u32x2*)(Kb + (size_t)row * 512 + cl + 4 * fq) = w;
                            w.x = cvt_pk_bf16(o2[0], o2[1]); w.y = cvt_pk_bf16(o2[2], o2[3]);
                            *(u32x2*)(Kb + (size_t)row * 512 + cl + 16 + 4 * fq) = w;
                        } else {
                            o1 = o1 * QSCALE; o2 = o2 * QSCALE;
                            u32x2 w; w.x = cvt_pk_bf16(o1[0], o1[1]); w.y = cvt_pk_bf16(o1[2], o1[3]);
                            *(u32x2*)(Qb + (size_t)row * 512 + cl + 4 * fq) = w;
                            w.x = cvt_pk_bf16(o2[0], o2[1]); w.y = cvt_pk_bf16(o2[2], o2[3]);
                            *(u32x2*)(Qb + (size_t)row * 512 + cl + 16 + 4 * fq) = w;
                        }
                    }
                }
        } else {
#pragma unroll
            for (int ai = 0; ai < 2; ++ai)
#pragma unroll
                for (int m = 0; m < 4; ++m) {
                    const int row = row0 + ai * HALF + m * 16;
#pragma unroll
                    for (int bj = 0; bj < 2; ++bj)
#pragma unroll
                        for (int n = 0; n < 2; ++n) {
                            const f32x4 v = acc[ai][bj][m][n]; const int col = (pn - 10) * BM + bj * HALF + wc * 32 + n * 16 + 4 * fq;
                            *(f32x4*)(ovf + (size_t)row * 512 + col) = v;
                            u32x2 w; w.x = cvt_pk_bf16(v[0], v[1]); w.y = cvt_pk_bf16(v[2], v[3]);
                            *(u32x2*)(Vb + (size_t)row * 512 + col) = w;
                        }
                }
        }
    }
};
}

DEV void phase_prep_mix(const FP& p, LAS unsigned char* lds, int gw, int ngw, int wave, int lane) {
    LAS float* scr = (LAS float*)(lds + wave * 16384);
    constexpr int I_IN = 16 * 97, I_OUT = 16 * 32;
    for (int it = gw; it < I_IN + I_OUT; it += ngw) {
        if (it < I_IN) transpose_item(p.in[9], 1024, 3080, (bf16_t*)(p.ws + WS_W_IN), it, scr, lane, RmIn{});
        else transpose_item(p.in[21], 1024, 1024, (bf16_t*)(p.ws + WS_W_OUT), it - I_IN, scr, lane, RmPlain{0});
    }
    __syncthreads();
    LAS float* wdt = (LAS float*)lds;
    for (int i = threadIdx.x; i < 8192; i += 512) wdt[i] = p.in[9][(size_t)(i >> 3) * 3080 + 1536 + (i & 7)];
    __syncthreads();
    const float* x = p.in[0]; const float* g = p.in[27]; bf16_t* xn = (bf16_t*)(p.ws + WS_XN); float* dtv = (float*)(p.ws + WS_DTV);
    const float bias = p.in[12][lane & 7];
    for (int r = gw; r < MP; r += ngw) {
        f32x4 h[4]; float ss = 0.f;
#pragma unroll
        for (int j = 0; j < 4; ++j) { h[j] = ((const f32x4*)(x + (size_t)r * 1024))[lane + 64 * j]; ss += h[j].x * h[j].x + h[j].y * h[j].y + h[j].z * h[j].z + h[j].w * h[j].w; }
        const float rs = rsqrtf(wave_sum(ss) * (1.f / 1024.f) + 1e-6f);
        float d[8];
#pragma unroll
        for (int k = 0; k < 8; ++k) d[k] = 0.f;
#pragma unroll
        for (int j = 0; j < 4; ++j) {
            const f32x4 gg = ((const f32x4*)g)[lane + 64 * j]; h[j] = h[j] * rs * gg;
            u32x2 w; w.x = pk2(h[j].x, h[j].y); w.y = pk2(h[j].z, h[j].w);
            ((u32x2*)(xn + (size_t)r * 1024))[lane + 64 * j] = w;
#pragma unroll
            for (int i = 0; i < 4; ++i) {
                const LAS f32x4* wp = (const LAS f32x4*)(wdt + (4 * (lane + 64 * j) + i) * 8);
                const f32x4 w0 = wp[0], w1 = wp[1]; const float hv = h[j][i];
                d[0] += hv * w0.x; d[1] += hv * w0.y; d[2] += hv * w0.z; d[3] += hv * w0.w; d[4] += hv * w1.x; d[5] += hv * w1.y; d[6] += hv * w1.z; d[7] += hv * w1.w;
            }
        }
#pragma unroll
        for (int k = 0; k < 8; ++k) d[k] = wave_sum(d[k]);
        float mine = d[0];
#pragma unroll
        for (int k = 1; k < 8; ++k) mine = ((lane & 7) == k) ? d[k] : mine;
        const float xx = mine + bias;
        if (lane < 8) dtv[(size_t)r * 8 + lane] = (xx > 20.f) ? xx : log1pf(expf(xx));
    }
    __syncthreads();
}
DEV void phase_inproj(const FP& p, LAS unsigned char* lds, int G, int bid) {
    pg8::Gemm g{(const bf16_t*)(p.ws + WS_XN), (const bf16_t*)(p.ws + WS_W_IN), MP, 3072, 1024};
    pg8::StaticOrder S; S.init(MP, 3072, G, bid);
    pg8::EpiIn E{(bf16_t*)(p.ws + WS_ZX), (bf16_t*)(p.ws + WS_Q), (bf16_t*)(p.ws + WS_K), (bf16_t*)(p.ws + WS_V), p.out + 16908288, p.out + 25296896, p.out + 33816576};
    pg8::gemm_phase<pg8::EpiIn, pg8::StaticOrder, true, true>(lds, g, S, E);
}
DEV void phase_outproj(const FP& p, LAS unsigned char* lds, int G, int bid) {
    pg8::Gemm g{(const bf16_t*)(p.ws + WS_CAT), (const bf16_t*)(p.ws + WS_W_OUT), MP, 1024, 1024};
    pg8::StaticOrder S; S.init(MP, 1024, G, bid);
    pg8::EpiBf16<0> E{(bf16_t*)(p.ws + WS_RAW), 1024, nullptr, 0, 0, 1.f};
    pg8::gemm_phase<pg8::EpiBf16<0>, pg8::StaticOrder, true, true>(lds, g, S, E);
}

DEV float ssd_tables(const FP& p, LAS float* tdt, LAS float* tac, size_t row0, int h, int lane) {
    const float dt = ((const float*)(p.ws + WS_DTV))[(row0 + lane) * 8 + h];
    const float a = -expf(p.in[13][h]);
    float v = dt * a;
#pragma unroll
    for (int o = 1; o < 64; o <<= 1) { const float t = __shfl_up(v, o); if (lane >= o) v += t; }
    tdt[lane * 8 + h] = dt; tac[lane * 8 + h] = v;
    return __shfl(v, 63);
}
template <class F> DEV void ssd_conv8(const FP& p, size_t row0, int col0, int l0, F emit) {
    const bf16_t* ZX = (const bf16_t*)(p.ws + WS_ZX);
    const float* cw = p.in[10]; const float* cb = p.in[11];
    f32x4 w[4][2], bias[2];
#pragma unroll
    for (int j = 0; j < 4; ++j) { w[j][0] = *(const f32x4*)(cw + j * 1024 + col0); w[j][1] = *(const f32x4*)(cw + j * 1024 + col0 + 4); }
    bias[0] = *(const f32x4*)(cb + col0); bias[1] = *(const f32x4*)(cb + col0 + 4);
    const int t0 = (int)(row0 & 8191);
    f32x4 u[4][2];
#pragma unroll
    for (int j = 0; j < 3; ++j) {
        const int l = l0 - 3 + j;
        if (t0 + l >= 0) {
            const u32x4 r = *(const u32x4*)(ZX + (row0 + l) * 1536 + 512 + col0);
            u[j][0] = (f32x4){bflo(r.x), bfhi(r.x), bflo(r.y), bfhi(r.y)}; u[j][1] = (f32x4){bflo(r.z), bfhi(r.z), bflo(r.w), bfhi(r.w)};
        } else { u[j][0] = (f32x4){0.f, 0.f, 0.f, 0.f}; u[j][1] = u[j][0]; }
    }
#pragma unroll
    for (int i = 0; i < 16; ++i) {
        const int l = l0 + i;
        const u32x4 r = *(const u32x4*)(ZX + (row0 + l) * 1536 + 512 + col0);
        u[3][0] = (f32x4){bflo(r.x), bfhi(r.x), bflo(r.y), bfhi(r.y)}; u[3][1] = (f32x4){bflo(r.z), bfhi(r.z), bflo(r.w), bfhi(r.w)};
        f32x4 a0 = bias[0] + w[0][0] * u[0][0] + w[1][0] * u[1][0] + w[2][0] * u[2][0] + w[3][0] * u[3][0];
        f32x4 a1 = bias[1] + w[0][1] * u[0][1] + w[1][1] * u[1][1] + w[2][1] * u[2][1] + w[3][1] * u[3][1];
#pragma unroll
        for (int k = 0; k < 4; ++k) { a0[k] = fast_silu(a0[k]); a1[k] = fast_silu(a1[k]); }
        emit(l, a0, a1);
        u[0][0] = u[1][0]; u[0][1] = u[1][1]; u[1][0] = u[2][0]; u[1][1] = u[2][1]; u[2][0] = u[3][0]; u[2][1] = u[3][1];
    }
}
constexpr int S_XS = 0, S_B = 65536, S_C = 98304, S_TDT = 131072, S_TAC = 133120, S_SSQ = 135168;
DEV int trlane(int lane) { return ((lane & 15) >> 2) * 64 + 32 * ((lane >> 4) & 1) + 8 * (lane & 3); }

DEV void phase_ssd1(const FP& p, LAS unsigned char* lds, int G, int bid) {
    const int tid = threadIdx.x, lane = tid & 63, wave = __builtin_amdgcn_readfirstlane(tid >> 6), hh = lane >> 5;
    LAS float* tdt = (LAS float*)(lds + S_TDT); LAS float* tac = (LAS float*)(lds + S_TAC);
    bf16_t* ST = (bf16_t*)(p.ws + WS_ST); float* cdec = (float*)(p.ws + WS_CDEC);
    for (int u = bid; u < 256; u += G) {
        const int b = u >> 7, c = u & 127; const size_t row0 = (size_t)b * 8192 + (size_t)c * 64;
        const float tot = ssd_tables(p, tdt, tac, row0, wave, lane);
        if (lane == 0) cdec[u * 8 + wave] = expf(tot);
        __syncthreads();
        { const int i = tid; const float t63 = tac[63 * 8 + (i & 7)]; const float s = tdt[i] * expf(t63 - tac[i]); __syncthreads(); tdt[i] = s; }
        __syncthreads();
        if (tid < 384) {
            const int cg = tid >> 2, tq = tid & 3, col0 = cg * 8;
            ssd_conv8(p, row0, col0, tq * 16, [&](int l, f32x4 a0, f32x4 a1) {
                u32x4 w;
                if (cg < 64) {
                    const int h = cg >> 3, pp = col0 & 63; const float s = tdt[l * 8 + h];
                    a0 = a0 * s; a1 = a1 * s;
                    w.x = pk2(a0[0], a0[1]); w.y = pk2(a0[2], a0[3]); w.z = pk2(a1[0], a1[1]); w.w = pk2(a1[2], a1[3]);
                    *(LAS u32x4*)(lds + S_XS + h * 8192 + (pp >> 5) * 4096 + l * 64 + (pp & 31) * 2) = w;
                } else {
                    const int n = col0 - 512, g = n >> 7, nn = n & 127;
                    w.x = pk2(a0[0], a0[1]); w.y = pk2(a0[2], a0[3]); w.z = pk2(a1[0], a1[1]); w.w = pk2(a1[2], a1[3]);
                    *(LAS u32x4*)(lds + S_B + g * 16384 + (nn >> 5) * 4096 + l * 64 + (nn & 31) * 2) = w;
                }
            });
        }
        __syncthreads();
        const int h = wave, g = h >> 2;
        f32x16 acc[2][4];
#pragma unroll
        for (int a = 0; a < 2; ++a)
#pragma unroll
            for (int n = 0; n < 4; ++n)
#pragma unroll
                for (int i = 0; i < 16; ++i) acc[a][n][i] = 0.f;
        const LAS unsigned char* xa = lds + S_XS + h * 8192 + hh * 512 + trlane(lane);
        const LAS unsigned char* ba = lds + S_B + g * 16384 + hh * 512 + trlane(lane);
#pragma unroll
        for (int s = 0; s < 4; ++s) {
            bf16x8 af[2], bfr[4];
#pragma unroll
            for (int a = 0; a < 2; ++a) af[a] = cat8(tr_read(xa + a * 4096 + s * 1024), tr_read(xa + a * 4096 + s * 1024 + 256));
#pragma unroll
            for (int n = 0; n < 4; ++n) bfr[n] = cat8(tr_read(ba + n * 4096 + s * 1024), tr_read(ba + n * 4096 + s * 1024 + 256));
#pragma unroll
            for (int a = 0; a < 2; ++a)
#pragma unroll
                for (int n = 0; n < 4; ++n) acc[a][n] = mfma32(af[a], bfr[n], acc[a][n]);
        }
        bf16_t* sp = ST + ((size_t)u * 8 + h) * 8192;
#pragma unroll
        for (int a = 0; a < 2; ++a)
#pragma unroll
            for (int n = 0; n < 4; ++n)
#pragma unroll
                for (int i = 0; i < 16; ++i) {
                    const int pr = 32 * a + (i & 3) + 8 * (i >> 2) + 4 * hh;
                    sp[pr * 128 + 32 * n + (lane & 31)] = (bf16_t)f2bf(acc[a][n][i]);
                }
        __syncthreads();
    }
}

DEV void phase_ssd2(const FP& p, int G, int bid) {
    const int tid = threadIdx.x;
    unsigned* ST = (unsigned*)(p.ws + WS_ST); const float* cdec = (const float*)(p.ws + WS_CDEC); float* pssm = p.out + 33685504;
    for (int blk = bid; blk < 128; blk += G) {
        const int idx = blk * 512 + tid;
        const int n2 = idx & 63, pr = (idx >> 6) & 63, h = (idx >> 12) & 7, b = idx >> 15;
        float s0 = 0.f, s1 = 0.f;
        for (int c0 = 0; c0 < 128; c0 += 16) {
            unsigned v[16];
#pragma unroll
            for (int j = 0; j < 16; ++j) v[j] = ST[(((size_t)(b * 128 + c0 + j) * 8 + h) * 64 + pr) * 64 + n2];
#pragma unroll
            for (int j = 0; j < 16; ++j) {
                const float dc = cdec[(b * 128 + c0 + j) * 8 + h];
                ST[(((size_t)(b * 128 + c0 + j) * 8 + h) * 64 + pr) * 64 + n2] = pk2(s0, s1);
                s0 = s0 * dc + bflo(v[j]); s1 = s1 * dc + bfhi(v[j]);
            }
        }
        float2 o; o.x = s0; o.y = s1;
        ((float2*)pssm)[(((size_t)b * 8 + h) * 64 + pr) * 64 + n2] = o;
    }
}

DEV void phase_ssd3(const FP& p, LAS unsigned char* lds, int G, int bid) {
    LAS float* tdt = (LAS float*)(lds + S_TDT); LAS float* tac = (LAS float*)(lds + S_TAC); LAS float* ssq = (LAS float*)(lds + S_SSQ);
    const bf16_t* ST = (const bf16_t*)(p.ws + WS_ST); const bf16_t* ZX = (const bf16_t*)(p.ws + WS_ZX); bf16_t* CAT = (bf16_t*)(p.ws + WS_CAT);
    for (int u = bid; u < 256; u += G) {
        int tid = threadIdx.x; asm volatile("" : "+v"(tid));
        const int lane = tid & 63, wave = __builtin_amdgcn_readfirstlane(tid >> 6), r = lane & 31, hh = lane >> 5;
        const int b = u >> 7, c = u & 127; const size_t row0 = (size_t)b * 8192 + (size_t)c * 64;
        (void)ssd_tables(p, tdt, tac, row0, wave, lane);
        {
            const int cg = tid >> 2, tq = tid & 3, col0 = cg * 8;
            ssd_conv8(p, row0, col0, tq * 16, [&](int l, f32x4 a0, f32x4 a1) {
                u32x4 w; w.x = pk2(a0[0], a0[1]); w.y = pk2(a0[2], a0[3]); w.z = pk2(a1[0], a1[1]); w.w = pk2(a1[2], a1[3]);
                if (cg < 64) {
                    const int h = cg >> 3, pp = col0 & 63;
                    *(LAS u32x4*)(lds + S_XS + h * 8192 + (pp >> 5) * 4096 + l * 64 + (pp & 31) * 2) = w;
                } else {
                    const int n = (col0 - 512) & 255, g = n >> 7, ch = (n & 127) >> 3;
                    *(LAS u32x4*)(lds + (col0 < 768 ? S_B : S_C) + g * 16384 + l * 256 + ((ch ^ (l & 15)) << 4)) = w;
                }
            });
        }
        __syncthreads();
        const int h = wave, g = h >> 2;
        f32x16 Y[2][2];
#pragma unroll
        for (int a = 0; a < 2; ++a)
#pragma unroll
            for (int l2 = 0; l2 < 2; ++l2)
#pragma unroll
                for (int i = 0; i < 16; ++i) Y[a][l2][i] = 0.f;
        const LAS unsigned char* cp = lds + S_C + g * 16384 + r * 256;
        const LAS unsigned char* bp = lds + S_B + g * 16384 + r * 256;
        const bf16_t* pv = ST + ((size_t)u * 8 + h) * 8192 + (size_t)r * 128 + 8 * hh;
#pragma unroll 2
        for (int ks = 0; ks < 8; ++ks) {
            const int sl = ((2 * ks + hh) ^ (r & 15)) << 4;
            const bf16x8 c0 = *(const LAS bf16x8*)(cp + sl), c1 = *(const LAS bf16x8*)(cp + 32 * 256 + sl);
            const bf16x8 p0 = *(const bf16x8*)(pv + 16 * ks), p1 = *(const bf16x8*)(pv + 32 * 128 + 16 * ks);
            Y[0][0] = mfma32(p0, c0, Y[0][0]); Y[0][1] = mfma32(p0, c1, Y[0][1]);
            Y[1][0] = mfma32(p1, c0, Y[1][0]); Y[1][1] = mfma32(p1, c1, Y[1][1]);
        }
        float acl[2];
#pragma unroll
        for (int l2 = 0; l2 < 2; ++l2) {
            acl[l2] = tac[(32 * l2 + r) * 8 + h]; const float e = expf(acl[l2]);
#pragma unroll
            for (int a = 0; a < 2; ++a)
#pragma unroll
                for (int i = 0; i < 16; ++i) Y[a][l2][i] *= e;
        }
        __builtin_amdgcn_sched_barrier(0);
        const LAS unsigned char* xa = lds + S_XS + h * 8192 + hh * 256 + trlane(lane);
#pragma unroll
        for (int lb = 0; lb < 2; ++lb)
#pragma unroll
            for (int sb = 0; sb <= lb; ++sb) {
                f32x16 T;
#pragma unroll
                for (int i = 0; i < 16; ++i) T[i] = 0.f;
#pragma unroll 2
                for (int ks = 0; ks < 8; ++ks) {
                    const int sl = ((2 * ks + hh) ^ (r & 15)) << 4;
                    const bf16x8 bb = *(const LAS bf16x8*)(bp + sb * 32 * 256 + sl), cc = *(const LAS bf16x8*)(cp + lb * 32 * 256 + sl);
                    T = mfma32(bb, cc, T);
                }
#pragma unroll
                for (int i = 0; i < 16; ++i) {
                    const int s = 32 * sb + (i & 3) + 8 * (i >> 2) + 4 * hh;
                    const float f = tdt[s * 8 + h] * __builtin_amdgcn_exp2f(1.4426950408889634f * fminf(acl[lb] - tac[s * 8 + h], 0.f));
                    T[i] = (s <= 32 * lb + r) ? T[i] * f : 0.f;
                }
                const bf16x8 P0 = pfrag(T, 0), P1 = pfrag(T, 1);
#pragma unroll
                for (int a = 0; a < 2; ++a) {
                    const bf16x8 x0 = cat8(tr_read(xa + a * 4096 + (2 * sb) * 1024), tr_read(xa + a * 4096 + (2 * sb) * 1024 + 512));
                    const bf16x8 x1 = cat8(tr_read(xa + a * 4096 + (2 * sb + 1) * 1024), tr_read(xa + a * 4096 + (2 * sb + 1) * 1024 + 512));
                    Y[a][lb] = mfma32(x0, P0, Y[a][lb]);
                    Y[a][lb] = mfma32(x1, P1, Y[a][lb]);
                }
            }
        __builtin_amdgcn_sched_barrier(0);
        const float Dh = p.in[14][h];
        float sq[2] = {0.f, 0.f};
#pragma unroll
        for (int a = 0; a < 2; ++a)
#pragma unroll
            for (int l2 = 0; l2 < 2; ++l2) {
                const int l = 32 * l2 + r;
#pragma unroll
                for (int g4 = 0; g4 < 4; ++g4) {
                    const int pp = 8 * g4 + 4 * hh;
                    const u32x2 xw = *(const LAS u32x2*)(lds + S_XS + h * 8192 + a * 4096 + l * 64 + pp * 2);
                    const u32x2 zw = *(const u32x2*)(ZX + (row0 + l) * 1536 + h * 64 + 32 * a + pp);
                    const float xv[4] = {bflo(xw.x), bfhi(xw.x), bflo(xw.y), bfhi(xw.y)}, zv[4] = {bflo(zw.x), bfhi(zw.x), bflo(zw.y), bfhi(zw.y)};
#pragma unroll
                    for (int i = 0; i < 4; ++i) { const float v = (Y[a][l2][4 * g4 + i] + Dh * xv[i]) * fast_silu(zv[i]); Y[a][l2][4 * g4 + i] = v; sq[l2] += v * v; }
                }
            }
#pragma unroll
        for (int l2 = 0; l2 < 2; ++l2) { sq[l2] = half_sum(sq[l2]); if (hh == 0) ssq[(h * 2 + l2) * 32 + r] = sq[l2]; }
        __syncthreads();
        float rs[2];
#pragma unroll
        for (int l2 = 0; l2 < 2; ++l2) {
            float t = 0.f;
#pragma unroll
            for (int k = 0; k < 4; ++k) t += ssq[((4 * g + k) * 2 + l2) * 32 + r];
            rs[l2] = rsqrtf(t * (1.f / 256.f) + 1e-5f);
        }
#pragma unroll
        for (int a = 0; a < 2; ++a)
#pragma unroll
            for (int g4 = 0; g4 < 4; ++g4) {
                const int pcol = h * 64 + 32 * a + 8 * g4 + 4 * hh;
                const f32x4 w = *(const f32x4*)(p.in[15] + pcol);
#pragma unroll
                for (int l2 = 0; l2 < 2; ++l2) {
                    u32x2 o; o.x = cvtpk(Y[a][l2][4 * g4 + 0] * rs[l2] * w[0], Y[a][l2][4 * g4 + 1] * rs[l2] * w[1]);
                    o.y = cvtpk(Y[a][l2][4 * g4 + 2] * rs[l2] * w[2], Y[a][l2][4 * g4 + 3] * rs[l2] * w[3]);
                    *(u32x2*)(CAT + (row0 + 32 * l2 + r) * 1024 + pcol) = o;
                }
            }
        __syncthreads();
    }
}

DEV void phase_attn(const FP& p, LAS unsigned char* lds, int G, int bid) {
    const int tid = threadIdx.x, lane = tid & 63, wave = __builtin_amdgcn_readfirstlane(tid >> 6), r = lane & 31, hh = lane >> 5, qb = wave & 3, c = wave >> 2;
    const bf16_t* Qg = (const bf16_t*)(p.ws + WS_Q); const bf16_t* Kg = (const bf16_t*)(p.ws + WS_K); const bf16_t* Vg = (const bf16_t*)(p.ws + WS_V);
    bf16_t* CAT = (bf16_t*)(p.ws + WS_CAT);
    const float lam_init = 0.2f;
    const float lam = expf(wave_sum(p.in[16][lane] * p.in[17][lane])) - expf(wave_sum(p.in[18][lane] * p.in[19][lane])) + lam_init;
    LAS float* subw = (LAS float*)(lds + 131072);
    if (tid < 128) subw[tid] = p.in[20][tid];
    const int vlane = (4 * hh) * 64 + trlane(lane);
    for (int pu = bid; pu < 256; pu += G) {
        const int bh = pu & 7, b = bh >> 2, h = bh & 3, pr = pu >> 3;
        for (int half = 0; half < 2; ++half) {
            const int jq = half ? 63 - pr : pr;
            const size_t rowb = (size_t)b * 8192; const int q0 = jq * 128;
            const int ntb = 2 * jq + 2, myn = 2 * jq + (qb >> 1) + 1;
            bf16x8 qf[4];
#pragma unroll
            for (int ks = 0; ks < 4; ++ks) qf[ks] = *(const bf16x8*)(Qg + (rowb + q0 + 32 * qb + r) * 512 + h * 128 + c * 64 + 16 * ks + 8 * hh);
            u32x4 kr[2], vr[2];
#pragma unroll
            for (int j = 0; j < 2; ++j) {
                const int id = tid + 512 * j, key = id >> 4, ch = id & 15;
                kr[j] = *(const u32x4*)(Kg + (rowb + key) * 512 + h * 128 + ch * 8);
                vr[j] = *(const u32x4*)(Vg + (rowb + key) * 512 + h * 128 + ch * 8);
            }
#pragma unroll
            for (int j = 0; j < 2; ++j) {
                const int id = tid + 512 * j, key = id >> 4, ch = id & 15;
                *(LAS u32x4*)(lds + (ch >> 3) * 8192 + key * 128 + (((ch & 7) ^ ((key >> 1) & 7)) << 4)) = kr[j];
                *(LAS u32x4*)(lds + 16384 + (ch >> 2) * 4096 + key * 64 + (ch & 3) * 16) = vr[j];
            }
            __syncthreads();
            f32x16 O[4];
#pragma unroll
            for (int e = 0; e < 4; ++e)
#pragma unroll
                for (int i = 0; i < 16; ++i) O[e][i] = 0.f;
            float mrun = -1e30f, lsum = 0.f;
            for (int t = 0; t < ntb; ++t) {
                const int buf = t & 1;
                if (t + 1 < ntb) {
#pragma unroll
                    for (int j = 0; j < 2; ++j) {
                        const int id = tid + 512 * j, key = id >> 4, ch = id & 15;
                        kr[j] = *(const u32x4*)(Kg + (rowb + 64 * (t + 1) + key) * 512 + h * 128 + ch * 8);
                        vr[j] = *(const u32x4*)(Vg + (rowb + 64 * (t + 1) + key) * 512 + h * 128 + ch * 8);
                    }
                }
                if (t < myn) {
                    const LAS unsigned char* kp = lds + buf * 32768 + c * 8192 + r * 128;
                    const LAS unsigned char* vp = lds + buf * 32768 + 16384 + vlane;
                    f32x16 S0, S1;
#pragma unroll
                    for (int i = 0; i < 16; ++i) { S0[i] = 0.f; S1[i] = 0.f; }
#pragma unroll
                    for (int ks = 0; ks < 4; ++ks) {
                        const int sl = ((2 * ks + hh) ^ ((r >> 1) & 7)) << 4;
                        const bf16x8 a0 = *(const LAS bf16x8*)(kp + sl), a1 = *(const LAS bf16x8*)(kp + 32 * 128 + sl);
                        S0 = mfma32(a0, qf[ks], S0); S1 = mfma32(a1, qf[ks], S1);
                    }
                    const float mx = half_max(fmaxf(max16(S0), max16(S1)));
                    const float mnew = fmaxf(mrun, mx), alpha = __builtin_amdgcn_exp2f(mrun - mnew);
                    mrun = mnew;
                    float ps = 0.f;
#pragma unroll
                    for (int i = 0; i < 16; ++i) { S0[i] = __builtin_amdgcn_exp2f(S0[i] - mnew); S1[i] = __builtin_amdgcn_exp2f(S1[i] - mnew); ps += S0[i] + S1[i]; }
                    lsum = lsum * alpha + ps;
#pragma unroll
                    for (int e = 0; e < 4; ++e)
#pragma unroll
                        for (int i = 0; i < 16; ++i) O[e][i] *= alpha;
                    const bf16x8 P0 = pfrag(S0, 0), P1 = pfrag(S0, 1), P2 = pfrag(S1, 0), P3 = pfrag(S1, 1);
#pragma unroll
                    for (int e = 0; e < 4; ++e) {
                        const bf16x8 v0 = cat8(tr_read(vp + e * 4096), tr_read(vp + e * 4096 + 512));
                        const bf16x8 v1 = cat8(tr_read(vp + e * 4096 + 1024), tr_read(vp + e * 4096 + 1536));
                        const bf16x8 v2 = cat8(tr_read(vp + e * 4096 + 2048), tr_read(vp + e * 4096 + 2560));
                        const bf16x8 v3 = cat8(tr_read(vp + e * 4096 + 3072), tr_read(vp + e * 4096 + 3584));
                        O[e] = mfma32(v0, P0, O[e]); O[e] = mfma32(v1, P1, O[e]); O[e] = mfma32(v2, P2, O[e]); O[e] = mfma32(v3, P3, O[e]);
                    }
                }
                if (t + 1 < ntb) {
#pragma unroll
                    for (int j = 0; j < 2; ++j) {
                        const int id = tid + 512 * j, key = id >> 4, ch = id & 15;
                        *(LAS u32x4*)(lds + (buf ^ 1) * 32768 + (ch >> 3) * 8192 + key * 128 + (((ch & 7) ^ ((key >> 1) & 7)) << 4)) = kr[j];
                        *(LAS u32x4*)(lds + (buf ^ 1) * 32768 + 16384 + (ch >> 2) * 4096 + key * 64 + (ch & 3) * 16) = vr[j];
                    }
                }
                __syncthreads();
            }
            const float inv = 1.f / half_sum(lsum);
            LAS float* xch = (LAS float*)(lds + qb * 16384);
            if (c == 1) {
                const float f = -lam * inv;
#pragma unroll
                for (int e = 0; e < 4; ++e)
#pragma unroll
                    for (int i = 0; i < 16; ++i) xch[(e * 16 + i) * 64 + lane] = O[e][i] * f;
            }
            __syncthreads();
            if (c == 0) {
                float ss = 0.f;
#pragma unroll
                for (int e = 0; e < 4; ++e)
#pragma unroll
                    for (int i = 0; i < 16; ++i) { const float v = O[e][i] * inv + xch[(e * 16 + i) * 64 + lane]; O[e][i] = v; ss += v * v; }
                ss = half_sum(ss);
                const float rs = rsqrtf(ss * (1.f / 128.f) + 1e-5f) * (1.f - lam_init);
                WAVE_SYNC();
                LAS unsigned char* stg = lds + qb * 16384;
#pragma unroll
                for (int e = 0; e < 4; ++e)
#pragma unroll
                    for (int g4 = 0; g4 < 4; ++g4) {
                        const int e0 = 32 * e + 8 * g4 + 4 * hh;
                        const f32x4 w = *(const LAS f32x4*)(subw + e0);
                        u32x2 o; o.x = cvtpk(O[e][4 * g4 + 0] * rs * w[0], O[e][4 * g4 + 1] * rs * w[1]); o.y = cvtpk(O[e][4 * g4 + 2] * rs * w[2], O[e][4 * g4 + 3] * rs * w[3]);
                        *(LAS u32x2*)(stg + r * 272 + e0 * 2) = o;
                    }
                WAVE_SYNC();
#pragma unroll
                for (int i = 0; i < 8; ++i) {
                    const int row = i * 4 + (lane >> 4), ch = lane & 15;
                    const u32x4 v = *(const LAS u32x4*)(stg + row * 272 + ch * 16);
                    *(u32x4*)(CAT + (rowb + q0 + 32 * qb + row) * 1024 + 512 + h * 128 + ch * 8) = v;
                }
            }
            __syncthreads();
        }
    }
}

enum { PH_PREP_FFN = 0, PH_PRENORM_FFN, PH_FFN_GU, PH_FFN_DOWN, PH_POST_FFN, PH_PREP_X, PH_MEMKV, PH_PRENORM_X, PH_WQ, PH_XATTN, PH_WO, PH_POST_X, PH_PREP_MIX, PH_INPROJ, PH_SSD1, PH_SSD2, PH_ATTN, PH_SSD3, PH_OUTPROJ, PH_POST_MIX, PH_PREP_ALL, PH_ROW_MIX, PH_ROW_X };
template <int PH> __global__ void __launch_bounds__(512, 2) k_fast(FP p) {
    extern __shared__ __attribute__((aligned(16))) unsigned char lds_raw[];
    LAS unsigned char* lds = (LAS unsigned char*)lds_raw;
    const int tid = threadIdx.x, lane = tid & 63, wave = __builtin_amdgcn_readfirstlane(tid >> 6);
    const int G = gridDim.x, bid = blockIdx.x, gw = bid * 8 + wave, ngw = G * 8;
    float* y = p.out;
    if constexpr (PH == PH_PREP_FFN) phase_prep_ffn(p, lds, gw, ngw, wave, lane);
    if constexpr (PH == PH_PRENORM_FFN) row_phase(nullptr, y, nullptr, nullptr, p.in[31], (bf16_t*)(p.ws + WS_XN), MP, gw, ngw, lane);
    if constexpr (PH == PH_FFN_GU) phase_ffn_gu(p, lds, G, bid);
    if constexpr (PH == PH_FFN_DOWN) phase_ffn_down(p, lds, G, bid);
    if constexpr (PH == PH_POST_FFN) row_phase((const bf16_t*)(p.ws + WS_RAW), y, p.in[32], y, nullptr, nullptr, MP, gw, ngw, lane);
    if constexpr (PH == PH_PREP_X) phase_prep_x(p, lds, gw, ngw, wave, lane);
    if constexpr (PH == PH_MEMKV) phase_memkv(p, lds, G, bid);
    if constexpr (PH == PH_PRENORM_X) row_phase(nullptr, y, nullptr, nullptr, p.in[29], (bf16_t*)(p.ws + WS_XN), MP, gw, ngw, lane);
    if constexpr (PH == PH_WQ) phase_wq(p, lds, G, bid);
    if constexpr (PH == PH_XATTN) phase_xattn(p, lds, G, bid);
    if constexpr (PH == PH_WO) phase_wo(p, lds, G, bid);
    if constexpr (PH == PH_POST_X) row_phase((const bf16_t*)(p.ws + WS_RAW), y, p.in[30], y, nullptr, nullptr, MP, gw, ngw, lane);
    if constexpr (PH == PH_PREP_MIX) phase_prep_mix(p, lds, gw, ngw, wave, lane);
    if constexpr (PH == PH_PREP_ALL) { phase_prep_x(p, lds, gw, ngw, wave, lane); phase_prep_ffn(p, lds, gw, ngw, wave, lane); phase_prep_mix(p, lds, gw, ngw, wave, lane); }
    if constexpr (PH == PH_ROW_MIX) row_phase((const bf16_t*)(p.ws + WS_RAW), p.in[0], p.in[28], y, p.in[29], (bf16_t*)(p.ws + WS_XN), MP, gw, ngw, lane);
    if constexpr (PH == PH_ROW_X) row_phase((const bf16_t*)(p.ws + WS_RAW), y, p.in[30], y, p.in[31], (bf16_t*)(p.ws + WS_XN), MP, gw, ngw, lane);
    if constexpr (PH == PH_INPROJ) phase_inproj(p, lds, G, bid);
    if constexpr (PH == PH_SSD1) phase_ssd1(p, lds, G, bid);
    if constexpr (PH == PH_SSD2) phase_ssd2(p, G, bid);
    if constexpr (PH == PH_ATTN) phase_attn(p, lds, G, bid);
    if constexpr (PH == PH_SSD3) phase_ssd3(p, lds, G, bid);
    if constexpr (PH == PH_OUTPROJ) phase_outproj(p, lds, G, bid);
    if constexpr (PH == PH_POST_MIX) row_phase((const bf16_t*)(p.ws + WS_RAW), p.in[0], p.in[28], y, nullptr, nullptr, MP, gw, ngw, lane);
}
struct Weights {
    const float *w_in, *conv_w, *conv_b, *dt_bias, *a_log, *d_skip, *ssm_norm_w, *lq1, *lk1, *lq2, *lk2, *subln, *w_out, *wq, *wo;
    const float *g_pre_mix, *g_post_mix, *g_pre_x, *g_post_x, *g_pre_ffn, *g_post_ffn, *w_gate, *w_up, *w_down;
};

static void gemm(hipStream_t s, const float* A, int lda, const float* W, int ldw, float* C, int ldc, int M, int N, int K) {
    const int tiles = (M / 128) * ((N + 63) / 64);
    hipLaunchKernelGGL(k_gemm, dim3(tiles < 4096 ? tiles : 4096), dim3(512), 0, s, A, lda, W, ldw, C, ldc, M, N, K);
}
constexpr int EG = 2048;

static void nv_mixer(hipStream_t s, const Weights& w, const float* x, int B, int L, int P, const float* conv_buf, const float* ssm0, const float* k_past, const float* v_past,
                     float* y, float* k_out, float* v_out, float* ssm_out, float* conv_out, float* ws) {
    const int M = B * L;
    float* hn = ws; float* z = hn + (size_t)M * 1024; float* raw = z + (size_t)M * 512; float* act = raw + (size_t)M * 1024; float* q = act + (size_t)M * 1024;
    float* dtr = q + (size_t)M * 512; float* dtv = dtr + (size_t)M * 8; float* ypre = dtv + (size_t)M * 8; float* cat = ypre + (size_t)M * 512; float* mix = cat + (size_t)M * 1024;
    const float lam_init = 0.2f;
    hipLaunchKernelGGL(k_rmsnorm, dim3(EG), dim3(512), 0, s, x, w.g_pre_mix, (const float*)nullptr, hn, M, 1e-6f);
    gemm(s, hn, 1024, w.w_in + 0, 3080, z, 512, M, 512, 1024);
    gemm(s, hn, 1024, w.w_in + 512, 3080, raw, 1024, M, 1024, 1024);
    gemm(s, hn, 1024, w.w_in + 1536, 3080, dtr, 8, M, 8, 1024);
    gemm(s, hn, 1024, w.w_in + 1544, 3080, q, 512, M, 512, 1024);
    gemm(s, hn, 1024, w.w_in + 2056, 3080, k_out, 512, M, 512, 1024);
    gemm(s, hn, 1024, w.w_in + 2568, 3080, v_out, 512, M, 512, 1024);
    hipLaunchKernelGGL(k_conv, dim3(EG), dim3(512), 0, s, raw, conv_buf, w.conv_w, w.conv_b, act, conv_out, B, L);
    hipLaunchKernelGGL(k_dt, dim3(64), dim3(512), 0, s, dtr, w.dt_bias, dtv, M * 8);
    hipLaunchKernelGGL(k_ssd, dim3(B * 8), dim3(512), 0, s, act, dtv, z, w.a_log, w.d_skip, ssm0, ypre, ssm_out, B, L);
    hipLaunchKernelGGL(k_ssd_norm, dim3(EG), dim3(512), 0, s, ypre, w.ssm_norm_w, cat, M);
    hipLaunchKernelGGL(k_rope, dim3(EG), dim3(512), 0, s, q, B, L, P);
    hipLaunchKernelGGL(k_rope, dim3(EG), dim3(512), 0, s, k_out, B, L, P);
    hipLaunchKernelGGL(k_attn, dim3(EG), dim3(512), 0, s, q, k_out, v_out, k_past, v_past, B, L, P, w.lq1, w.lk1, w.lq2, w.lk2, w.subln, lam_init, cat);
    gemm(s, cat, 1024, w.w_out, 1024, mix, 1024, M, 1024, 1024);
    hipLaunchKernelGGL(k_rmsnorm, dim3(EG), dim3(512), 0, s, mix, w.g_post_mix, x, y, M, 1e-6f);
}
static void nv_xattn(hipStream_t s, const Weights& w, int B, int L, const float* mem_k, const float* mem_v, float* y, float* ws) {
    const int M = B * L;
    float* hn = ws; float* qx = hn + (size_t)M * 1024; float* ox = qx + (size_t)M * 1024; float* mix = ox + (size_t)M * 1024;
    hipLaunchKernelGGL(k_rmsnorm, dim3(EG), dim3(512), 0, s, y, w.g_pre_x, (const float*)nullptr, hn, M, 1e-6f);
    gemm(s, hn, 1024, w.wq, 1024, qx, 1024, M, 1024, 1024);
    hipLaunchKernelGGL(k_xattn, dim3(EG), dim3(512), 0, s, qx, mem_k, mem_v, ox, B, L);
    gemm(s, ox, 1024, w.wo, 1024, mix, 1024, M, 1024, 1024);
    hipLaunchKernelGGL(k_rmsnorm, dim3(EG), dim3(512), 0, s, mix, w.g_post_x, y, y, M, 1e-6f);
}
static void nv_ffn(hipStream_t s, const Weights& w, int B, int L, float* y, float* ws) {
    const int M = B * L;
    float* hn = ws; float* mix = hn + (size_t)M * 1024;
    const int CH = (M < 2048) ? M : 2048;
    float* G = mix + (size_t)M * 1024; float* U = G + (size_t)CH * 2816;
    hipLaunchKernelGGL(k_rmsnorm, dim3(EG), dim3(512), 0, s, y, w.g_pre_ffn, (const float*)nullptr, hn, M, 1e-6f);
    for (int r0 = 0; r0 < M; r0 += CH) {
        gemm(s, hn + (size_t)r0 * 1024, 1024, w.w_gate, 2816, G, 2816, CH, 2816, 1024);
        gemm(s, hn + (size_t)r0 * 1024, 1024, w.w_up, 2816, U, 2816, CH, 2816, 1024);
        hipLaunchKernelGGL(k_silu_mul, dim3(EG), dim3(512), 0, s, G, U, (size_t)CH * 2816);
        gemm(s, G, 2816, w.w_down, 1024, mix + (size_t)r0 * 1024, 1024, CH, 1024, 2816);
    }
    hipLaunchKernelGGL(k_rmsnorm, dim3(EG), dim3(512), 0, s, mix, w.g_post_ffn, y, y, M, 1e-6f);
}

template <int PH> static void launch_fast(hipStream_t s, const FP& p, int grid) {
    static bool attr = false;
    if (!attr) { (void)hipFuncSetAttribute((const void*)k_fast<PH>, hipFuncAttributeMaxDynamicSharedMemorySize, LDS_BYTES); attr = true; }
    hipLaunchKernelGGL(k_fast<PH>, dim3(grid), dim3(512), LDS_BYTES, s, p);
}

extern "C" void kernel_launch(void* const* d_in, const int* in_sizes, int n_in, void* d_out, int out_size, void* d_ws, size_t ws_size, hipStream_t stream) {
    const float* const* in = (const float* const*)d_in;
    const float *x_prompt = in[0], *x_sample = in[1], *cache_k = in[2], *cache_v = in[3], *state_ssm = in[4], *state_conv = in[5], *cache_mk = in[6], *cache_mv = in[7], *mem_prompt = in[8];
    Weights w;
    w.w_in = in[9]; w.conv_w = in[10]; w.conv_b = in[11]; w.dt_bias = in[12]; w.a_log = in[13]; w.d_skip = in[14]; w.ssm_norm_w = in[15];
    w.lq1 = in[16]; w.lk1 = in[17]; w.lq2 = in[18]; w.lk2 = in[19]; w.subln = in[20]; w.w_out = in[21];
    const float* g_mem = in[22]; w.wq = in[23]; const float* wk = in[24]; const float* wv = in[25]; w.wo = in[26];
    w.g_pre_mix = in[27]; w.g_post_mix = in[28]; w.g_pre_x = in[29]; w.g_post_x = in[30]; w.g_pre_ffn = in[31]; w.g_post_ffn = in[32];
    w.w_gate = in[33]; w.w_up = in[34]; w.w_down = in[35];
    float* out = (float*)d_out;
    float* y_prompt = out;
    float* y_sample = out + 16777216;
    float* p_attn_k = out + 16908288;
    float* p_attn_v = out + 25296896;
    float* p_ssm = out + 33685504;
    float* p_conv = out + 33816576;
    float* p_mem_k = out + 33822720;
    float* p_mem_v = out + 34347008;
    float* s_attn_k = out + 34871296;
    float* s_attn_v = out + 34936832;
    float* s_ssm = out + 35002368;
    float* s_conv = out + 35526656;
    float* ws = (float*)d_ws;
    FP p{};
    for (int i = 0; i < 36; ++i) p.in[i] = in[i];
    p.out = out; p.ws = (unsigned char*)d_ws;
    (void)mem_prompt; (void)g_mem; (void)wk; (void)wv; (void)p_mem_k; (void)p_mem_v;
    launch_fast<PH_PREP_ALL>(stream, p, 256);
    launch_fast<PH_INPROJ>(stream, p, 256);
    launch_fast<PH_SSD1>(stream, p, 256);
    launch_fast<PH_MEMKV>(stream, p, 256);
    launch_fast<PH_SSD2>(stream, p, 256);
    launch_fast<PH_ATTN>(stream, p, 256);
    launch_fast<PH_SSD3>(stream, p, 256);
    launch_fast<PH_OUTPROJ>(stream, p, 256);
    launch_fast<PH_ROW_MIX>(stream, p, 256);
    launch_fast<PH_WQ>(stream, p, 256);
    launch_fast<PH_XATTN>(stream, p, 256);
    launch_fast<PH_WO>(stream, p, 256);
    launch_fast<PH_ROW_X>(stream, p, 256);
    launch_fast<PH_FFN_GU>(stream, p, 256);
    launch_fast<PH_FFN_DOWN>(stream, p, 256);
    launch_fast<PH_POST_FFN>(stream, p, 256);
    float* wss = (float*)((unsigned char*)d_ws + WS_SMP);
    nv_mixer(stream, w, x_sample, 8, 16, 2048, state_conv, state_ssm, cache_k, cache_v, y_sample, s_attn_k, s_attn_v, s_ssm, s_conv, wss);
    nv_xattn(stream, w, 8, 16, cache_mk, cache_mv, y_sample, wss);
    nv_ffn(stream, w, 8, 16, y_sample, wss);
    (void)p_attn_k; (void)p_attn_v; (void)p_ssm; (void)p_conv; (void)x_prompt; (void)y_prompt; (void)ws;
}
```

```cpp
#include <hip/hip_runtime.h>
#include <cstdint>
#include <cstdio>
#include <hip/hip_cooperative_groups.h>

#define DEV static __device__ __forceinline__
#define LAS __attribute__((address_space(3)))
#define WAVE_SYNC() asm volatile("s_waitcnt lgkmcnt(0)" ::: "memory")

DEV float wave_sum(float v) {
#pragma unroll
    for (int o = 32; o > 0; o >>= 1) v += __shfl_xor(v, o);
    return v;
}
DEV float wave_max(float v) {
#pragma unroll
    for (int o = 32; o > 0; o >>= 1) v = fmaxf(v, __shfl_xor(v, o));
    return v;
}
typedef float nf4 __attribute__((ext_vector_type(4)));
DEV float4 lds_ld4(const LAS float* p) { const nf4 v = *(const LAS nf4*)p; float4 r; r.x = v[0]; r.y = v[1]; r.z = v[2]; r.w = v[3]; return r; }
DEV float silu_f(float x) { return x / (1.f + expf(-x)); }

DEV void d_rmsnorm(const float* x, const float* g, const float* res, float* out, int M, float eps, int bid, int nb, LAS unsigned char* lds) {
    const int wid = __builtin_amdgcn_readfirstlane(threadIdx.x >> 6), lane = threadIdx.x & 63, wpb = 512 >> 6;
    for (int r = bid * wpb + wid; r < M; r += nb * wpb) {
        const float4* xr = (const float4*)(x + (size_t)r * 1024);
        float4 v[4]; float s = 0.f;
#pragma unroll
        for (int j = 0; j < 4; ++j) { v[j] = xr[lane + 64 * j]; s += v[j].x * v[j].x + v[j].y * v[j].y + v[j].z * v[j].z + v[j].w * v[j].w; }
        s = wave_sum(s);
        const float rs = rsqrtf(s * (1.f / 1024.f) + eps);
#pragma unroll
        for (int j = 0; j < 4; ++j) {
            const float4 gg = ((const float4*)g)[lane + 64 * j];
            float4 o; o.x = v[j].x * rs * gg.x; o.y = v[j].y * rs * gg.y; o.z = v[j].z * rs * gg.z; o.w = v[j].w * rs * gg.w;
            if (res) { const float4 rr = ((const float4*)(res + (size_t)r * 1024))[lane + 64 * j]; o.x += rr.x; o.y += rr.y; o.z += rr.z; o.w += rr.w; }
            ((float4*)(out + (size_t)r * 1024))[lane + 64 * j] = o;
        }
    }
}

DEV void d_gemm(const float* A, int lda, const float* W, int ldw, float* C, int ldc, int M, int N, int K, int bid, int nb, LAS unsigned char* lds) {
    LAS float (*As)[132] = (LAS float (*)[132])lds;
    LAS float (*Ws)[64] = (LAS float (*)[64])(lds + 16 * 132 * 4);
    const int tid = threadIdx.x, ty = tid >> 4, tx = tid & 15;
    const int tilesN = (N + 63) / 64, tilesM = M / 128;
    for (int tile = bid; tile < tilesM * tilesN; tile += nb) {
        const int tm = tile / tilesN, tn = tile % tilesN, m0 = tm * 128, n0 = tn * 64;
        float acc[4][4];
#pragma unroll
        for (int i = 0; i < 4; ++i)
#pragma unroll
            for (int j = 0; j < 4; ++j) acc[i][j] = 0.f;
        for (int k0 = 0; k0 < K; k0 += 16) {
            {
                const int r = tid >> 2, kq = (tid & 3) * 4;
                const float4 a = *(const float4*)(A + (size_t)(m0 + r) * lda + k0 + kq);
                As[kq + 0][r] = a.x; As[kq + 1][r] = a.y; As[kq + 2][r] = a.z; As[kq + 3][r] = a.w;
            }
            {
                const int kk = tid >> 5, n2 = (tid & 31) * 2, n = n0 + n2;
                const float* wp = W + (size_t)(k0 + kk) * ldw + n;
                Ws[kk][n2] = (n < N) ? wp[0] : 0.f; Ws[kk][n2 + 1] = (n + 1 < N) ? wp[1] : 0.f;
            }
            __syncthreads();
#pragma unroll
            for (int kk = 0; kk < 16; ++kk) {
                const float4 a = lds_ld4(&As[kk][ty * 4]);
                const float4 b = lds_ld4(&Ws[kk][tx * 4]);
                const float av[4] = {a.x, a.y, a.z, a.w}, bv[4] = {b.x, b.y, b.z, b.w};
#pragma unroll
                for (int i = 0; i < 4; ++i)
#pragma unroll
                    for (int j = 0; j < 4; ++j) acc[i][j] += av[i] * bv[j];
            }
            __syncthreads();
        }
#pragma unroll
        for (int i = 0; i < 4; ++i)
#pragma unroll
            for (int j = 0; j < 4; ++j) { const int col = n0 + tx * 4 + j; if (col < N) C[(size_t)(m0 + ty * 4 + i) * ldc + col] = acc[i][j]; }
    }
}

DEV void d_conv(const float* raw, const float* buf, const float* cw, const float* cb, float* act, float* conv_new, int B, int L, int bid, int nb, LAS unsigned char* lds) {
    const size_t total = (size_t)B * L * 1024;
    for (size_t i = (size_t)bid * 512 + threadIdx.x; i < total; i += (size_t)nb * 512) {
        const int c = (int)(i & 1023); const size_t bt = i >> 10; const int t = (int)(bt % L), b = (int)(bt / L);
        float acc = cb[c];
#pragma unroll
        for (int j = 0; j < 4; ++j) {
            const int tt = t - 3 + j;
            const float u = (tt >= 0) ? raw[((size_t)b * L + tt) * 1024 + c] : (buf ? buf[(size_t)(b * 3 + (tt + 3)) * 1024 + c] : 0.f);
            acc += cw[j * 1024 + c] * u;
        }
        act[i] = silu_f(acc);
        if (t >= L - 3) conv_new[(size_t)(b * 3 + (t - (L - 3))) * 1024 + c] = raw[i];
    }
}

DEV void d_dt(const float* dt_raw, const float* dt_bias, float* dt, int n, int bid, int nb, LAS unsigned char* lds) {
    for (int i = bid * 512 + threadIdx.x; i < n; i += nb * 512) {
        const float x = dt_raw[i] + dt_bias[i & 7];
        dt[i] = (x > 20.f) ? x : log1pf(expf(x));
    }
}

DEV void d_ssd(const float* act, const float* dtv, const float* z, const float* a_log, const float* d_skip,
                                             const float* ssm0, float* ypre, float* ssm_new, int B, int L, int bid, int nb, LAS unsigned char* lds) {
    const int tid = threadIdx.x, p = tid >> 3, seg = tid & 7;
    for (int item = bid; item < B * 8; item += nb) {
        const int b = item >> 3, h = item & 7, g = h >> 2;
        float hs[16];
        const size_t sbase = ((size_t)(b * 8 + h) * 64 + p) * 128 + seg * 16;
#pragma unroll
        for (int i = 0; i < 16; ++i) hs[i] = ssm0 ? ssm0[sbase + i] : 0.f;
        const float a = -expf(a_log[h]), D = d_skip[h];
        for (int t = 0; t < L; ++t) {
            const size_t row = (size_t)b * L + t;
            const float dt = dtv[row * 8 + h];
            const float x = act[row * 1024 + h * 64 + p];
            const float4* Bp = (const float4*)(act + row * 1024 + 512 + g * 128 + seg * 16);
            const float4* Cp = (const float4*)(act + row * 1024 + 768 + g * 128 + seg * 16);
            const float dA = expf(dt * a), coef = dt * x;
            float y = 0.f;
#pragma unroll
            for (int q4 = 0; q4 < 4; ++q4) {
                const float4 bv = Bp[q4], cv = Cp[q4];
                hs[4 * q4 + 0] = dA * hs[4 * q4 + 0] + coef * bv.x; y += cv.x * hs[4 * q4 + 0];
                hs[4 * q4 + 1] = dA * hs[4 * q4 + 1] + coef * bv.y; y += cv.y * hs[4 * q4 + 1];
                hs[4 * q4 + 2] = dA * hs[4 * q4 + 2] + coef * bv.z; y += cv.z * hs[4 * q4 + 2];
                hs[4 * q4 + 3] = dA * hs[4 * q4 + 3] + coef * bv.w; y += cv.w * hs[4 * q4 + 3];
            }
            y += __shfl_xor(y, 1); y += __shfl_xor(y, 2); y += __shfl_xor(y, 4);
            if (seg == 0) { const float zz = z[row * 512 + h * 64 + p]; ypre[row * 512 + h * 64 + p] = (y + D * x) * silu_f(zz); }
        }
#pragma unroll
        for (int i = 0; i < 16; ++i) ssm_new[sbase + i] = hs[i];
    }
}

DEV void d_ssd_norm(const float* ypre, const float* w, float* cat, int M, int bid, int nb, LAS unsigned char* lds) {
    const int wid = __builtin_amdgcn_readfirstlane(threadIdx.x >> 6), lane = threadIdx.x & 63, wpb = 512 >> 6;
    for (int it = bid * wpb + wid; it < M * 2; it += nb * wpb) {
        const int row = it >> 1, g = it & 1;
        const float4 v = ((const float4*)(ypre + (size_t)row * 512 + g * 256))[lane];
        const float s = wave_sum(v.x * v.x + v.y * v.y + v.z * v.z + v.w * v.w);
        const float rs = rsqrtf(s * (1.f / 256.f) + 1e-5f);
        const float4 ww = ((const float4*)(w + g * 256))[lane];
        float4 o; o.x = v.x * rs * ww.x; o.y = v.y * rs * ww.y; o.z = v.z * rs * ww.z; o.w = v.w * rs * ww.w;
        ((float4*)(cat + (size_t)row * 1024 + g * 256))[lane] = o;
    }
}

DEV void d_rope(float* x, int B, int L, int P, int bid, int nb, LAS unsigned char* lds) {
    const size_t total = (size_t)B * L * 8 * 32;
    for (size_t i = (size_t)bid * 512 + threadIdx.x; i < total; i += (size_t)nb * 512) {
        const int d = (int)(i & 31), u = (int)((i >> 5) & 7); const size_t bt = i >> 8; const int t = (int)(bt % L);
        const float pos = (float)(P + t);
        const float inv = exp2f(-(float)d * (13.287712379549449f / 32.f));
        const float ang = pos * inv;
        float rev = ang * 0.15915494309189535f; rev -= floorf(rev);
        const float sn = __builtin_amdgcn_sinf(rev), cs = __builtin_amdgcn_cosf(rev);
        float* p = x + bt * 512 + u * 64 + d;
        const float x1 = p[0], x2 = p[32];
        p[0] = x1 * cs - x2 * sn; p[32] = x2 * cs + x1 * sn;
    }
}

DEV void d_attn(const float* q, const float* kn, const float* vn, const float* kp, const float* vp, int B, int L, int P,
                                              const float* lq1, const float* lk1, const float* lq2, const float* lk2, const float* subln, float lam_init, float* cat, int bid, int nb, LAS unsigned char* lds) {
    LAS float (*qs)[4][128] = (LAS float (*)[4][128])lds;
    LAS float (*ps)[2][4][64] = (LAS float (*)[2][4][64])(lds + 8 * 4 * 128 * 4);
    const int wid = __builtin_amdgcn_readfirstlane(threadIdx.x >> 6), lane = threadIdx.x & 63;
    const float lam = expf(wave_sum(lq1[lane] * lk1[lane])) - expf(wave_sum(lq2[lane] * lk2[lane])) + lam_init;
    const int ngrp = L / 4, nitems = B * 4 * ngrp;
    for (int it = bid * 8 + wid; it < nitems; it += nb * 8) {
        const int qg = it % ngrp, bh = it / ngrp, h = bh & 3, b = bh >> 2, t0 = qg * 4;
        int nvis = ((P + t0) / 64 + 1) * 64; if (nvis > P + L) nvis = P + L;
        WAVE_SYNC();
#pragma unroll
        for (int i = 0; i < 8; ++i) { const int idx = lane + 64 * i, qi = idx >> 7, j = idx & 127; qs[wid][qi][j] = q[(((size_t)b * L + t0 + qi) * 4 + h) * 128 + j]; }
        WAVE_SYNC();
        float m[4][2], l[4][2], O[4][2][2];
#pragma unroll
        for (int qi = 0; qi < 4; ++qi)
#pragma unroll
            for (int c = 0; c < 2; ++c) { m[qi][c] = -1e30f; l[qi][c] = 0.f; O[qi][c][0] = 0.f; O[qi][c][1] = 0.f; }
        const int ntiles = (nvis + 63) / 64;
        for (int tile = 0; tile < ntiles; ++tile) {
            const int kk = tile * 64 + lane; const bool valid = kk < nvis; const int kc = valid ? kk : nvis - 1;
            const float* krow = (kc < P) ? kp + (((size_t)b * P + kc) * 4 + h) * 128 : kn + (((size_t)b * L + (kc - P)) * 4 + h) * 128;
            float s[4][2];
#pragma unroll
            for (int qi = 0; qi < 4; ++qi) { s[qi][0] = 0.f; s[qi][1] = 0.f; }
#pragma unroll
            for (int c = 0; c < 2; ++c)
#pragma unroll 4
                for (int d4 = 0; d4 < 16; ++d4) {
                    const float4 kv = ((const float4*)krow)[c * 16 + d4];
#pragma unroll
                    for (int qi = 0; qi < 4; ++qi) { const float4 qv = lds_ld4(&qs[wid][qi][c * 64 + d4 * 4]); s[qi][c] += kv.x * qv.x + kv.y * qv.y + kv.z * qv.z + kv.w * qv.w; }
                }
#pragma unroll
            for (int qi = 0; qi < 4; ++qi)
#pragma unroll
                for (int c = 0; c < 2; ++c) {
                    const float sv = valid ? s[qi][c] * 0.125f : -1e30f;
                    const float mt = wave_max(sv), mn = fmaxf(m[qi][c], mt), alpha = expf(m[qi][c] - mn);
                    const float pp = valid ? expf(sv - mn) : 0.f;
                    l[qi][c] = l[qi][c] * alpha + wave_sum(pp); O[qi][c][0] *= alpha; O[qi][c][1] *= alpha; m[qi][c] = mn;
                    ps[wid][c][qi][lane] = pp;
                }
            WAVE_SYNC();
            int nk = nvis - tile * 64; if (nk > 64) nk = 64;
            for (int j = 0; j < nk; ++j) {
                const int kj = tile * 64 + j;
                const float* vrow = (kj < P) ? vp + (((size_t)b * P + kj) * 4 + h) * 128 : vn + (((size_t)b * L + (kj - P)) * 4 + h) * 128;
                const float2 v = ((const float2*)vrow)[lane];
#pragma unroll
                for (int qi = 0; qi < 4; ++qi)
#pragma unroll
                    for (int c = 0; c < 2; ++c) { const float pv = ps[wid][c][qi][j]; O[qi][c][0] += pv * v.x; O[qi][c][1] += pv * v.y; }
            }
            WAVE_SYNC();
        }
        const float2 w = ((const float2*)subln)[lane];
#pragma unroll
        for (int qi = 0; qi < 4; ++qi) {
            const float ox = O[qi][0][0] / l[qi][0] - lam * O[qi][1][0] / l[qi][1];
            const float oy = O[qi][0][1] / l[qi][0] - lam * O[qi][1][1] / l[qi][1];
            const float ms = wave_sum(ox * ox + oy * oy) * (1.f / 128.f);
            const float r = rsqrtf(ms + 1e-5f) * (1.f - lam_init);
            float2 o; o.x = ox * r * w.x; o.y = oy * r * w.y;
            ((float2*)(cat + ((size_t)b * L + t0 + qi) * 1024 + 512 + h * 128))[lane] = o;
        }
    }
}

DEV void d_xattn(const float* qx, const float* mk, const float* mv, float* ox, int B, int L, int bid, int nb, LAS unsigned char* lds) {
    LAS float (*qs)[4][256] = (LAS float (*)[4][256])lds;
    LAS float (*ps)[4][64] = (LAS float (*)[4][64])(lds + 8 * 4 * 256 * 4);
    const int wid = __builtin_amdgcn_readfirstlane(threadIdx.x >> 6), lane = threadIdx.x & 63;
    const int ngrp = L / 4, nitems = B * 4 * ngrp;
    for (int it = bid * 8 + wid; it < nitems; it += nb * 8) {
        const int qg = it % ngrp, bh = it / ngrp, h = bh & 3, b = bh >> 2, t0 = qg * 4;
        WAVE_SYNC();
#pragma unroll
        for (int i = 0; i < 16; ++i) { const int idx = lane + 64 * i, qi = idx >> 8, j = idx & 255; qs[wid][qi][j] = qx[((size_t)b * L + t0 + qi) * 1024 + h * 256 + j]; }
        WAVE_SYNC();
        float m[4], l[4], O[4][4];
#pragma unroll
        for (int qi = 0; qi < 4; ++qi) { m[qi] = -1e30f; l[qi] = 0.f; O[qi][0] = O[qi][1] = O[qi][2] = O[qi][3] = 0.f; }
        for (int tile = 0; tile < 4; ++tile) {
            const int kk = tile * 64 + lane;
            const float* krow = mk + (((size_t)b * 256 + kk) * 4 + h) * 256;
            float s[4] = {0.f, 0.f, 0.f, 0.f};
#pragma unroll 4
            for (int d4 = 0; d4 < 64; ++d4) {
                const float4 kv = ((const float4*)krow)[d4];
#pragma unroll
                for (int qi = 0; qi < 4; ++qi) { const float4 qv = lds_ld4(&qs[wid][qi][d4 * 4]); s[qi] += kv.x * qv.x + kv.y * qv.y + kv.z * qv.z + kv.w * qv.w; }
            }
#pragma unroll
            for (int qi = 0; qi < 4; ++qi) {
                const float sv = s[qi] * 0.0625f;
                const float mt = wave_max(sv), mn = fmaxf(m[qi], mt), alpha = expf(m[qi] - mn), pp = expf(sv - mn);
                l[qi] = l[qi] * alpha + wave_sum(pp); O[qi][0] *= alpha; O[qi][1] *= alpha; O[qi][2] *= alpha; O[qi][3] *= alpha; m[qi] = mn;
                ps[wid][qi][lane] = pp;
            }
            WAVE_SYNC();
            for (int j = 0; j < 64; ++j) {
                const float4 v = ((const float4*)(mv + (((size_t)b * 256 + tile * 64 + j) * 4 + h) * 256))[lane];
#pragma unroll
                for (int qi = 0; qi < 4; ++qi) { const float pv = ps[wid][qi][j]; O[qi][0] += pv * v.x; O[qi][1] += pv * v.y; O[qi][2] += pv * v.z; O[qi][3] += pv * v.w; }
            }
            WAVE_SYNC();
        }
#pragma unroll
        for (int qi = 0; qi < 4; ++qi) {
            const float il = 1.f / l[qi];
            float4 o; o.x = O[qi][0] * il; o.y = O[qi][1] * il; o.z = O[qi][2] * il; o.w = O[qi][3] * il;
            ((float4*)(ox + ((size_t)b * L + t0 + qi) * 1024 + h * 256))[lane] = o;
        }
    }
}

DEV void d_silu_mul(float* g, const float* u, size_t n, int bid, int nb, LAS unsigned char* lds) {
    for (size_t i = (size_t)bid * 512 + threadIdx.x; i < n; i += (size_t)nb * 512) g[i] = silu_f(g[i]) * u[i];
}


typedef unsigned short bf16_t;
typedef float f32x4 __attribute__((ext_vector_type(4)));
typedef float f32x16 __attribute__((ext_vector_type(16)));
typedef short bf16x8 __attribute__((ext_vector_type(8)));
typedef short s16x4 __attribute__((ext_vector_type(4)));
typedef unsigned u32x4 __attribute__((ext_vector_type(4)));
typedef unsigned u32x2 __attribute__((ext_vector_type(2)));

constexpr size_t MiB = 1u << 20;
constexpr size_t WS_W_IN = 0, WS_W_OUT = 6 * MiB, WS_W_Q = 8 * MiB, WS_W_KV = 10 * MiB, WS_W_O = 14 * MiB, WS_W_GU = 16 * MiB, WS_W_DOWN = 27 * MiB;
constexpr size_t WS_CTL = 33 * MiB, WS_DTV = 34 * MiB, WS_CDEC = 34 * MiB + 512 * 1024, WS_MN = 35 * MiB;
constexpr size_t WS_XN = 36 * MiB, WS_CAT = 68 * MiB, WS_QX = 68 * MiB, WS_Q = 100 * MiB, WS_K = 116 * MiB, WS_RAW = 100 * MiB;
constexpr size_t WS_ZX = 132 * MiB, WS_OX = 132 * MiB, WS_V = 180 * MiB, WS_ST = 196 * MiB, WS_HID = 132 * MiB, WS_KM = 228 * MiB, WS_VM = 229 * MiB, WS_SMP = 230 * MiB;
constexpr int MP = 16384;
constexpr int LDS_BYTES = 147456;

DEV unsigned f2bf(float f) { unsigned u = __builtin_bit_cast(unsigned, f); return (u + 0x7fffu + ((u >> 16) & 1u)) >> 16; }
DEV unsigned pk2(float lo, float hi) { return f2bf(lo) | (f2bf(hi) << 16); }
DEV float bflo(unsigned w) { return __builtin_bit_cast(float, w << 16); }
DEV float bfhi(unsigned w) { return __builtin_bit_cast(float, w & 0xffff0000u); }
DEV float fast_silu(float x) { return x * __builtin_amdgcn_rcpf(1.f + __builtin_amdgcn_exp2f(-1.4426950408889634f * x)); }

struct FP {
    const float* in[36];
    float* out;
    unsigned char* ws;
};

template <class RowMap>
DEV void transpose_item(const float* W, int K, int N, bf16_t* WT, int item, LAS float* scr, int lane, RowMap rm) {
    const int nblk = (N + 31) / 32, kb = item / nblk, nb = item % nblk, k0 = 64 * kb, n0 = 32 * nb;
    const int ncol = n0 + (lane & 31);
#pragma unroll 8
    for (int i = 0; i < 32; ++i) { const int kk = 2 * i + (lane >> 5); scr[kk * 33 + (lane & 31)] = (ncol < N) ? W[(size_t)(k0 + kk) * N + ncol] : 0.f; }
    WAVE_SYNC();
    const int c = lane & 7;
#pragma unroll
    for (int j = 0; j < 4; ++j) {
        const int n = (lane >> 3) + 8 * j; const LAS float* s = scr + (8 * c) * 33 + n;
        const int src = n0 + n; const int dst = (src < N) ? rm(src) : -1;
        u32x4 o; o.x = pk2(s[0 * 33], s[1 * 33]); o.y = pk2(s[2 * 33], s[3 * 33]); o.z = pk2(s[4 * 33], s[5 * 33]); o.w = pk2(s[6 * 33], s[7 * 33]);
        if (dst >= 0) *(u32x4*)(WT + (size_t)dst * K + k0 + 8 * c) = o;
    }
    WAVE_SYNC();
}
struct RmPlain { int off; __device__ __forceinline__ int operator()(int n) const { return off + n; } };
struct RmGU { int up; __device__ __forceinline__ int operator()(int n) const { return 32 * (n >> 4) + 16 * up + (n & 15); } };
struct RmIn {
    __device__ __forceinline__ int operator()(int n) const {
        if (n < 1536) return n;
        if (n < 1544) return -1;
        const int m = n - 1544;
        if (m < 1024) { const int u = m >> 6, d = m & 63; return 1536 + 64 * u + 32 * ((d & 31) >> 4) + 16 * (d >> 5) + (d & 15); }
        return 1536 + m;
    }
};

DEV void row_phase(const bf16_t* raw, const float* hin, const float* gpost, float* hout, const float* gpre, bf16_t* xn, int M, int gw, int ngw, int lane) {
    for (int r = gw; r < M; r += ngw) {
        f32x4 h[4];
#pragma unroll
        for (int j = 0; j < 4; ++j) h[j] = ((const f32x4*)(hin + (size_t)r * 1024))[lane + 64 * j];
        if (raw) {
            f32x4 v[4]; float ss = 0.f;
#pragma unroll
            for (int j = 0; j < 4; ++j) {
                const u32x2 w = ((const u32x2*)(raw + (size_t)r * 1024))[lane + 64 * j];
                v[j] = (f32x4){bflo(w.x), bfhi(w.x), bflo(w.y), bfhi(w.y)};
                ss += v[j].x * v[j].x + v[j].y * v[j].y + v[j].z * v[j].z + v[j].w * v[j].w;
            }
            const float rs = rsqrtf(wave_sum(ss) * (1.f / 1024.f) + 1e-6f);
#pragma unroll
            for (int j = 0; j < 4; ++j) { const f32x4 g = ((const f32x4*)gpost)[lane + 64 * j]; h[j] += v[j] * rs * g; }
        }
        if (hout) {
#pragma unroll
            for (int j = 0; j < 4; ++j) ((f32x4*)(hout + (size_t)r * 1024))[lane + 64 * j] = h[j];
        }
        if (gpre) {
            float ss = 0.f;
#pragma unroll
            for (int j = 0; j < 4; ++j) ss += h[j].x * h[j].x + h[j].y * h[j].y + h[j].z * h[j].z + h[j].w * h[j].w;
            const float rs = rsqrtf(wave_sum(ss) * (1.f / 1024.f) + 1e-6f);
#pragma unroll
            for (int j = 0; j < 4; ++j) {
                const f32x4 g = ((const f32x4*)gpre)[lane + 64 * j]; const f32x4 o = h[j] * rs * g;
                u32x2 w; w.x = pk2(o.x, o.y); w.y = pk2(o.z, o.w);
                ((u32x2*)(xn + (size_t)r * 1024))[lane + 64 * j] = w;
            }
        }
    }
}
namespace pg8 {
#define PG8_LAS __attribute__((address_space(3)))
typedef unsigned short bf16_t;
typedef short bf16x8 __attribute__((ext_vector_type(8)));
typedef float f32x4 __attribute__((ext_vector_type(4)));
typedef unsigned u32x4 __attribute__((ext_vector_type(4)));
constexpr int BM = 256, BK = 64, HALF = 128, HTB = HALF * BK * 2  , STAGE_BYTES = 8 * HTB, NXCD = 8, WGM = 8;

__host__ __device__ __forceinline__ int lds_byte(int r, int c) { const int st = (r >> 4) * 2 + (c >> 5), rr = r & 15, cc = c & 31, ob = rr * 64 + cc * 2; return st * 1024 + (ob ^ (((ob >> 9) & 1) << 5)); }
__host__ __device__ __forceinline__ void stage_rc(int b, int& R, int& C) { const int st = b / 1024, sb = b % 1024, swz = sb ^ (((sb >> 9) & 1) << 5); R = (st >> 1) * 16 + swz / 64; C = (st & 1) * 32 + (swz % 64) / 2; }
__host__ __device__ __forceinline__ int perm32(int rho) { const int n = rho >> 4, i = rho & 15; return 8 * (i >> 2) + 4 * n + (i & 3); }

struct Unit { int pm, pn; };
struct Gemm { const bf16_t* A; const bf16_t* Bt; int M, N, K; };

struct StaticOrder {
    int nM, nN, nwg, G, c;
    __host__ __device__ void init(int M, int N, int G_, int c_) { nM = M / BM; nN = N / BM; nwg = nM * nN; G = G_; c = c_; }
    __host__ __device__ bool next(int i, Unit& u) const {
        const long L = (long)i * G + c; if (L >= nwg) return false;
        int wgid = (int)L; { const int q = nwg / NXCD, r = nwg % NXCD, xcd = wgid % NXCD, off = wgid / NXCD; wgid = (xcd < r ? xcd * (q + 1) : r * (q + 1) + (xcd - r) * q) + off; }
        const int nig = WGM * nN, gid = wgid / nig, fm = gid * WGM, gsz = (nM - fm) < WGM ? (nM - fm) : WGM;
        u.pm = fm + ((wgid % nig) % gsz); u.pn = (wgid % nig) / gsz; return true;
    }
    __device__ __forceinline__ void a_ready(const Unit&) const {}
    __device__ __forceinline__ void done(const Unit&) const {}
};

__device__ __forceinline__ unsigned cvt_pk_bf16(float lo, float hi) { unsigned r; asm volatile("v_cvt_pk_bf16_f32 %0, %1, %2" : "=v"(r) : "v"(lo), "v"(hi)); return r; }
typedef float f32x2 __attribute__((ext_vector_type(2)));
__device__ __forceinline__ f32x2 gelu_pk(f32x2 v) {
    const f32x2 av = __builtin_elementwise_abs(v), d = av * 0.2316418882f + 1.0f;
    f32x2 t; t.x = __builtin_amdgcn_rcpf(d.x); t.y = __builtin_amdgcn_rcpf(d.y);
    f32x2 q = t * 0.5307027145f + (-0.7265760135f); q = q * t + 0.7107068705f; q = q * t + (-0.142248368f); q = q * t + 0.127414796f; q = q * t;
    const f32x2 s = (v * v) * (-0.72134752044f);
    f32x2 e; e.x = __builtin_amdgcn_exp2f(s.x); e.y = __builtin_amdgcn_exp2f(s.y);
    const f32x2 m = v * (q * e), r = v - m;
    f32x2 o; o.x = v.x < 0.f ? m.x : r.x; o.y = v.y < 0.f ? m.y : r.y; return o;
}

template <int ACT  > struct EpiBf16 {
    static constexpr bool PERM = true, AFTER_DRAIN = false; static_assert(ACT == 0 || ACT == 1, "EpiBf16: ACT is 0 (none) or 1 (gelu_pk)");
    bf16_t* O; int ldc; const float* bias; int split_cols; size_t split_stride; float scale0;
    __device__ __forceinline__ void operator()(const f32x4 (&acc)[2][2][4][2], const Unit& u, int wr, int wc, int fr, int fq) const {
        const int row0 = u.pm * BM + wr * 64 + fr; int colt = u.pn * BM; bf16_t* base = O;
        float sc = 1.f; if (split_cols) { const int t = colt / split_cols; base += (size_t)t * split_stride; colt -= t * split_cols; if (t == 0) sc = scale0; }
        const int col0 = colt + wc * 32 + 8 * fq, bcol0 = u.pn * BM + wc * 32 + 8 * fq;
        f32x4 bv[2][2];
#pragma unroll
        for (int bj = 0; bj < 2; ++bj)
#pragma unroll
            for (int n = 0; n < 2; ++n) bv[bj][n] = bias ? *(const f32x4*)(bias + bcol0 + bj * HALF + 4 * n) : (f32x4){0.f, 0.f, 0.f, 0.f};
#pragma unroll
        for (int ai = 0; ai < 2; ++ai)
#pragma unroll
            for (int m = 0; m < 4; ++m) { bf16_t* rowp = base + (size_t)(row0 + ai * HALF + m * 16) * ldc + col0;
#pragma unroll
                for (int bj = 0; bj < 2; ++bj) { f32x4 v0 = acc[ai][bj][m][0] + bv[bj][0], v1 = acc[ai][bj][m][1] + bv[bj][1];
                    if (ACT == 1) { f32x2 a = gelu_pk((f32x2){v0[0], v0[1]}), b = gelu_pk((f32x2){v0[2], v0[3]}), c = gelu_pk((f32x2){v1[0], v1[1]}), d = gelu_pk((f32x2){v1[2], v1[3]});
                        v0 = (f32x4){a.x, a.y, b.x, b.y}; v1 = (f32x4){c.x, c.y, d.x, d.y}; }
                    v0 = v0 * sc; v1 = v1 * sc; u32x4 w; w.x = cvt_pk_bf16(v0[0], v0[1]); w.y = cvt_pk_bf16(v0[2], v0[3]); w.z = cvt_pk_bf16(v1[0], v1[1]); w.w = cvt_pk_bf16(v1[2], v1[3]);
                    *(u32x4*)(rowp + bj * HALF) = w; } }
    }
};
template <class Epi, class Sched, bool ALIGN_EPI = false, bool SP2 = false>
__device__ __forceinline__ void gemm_phase(PG8_LAS unsigned char* lds, const Gemm g, const Sched& S, const Epi& E) {
    int tid_l = threadIdx.x; asm volatile("" : "+v"(tid_l));
    const int tid = tid_l, wid = __builtin_amdgcn_readfirstlane(tid >> 6), lane = tid & 63, wr = wid >> 2, wc = wid & 3, fr = lane & 15, fq = lane >> 4;
    const int K = g.K, nt = K / BK;
    unsigned voffA[2], voffB[2];
#pragma unroll
    for (int i = 0; i < 2; ++i) { int R, C; stage_rc(tid * 16 + i * 8192, R, C); const int Rb = Epi::PERM ? ((R & ~31) + perm32(R & 31)) : R;
        voffA[i] = (unsigned)(R * K + C) * 2u; voffB[i] = (unsigned)(Rb * K + C) * 2u; }
    const size_t kstep = (size_t)(BK * 2);
    const size_t hstep = (size_t)HALF * K * 2;
    const size_t tstep = 2 * hstep;
    const unsigned ldsw = (unsigned)wid * 1024u;
    const int aoff = lds_byte(wr * 64 + fr, fq * 8), boff = lds_byte(wc * 32 + fr, fq * 8);
#define PG8_SA(b, h) (((b) * 2 + (h)) * HTB)
#define PG8_SB(b, h) ((4 + (b) * 2 + (h)) * HTB)
#define PG8_STAGE(bufoff, gbase, voff) do { _Pragma("unroll") for (int _i = 0; _i < 2; ++_i) \
        __builtin_amdgcn_global_load_lds((const unsigned*)((const char*)(gbase) + (voff)[_i]), (PG8_LAS unsigned*)(lds + (bufoff) + ldsw + _i * 8192), 16, 0, 0); } while (0)
#define PG8_LDA(dst, b, h) do { _Pragma("unroll") for (int m = 0; m < 4; ++m) _Pragma("unroll") for (int k = 0; k < 2; ++k) dst[m][k] = *(const PG8_LAS bf16x8*)(lds + PG8_SA(b, h) + aoff + m * 2048 + k * 1024); } while (0)
#define PG8_LDB(dst, b, h) do { _Pragma("unroll") for (int n = 0; n < 2; ++n) _Pragma("unroll") for (int k = 0; k < 2; ++k) dst[n][k] = *(const PG8_LAS bf16x8*)(lds + PG8_SB(b, h) + boff + n * 2048 + k * 1024); } while (0)
#define PG8_MMA(ai, bj, At, Bt) do { __builtin_amdgcn_s_setprio(1); _Pragma("unroll") for (int m = 0; m < 4; ++m) _Pragma("unroll") for (int n = 0; n < 2; ++n) _Pragma("unroll") for (int k = 0; k < 2; ++k) \
        acc[ai][bj][m][n] = __builtin_amdgcn_mfma_f32_16x16x32_bf16(Bt[n][k], At[m][k], acc[ai][bj][m][n], 0, 0, 0); __builtin_amdgcn_s_setprio(0); } while (0)
#define PG8_WAIT_V(n) asm volatile("s_waitcnt vmcnt(" #n ")" ::: "memory")
#define PG8_WAIT_L(n) asm volatile("s_waitcnt lgkmcnt(" #n ")" ::: "memory")
#define PG8_BAR __builtin_amdgcn_s_barrier()
#define PG8_SCHED __builtin_amdgcn_sched_barrier(0)
    Unit cur, nxt; int ui = 0;
    if (!S.next(0, cur)) return;
    f32x4 acc[2][2][4][2];
#pragma unroll
    for (int a = 0; a < 2; ++a)
#pragma unroll
        for (int b = 0; b < 2; ++b)
#pragma unroll
            for (int m = 0; m < 4; ++m)
#pragma unroll
                for (int n = 0; n < 2; ++n) acc[a][b][m][n] = (f32x4){0.f, 0.f, 0.f, 0.f};
    bf16x8 At[4][2], B0[2][2], B1[2][2];
    const char* cA = (const char*)g.A + (size_t)cur.pm * tstep; const char* cB = (const char*)g.Bt + (size_t)cur.pn * tstep;
    S.a_ready(cur);
    if constexpr (SP2) {
        PG8_STAGE(PG8_SB(0, 0), cB, voffB); PG8_STAGE(PG8_SB(0, 1), cB + hstep, voffB); PG8_STAGE(PG8_SA(0, 0), cA, voffA); PG8_STAGE(PG8_SA(0, 1), cA + hstep, voffA);
        if (wr == 1) PG8_BAR;
        PG8_WAIT_V(2); PG8_BAR;
        PG8_STAGE(PG8_SB(1, 0), cB + kstep, voffB); PG8_STAGE(PG8_SA(1, 0), cA + kstep, voffA); PG8_STAGE(PG8_SB(1, 1), cB + hstep + kstep, voffB);
        PG8_WAIT_V(6); PG8_BAR;
    } else {
        PG8_STAGE(PG8_SB(0, 0), cB, voffB); PG8_STAGE(PG8_SA(0, 0), cA, voffA); PG8_STAGE(PG8_SB(0, 1), cB + hstep, voffB); PG8_STAGE(PG8_SA(0, 1), cA + hstep, voffA);
        if (wr == 1) PG8_BAR;
        PG8_WAIT_V(4); PG8_BAR;
        PG8_STAGE(PG8_SB(1, 0), cB + kstep, voffB); PG8_STAGE(PG8_SA(1, 0), cA + kstep, voffA); PG8_STAGE(PG8_SB(1, 1), cB + hstep + kstep, voffB);
        PG8_WAIT_V(6); PG8_BAR;
    }
    for (;;) {
        const bool has_next = S.next(ui + 1, nxt);
        const char* nA = has_next ? (const char*)g.A + (size_t)nxt.pm * tstep : cA; const char* nB = has_next ? (const char*)g.Bt + (size_t)nxt.pn * tstep : cB;
        for (int t = 0; t < nt; t += 2) {
            const bool last = (t == nt - 2);
            const char* a1 = cA + (size_t)(t + 1) * kstep;
            const char* a2 = last ? nA : cA + (size_t)(t + 2) * kstep; const char* b2 = last ? nB : cB + (size_t)(t + 2) * kstep;
            const char* a3 = a2 + kstep; const char* b3 = b2 + kstep;
            if (last && has_next) S.a_ready(nxt);
            if constexpr (SP2) {
            PG8_LDB(B0, 0, 0); PG8_LDB(B1, 0, 1); PG8_SCHED; PG8_LDA(At, 0, 0); PG8_STAGE(PG8_SA(1, 1), a1 + hstep, voffA);
            PG8_WAIT_V(8); PG8_WAIT_L(0); PG8_BAR; PG8_MMA(0, 0, At, B0); PG8_MMA(0, 1, At, B1); PG8_BAR; PG8_SCHED;
            PG8_LDA(At, 0, 1); PG8_STAGE(PG8_SB(0, 0), b2, voffB); PG8_STAGE(PG8_SB(0, 1), b2 + hstep, voffB); PG8_STAGE(PG8_SA(0, 0), a2, voffA);
            PG8_WAIT_V(8); PG8_WAIT_L(0); PG8_BAR; PG8_MMA(1, 0, At, B0); PG8_MMA(1, 1, At, B1); PG8_BAR; PG8_SCHED;
            PG8_LDB(B0, 1, 0); PG8_LDB(B1, 1, 1); PG8_SCHED; PG8_LDA(At, 1, 0); PG8_STAGE(PG8_SA(0, 1), a2 + hstep, voffA);
            PG8_WAIT_V(8); PG8_WAIT_L(0); PG8_BAR; PG8_MMA(0, 0, At, B0); PG8_MMA(0, 1, At, B1); PG8_BAR; PG8_SCHED;
            PG8_LDA(At, 1, 1); PG8_STAGE(PG8_SB(1, 0), b3, voffB); PG8_STAGE(PG8_SB(1, 1), b3 + hstep, voffB); PG8_STAGE(PG8_SA(1, 0), a3, voffA);
            PG8_WAIT_V(8); PG8_WAIT_L(0); PG8_BAR; PG8_MMA(1, 0, At, B0); PG8_MMA(1, 1, At, B1); PG8_BAR; PG8_SCHED;
            } else {
            PG8_LDB(B0, 0, 0); PG8_SCHED; PG8_LDA(At, 0, 0); PG8_STAGE(PG8_SA(1, 1), a1 + hstep, voffA);
            PG8_WAIT_L(8); PG8_BAR; PG8_WAIT_L(0); PG8_MMA(0, 0, At, B0); PG8_BAR; PG8_SCHED;
            PG8_LDB(B1, 0, 1); PG8_STAGE(PG8_SB(0, 0), b2, voffB);
            PG8_BAR; PG8_WAIT_L(0); PG8_MMA(0, 1, At, B1); PG8_BAR;
            PG8_LDA(At, 0, 1); PG8_STAGE(PG8_SA(0, 0), a2, voffA);
            PG8_BAR; PG8_WAIT_L(0); PG8_MMA(1, 0, At, B0); PG8_BAR; PG8_SCHED;
            PG8_STAGE(PG8_SB(0, 1), b2 + hstep, voffB);
            PG8_WAIT_V(6); PG8_BAR; PG8_MMA(1, 1, At, B1); PG8_BAR;
            PG8_LDB(B0, 1, 0); PG8_SCHED; PG8_LDA(At, 1, 0); PG8_STAGE(PG8_SA(0, 1), a2 + hstep, voffA);
            PG8_WAIT_L(8); PG8_BAR; PG8_WAIT_L(0); PG8_MMA(0, 0, At, B0); PG8_BAR; PG8_SCHED;
            PG8_LDB(B1, 1, 1); PG8_STAGE(PG8_SB(1, 0), b3, voffB);
            PG8_BAR; PG8_WAIT_L(0); PG8_MMA(0, 1, At, B1); PG8_BAR;
            PG8_LDA(At, 1, 1); PG8_STAGE(PG8_SA(1, 0), a3, voffA);
            PG8_BAR; PG8_WAIT_L(0); PG8_MMA(1, 0, At, B0); PG8_BAR; PG8_SCHED;
            PG8_STAGE(PG8_SB(1, 1), b3 + hstep, voffB);
            PG8_WAIT_V(6); PG8_BAR; PG8_MMA(1, 1, At, B1); PG8_BAR;
            }
        }
        if constexpr (ALIGN_EPI) { if (wr == 0) PG8_BAR; }
        if constexpr (!Epi::AFTER_DRAIN) { E(acc, cur, wr, wc, fr, fq); S.done(cur); }
        if (!has_next) break;
#pragma unroll
        for (int a = 0; a < 2; ++a)
#pragma unroll
            for (int b = 0; b < 2; ++b)
#pragma unroll
                for (int m = 0; m < 4; ++m)
#pragma unroll
                    for (int n = 0; n < 2; ++n) acc[a][b][m][n] = (f32x4){0.f, 0.f, 0.f, 0.f};
        cur = nxt; cA = nA; cB = nB; ++ui;
        if constexpr (ALIGN_EPI) { if (wr == 1) PG8_BAR; }
    }
    PG8_WAIT_V(0);
    if constexpr (!ALIGN_EPI) { if (wr == 0) PG8_BAR; }
    PG8_BAR;
    if constexpr (Epi::AFTER_DRAIN) { E.fused(acc, cur, wr, wc, fr, fq, lds, wid, lane); S.done(cur); }
#undef PG8_SA
#undef PG8_SB
#undef PG8_STAGE
#undef PG8_LDA
#undef PG8_LDB
#undef PG8_MMA
#undef PG8_WAIT_V
#undef PG8_WAIT_L
#undef PG8_BAR
#undef PG8_SCHED
}
}

namespace pg8 {
struct EpiSwiglu {
    static constexpr bool PERM = false, AFTER_DRAIN = false;
    bf16_t* O; int ldo;
    __device__ __forceinline__ void operator()(const f32x4 (&acc)[2][2][4][2], const Unit& u, int wr, int wc, int fr, int fq) const {
        const int row0 = u.pm * BM + wr * 64 + fr;
#pragma unroll
        for (int ai = 0; ai < 2; ++ai)
#pragma unroll
            for (int m = 0; m < 4; ++m) {
                bf16_t* rowp = O + (size_t)(row0 + ai * HALF + m * 16) * ldo;
#pragma unroll
                for (int bj = 0; bj < 2; ++bj) {
                    const int grp = u.pn * 8 + bj * 4 + wc;
                    const f32x4 g = acc[ai][bj][m][0], up = acc[ai][bj][m][1];
                    const float h0 = fast_silu(g[0]) * up[0], h1 = fast_silu(g[1]) * up[1], h2 = fast_silu(g[2]) * up[2], h3 = fast_silu(g[3]) * up[3];
                    u32x2 w; w.x = cvt_pk_bf16(h0, h1); w.y = cvt_pk_bf16(h2, h3);
                    *(u32x2*)(rowp + grp * 16 + 4 * fq) = w;
                }
            }
    }
};
}

DEV void phase_prep_ffn(const FP& p, LAS unsigned char* lds, int gw, int ngw, int wave, int lane) {
    LAS float* scr = (LAS float*)(lds + wave * 16384);
    const float *wg = p.in[33], *wu = p.in[34], *wd = p.in[35];
    bf16_t* GU = (bf16_t*)(p.ws + WS_W_GU); bf16_t* DN = (bf16_t*)(p.ws + WS_W_DOWN);
    constexpr int I_G = 16 * 88, I_D = 44 * 32;
    for (int it = gw; it < 2 * I_G + I_D; it += ngw) {
        int r = it;
        if (r < I_G) { transpose_item(wg, 1024, 2816, GU, r, scr, lane, RmGU{0}); continue; } r -= I_G;
        if (r < I_G) { transpose_item(wu, 1024, 2816, GU, r, scr, lane, RmGU{1}); continue; } r -= I_G;
        transpose_item(wd, 2816, 1024, DN, r, scr, lane, RmPlain{0});
    }
}
DEV void phase_ffn_gu(const FP& p, LAS unsigned char* lds, int G, int bid) {
    pg8::Gemm g{(const bf16_t*)(p.ws + WS_XN), (const bf16_t*)(p.ws + WS_W_GU), MP, 5632, 1024};
    pg8::StaticOrder S; S.init(MP, 5632, G, bid);
    pg8::EpiSwiglu E{(bf16_t*)(p.ws + WS_HID), 2816};
    pg8::gemm_phase<pg8::EpiSwiglu, pg8::StaticOrder, true, true>(lds, g, S, E);
}
DEV void phase_ffn_down(const FP& p, LAS unsigned char* lds, int G, int bid) {
    pg8::Gemm g{(const bf16_t*)(p.ws + WS_HID), (const bf16_t*)(p.ws + WS_W_DOWN), MP, 1024, 2816};
    pg8::StaticOrder S; S.init(MP, 1024, G, bid);
    pg8::EpiBf16<0> E{(bf16_t*)(p.ws + WS_RAW), 1024, nullptr, 0, 0, 1.f};
    pg8::gemm_phase<pg8::EpiBf16<0>, pg8::StaticOrder, true, true>(lds, g, S, E);
}

typedef short v4i16_t __attribute__((ext_vector_type(4)));
typedef float f32x2_t __attribute__((ext_vector_type(2)));
typedef __bf16 bf16x2_t __attribute__((ext_vector_type(2)));
DEV unsigned cvtpk(float lo, float hi) { f32x2_t v = {lo, hi}; bf16x2_t b = __builtin_convertvector(v, bf16x2_t); return __builtin_bit_cast(unsigned, b); }
DEV f32x16 mfma32(bf16x8 a, bf16x8 b, f32x16 c) { return __builtin_amdgcn_mfma_f32_32x32x16_bf16(a, b, c, 0, 0, 0); }
DEV s16x4 tr_read(LAS const unsigned char* p) { return __builtin_bit_cast(s16x4, __builtin_amdgcn_ds_read_tr16_b64_v4i16((LAS v4i16_t*)p)); }
DEV bf16x8 cat8(s16x4 lo, s16x4 hi) { return (bf16x8){lo[0], lo[1], lo[2], lo[3], hi[0], hi[1], hi[2], hi[3]}; }
DEV float half_max(float v) { auto rr = __builtin_amdgcn_permlane32_swap(__float_as_uint(v), __float_as_uint(v), false, false); return fmaxf(__uint_as_float(rr[0]), __uint_as_float(rr[1])); }
DEV float half_sum(float v) { auto rr = __builtin_amdgcn_permlane32_swap(__float_as_uint(v), __float_as_uint(v), false, false); return __uint_as_float(rr[0]) + __uint_as_float(rr[1]); }
DEV bf16x8 pfrag(const f32x16& S, int s) {
    u32x4 w;
    if (s == 0) { w.x = cvtpk(S[0], S[1]); w.y = cvtpk(S[2], S[3]); w.z = cvtpk(S[4], S[5]); w.w = cvtpk(S[6], S[7]); }
    else { w.x = cvtpk(S[8], S[9]); w.y = cvtpk(S[10], S[11]); w.z = cvtpk(S[12], S[13]); w.w = cvtpk(S[14], S[15]); }
    return __builtin_bit_cast(bf16x8, w);
}
DEV float max16(const f32x16& S) {
    float a = fmaxf(fmaxf(S[0], S[1]), fmaxf(S[2], S[3])), b = fmaxf(fmaxf(S[4], S[5]), fmaxf(S[6], S[7]));
    float c = fmaxf(fmaxf(S[8], S[9]), fmaxf(S[10], S[11])), d = fmaxf(fmaxf(S[12], S[13]), fmaxf(S[14], S[15]));
    return fmaxf(fmaxf(a, b), fmaxf(c, d));
}

namespace pg8 {
struct EpiMemKV {
    static constexpr bool PERM = false, AFTER_DRAIN = false;
    float* ok; float* ov; bf16_t* bk; bf16_t* bv;
    __device__ __forceinline__ void operator()(const f32x4 (&acc)[2][2][4][2], const Unit& u, int wr, int wc, int fr, int fq) const {
        const int row0 = u.pm * BM + wr * 64 + fr; const bool isv = u.pn >= 4; const int colt = (u.pn & 3) * BM + wc * 32 + 4 * fq;
        float* of = isv ? ov : ok; bf16_t* ob = isv ? bv : bk;
#pragma unroll
        for (int ai = 0; ai < 2; ++ai)
#pragma unroll
            for (int m = 0; m < 4; ++m) {
                const size_t ro = (size_t)(row0 + ai * HALF + m * 16) * 1024;
#pragma unroll
                for (int bj = 0; bj < 2; ++bj)
#pragma unroll
                    for (int n = 0; n < 2; ++n) {
                        const f32x4 v = acc[ai][bj][m][n]; const int col = colt + bj * HALF + n * 16;
                        *(f32x4*)(of + ro + col) = v;
                        u32x2 w; w.x = cvt_pk_bf16(v[0], v[1]); w.y = cvt_pk_bf16(v[2], v[3]);
                        *(u32x2*)(ob + ro + col) = w;
                    }
            }
    }
};
}

DEV void phase_prep_x(const FP& p, LAS unsigned char* lds, int gw, int ngw, int wave, int lane) {
    LAS float* scr = (LAS float*)(lds + wave * 16384);
    constexpr int I_S = 16 * 32;
    for (int it = gw; it < 4 * I_S; it += ngw) {
        int r = it;
        if (r < I_S) { transpose_item(p.in[23], 1024, 1024, (bf16_t*)(p.ws + WS_W_Q), r, scr, lane, RmPlain{0}); continue; } r -= I_S;
        if (r < I_S) { transpose_item(p.in[24], 1024, 1024, (bf16_t*)(p.ws + WS_W_KV), r, scr, lane, RmPlain{0}); continue; } r -= I_S;
        if (r < I_S) { transpose_item(p.in[25], 1024, 1024, (bf16_t*)(p.ws + WS_W_KV), r, scr, lane, RmPlain{1024}); continue; } r -= I_S;
        transpose_item(p.in[26], 1024, 1024, (bf16_t*)(p.ws + WS_W_O), r, scr, lane, RmPlain{0});
    }
    row_phase(nullptr, p.in[8], nullptr, nullptr, p.in[22], (bf16_t*)(p.ws + WS_MN), 512, gw, ngw, lane);
}
DEV void phase_memkv(const FP& p, LAS unsigned char* lds, int G, int bid) {
    pg8::Gemm g{(const bf16_t*)(p.ws + WS_MN), (const bf16_t*)(p.ws + WS_W_KV), 512, 2048, 1024};
    pg8::StaticOrder S; S.init(512, 2048, G, bid);
    pg8::EpiMemKV E{p.out + 33822720, p.out + 34347008, (bf16_t*)(p.ws + WS_KM), (bf16_t*)(p.ws + WS_VM)};
    pg8::gemm_phase<pg8::EpiMemKV, pg8::StaticOrder, true, true>(lds, g, S, E);
}
DEV void phase_wq(const FP& p, LAS unsigned char* lds, int G, int bid) {
    pg8::Gemm g{(const bf16_t*)(p.ws + WS_XN), (const bf16_t*)(p.ws + WS_W_Q), MP, 1024, 1024};
    pg8::StaticOrder S; S.init(MP, 1024, G, bid);
    pg8::EpiBf16<0> E{(bf16_t*)(p.ws + WS_QX), 1024, nullptr, 1024, 0, 0.0625f * 1.4426950408889634f};
    pg8::gemm_phase<pg8::EpiBf16<0>, pg8::StaticOrder, true, true>(lds, g, S, E);
}
DEV void phase_wo(const FP& p, LAS unsigned char* lds, int G, int bid) {
    pg8::Gemm g{(const bf16_t*)(p.ws + WS_OX), (const bf16_t*)(p.ws + WS_W_O), MP, 1024, 1024};
    pg8::StaticOrder S; S.init(MP, 1024, G, bid);
    pg8::EpiBf16<0> E{(bf16_t*)(p.ws + WS_RAW), 1024, nullptr, 0, 0, 1.f};
    pg8::gemm_phase<pg8::EpiBf16<0>, pg8::StaticOrder, true, true>(lds, g, S, E);
}

DEV void phase_xattn(const FP& p, LAS unsigned char* lds, int G, int bid) {
    const int tid = threadIdx.x, lane = tid & 63, wave = __builtin_amdgcn_readfirstlane(tid >> 6), r = lane & 31, hh = lane >> 5, qb = wave & 3, eh = wave >> 2;
    const bf16_t* QX = (const bf16_t*)(p.ws + WS_QX); const bf16_t* KM = (const bf16_t*)(p.ws + WS_KM); const bf16_t* VM = (const bf16_t*)(p.ws + WS_VM);
    bf16_t* OX = (bf16_t*)(p.ws + WS_OX);
    constexpr int QOFF = 0, KOFF = 65536, VOFF = 98304;
    const int vlane = (4 * hh + ((lane & 15) >> 2)) * 64 + 32 * ((lane >> 4) & 1) + 8 * (lane & 3);
    for (int u = bid; u < 512; u += G) {
        const int bh = u & 7, b = bh >> 2, h = bh & 3, qblk = u >> 3;
        const size_t qrow0 = (size_t)b * 8192 + (size_t)qblk * 128;
#pragma unroll
        for (int j = 0; j < 8; ++j) {
            const int id = tid + 512 * j, row = id >> 5, ch = id & 31;
            const u32x4 v = *(const u32x4*)(QX + (qrow0 + row) * 1024 + h * 256 + ch * 8);
            *(LAS u32x4*)(lds + QOFF + row * 512 + ((ch ^ (row & 15)) << 4)) = v;
        }
        u32x4 kr[2], vr[2];
#pragma unroll
        for (int j = 0; j < 2; ++j) {
            const int id = tid + 512 * j, key = id >> 5, ch = id & 31;
            kr[j] = *(const u32x4*)(KM + ((size_t)b * 256 + key) * 1024 + h * 256 + ch * 8);
            vr[j] = *(const u32x4*)(VM + ((size_t)b * 256 + key) * 1024 + h * 256 + ch * 8);
        }
#pragma unroll
        for (int j = 0; j < 2; ++j) {
            const int id = tid + 512 * j, key = id >> 5, ch = id & 31;
            *(LAS u32x4*)(lds + KOFF + key * 512 + ((ch ^ (key & 15)) << 4)) = kr[j];
            *(LAS u32x4*)(lds + VOFF + (ch >> 2) * 2048 + key * 64 + (ch & 3) * 16) = vr[j];
        }
        __syncthreads();
        f32x16 O[4];
#pragma unroll
        for (int e = 0; e < 4; ++e)
#pragma unroll
            for (int i = 0; i < 16; ++i) O[e][i] = 0.f;
        float mrun = -1e30f, lsum = 0.f;
        const LAS unsigned char* qp = lds + QOFF + (32 * qb + r) * 512;
        for (int t = 0; t < 8; ++t) {
            const int buf = t & 1;
            if (t + 1 < 8) {
#pragma unroll
                for (int j = 0; j < 2; ++j) {
                    const int id = tid + 512 * j, key = id >> 5, ch = id & 31;
                    kr[j] = *(const u32x4*)(KM + ((size_t)b * 256 + 32 * (t + 1) + key) * 1024 + h * 256 + ch * 8);
                    vr[j] = *(const u32x4*)(VM + ((size_t)b * 256 + 32 * (t + 1) + key) * 1024 + h * 256 + ch * 8);
                }
            }
            const LAS unsigned char* kp = lds + KOFF + buf * 16384 + r * 512;
            const LAS unsigned char* vp = lds + VOFF + buf * 16384 + (4 * eh) * 2048 + vlane;
            f32x16 S;
#pragma unroll
            for (int i = 0; i < 16; ++i) S[i] = 0.f;
#pragma unroll 4
            for (int ks = 0; ks < 16; ++ks) {
                const int sl = ((2 * ks + hh) ^ (r & 15)) << 4;
                const bf16x8 a = *(const LAS bf16x8*)(kp + sl);
                const bf16x8 q = *(const LAS bf16x8*)(qp + sl);
                S = mfma32(a, q, S);
            }
            const float mx = half_max(max16(S));
            const float mnew = fmaxf(mrun, mx), alpha = __builtin_amdgcn_exp2f(mrun - mnew);
            mrun = mnew;
            float ps = 0.f;
#pragma unroll
            for (int i = 0; i < 16; ++i) { S[i] = __builtin_amdgcn_exp2f(S[i] - mnew); ps += S[i]; }
            lsum = lsum * alpha + ps;
#pragma unroll
            for (int e = 0; e < 4; ++e)
#pragma unroll
                for (int i = 0; i < 16; ++i) O[e][i] *= alpha;
            const bf16x8 P0 = pfrag(S, 0), P1 = pfrag(S, 1);
#pragma unroll
            for (int e = 0; e < 4; ++e) {
                const bf16x8 v0 = cat8(tr_read(vp + e * 2048), tr_read(vp + e * 2048 + 512));
                const bf16x8 v1 = cat8(tr_read(vp + e * 2048 + 1024), tr_read(vp + e * 2048 + 1536));
                O[e] = mfma32(v0, P0, O[e]);
                O[e] = mfma32(v1, P1, O[e]);
            }
            if (t + 1 < 8) {
#pragma unroll
                for (int j = 0; j < 2; ++j) {
                    const int id = tid + 512 * j, key = id >> 5, ch = id & 31;
                    *(LAS u32x4*)(lds + KOFF + (buf ^ 1) * 16384 + key * 512 + ((ch ^ (key & 15)) << 4)) = kr[j];
                    *(LAS u32x4*)(lds + VOFF + (buf ^ 1) * 16384 + (ch >> 2) * 2048 + key * 64 + (ch & 3) * 16) = vr[j];
                }
            }
            __syncthreads();
        }
        const float inv = 1.f / half_sum(lsum);
        LAS unsigned char* stg = lds + wave * 16384;
#pragma unroll
        for (int e = 0; e < 4; ++e)
#pragma unroll
            for (int g4 = 0; g4 < 4; ++g4) {
                u32x2 w; w.x = cvtpk(O[e][4 * g4 + 0] * inv, O[e][4 * g4 + 1] * inv); w.y = cvtpk(O[e][4 * g4 + 2] * inv, O[e][4 * g4 + 3] * inv);
                *(LAS u32x2*)(stg + r * 272 + (32 * e + 8 * g4 + 4 * hh) * 2) = w;
            }
        WAVE_SYNC();
#pragma unroll
        for (int i = 0; i < 8; ++i) {
            const int row = i * 4 + (lane >> 4), ch = lane & 15;
            const u32x4 v = *(const LAS u32x4*)(stg + row * 272 + ch * 16);
            *(u32x4*)(OX + (qrow0 + 32 * qb + row) * 1024 + h * 256 + 128 * eh + ch * 8) = v;
        }
        __syncthreads();
    }
}

constexpr float QSCALE = 0.125f * 1.4426950408889634f;
namespace pg8 {
struct EpiIn {
    static constexpr bool PERM = false, AFTER_DRAIN = false;
    bf16_t* ZX; bf16_t* Qb; bf16_t* Kb; bf16_t* Vb; float* okf; float* ovf; float* oconv;
    __device__ __forceinline__ void operator()(const f32x4 (&acc)[2][2][4][2], const Unit& u, int wr, int wc, int fr, int fq) const {
        const int row0 = u.pm * BM + wr * 64 + fr, pn = u.pn;
        if (pn < 6) {
#pragma unroll
            for (int ai = 0; ai < 2; ++ai)
#pragma unroll
                for (int m = 0; m < 4; ++m) {
                    const int row = row0 + ai * HALF + m * 16; const int t = row & 8191;
#pragma unroll
                    for (int bj = 0; bj < 2; ++bj)
#pragma unroll
                        for (int n = 0; n < 2; ++n) {
                            const f32x4 v = acc[ai][bj][m][n]; const int col = pn * BM + bj * HALF + wc * 32 + n * 16 + 4 * fq;
                            u32x2 w; w.x = cvt_pk_bf16(v[0], v[1]); w.y = cvt_pk_bf16(v[2], v[3]);
                            *(u32x2*)(ZX + (size_t)row * 1536 + col) = w;
                            if (pn >= 2 && t >= 8189) *(f32x4*)(oconv + (size_t)((row >> 13) * 3 + (t - 8189)) * 1024 + (col - 512)) = v;
                        }
                }
        } else if (pn < 10) {
            const bool isk = pn >= 8;
            const int g = wc & 1;
            float inv[4];
#pragma unroll
            for (int i = 0; i < 4; ++i) inv[i] = __builtin_amdgcn_exp2f(-(float)(16 * g + 4 * fq + i) * (13.287712379549449f / 32.f)) * 0.15915494309189535f;
#pragma unroll
            for (int ai = 0; ai < 2; ++ai)
#pragma unroll
                for (int m = 0; m < 4; ++m) {
                    const int row = row0 + ai * HALF + m * 16; const float pos = (float)(row & 8191);
                    float cs[4], sn[4];
#pragma unroll
                    for (int i = 0; i < 4; ++i) { float rev = pos * inv[i]; rev -= floorf(rev); sn[i] = __builtin_amdgcn_sinf(rev); cs[i] = __builtin_amdgcn_cosf(rev); }
#pragma unroll
                    for (int bj = 0; bj < 2; ++bj) {
                        const int cl = (pn & 1) * BM + bj * HALF + wc * 32;
                        const f32x4 x1 = acc[ai][bj][m][0], x2 = acc[ai][bj][m][1];
                        f32x4 o1, o2;
#pragma unroll
                        for (int i = 0; i < 4; ++i) { o1[i] = x1[i] * cs[i] - x2[i] * sn[i]; o2[i] = x2[i] * cs[i] + x1[i] * sn[i]; }
                        if (isk) {
                            float* kf = okf + (size_t)row * 512 + (cl >> 6) * 64 + 16 * g + 4 * fq;
                            *(f32x4*)kf = o1; *(f32x4*)(kf + 32) = o2;
                            u32x2 w; w.x = cvt_pk_bf16(o1[0], o1[1]); w.y = cvt_pk_bf16(o1[2], o1[3]);
                            *(u32x2*)(Kb + (size_t)row * 512 + cl + 4 * fq) = w;
                            w.x = cvt_pk_bf16(o2[0], o2[1]); w.y = cvt_pk_bf16(o2[2], o2[3]);
                            *(u32x2*)(Kb + (size_t)row * 512 + cl + 16 + 4 * fq) = w;
                        } else {
                            o1 = o1 * QSCALE; o2 = o2 * QSCALE;
                            u32x2 w; w.x = cvt_pk_bf16(o1[0], o1[1]); w.y = cvt_pk_bf16(o1[2], o1[3]);
                            *(u32x2*)(Qb + (size_t)row * 512 + cl + 4 * fq) = w;
                            w.x = cvt_pk_bf16(o2[0], o2[1]); w.y = cvt_pk_bf16(o2[2], o2[3]);
                            *(u32x2*)(Qb + (size_t)row * 512 + cl + 16 + 4 * fq) = w;
                        }
                    }
                }
        } else {
#pragma unroll
            for (int ai = 0; ai < 2; ++ai)
#pragma unroll
                for (int m = 0; m < 4; ++m) {
                    const int row = row0 + ai * HALF + m * 16;
#pragma unroll
                    for (int bj = 0; bj < 2; ++bj)
#pragma unroll
                        for (int n = 0; n < 2; ++n) {
                            const f32x4 v = acc[ai][bj][m][n]; const int col = (pn - 10) * BM + bj * HALF + wc * 32 + n * 16 + 4 * fq;
                            *(f32x4*)(ovf + (size_t)row * 512 + col) = v;
                            u32x2 w; w.x = cvt_pk_bf16(v[0], v[1]); w.y = cvt_pk_bf16(v[2], v[3]);
                            *(u32x2*)(Vb + (size_t)row * 512 + col) = w;
                        }
                }
        }
    }
};
}

DEV void phase_prep_mix(const FP& p, LAS unsigned char* lds, int gw, int ngw, int wave, int lane) {
    LAS float* scr = (LAS float*)(lds + wave * 16384);
    constexpr int I_IN = 16 * 97, I_OUT = 16 * 32;
    for (int it = gw; it < I_IN + I_OUT; it += ngw) {
        if (it < I_IN) transpose_item(p.in[9], 1024, 3080, (bf16_t*)(p.ws + WS_W_IN), it, scr, lane, RmIn{});
        else transpose_item(p.in[21], 1024, 1024, (bf16_t*)(p.ws + WS_W_OUT), it - I_IN, scr, lane, RmPlain{0});
    }
    __syncthreads();
    LAS float* wdt = (LAS float*)lds;
    for (int i = threadIdx.x; i < 8192; i += 512) wdt[i] = p.in[9][(size_t)(i >> 3) * 3080 + 1536 + (i & 7)];
    __syncthreads();
    const float* x = p.in[0]; const float* g = p.in[27]; bf16_t* xn = (bf16_t*)(p.ws + WS_XN); float* dtv = (float*)(p.ws + WS_DTV);
    const float bias = p.in[12][lane & 7];
    for (int r = gw; r < MP; r += ngw) {
        f32x4 h[4]; float ss = 0.f;
#pragma unroll
        for (int j = 0; j < 4; ++j) { h[j] = ((const f32x4*)(x + (size_t)r * 1024))[lane + 64 * j]; ss += h[j].x * h[j].x + h[j].y * h[j].y + h[j].z * h[j].z + h[j].w * h[j].w; }
        const float rs = rsqrtf(wave_sum(ss) * (1.f / 1024.f) + 1e-6f);
        float d[8];
#pragma unroll
        for (int k = 0; k < 8; ++k) d[k] = 0.f;
#pragma unroll
        for (int j = 0; j < 4; ++j) {
            const f32x4 gg = ((const f32x4*)g)[lane + 64 * j]; h[j] = h[j] * rs * gg;
            u32x2 w; w.x = pk2(h[j].x, h[j].y); w.y = pk2(h[j].z, h[j].w);
            ((u32x2*)(xn + (size_t)r * 1024))[lane + 64 * j] = w;
#pragma unroll
            for (int i = 0; i < 4; ++i) {
                const LAS f32x4* wp = (const LAS f32x4*)(wdt + (4 * (lane + 64 * j) + i) * 8);
                const f32x4 w0 = wp[0], w1 = wp[1]; const float hv = h[j][i];
                d[0] += hv * w0.x; d[1] += hv * w0.y; d[2] += hv * w0.z; d[3] += hv * w0.w; d[4] += hv * w1.x; d[5] += hv * w1.y; d[6] += hv * w1.z; d[7] += hv * w1.w;
            }
        }
#pragma unroll
        for (int k = 0; k < 8; ++k) d[k] = wave_sum(d[k]);
        float mine = d[0];
#pragma unroll
        for (int k = 1; k < 8; ++k) mine = ((lane & 7) == k) ? d[k] : mine;
        const float xx = mine + bias;
        if (lane < 8) dtv[(size_t)r * 8 + lane] = (xx > 20.f) ? xx : log1pf(expf(xx));
    }
    __syncthreads();
}
DEV void phase_inproj(const FP& p, LAS unsigned char* lds, int G, int bid) {
    pg8::Gemm g{(const bf16_t*)(p.ws + WS_XN), (const bf16_t*)(p.ws + WS_W_IN), MP, 3072, 1024};
    pg8::StaticOrder S; S.init(MP, 3072, G, bid);
    pg8::EpiIn E{(bf16_t*)(p.ws + WS_ZX), (bf16_t*)(p.ws + WS_Q), (bf16_t*)(p.ws + WS_K), (bf16_t*)(p.ws + WS_V), p.out + 16908288, p.out + 25296896, p.out + 33816576};
    pg8::gemm_phase<pg8::EpiIn, pg8::StaticOrder, true, true>(lds, g, S, E);
}
DEV void phase_outproj(const FP& p, LAS unsigned char* lds, int G, int bid) {
    pg8::Gemm g{(const bf16_t*)(p.ws + WS_CAT), (const bf16_t*)(p.ws + WS_W_OUT), MP, 1024, 1024};
    pg8::StaticOrder S; S.init(MP, 1024, G, bid);
    pg8::EpiBf16<0> E{(bf16_t*)(p.ws + WS_RAW), 1024, nullptr, 0, 0, 1.f};
    pg8::gemm_phase<pg8::EpiBf16<0>, pg8::StaticOrder, true, true>(lds, g, S, E);
}

DEV float ssd_tables(const FP& p, LAS float* tdt, LAS float* tac, size_t row0, int h, int lane) {
    const float dt = ((const float*)(p.ws + WS_DTV))[(row0 + lane) * 8 + h];
    const float a = -expf(p.in[13][h]);
    float v = dt * a;
#pragma unroll
    for (int o = 1; o < 64; o <<= 1) { const float t = __shfl_up(v, o); if (lane >= o) v += t; }
    tdt[lane * 8 + h] = dt; tac[lane * 8 + h] = v;
    return __shfl(v, 63);
}
template <class F> DEV void ssd_conv8(const FP& p, size_t row0, int col0, int l0, F emit) {
    const bf16_t* ZX = (const bf16_t*)(p.ws + WS_ZX);
    const float* cw = p.in[10]; const float* cb = p.in[11];
    f32x4 w[4][2], bias[2];
#pragma unroll
    for (int j = 0; j < 4; ++j) { w[j][0] = *(const f32x4*)(cw + j * 1024 + col0); w[j][1] = *(const f32x4*)(cw + j * 1024 + col0 + 4); }
    bias[0] = *(const f32x4*)(cb + col0); bias[1] = *(const f32x4*)(cb + col0 + 4);
    const int t0 = (int)(row0 & 8191);
    f32x4 u[4][2];
#pragma unroll
    for (int j = 0; j < 3; ++j) {
        const int l = l0 - 3 + j;
        if (t0 + l >= 0) {
            const u32x4 r = *(const u32x4*)(ZX + (row0 + l) * 1536 + 512 + col0);
            u[j][0] = (f32x4){bflo(r.x), bfhi(r.x), bflo(r.y), bfhi(r.y)}; u[j][1] = (f32x4){bflo(r.z), bfhi(r.z), bflo(r.w), bfhi(r.w)};
        } else { u[j][0] = (f32x4){0.f, 0.f, 0.f, 0.f}; u[j][1] = u[j][0]; }
    }
#pragma unroll
    for (int i = 0; i < 16; ++i) {
        const int l = l0 + i;
        const u32x4 r = *(const u32x4*)(ZX + (row0 + l) * 1536 + 512 + col0);
        u[3][0] = (f32x4){bflo(r.x), bfhi(r.x), bflo(r.y), bfhi(r.y)}; u[3][1] = (f32x4){bflo(r.z), bfhi(r.z), bflo(r.w), bfhi(r.w)};
        f32x4 a0 = bias[0] + w[0][0] * u[0][0] + w[1][0] * u[1][0] + w[2][0] * u[2][0] + w[3][0] * u[3][0];
        f32x4 a1 = bias[1] + w[0][1] * u[0][1] + w[1][1] * u[1][1] + w[2][1] * u[2][1] + w[3][1] * u[3][1];
#pragma unroll
        for (int k = 0; k < 4; ++k) { a0[k] = fast_silu(a0[k]); a1[k] = fast_silu(a1[k]); }
        emit(l, a0, a1);
        u[0][0] = u[1][0]; u[0][1] = u[1][1]; u[1][0] = u[2][0]; u[1][1] = u[2][1]; u[2][0] = u[3][0]; u[2][1] = u[3][1];
    }
}
constexpr int S_XS = 0, S_B = 65536, S_C = 98304, S_TDT = 131072, S_TAC = 133120, S_SSQ = 135168;
DEV int trlane(int lane) { return ((lane & 15) >> 2) * 64 + 32 * ((lane >> 4) & 1) + 8 * (lane & 3); }

DEV void phase_ssd1(const FP& p, LAS unsigned char* lds, int G, int bid) {
    const int tid = threadIdx.x, lane = tid & 63, wave = __builtin_amdgcn_readfirstlane(tid >> 6), hh = lane >> 5;
    LAS float* tdt = (LAS float*)(lds + S_TDT); LAS float* tac = (LAS float*)(lds + S_TAC);
    bf16_t* ST = (bf16_t*)(p.ws + WS_ST); float* cdec = (float*)(p.ws + WS_CDEC);
    for (int u = bid; u < 256; u += G) {
        const int b = u >> 7, c = u & 127; const size_t row0 = (size_t)b * 8192 + (size_t)c * 64;
        const float tot = ssd_tables(p, tdt, tac, row0, wave, lane);
        if (lane == 0) cdec[u * 8 + wave] = expf(tot);
        __syncthreads();
        { const int i = tid; const float t63 = tac[63 * 8 + (i & 7)]; const float s = tdt[i] * expf(t63 - tac[i]); __syncthreads(); tdt[i] = s; }
        __syncthreads();
        if (tid < 384) {
            const int cg = tid >> 2, tq = tid & 3, col0 = cg * 8;
            ssd_conv8(p, row0, col0, tq * 16, [&](int l, f32x4 a0, f32x4 a1) {
                u32x4 w;
                if (cg < 64) {
                    const int h = cg >> 3, pp = col0 & 63; const float s = tdt[l * 8 + h];
                    a0 = a0 * s; a1 = a1 * s;
                    w.x = pk2(a0[0], a0[1]); w.y = pk2(a0[2], a0[3]); w.z = pk2(a1[0], a1[1]); w.w = pk2(a1[2], a1[3]);
                    *(LAS u32x4*)(lds + S_XS + h * 8192 + (pp >> 5) * 4096 + l * 64 + (pp & 31) * 2) = w;
                } else {
                    const int n = col0 - 512, g = n >> 7, nn = n & 127;
                    w.x = pk2(a0[0], a0[1]); w.y = pk2(a0[2], a0[3]); w.z = pk2(a1[0], a1[1]); w.w = pk2(a1[2], a1[3]);
                    *(LAS u32x4*)(lds + S_B + g * 16384 + (nn >> 5) * 4096 + l * 64 + (nn & 31) * 2) = w;
                }
            });
        }
        __syncthreads();
        const int h = wave, g = h >> 2;
        const LAS unsigned char* xa = lds + S_XS + h * 8192 + hh * 512 + trlane(lane);
        const LAS unsigned char* ba = lds + S_B + g * 16384 + hh * 512 + trlane(lane);
        bf16_t* sp = ST + ((size_t)u * 8 + h) * 8192;
#pragma unroll 1
        for (int nh = 0; nh < 2; ++nh) {
            f32x16 acc[2][2];
#pragma unroll
            for (int a = 0; a < 2; ++a)
#pragma unroll
                for (int n = 0; n < 2; ++n)
#pragma unroll
                    for (int i = 0; i < 16; ++i) acc[a][n][i] = 0.f;
#pragma unroll 2
            for (int s = 0; s < 4; ++s) {
                bf16x8 af[2], bfr[2];
#pragma unroll
                for (int a = 0; a < 2; ++a) af[a] = cat8(tr_read(xa + a * 4096 + s * 1024), tr_read(xa + a * 4096 + s * 1024 + 256));
#pragma unroll
                for (int n = 0; n < 2; ++n) bfr[n] = cat8(tr_read(ba + (2 * nh + n) * 4096 + s * 1024), tr_read(ba + (2 * nh + n) * 4096 + s * 1024 + 256));
#pragma unroll
                for (int a = 0; a < 2; ++a)
#pragma unroll
                    for (int n = 0; n < 2; ++n) acc[a][n] = mfma32(af[a], bfr[n], acc[a][n]);
            }
#pragma unroll
            for (int a = 0; a < 2; ++a)
#pragma unroll
                for (int n = 0; n < 2; ++n)
#pragma unroll
                    for (int i = 0; i < 16; ++i) {
                        const int pr = 32 * a + (i & 3) + 8 * (i >> 2) + 4 * hh;
                        sp[pr * 128 + 32 * (2 * nh + n) + (lane & 31)] = (bf16_t)f2bf(acc[a][n][i]);
                    }
        }
        __syncthreads();
    }
}

DEV void phase_ssd2(const FP& p, int G, int bid) {
    const int tid = threadIdx.x;
    unsigned* ST = (unsigned*)(p.ws + WS_ST); const float* cdec = (const float*)(p.ws + WS_CDEC); float* pssm = p.out + 33685504;
    for (int blk = bid; blk < 128; blk += G) {
        const int idx = blk * 512 + tid;
        const int n2 = idx & 63, pr = (idx >> 6) & 63, h = (idx >> 12) & 7, b = idx >> 15;
        float s0 = 0.f, s1 = 0.f;
        for (int c0 = 0; c0 < 128; c0 += 16) {
            unsigned v[16];
#pragma unroll
            for (int j = 0; j < 16; ++j) v[j] = ST[(((size_t)(b * 128 + c0 + j) * 8 + h) * 64 + pr) * 64 + n2];
#pragma unroll
            for (int j = 0; j < 16; ++j) {
                const float dc = cdec[(b * 128 + c0 + j) * 8 + h];
                ST[(((size_t)(b * 128 + c0 + j) * 8 + h) * 64 + pr) * 64 + n2] = pk2(s0, s1);
                s0 = s0 * dc + bflo(v[j]); s1 = s1 * dc + bfhi(v[j]);
            }
        }
        float2 o; o.x = s0; o.y = s1;
        ((float2*)pssm)[(((size_t)b * 8 + h) * 64 + pr) * 64 + n2] = o;
    }
}

DEV void phase_ssd3(const FP& p, LAS unsigned char* lds, int G, int bid) {
    LAS float* tdt = (LAS float*)(lds + S_TDT); LAS float* tac = (LAS float*)(lds + S_TAC); LAS float* ssq = (LAS float*)(lds + S_SSQ);
    const bf16_t* ST = (const bf16_t*)(p.ws + WS_ST); const bf16_t* ZX = (const bf16_t*)(p.ws + WS_ZX); bf16_t* CAT = (bf16_t*)(p.ws + WS_CAT);
    for (int u = bid; u < 256; u += G) {
        int tid = threadIdx.x; asm volatile("" : "+v"(tid));
        const int lane = tid & 63, wave = __builtin_amdgcn_readfirstlane(tid >> 6), r = lane & 31, hh = lane >> 5;
        const int b = u >> 7, c = u & 127; const size_t row0 = (size_t)b * 8192 + (size_t)c * 64;
        (void)ssd_tables(p, tdt, tac, row0, wave, lane);
        {
            const int cg = tid >> 2, tq = tid & 3, col0 = cg * 8;
            ssd_conv8(p, row0, col0, tq * 16, [&](int l, f32x4 a0, f32x4 a1) {
                u32x4 w; w.x = pk2(a0[0], a0[1]); w.y = pk2(a0[2], a0[3]); w.z = pk2(a1[0], a1[1]); w.w = pk2(a1[2], a1[3]);
                if (cg < 64) {
                    const int h = cg >> 3, pp = col0 & 63;
                    *(LAS u32x4*)(lds + S_XS + h * 8192 + (pp >> 5) * 4096 + l * 64 + (pp & 31) * 2) = w;
                } else {
                    const int n = (col0 - 512) & 255, g = n >> 7, ch = (n & 127) >> 3;
                    *(LAS u32x4*)(lds + (col0 < 768 ? S_B : S_C) + g * 16384 + l * 256 + ((ch ^ (l & 15)) << 4)) = w;
                }
            });
        }
        __syncthreads();
        const int h = wave, g = h >> 2;
        f32x16 Y[2][2];
#pragma unroll
        for (int a = 0; a < 2; ++a)
#pragma unroll
            for (int l2 = 0; l2 < 2; ++l2)
#pragma unroll
                for (int i = 0; i < 16; ++i) Y[a][l2][i] = 0.f;
        const LAS unsigned char* cp = lds + S_C + g * 16384 + r * 256;
        const LAS unsigned char* bp = lds + S_B + g * 16384 + r * 256;
        const bf16_t* pv = ST + ((size_t)u * 8 + h) * 8192 + (size_t)r * 128 + 8 * hh;
#pragma unroll 2
        for (int ks = 0; ks < 8; ++ks) {
            const int sl = ((2 * ks + hh) ^ (r & 15)) << 4;
            const bf16x8 c0 = *(const LAS bf16x8*)(cp + sl), c1 = *(const LAS bf16x8*)(cp + 32 * 256 + sl);
            const bf16x8 p0 = *(const bf16x8*)(pv + 16 * ks), p1 = *(const bf16x8*)(pv + 32 * 128 + 16 * ks);
            Y[0][0] = mfma32(p0, c0, Y[0][0]); Y[0][1] = mfma32(p0, c1, Y[0][1]);
            Y[1][0] = mfma32(p1, c0, Y[1][0]); Y[1][1] = mfma32(p1, c1, Y[1][1]);
        }
        float acl[2];
#pragma unroll
        for (int l2 = 0; l2 < 2; ++l2) {
            acl[l2] = tac[(32 * l2 + r) * 8 + h]; const float e = expf(acl[l2]);
#pragma unroll
            for (int a = 0; a < 2; ++a)
#pragma unroll
                for (int i = 0; i < 16; ++i) Y[a][l2][i] *= e;
        }
        __builtin_amdgcn_sched_barrier(0);
        const LAS unsigned char* xa = lds + S_XS + h * 8192 + hh * 256 + trlane(lane);
#pragma unroll
        for (int lb = 0; lb < 2; ++lb)
#pragma unroll
            for (int sb = 0; sb <= lb; ++sb) {
                f32x16 T;
#pragma unroll
                for (int i = 0; i < 16; ++i) T[i] = 0.f;
#pragma unroll 2
                for (int ks = 0; ks < 8; ++ks) {
                    const int sl = ((2 * ks + hh) ^ (r & 15)) << 4;
                    const bf16x8 bb = *(const LAS bf16x8*)(bp + sb * 32 * 256 + sl), cc = *(const LAS bf16x8*)(cp + lb * 32 * 256 + sl);
                    T = mfma32(bb, cc, T);
                }
#pragma unroll
                for (int i = 0; i < 16; ++i) {
                    const int s = 32 * sb + (i & 3) + 8 * (i >> 2) + 4 * hh;
                    const float f = tdt[s * 8 + h] * __builtin_amdgcn_exp2f(1.4426950408889634f * fminf(acl[lb] - tac[s * 8 + h], 0.f));
                    T[i] = (s <= 32 * lb + r) ? T[i] * f : 0.f;
                }
                const bf16x8 P0 = pfrag(T, 0), P1 = pfrag(T, 1);
#pragma unroll
                for (int a = 0; a < 2; ++a) {
                    const bf16x8 x0 = cat8(tr_read(xa + a * 4096 + (2 * sb) * 1024), tr_read(xa + a * 4096 + (2 * sb) * 1024 + 512));
                    const bf16x8 x1 = cat8(tr_read(xa + a * 4096 + (2 * sb + 1) * 1024), tr_read(xa + a * 4096 + (2 * sb + 1) * 1024 + 512));
                    Y[a][lb] = mfma32(x0, P0, Y[a][lb]);
                    Y[a][lb] = mfma32(x1, P1, Y[a][lb]);
                }
            }
        __builtin_amdgcn_sched_barrier(0);
        const float Dh = p.in[14][h];
        float sq[2] = {0.f, 0.f};
#pragma unroll
        for (int a = 0; a < 2; ++a)
#pragma unroll
            for (int l2 = 0; l2 < 2; ++l2) {
                const int l = 32 * l2 + r;
#pragma unroll
                for (int g4 = 0; g4 < 4; ++g4) {
                    const int pp = 8 * g4 + 4 * hh;
                    const u32x2 xw = *(const LAS u32x2*)(lds + S_XS + h * 8192 + a * 4096 + l * 64 + pp * 2);
                    const u32x2 zw = *(const u32x2*)(ZX + (row0 + l) * 1536 + h * 64 + 32 * a + pp);
                    const float xv[4] = {bflo(xw.x), bfhi(xw.x), bflo(xw.y), bfhi(xw.y)}, zv[4] = {bflo(zw.x), bfhi(zw.x), bflo(zw.y), bfhi(zw.y)};
#pragma unroll
                    for (int i = 0; i < 4; ++i) { const float v = (Y[a][l2][4 * g4 + i] + Dh * xv[i]) * fast_silu(zv[i]); Y[a][l2][4 * g4 + i] = v; sq[l2] += v * v; }
                }
            }
#pragma unroll
        for (int l2 = 0; l2 < 2; ++l2) { sq[l2] = half_sum(sq[l2]); if (hh == 0) ssq[(h * 2 + l2) * 32 + r] = sq[l2]; }
        __syncthreads();
        float rs[2];
#pragma unroll
        for (int l2 = 0; l2 < 2; ++l2) {
            float t = 0.f;
#pragma unroll
            for (int k = 0; k < 4; ++k) t += ssq[((4 * g + k) * 2 + l2) * 32 + r];
            rs[l2] = rsqrtf(t * (1.f / 256.f) + 1e-5f);
        }
#pragma unroll
        for (int a = 0; a < 2; ++a)
#pragma unroll
            for (int g4 = 0; g4 < 4; ++g4) {
                const int pcol = h * 64 + 32 * a + 8 * g4 + 4 * hh;
                const f32x4 w = *(const f32x4*)(p.in[15] + pcol);
#pragma unroll
                for (int l2 = 0; l2 < 2; ++l2) {
                    u32x2 o; o.x = cvtpk(Y[a][l2][4 * g4 + 0] * rs[l2] * w[0], Y[a][l2][4 * g4 + 1] * rs[l2] * w[1]);
                    o.y = cvtpk(Y[a][l2][4 * g4 + 2] * rs[l2] * w[2], Y[a][l2][4 * g4 + 3] * rs[l2] * w[3]);
                    *(u32x2*)(CAT + (row0 + 32 * l2 + r) * 1024 + pcol) = o;
                }
            }
        __syncthreads();
    }
}

DEV void phase_attn(const FP& p, LAS unsigned char* lds, int G, int bid) {
    const int tid0 = threadIdx.x, lane0 = tid0 & 63;
    const bf16_t* Qg = (const bf16_t*)(p.ws + WS_Q); const bf16_t* Kg = (const bf16_t*)(p.ws + WS_K); const bf16_t* Vg = (const bf16_t*)(p.ws + WS_V);
    bf16_t* CAT = (bf16_t*)(p.ws + WS_CAT);
    const float lam_init = 0.2f;
    const float lam = expf(wave_sum(p.in[16][lane0] * p.in[17][lane0])) - expf(wave_sum(p.in[18][lane0] * p.in[19][lane0])) + lam_init;
    LAS float* subw = (LAS float*)(lds + 131072);
    if (tid0 < 128) subw[tid0] = p.in[20][tid0];
    for (int pu = bid; pu < 256; pu += G) {
        const int bh = pu & 7, b = bh >> 2, h = bh & 3, pr = pu >> 3;
        for (int half = 0; half < 2; ++half) {
            int tid = threadIdx.x; asm volatile("" : "+v"(tid));
            const int lane = tid & 63, wave = __builtin_amdgcn_readfirstlane(tid >> 6), r = lane & 31, hh = lane >> 5, qb = wave & 3, c = wave >> 2;
            const int vlane = (4 * hh) * 64 + trlane(lane);
            const int jq = half ? 63 - pr : pr;
            const size_t rowb = (size_t)b * 8192; const int q0 = jq * 128;
            const int ntb = 2 * jq + 2, myn = 2 * jq + (qb >> 1) + 1;
            bf16x8 qf[4];
#pragma unroll
            for (int ks = 0; ks < 4; ++ks) qf[ks] = *(const bf16x8*)(Qg + (rowb + q0 + 32 * qb + r) * 512 + h * 128 + c * 64 + 16 * ks + 8 * hh);
            u32x4 kr[2], vr[2];
#pragma unroll
            for (int j = 0; j < 2; ++j) {
                const int id = tid + 512 * j, key = id >> 4, ch = id & 15;
                kr[j] = *(const u32x4*)(Kg + (rowb + key) * 512 + h * 128 + ch * 8);
                vr[j] = *(const u32x4*)(Vg + (rowb + key) * 512 + h * 128 + ch * 8);
            }
#pragma unroll
            for (int j = 0; j < 2; ++j) {
                const int id = tid + 512 * j, key = id >> 4, ch = id & 15;
                *(LAS u32x4*)(lds + (ch >> 3) * 8192 + key * 128 + (((ch & 7) ^ ((key >> 1) & 7)) << 4)) = kr[j];
                *(LAS u32x4*)(lds + 16384 + (ch >> 2) * 4096 + key * 64 + (ch & 3) * 16) = vr[j];
            }
            __syncthreads();
            f32x16 O[4];
#pragma unroll
            for (int e = 0; e < 4; ++e)
#pragma unroll
                for (int i = 0; i < 16; ++i) O[e][i] = 0.f;
            float mrun = -1e30f, lsum = 0.f;
            for (int t = 0; t < ntb; ++t) {
                const int buf = t & 1;
                if (t + 1 < ntb) {
#pragma unroll
                    for (int j = 0; j < 2; ++j) {
                        const int id = tid + 512 * j, key = id >> 4, ch = id & 15;
                        kr[j] = *(const u32x4*)(Kg + (rowb + 64 * (t + 1) + key) * 512 + h * 128 + ch * 8);
                        vr[j] = *(const u32x4*)(Vg + (rowb + 64 * (t + 1) + key) * 512 + h * 128 + ch * 8);
                    }
                }
                if (t < myn) {
                    const LAS unsigned char* kp = lds + buf * 32768 + c * 8192 + r * 128;
                    const LAS unsigned char* vp = lds + buf * 32768 + 16384 + vlane;
                    f32x16 S0, S1;
#pragma unroll
                    for (int i = 0; i < 16; ++i) { S0[i] = 0.f; S1[i] = 0.f; }
#pragma unroll
                    for (int ks = 0; ks < 4; ++ks) {
                        const int sl = ((2 * ks + hh) ^ ((r >> 1) & 7)) << 4;
                        const bf16x8 a0 = *(const LAS bf16x8*)(kp + sl), a1 = *(const LAS bf16x8*)(kp + 32 * 128 + sl);
                        S0 = mfma32(a0, qf[ks], S0); S1 = mfma32(a1, qf[ks], S1);
                    }
                    const float mx = half_max(fmaxf(max16(S0), max16(S1)));
                    const float mnew = fmaxf(mrun, mx), alpha = __builtin_amdgcn_exp2f(mrun - mnew);
                    mrun = mnew;
                    float ps = 0.f;
#pragma unroll
                    for (int i = 0; i < 16; ++i) { S0[i] = __builtin_amdgcn_exp2f(S0[i] - mnew); S1[i] = __builtin_amdgcn_exp2f(S1[i] - mnew); ps += S0[i] + S1[i]; }
                    lsum = lsum * alpha + ps;
#pragma unroll
                    for (int e = 0; e < 4; ++e)
#pragma unroll
                        for (int i = 0; i < 16; ++i) O[e][i] *= alpha;
                    const bf16x8 P0 = pfrag(S0, 0), P1 = pfrag(S0, 1), P2 = pfrag(S1, 0), P3 = pfrag(S1, 1);
#pragma unroll
                    for (int e = 0; e < 4; ++e) {
                        const bf16x8 v0 = cat8(tr_read(vp + e * 4096), tr_read(vp + e * 4096 + 512));
                        const bf16x8 v1 = cat8(tr_read(vp + e * 4096 + 1024), tr_read(vp + e * 4096 + 1536));
                        const bf16x8 v2 = cat8(tr_read(vp + e * 4096 + 2048), tr_read(vp + e * 4096 + 2560));
                        const bf16x8 v3 = cat8(tr_read(vp + e * 4096 + 3072), tr_read(vp + e * 4096 + 3584));
                        O[e] = mfma32(v0, P0, O[e]); O[e] = mfma32(v1, P1, O[e]); O[e] = mfma32(v2, P2, O[e]); O[e] = mfma32(v3, P3, O[e]);
                        if (e & 1) __builtin_amdgcn_sched_barrier(0);
                    }
                }
                if (t + 1 < ntb) {
#pragma unroll
                    for (int j = 0; j < 2; ++j) {
                        const int id = tid + 512 * j, key = id >> 4, ch = id & 15;
                        *(LAS u32x4*)(lds + (buf ^ 1) * 32768 + (ch >> 3) * 8192 + key * 128 + (((ch & 7) ^ ((key >> 1) & 7)) << 4)) = kr[j];
                        *(LAS u32x4*)(lds + (buf ^ 1) * 32768 + 16384 + (ch >> 2) * 4096 + key * 64 + (ch & 3) * 16) = vr[j];
                    }
                }
                __syncthreads();
            }
            const float inv = 1.f / half_sum(lsum);
            LAS float* xch = (LAS float*)(lds + qb * 16384);
            if (c == 1) {
                const float f = -lam * inv;
#pragma unroll
                for (int e = 0; e < 4; ++e)
#pragma unroll
                    for (int i = 0; i < 16; ++i) xch[(e * 16 + i) * 64 + lane] = O[e][i] * f;
            }
            __syncthreads();
            if (c == 0) {
                float ss = 0.f;
#pragma unroll
                for (int e = 0; e < 4; ++e)
#pragma unroll
                    for (int i = 0; i < 16; ++i) { const float v = O[e][i] * inv + xch[(e * 16 + i) * 64 + lane]; O[e][i] = v; ss += v * v; }
                ss = half_sum(ss);
                const float rs = rsqrtf(ss * (1.f / 128.f) + 1e-5f) * (1.f - lam_init);
                WAVE_SYNC();
                LAS unsigned char* stg = lds + qb * 16384;
#pragma unroll
                for (int e = 0; e < 4; ++e)
#pragma unroll
                    for (int g4 = 0; g4 < 4; ++g4) {
                        const int e0 = 32 * e + 8 * g4 + 4 * hh;
                        const f32x4 w = *(const LAS f32x4*)(subw + e0);
                        u32x2 o; o.x = cvtpk(O[e][4 * g4 + 0] * rs * w[0], O[e][4 * g4 + 1] * rs * w[1]); o.y = cvtpk(O[e][4 * g4 + 2] * rs * w[2], O[e][4 * g4 + 3] * rs * w[3]);
                        *(LAS u32x2*)(stg + r * 272 + e0 * 2) = o;
                    }
                WAVE_SYNC();
#pragma unroll
                for (int i = 0; i < 8; ++i) {
                    const int row = i * 4 + (lane >> 4), ch = lane & 15;
                    const u32x4 v = *(const LAS u32x4*)(stg + row * 272 + ch * 16);
                    *(u32x4*)(CAT + (rowb + q0 + 32 * qb + row) * 1024 + 512 + h * 128 + ch * 8) = v;
                }
            }
            __syncthreads();
        }
    }
}

namespace cg = cooperative_groups;
struct SampleBufs { float *hn, *z, *raw, *act, *q, *dtr, *dtv, *ypre, *cat, *mix, *G, *U; };
DEV SampleBufs sample_bufs(unsigned char* ws) {
    SampleBufs s; float* b = (float*)(ws + WS_SMP);
    s.hn = b; b += 128 * 1024; s.z = b; b += 128 * 512; s.raw = b; b += 128 * 1024; s.act = b; b += 128 * 1024; s.q = b; b += 128 * 512;
    s.dtr = b; b += 128 * 8; s.dtv = b; b += 128 * 8; s.ypre = b; b += 128 * 512; s.cat = b; b += 128 * 1024; s.mix = b; b += 128 * 1024;
    s.G = b; b += 128 * 2816; s.U = b;
    return s;
}
__global__ void __launch_bounds__(512, 2) k_mega(FP p) {
    extern __shared__ __attribute__((aligned(16))) unsigned char lds_raw[];
    LAS unsigned char* lds = (LAS unsigned char*)lds_raw;
    cg::grid_group grid = cg::this_grid();
    const int tid = threadIdx.x, lane = tid & 63, wave = __builtin_amdgcn_readfirstlane(tid >> 6);
    const int G = gridDim.x, bid = blockIdx.x, gw = bid * 8 + wave, ngw = G * 8;
    float* y = p.out; float* ys = p.out + 16777216;
    const SampleBufs s = sample_bufs(p.ws);
    const float* xs = p.in[1];
    float* s_k = p.out + 34871296; float* s_v = p.out + 34936832; float* s_ssm = p.out + 35002368; float* s_conv = p.out + 35526656;
    const float* w_in = p.in[9];
    phase_prep_x(p, lds, gw, ngw, wave, lane); phase_prep_ffn(p, lds, gw, ngw, wave, lane); phase_prep_mix(p, lds, gw, ngw, wave, lane);
    d_rmsnorm(xs, p.in[27], nullptr, s.hn, 128, 1e-6f, bid, G, lds);
    grid.sync();
    phase_inproj(p, lds, G, bid);
    __syncthreads();
    d_gemm(s.hn, 1024, w_in + 0, 3080, s.z, 512, 128, 512, 1024, bid, G, lds);
    d_gemm(s.hn, 1024, w_in + 512, 3080, s.raw, 1024, 128, 1024, 1024, bid, G, lds);
    d_gemm(s.hn, 1024, w_in + 1536, 3080, s.dtr, 8, 128, 8, 1024, bid, G, lds);
    d_gemm(s.hn, 1024, w_in + 1544, 3080, s.q, 512, 128, 512, 1024, bid, G, lds);
    d_gemm(s.hn, 1024, w_in + 2056, 3080, s_k, 512, 128, 512, 1024, bid, G, lds);
    d_gemm(s.hn, 1024, w_in + 2568, 3080, s_v, 512, 128, 512, 1024, bid, G, lds);
    grid.sync();
    phase_ssd1(p, lds, G, bid);
    phase_memkv(p, lds, G, bid);
    d_conv(s.raw, p.in[5], p.in[10], p.in[11], s.act, s_conv, 8, 16, bid, G, lds);
    d_dt(s.dtr, p.in[12], s.dtv, 128 * 8, bid, G, lds);
    d_rope(s.q, 8, 16, 2048, bid, G, lds);
    d_rope(s_k, 8, 16, 2048, bid, G, lds);
    grid.sync();
    phase_ssd2(p, G, bid);
    phase_attn(p, lds, G, bid);
    __syncthreads();
    d_ssd(s.act, s.dtv, s.z, p.in[13], p.in[14], p.in[4], s.ypre, s_ssm, 8, 16, bid, G, lds);
    d_attn(s.q, s_k, s_v, p.in[2], p.in[3], 8, 16, 2048, p.in[16], p.in[17], p.in[18], p.in[19], p.in[20], 0.2f, s.cat, bid, G, lds);
    grid.sync();
    phase_ssd3(p, lds, G, bid);
    d_ssd_norm(s.ypre, p.in[15], s.cat, 128, bid, G, lds);
    grid.sync();
    phase_outproj(p, lds, G, bid);
    __syncthreads();
    d_gemm(s.cat, 1024, p.in[21], 1024, s.mix, 1024, 128, 1024, 1024, bid, G, lds);
    grid.sync();
    row_phase((const bf16_t*)(p.ws + WS_RAW), p.in[0], p.in[28], y, p.in[29], (bf16_t*)(p.ws + WS_XN), MP, gw, ngw, lane);
    d_rmsnorm(s.mix, p.in[28], xs, ys, 128, 1e-6f, bid, G, lds);
    grid.sync();
    phase_wq(p, lds, G, bid);
    d_rmsnorm(ys, p.in[29], nullptr, s.hn, 128, 1e-6f, bid, G, lds);
    grid.sync();
    phase_xattn(p, lds, G, bid);
    d_gemm(s.hn, 1024, p.in[23], 1024, s.raw, 1024, 128, 1024, 1024, bid, G, lds);
    grid.sync();
    phase_wo(p, lds, G, bid);
    __syncthreads();
    d_xattn(s.raw, p.in[6], p.in[7], s.act, 8, 16, bid, G, lds);
    grid.sync();
    row_phase((const bf16_t*)(p.ws + WS_RAW), y, p.in[30], y, p.in[31], (bf16_t*)(p.ws + WS_XN), MP, gw, ngw, lane);
    d_gemm(s.act, 1024, p.in[26], 1024, s.mix, 1024, 128, 1024, 1024, bid, G, lds);
    grid.sync();
    phase_ffn_gu(p, lds, G, bid);
    d_rmsnorm(s.mix, p.in[30], ys, ys, 128, 1e-6f, bid, G, lds);
    grid.sync();
    phase_ffn_down(p, lds, G, bid);
    d_rmsnorm(ys, p.in[31], nullptr, s.hn, 128, 1e-6f, bid, G, lds);
    grid.sync();
    row_phase((const bf16_t*)(p.ws + WS_RAW), y, p.in[32], y, nullptr, nullptr, MP, gw, ngw, lane);
    d_gemm(s.hn, 1024, p.in[33], 2816, s.G, 2816, 128, 2816, 1024, bid, G, lds);
    d_gemm(s.hn, 1024, p.in[34], 2816, s.U, 2816, 128, 2816, 1024, bid, G, lds);
    grid.sync();
    d_silu_mul(s.G, s.U, (size_t)128 * 2816, bid, G, lds);
    grid.sync();
    d_gemm(s.G, 2816, p.in[35], 1024, s.mix, 1024, 128, 1024, 2816, bid, G, lds);
    grid.sync();
    d_rmsnorm(s.mix, p.in[32], ys, ys, 128, 1e-6f, bid, G, lds);
}

extern "C" void kernel_launch(void* const* d_in, const int* in_sizes, int n_in, void* d_out, int out_size, void* d_ws, size_t ws_size, hipStream_t stream) {
    static int grid = 0;
    if (!grid) {
        int dev = 0, cus = 0, per_cu = 0;
        (void)hipGetDevice(&dev);
        (void)hipDeviceGetAttribute(&cus, hipDeviceAttributeMultiprocessorCount, dev);
        (void)hipFuncSetAttribute((const void*)k_mega, hipFuncAttributeMaxDynamicSharedMemorySize, LDS_BYTES);
        (void)hipOccupancyMaxActiveBlocksPerMultiprocessor(&per_cu, (const void*)k_mega, 512, LDS_BYTES);
        if (per_cu < 1) per_cu = 1;
        grid = cus * per_cu;
        if (grid > 256) grid = 256;
        if (n_in != 36 || ws_size < 256 * MiB) fprintf(stderr, "kernel_launch: unexpected n_in %d / ws_size %zu\n", n_in, ws_size);
    }
    FP p{};
    for (int i = 0; i < 36; ++i) p.in[i] = (const float*)d_in[i];
    p.out = (float*)d_out; p.ws = (unsigned char*)d_ws;
    void* args[] = {&p};
    hipError_t e = hipLaunchCooperativeKernel((const void*)k_mega, dim3(grid), dim3(512), args, LDS_BYTES, stream);
    if (e != hipSuccess) fprintf(stderr, "cooperative launch failed: %s (grid %d)\n", hipGetErrorString(e), grid);
}
```

```cpp
#include <hip/hip_runtime.h>
#include <cstdint>
#include <cstdio>
#include <hip/hip_cooperative_groups.h>

#define DEV static __device__ __forceinline__
#define LAS __attribute__((address_space(3)))
#define WAVE_SYNC() asm volatile("s_waitcnt lgkmcnt(0)" ::: "memory")

DEV float wave_sum(float v) {
#pragma unroll
    for (int o = 32; o > 0; o >>= 1) v += __shfl_xor(v, o);
    return v;
}
DEV float wave_max(float v) {
#pragma unroll
    for (int o = 32; o > 0; o >>= 1) v = fmaxf(v, __shfl_xor(v, o));
    return v;
}
typedef float nf4 __attribute__((ext_vector_type(4)));
DEV float4 lds_ld4(const LAS float* p) { const nf4 v = *(const LAS nf4*)p; float4 r; r.x = v[0]; r.y = v[1]; r.z = v[2]; r.w = v[3]; return r; }
DEV float silu_f(float x) { return x / (1.f + expf(-x)); }


typedef unsigned short bf16_t;
typedef float f32x4 __attribute__((ext_vector_type(4)));
typedef float f32x16 __attribute__((ext_vector_type(16)));
typedef short bf16x8 __attribute__((ext_vector_type(8)));
typedef short s16x4 __attribute__((ext_vector_type(4)));
typedef unsigned u32x4 __attribute__((ext_vector_type(4)));
typedef unsigned u32x2 __attribute__((ext_vector_type(2)));

constexpr size_t MiB = 1u << 20;
constexpr size_t WS_W_IN = 0, WS_W_OUT = 6 * MiB, WS_W_Q = 8 * MiB, WS_W_KV = 10 * MiB, WS_W_O = 14 * MiB, WS_W_GU = 16 * MiB, WS_W_DOWN = 27 * MiB;
constexpr size_t WS_CTL = 33 * MiB, WS_DTV = 34 * MiB, WS_CDEC = 34 * MiB + 512 * 1024, WS_MN = 35 * MiB;
constexpr size_t WS_XN = 36 * MiB, WS_CAT = 68 * MiB, WS_QX = 68 * MiB, WS_Q = 100 * MiB, WS_K = 116 * MiB, WS_RAW = 100 * MiB;
constexpr size_t WS_ZX = 132 * MiB, WS_OX = 132 * MiB, WS_V = 180 * MiB, WS_ST = 196 * MiB, WS_HID = 132 * MiB, WS_KM = 228 * MiB, WS_VM = 229 * MiB, WS_SMP = 230 * MiB;
constexpr int MP = 16384;
constexpr int LDS_BYTES = 147456;

DEV unsigned f2bf(float f) { unsigned u = __builtin_bit_cast(unsigned, f); return (u + 0x7fffu + ((u >> 16) & 1u)) >> 16; }
DEV unsigned pk2(float lo, float hi) { return f2bf(lo) | (f2bf(hi) << 16); }
DEV float bflo(unsigned w) { return __builtin_bit_cast(float, w << 16); }
DEV float bfhi(unsigned w) { return __builtin_bit_cast(float, w & 0xffff0000u); }
DEV float fast_silu(float x) { return x * __builtin_amdgcn_rcpf(1.f + __builtin_amdgcn_exp2f(-1.4426950408889634f * x)); }

struct FP {
    const float* in[36];
    float* out;
    unsigned char* ws;
};

template <class RowMap>
DEV void transpose_item(const float* W, int K, int N, bf16_t* WT, int item, LAS float* scr, int lane, RowMap rm) {
    const int nblk = (N + 31) / 32, kb = item / nblk, nb = item % nblk, k0 = 64 * kb, n0 = 32 * nb;
    const int ncol = n0 + (lane & 31);
#pragma unroll 8
    for (int i = 0; i < 32; ++i) { const int kk = 2 * i + (lane >> 5); scr[kk * 33 + (lane & 31)] = (ncol < N) ? W[(size_t)(k0 + kk) * N + ncol] : 0.f; }
    WAVE_SYNC();
    const int c = lane & 7;
#pragma unroll
    for (int j = 0; j < 4; ++j) {
        const int n = (lane >> 3) + 8 * j; const LAS float* s = scr + (8 * c) * 33 + n;
        const int src = n0 + n; const int dst = (src < N) ? rm(src) : -1;
        u32x4 o; o.x = pk2(s[0 * 33], s[1 * 33]); o.y = pk2(s[2 * 33], s[3 * 33]); o.z = pk2(s[4 * 33], s[5 * 33]); o.w = pk2(s[6 * 33], s[7 * 33]);
        if (dst >= 0) *(u32x4*)(WT + (size_t)dst * K + k0 + 8 * c) = o;
    }
    WAVE_SYNC();
}
struct RmPlain { int off; __device__ __forceinline__ int operator()(int n) const { return off + n; } };
struct RmGU { int up; __device__ __forceinline__ int operator()(int n) const { return 32 * (n >> 4) + 16 * up + (n & 15); } };
struct RmIn {
    __device__ __forceinline__ int operator()(int n) const {
        if (n < 1536) return n;
        if (n < 1544) return -1;
        const int m = n - 1544;
        if (m < 1024) { const int u = m >> 6, d = m & 63; return 1536 + 64 * u + 32 * ((d & 31) >> 4) + 16 * (d >> 5) + (d & 15); }
        return 1536 + m;
    }
};

DEV void row_phase(const bf16_t* raw, const float* hin, const float* gpost, float* hout, const float* gpre, bf16_t* xn, int M, int gw, int ngw, int lane) {
    for (int r = gw; r < M; r += ngw) {
        f32x4 h[4];
#pragma unroll
        for (int j = 0; j < 4; ++j) h[j] = ((const f32x4*)(hin + (size_t)r * 1024))[lane + 64 * j];
        if (raw) {
            f32x4 v[4]; float ss = 0.f;
#pragma unroll
            for (int j = 0; j < 4; ++j) {
                const u32x2 w = ((const u32x2*)(raw + (size_t)r * 1024))[lane + 64 * j];
                v[j] = (f32x4){bflo(w.x), bfhi(w.x), bflo(w.y), bfhi(w.y)};
                ss += v[j].x * v[j].x + v[j].y * v[j].y + v[j].z * v[j].z + v[j].w * v[j].w;
            }
            const float rs = rsqrtf(wave_sum(ss) * (1.f / 1024.f) + 1e-6f);
#pragma unroll
            for (int j = 0; j < 4; ++j) { const f32x4 g = ((const f32x4*)gpost)[lane + 64 * j]; h[j] += v[j] * rs * g; }
        }
        if (hout) {
#pragma unroll
            for (int j = 0; j < 4; ++j) ((f32x4*)(hout + (size_t)r * 1024))[lane + 64 * j] = h[j];
        }
        if (gpre) {
            float ss = 0.f;
#pragma unroll
            for (int j = 0; j < 4; ++j) ss += h[j].x * h[j].x + h[j].y * h[j].y + h[j].z * h[j].z + h[j].w * h[j].w;
            const float rs = rsqrtf(wave_sum(ss) * (1.f / 1024.f) + 1e-6f);
#pragma unroll
            for (int j = 0; j < 4; ++j) {
                const f32x4 g = ((const f32x4*)gpre)[lane + 64 * j]; const f32x4 o = h[j] * rs * g;
                u32x2 w; w.x = pk2(o.x, o.y); w.y = pk2(o.z, o.w);
                ((u32x2*)(xn + (size_t)r * 1024))[lane + 64 * j] = w;
            }
        }
    }
}
namespace pg8 {
#define PG8_LAS __attribute__((address_space(3)))
typedef unsigned short bf16_t;
typedef short bf16x8 __attribute__((ext_vector_type(8)));
typedef float f32x4 __attribute__((ext_vector_type(4)));
typedef unsigned u32x4 __attribute__((ext_vector_type(4)));
constexpr int BM = 256, BK = 64, HALF = 128, HTB = HALF * BK * 2  , STAGE_BYTES = 8 * HTB, NXCD = 8, WGM = 8;

__host__ __device__ __forceinline__ int lds_byte(int r, int c) { const int st = (r >> 4) * 2 + (c >> 5), rr = r & 15, cc = c & 31, ob = rr * 64 + cc * 2; return st * 1024 + (ob ^ (((ob >> 9) & 1) << 5)); }
__host__ __device__ __forceinline__ void stage_rc(int b, int& R, int& C) { const int st = b / 1024, sb = b % 1024, swz = sb ^ (((sb >> 9) & 1) << 5); R = (st >> 1) * 16 + swz / 64; C = (st & 1) * 32 + (swz % 64) / 2; }
__host__ __device__ __forceinline__ int perm32(int rho) { const int n = rho >> 4, i = rho & 15; return 8 * (i >> 2) + 4 * n + (i & 3); }

struct Unit { int pm, pn; };
struct Gemm { const bf16_t* A; const bf16_t* Bt; int M, N, K; };

struct StaticOrder {
    int nM, nN, nwg, G, c;
    __host__ __device__ void init(int M, int N, int G_, int c_) { nM = M / BM; nN = N / BM; nwg = nM * nN; G = G_; c = c_; }
    __host__ __device__ bool next(int i, Unit& u) const {
        const long L = (long)i * G + c; if (L >= nwg) return false;
        int wgid = (int)L; { const int q = nwg / NXCD, r = nwg % NXCD, xcd = wgid % NXCD, off = wgid / NXCD; wgid = (xcd < r ? xcd * (q + 1) : r * (q + 1) + (xcd - r) * q) + off; }
        const int nig = WGM * nN, gid = wgid / nig, fm = gid * WGM, gsz = (nM - fm) < WGM ? (nM - fm) : WGM;
        u.pm = fm + ((wgid % nig) % gsz); u.pn = (wgid % nig) / gsz; return true;
    }
    __device__ __forceinline__ void a_ready(const Unit&) const {}
    __device__ __forceinline__ void done(const Unit&) const {}
};

__device__ __forceinline__ unsigned cvt_pk_bf16(float lo, float hi) { unsigned r; asm volatile("v_cvt_pk_bf16_f32 %0, %1, %2" : "=v"(r) : "v"(lo), "v"(hi)); return r; }
typedef float f32x2 __attribute__((ext_vector_type(2)));
__device__ __forceinline__ f32x2 gelu_pk(f32x2 v) {
    const f32x2 av = __builtin_elementwise_abs(v), d = av * 0.2316418882f + 1.0f;
    f32x2 t; t.x = __builtin_amdgcn_rcpf(d.x); t.y = __builtin_amdgcn_rcpf(d.y);
    f32x2 q = t * 0.5307027145f + (-0.7265760135f); q = q * t + 0.7107068705f; q = q * t + (-0.142248368f); q = q * t + 0.127414796f; q = q * t;
    const f32x2 s = (v * v) * (-0.72134752044f);
    f32x2 e; e.x = __builtin_amdgcn_exp2f(s.x); e.y = __builtin_amdgcn_exp2f(s.y);
    const f32x2 m = v * (q * e), r = v - m;
    f32x2 o; o.x = v.x < 0.f ? m.x : r.x; o.y = v.y < 0.f ? m.y : r.y; return o;
}

template <int ACT  > struct EpiBf16 {
    static constexpr bool PERM = true, AFTER_DRAIN = false; static_assert(ACT == 0 || ACT == 1, "EpiBf16: ACT is 0 (none) or 1 (gelu_pk)");
    bf16_t* O; int ldc; const float* bias; int split_cols; size_t split_stride; float scale0;
    __device__ __forceinline__ void operator()(const f32x4 (&acc)[2][2][4][2], const Unit& u, int wr, int wc, int fr, int fq) const {
        const int row0 = u.pm * BM + wr * 64 + fr; int colt = u.pn * BM; bf16_t* base = O;
        float sc = 1.f; if (split_cols) { const int t = colt / split_cols; base += (size_t)t * split_stride; colt -= t * split_cols; if (t == 0) sc = scale0; }
        const int col0 = colt + wc * 32 + 8 * fq, bcol0 = u.pn * BM + wc * 32 + 8 * fq;
        f32x4 bv[2][2];
#pragma unroll
        for (int bj = 0; bj < 2; ++bj)
#pragma unroll
            for (int n = 0; n < 2; ++n) bv[bj][n] = bias ? *(const f32x4*)(bias + bcol0 + bj * HALF + 4 * n) : (f32x4){0.f, 0.f, 0.f, 0.f};
#pragma unroll
        for (int ai = 0; ai < 2; ++ai)
#pragma unroll
            for (int m = 0; m < 4; ++m) { bf16_t* rowp = base + (size_t)(row0 + ai * HALF + m * 16) * ldc + col0;
#pragma unroll
                for (int bj = 0; bj < 2; ++bj) { f32x4 v0 = acc[ai][bj][m][0] + bv[bj][0], v1 = acc[ai][bj][m][1] + bv[bj][1];
                    if (ACT == 1) { f32x2 a = gelu_pk((f32x2){v0[0], v0[1]}), b = gelu_pk((f32x2){v0[2], v0[3]}), c = gelu_pk((f32x2){v1[0], v1[1]}), d = gelu_pk((f32x2){v1[2], v1[3]});
                        v0 = (f32x4){a.x, a.y, b.x, b.y}; v1 = (f32x4){c.x, c.y, d.x, d.y}; }
                    v0 = v0 * sc; v1 = v1 * sc; u32x4 w; w.x = cvt_pk_bf16(v0[0], v0[1]); w.y = cvt_pk_bf16(v0[2], v0[3]); w.z = cvt_pk_bf16(v1[0], v1[1]); w.w = cvt_pk_bf16(v1[2], v1[3]);
                    *(u32x4*)(rowp + bj * HALF) = w; } }
    }
};
template <class Epi, class Sched, bool ALIGN_EPI = false, bool SP2 = false>
__device__ __forceinline__ void gemm_phase(PG8_LAS unsigned char* lds, const Gemm g, const Sched& S, const Epi& E) {
    int tid_l = threadIdx.x; asm volatile("" : "+v"(tid_l));
    const int tid = tid_l, wid = __builtin_amdgcn_readfirstlane(tid >> 6), lane = tid & 63, wr = wid >> 2, wc = wid & 3, fr = lane & 15, fq = lane >> 4;
    const int K = g.K, nt = K / BK;
    unsigned voffA[2], voffB[2];
#pragma unroll
    for (int i = 0; i < 2; ++i) { int R, C; stage_rc(tid * 16 + i * 8192, R, C); const int Rb = Epi::PERM ? ((R & ~31) + perm32(R & 31)) : R;
        voffA[i] = (unsigned)(R * K + C) * 2u; voffB[i] = (unsigned)(Rb * K + C) * 2u; }
    const size_t kstep = (size_t)(BK * 2);
    const size_t hstep = (size_t)HALF * K * 2;
    const size_t tstep = 2 * hstep;
    const unsigned ldsw = (unsigned)wid * 1024u;
    const int aoff = lds_byte(wr * 64 + fr, fq * 8), boff = lds_byte(wc * 32 + fr, fq * 8);
#define PG8_SA(b, h) (((b) * 2 + (h)) * HTB)
#define PG8_SB(b, h) ((4 + (b) * 2 + (h)) * HTB)
#define PG8_STAGE(bufoff, gbase, voff) do { _Pragma("unroll") for (int _i = 0; _i < 2; ++_i) \
        __builtin_amdgcn_global_load_lds((const unsigned*)((const char*)(gbase) + (voff)[_i]), (PG8_LAS unsigned*)(lds + (bufoff) + ldsw + _i * 8192), 16, 0, 0); } while (0)
#define PG8_LDA(dst, b, h) do { _Pragma("unroll") for (int m = 0; m < 4; ++m) _Pragma("unroll") for (int k = 0; k < 2; ++k) dst[m][k] = *(const PG8_LAS bf16x8*)(lds + PG8_SA(b, h) + aoff + m * 2048 + k * 1024); } while (0)
#define PG8_LDB(dst, b, h) do { _Pragma("unroll") for (int n = 0; n < 2; ++n) _Pragma("unroll") for (int k = 0; k < 2; ++k) dst[n][k] = *(const PG8_LAS bf16x8*)(lds + PG8_SB(b, h) + boff + n * 2048 + k * 1024); } while (0)
#define PG8_MMA(ai, bj, At, Bt) do { __builtin_amdgcn_s_setprio(1); _Pragma("unroll") for (int m = 0; m < 4; ++m) _Pragma("unroll") for (int n = 0; n < 2; ++n) _Pragma("unroll") for (int k = 0; k < 2; ++k) \
        acc[ai][bj][m][n] = __builtin_amdgcn_mfma_f32_16x16x32_bf16(Bt[n][k], At[m][k], acc[ai][bj][m][n], 0, 0, 0); __builtin_amdgcn_s_setprio(0); } while (0)
#define PG8_WAIT_V(n) asm volatile("s_waitcnt vmcnt(" #n ")" ::: "memory")
#define PG8_WAIT_L(n) asm volatile("s_waitcnt lgkmcnt(" #n ")" ::: "memory")
#define PG8_BAR __builtin_amdgcn_s_barrier()
#define PG8_SCHED __builtin_amdgcn_sched_barrier(0)
    Unit cur, nxt; int ui = 0;
    if (!S.next(0, cur)) return;
    f32x4 acc[2][2][4][2];
#pragma unroll
    for (int a = 0; a < 2; ++a)
#pragma unroll
        for (int b = 0; b < 2; ++b)
#pragma unroll
            for (int m = 0; m < 4; ++m)
#pragma unroll
                for (int n = 0; n < 2; ++n) acc[a][b][m][n] = (f32x4){0.f, 0.f, 0.f, 0.f};
    bf16x8 At[4][2], B0[2][2], B1[2][2];
    const char* cA = (const char*)g.A + (size_t)cur.pm * tstep; const char* cB = (const char*)g.Bt + (size_t)cur.pn * tstep;
    S.a_ready(cur);
    if constexpr (SP2) {
        PG8_STAGE(PG8_SB(0, 0), cB, voffB); PG8_STAGE(PG8_SB(0, 1), cB + hstep, voffB); PG8_STAGE(PG8_SA(0, 0), cA, voffA); PG8_STAGE(PG8_SA(0, 1), cA + hstep, voffA);
        if (wr == 1) PG8_BAR;
        PG8_WAIT_V(2); PG8_BAR;
        PG8_STAGE(PG8_SB(1, 0), cB + kstep, voffB); PG8_STAGE(PG8_SA(1, 0), cA + kstep, voffA); PG8_STAGE(PG8_SB(1, 1), cB + hstep + kstep, voffB);
        PG8_WAIT_V(6); PG8_BAR;
    } else {
        PG8_STAGE(PG8_SB(0, 0), cB, voffB); PG8_STAGE(PG8_SA(0, 0), cA, voffA); PG8_STAGE(PG8_SB(0, 1), cB + hstep, voffB); PG8_STAGE(PG8_SA(0, 1), cA + hstep, voffA);
        if (wr == 1) PG8_BAR;
        PG8_WAIT_V(4); PG8_BAR;
        PG8_STAGE(PG8_SB(1, 0), cB + kstep, voffB); PG8_STAGE(PG8_SA(1, 0), cA + kstep, voffA); PG8_STAGE(PG8_SB(1, 1), cB + hstep + kstep, voffB);
        PG8_WAIT_V(6); PG8_BAR;
    }
    for (;;) {
        const bool has_next = S.next(ui + 1, nxt);
        const char* nA = has_next ? (const char*)g.A + (size_t)nxt.pm * tstep : cA; const char* nB = has_next ? (const char*)g.Bt + (size_t)nxt.pn * tstep : cB;
        for (int t = 0; t < nt; t += 2) {
            const bool last = (t == nt - 2);
            const char* a1 = cA + (size_t)(t + 1) * kstep;
            const char* a2 = last ? nA : cA + (size_t)(t + 2) * kstep; const char* b2 = last ? nB : cB + (size_t)(t + 2) * kstep;
            const char* a3 = a2 + kstep; const char* b3 = b2 + kstep;
            if (last && has_next) S.a_ready(nxt);
            if constexpr (SP2) {
            PG8_LDB(B0, 0, 0); PG8_LDB(B1, 0, 1); PG8_SCHED; PG8_LDA(At, 0, 0); PG8_STAGE(PG8_SA(1, 1), a1 + hstep, voffA);
            PG8_WAIT_V(8); PG8_WAIT_L(0); PG8_BAR; PG8_MMA(0, 0, At, B0); PG8_MMA(0, 1, At, B1); PG8_BAR; PG8_SCHED;
            PG8_LDA(At, 0, 1); PG8_STAGE(PG8_SB(0, 0), b2, voffB); PG8_STAGE(PG8_SB(0, 1), b2 + hstep, voffB); PG8_STAGE(PG8_SA(0, 0), a2, voffA);
            PG8_WAIT_V(8); PG8_WAIT_L(0); PG8_BAR; PG8_MMA(1, 0, At, B0); PG8_MMA(1, 1, At, B1); PG8_BAR; PG8_SCHED;
            PG8_LDB(B0, 1, 0); PG8_LDB(B1, 1, 1); PG8_SCHED; PG8_LDA(At, 1, 0); PG8_STAGE(PG8_SA(0, 1), a2 + hstep, voffA);
            PG8_WAIT_V(8); PG8_WAIT_L(0); PG8_BAR; PG8_MMA(0, 0, At, B0); PG8_MMA(0, 1, At, B1); PG8_BAR; PG8_SCHED;
            PG8_LDA(At, 1, 1); PG8_STAGE(PG8_SB(1, 0), b3, voffB); PG8_STAGE(PG8_SB(1, 1), b3 + hstep, voffB); PG8_STAGE(PG8_SA(1, 0), a3, voffA);
            PG8_WAIT_V(8); PG8_WAIT_L(0); PG8_BAR; PG8_MMA(1, 0, At, B0); PG8_MMA(1, 1, At, B1); PG8_BAR; PG8_SCHED;
            } else {
            PG8_LDB(B0, 0, 0); PG8_SCHED; PG8_LDA(At, 0, 0); PG8_STAGE(PG8_SA(1, 1), a1 + hstep, voffA);
            PG8_WAIT_L(8); PG8_BAR; PG8_WAIT_L(0); PG8_MMA(0, 0, At, B0); PG8_BAR; PG8_SCHED;
            PG8_LDB(B1, 0, 1); PG8_STAGE(PG8_SB(0, 0), b2, voffB);
            PG8_BAR; PG8_WAIT_L(0); PG8_MMA(0, 1, At, B1); PG8_BAR;
            PG8_LDA(At, 0, 1); PG8_STAGE(PG8_SA(0, 0), a2, voffA);
            PG8_BAR; PG8_WAIT_L(0); PG8_MMA(1, 0, At, B0); PG8_BAR; PG8_SCHED;
            PG8_STAGE(PG8_SB(0, 1), b2 + hstep, voffB);
            PG8_WAIT_V(6); PG8_BAR; PG8_MMA(1, 1, At, B1); PG8_BAR;
            PG8_LDB(B0, 1, 0); PG8_SCHED; PG8_LDA(At, 1, 0); PG8_STAGE(PG8_SA(0, 1), a2 + hstep, voffA);
            PG8_WAIT_L(8); PG8_BAR; PG8_WAIT_L(0); PG8_MMA(0, 0, At, B0); PG8_BAR; PG8_SCHED;
            PG8_LDB(B1, 1, 1); PG8_STAGE(PG8_SB(1, 0), b3, voffB);
            PG8_BAR; PG8_WAIT_L(0); PG8_MMA(0, 1, At, B1); PG8_BAR;
            PG8_LDA(At, 1, 1); PG8_STAGE(PG8_SA(1, 0), a3, voffA);
            PG8_BAR; PG8_WAIT_L(0); PG8_MMA(1, 0, At, B0); PG8_BAR; PG8_SCHED;
            PG8_STAGE(PG8_SB(1, 1), b3 + hstep, voffB);
            PG8_WAIT_V(6); PG8_BAR; PG8_MMA(1, 1, At, B1); PG8_BAR;
            }
        }
        if constexpr (ALIGN_EPI) { if (wr == 0) PG8_BAR; }
        if constexpr (!Epi::AFTER_DRAIN) { E(acc, cur, wr, wc, fr, fq); S.done(cur); }
        if (!has_next) break;
#pragma unroll
        for (int a = 0; a < 2; ++a)
#pragma unroll
            for (int b = 0; b < 2; ++b)
#pragma unroll
                for (int m = 0; m < 4; ++m)
#pragma unroll
                    for (int n = 0; n < 2; ++n) acc[a][b][m][n] = (f32x4){0.f, 0.f, 0.f, 0.f};
        cur = nxt; cA = nA; cB = nB; ++ui;
        if constexpr (ALIGN_EPI) { if (wr == 1) PG8_BAR; }
    }
    PG8_WAIT_V(0);
    if constexpr (!ALIGN_EPI) { if (wr == 0) PG8_BAR; }
    PG8_BAR;
    if constexpr (Epi::AFTER_DRAIN) { E.fused(acc, cur, wr, wc, fr, fq, lds, wid, lane); S.done(cur); }
#undef PG8_SA
#undef PG8_SB
#undef PG8_STAGE
#undef PG8_LDA
#undef PG8_LDB
#undef PG8_MMA
#undef PG8_WAIT_V
#undef PG8_WAIT_L
#undef PG8_BAR
#undef PG8_SCHED
}
}

namespace pg8 {
struct EpiSwiglu {
    static constexpr bool PERM = false, AFTER_DRAIN = false;
    bf16_t* O; int ldo;
    __device__ __forceinline__ void operator()(const f32x4 (&acc)[2][2][4][2], const Unit& u, int wr, int wc, int fr, int fq) const {
        const int row0 = u.pm * BM + wr * 64 + fr;
#pragma unroll
        for (int ai = 0; ai < 2; ++ai)
#pragma unroll
            for (int m = 0; m < 4; ++m) {
                bf16_t* rowp = O + (size_t)(row0 + ai * HALF + m * 16) * ldo;
#pragma unroll
                for (int bj = 0; bj < 2; ++bj) {
                    const int grp = u.pn * 8 + bj * 4 + wc;
                    const f32x4 g = acc[ai][bj][m][0], up = acc[ai][bj][m][1];
                    const float h0 = fast_silu(g[0]) * up[0], h1 = fast_silu(g[1]) * up[1], h2 = fast_silu(g[2]) * up[2], h3 = fast_silu(g[3]) * up[3];
                    u32x2 w; w.x = cvt_pk_bf16(h0, h1); w.y = cvt_pk_bf16(h2, h3);
                    *(u32x2*)(rowp + grp * 16 + 4 * fq) = w;
                }
            }
    }
};
}

DEV void phase_prep_ffn(const FP& p, LAS unsigned char* lds, int gw, int ngw, int wave, int lane) {
    LAS float* scr = (LAS float*)(lds + wave * 16384);
    const float *wg = p.in[33], *wu = p.in[34], *wd = p.in[35];
    bf16_t* GU = (bf16_t*)(p.ws + WS_W_GU); bf16_t* DN = (bf16_t*)(p.ws + WS_W_DOWN);
    constexpr int I_G = 16 * 88, I_D = 44 * 32;
    for (int it = gw; it < 2 * I_G + I_D; it += ngw) {
        int r = it;
        if (r < I_G) { transpose_item(wg, 1024, 2816, GU, r, scr, lane, RmGU{0}); continue; } r -= I_G;
        if (r < I_G) { transpose_item(wu, 1024, 2816, GU, r, scr, lane, RmGU{1}); continue; } r -= I_G;
        transpose_item(wd, 2816, 1024, DN, r, scr, lane, RmPlain{0});
    }
}
DEV void phase_ffn_gu(const FP& p, LAS unsigned char* lds, int G, int bid) {
    pg8::Gemm g{(const bf16_t*)(p.ws + WS_XN), (const bf16_t*)(p.ws + WS_W_GU), MP, 5632, 1024};
    pg8::StaticOrder S; S.init(MP, 5632, G, bid);
    pg8::EpiSwiglu E{(bf16_t*)(p.ws + WS_HID), 2816};
    pg8::gemm_phase<pg8::EpiSwiglu, pg8::StaticOrder, true, true>(lds, g, S, E);
}
DEV void phase_ffn_down(const FP& p, LAS unsigned char* lds, int G, int bid) {
    pg8::Gemm g{(const bf16_t*)(p.ws + WS_HID), (const bf16_t*)(p.ws + WS_W_DOWN), MP, 1024, 2816};
    pg8::StaticOrder S; S.init(MP, 1024, G, bid);
    pg8::EpiBf16<0> E{(bf16_t*)(p.ws + WS_RAW), 1024, nullptr, 0, 0, 1.f};
    pg8::gemm_phase<pg8::EpiBf16<0>, pg8::StaticOrder, true, true>(lds, g, S, E);
}

typedef short v4i16_t __attribute__((ext_vector_type(4)));
typedef float f32x2_t __attribute__((ext_vector_type(2)));
typedef __bf16 bf16x2_t __attribute__((ext_vector_type(2)));
DEV unsigned cvtpk(float lo, float hi) { f32x2_t v = {lo, hi}; bf16x2_t b = __builtin_convertvector(v, bf16x2_t); return __builtin_bit_cast(unsigned, b); }
DEV f32x16 mfma32(bf16x8 a, bf16x8 b, f32x16 c) { return __builtin_amdgcn_mfma_f32_32x32x16_bf16(a, b, c, 0, 0, 0); }
DEV s16x4 tr_read(LAS const unsigned char* p) { return __builtin_bit_cast(s16x4, __builtin_amdgcn_ds_read_tr16_b64_v4i16((LAS v4i16_t*)p)); }
DEV bf16x8 cat8(s16x4 lo, s16x4 hi) { return (bf16x8){lo[0], lo[1], lo[2], lo[3], hi[0], hi[1], hi[2], hi[3]}; }
DEV float half_max(float v) { auto rr = __builtin_amdgcn_permlane32_swap(__float_as_uint(v), __float_as_uint(v), false, false); return fmaxf(__uint_as_float(rr[0]), __uint_as_float(rr[1])); }
DEV float half_sum(float v) { auto rr = __builtin_amdgcn_permlane32_swap(__float_as_uint(v), __float_as_uint(v), false, false); return __uint_as_float(rr[0]) + __uint_as_float(rr[1]); }
DEV bf16x8 pfrag(const f32x16& S, int s) {
    u32x4 w;
    if (s == 0) { w.x = cvtpk(S[0], S[1]); w.y = cvtpk(S[2], S[3]); w.z = cvtpk(S[4], S[5]); w.w = cvtpk(S[6], S[7]); }
    else { w.x = cvtpk(S[8], S[9]); w.y = cvtpk(S[10], S[11]); w.z = cvtpk(S[12], S[13]); w.w = cvtpk(S[14], S[15]); }
    return __builtin_bit_cast(bf16x8, w);
}
DEV float max16(const f32x16& S) {
    float a = fmaxf(fmaxf(S[0], S[1]), fmaxf(S[2], S[3])), b = fmaxf(fmaxf(S[4], S[5]), fmaxf(S[6], S[7]));
    float c = fmaxf(fmaxf(S[8], S[9]), fmaxf(S[10], S[11])), d = fmaxf(fmaxf(S[12], S[13]), fmaxf(S[14], S[15]));
    return fmaxf(fmaxf(a, b), fmaxf(c, d));
}

namespace pg8 {
struct EpiMemKV {
    static constexpr bool PERM = false, AFTER_DRAIN = false;
    float* ok; float* ov; bf16_t* bk; bf16_t* bv;
    __device__ __forceinline__ void operator()(const f32x4 (&acc)[2][2][4][2], const Unit& u, int wr, int wc, int fr, int fq) const {
        const int row0 = u.pm * BM + wr * 64 + fr; const bool isv = u.pn >= 4; const int colt = (u.pn & 3) * BM + wc * 32 + 4 * fq;
        float* of = isv ? ov : ok; bf16_t* ob = isv ? bv : bk;
#pragma unroll
        for (int ai = 0; ai < 2; ++ai)
#pragma unroll
            for (int m = 0; m < 4; ++m) {
                const size_t ro = (size_t)(row0 + ai * HALF + m * 16) * 1024;
#pragma unroll
                for (int bj = 0; bj < 2; ++bj)
#pragma unroll
                    for (int n = 0; n < 2; ++n) {
                        const f32x4 v = acc[ai][bj][m][n]; const int col = colt + bj * HALF + n * 16;
                        *(f32x4*)(of + ro + col) = v;
                        u32x2 w; w.x = cvt_pk_bf16(v[0], v[1]); w.y = cvt_pk_bf16(v[2], v[3]);
                        *(u32x2*)(ob + ro + col) = w;
                    }
            }
    }
};
}

DEV void phase_prep_x(const FP& p, LAS unsigned char* lds, int gw, int ngw, int wave, int lane) {
    LAS float* scr = (LAS float*)(lds + wave * 16384);
    constexpr int I_S = 16 * 32;
    for (int it = gw; it < 4 * I_S; it += ngw) {
        int r = it;
        if (r < I_S) { transpose_item(p.in[23], 1024, 1024, (bf16_t*)(p.ws + WS_W_Q), r, scr, lane, RmPlain{0}); continue; } r -= I_S;
        if (r < I_S) { transpose_item(p.in[24], 1024, 1024, (bf16_t*)(p.ws + WS_W_KV), r, scr, lane, RmPlain{0}); continue; } r -= I_S;
        if (r < I_S) { transpose_item(p.in[25], 1024, 1024, (bf16_t*)(p.ws + WS_W_KV), r, scr, lane, RmPlain{1024}); continue; } r -= I_S;
        transpose_item(p.in[26], 1024, 1024, (bf16_t*)(p.ws + WS_W_O), r, scr, lane, RmPlain{0});
    }
    row_phase(nullptr, p.in[8], nullptr, nullptr, p.in[22], (bf16_t*)(p.ws + WS_MN), 512, gw, ngw, lane);
}
DEV void phase_memkv(const FP& p, LAS unsigned char* lds, int G, int bid) {
    pg8::Gemm g{(const bf16_t*)(p.ws + WS_MN), (const bf16_t*)(p.ws + WS_W_KV), 512, 2048, 1024};
    pg8::StaticOrder S; S.init(512, 2048, G, bid);
    pg8::EpiMemKV E{p.out + 33822720, p.out + 34347008, (bf16_t*)(p.ws + WS_KM), (bf16_t*)(p.ws + WS_VM)};
    pg8::gemm_phase<pg8::EpiMemKV, pg8::StaticOrder, true, true>(lds, g, S, E);
}
DEV void phase_wq(const FP& p, LAS unsigned char* lds, int G, int bid) {
    pg8::Gemm g{(const bf16_t*)(p.ws + WS_XN), (const bf16_t*)(p.ws + WS_W_Q), MP, 1024, 1024};
    pg8::StaticOrder S; S.init(MP, 1024, G, bid);
    pg8::EpiBf16<0> E{(bf16_t*)(p.ws + WS_QX), 1024, nullptr, 1024, 0, 0.0625f * 1.4426950408889634f};
    pg8::gemm_phase<pg8::EpiBf16<0>, pg8::StaticOrder, true, true>(lds, g, S, E);
}
DEV void phase_wo(const FP& p, LAS unsigned char* lds, int G, int bid) {
    pg8::Gemm g{(const bf16_t*)(p.ws + WS_OX), (const bf16_t*)(p.ws + WS_W_O), MP, 1024, 1024};
    pg8::StaticOrder S; S.init(MP, 1024, G, bid);
    pg8::EpiBf16<0> E{(bf16_t*)(p.ws + WS_RAW), 1024, nullptr, 0, 0, 1.f};
    pg8::gemm_phase<pg8::EpiBf16<0>, pg8::StaticOrder, true, true>(lds, g, S, E);
}

DEV void phase_xattn(const FP& p, LAS unsigned char* lds, int G, int bid) {
    const int tid = threadIdx.x, lane = tid & 63, wave = __builtin_amdgcn_readfirstlane(tid >> 6), r = lane & 31, hh = lane >> 5, qb = wave & 3, eh = wave >> 2;
    const bf16_t* QX = (const bf16_t*)(p.ws + WS_QX); const bf16_t* KM = (const bf16_t*)(p.ws + WS_KM); const bf16_t* VM = (const bf16_t*)(p.ws + WS_VM);
    bf16_t* OX = (bf16_t*)(p.ws + WS_OX);
    constexpr int QOFF = 0, KOFF = 65536, VOFF = 98304;
    const int vlane = (4 * hh + ((lane & 15) >> 2)) * 64 + 32 * ((lane >> 4) & 1) + 8 * (lane & 3);
    for (int u = bid; u < 512; u += G) {
        const int bh = u & 7, b = bh >> 2, h = bh & 3, qblk = u >> 3;
        const size_t qrow0 = (size_t)b * 8192 + (size_t)qblk * 128;
#pragma unroll
        for (int j = 0; j < 8; ++j) {
            const int id = tid + 512 * j, row = id >> 5, ch = id & 31;
            const u32x4 v = *(const u32x4*)(QX + (qrow0 + row) * 1024 + h * 256 + ch * 8);
            *(LAS u32x4*)(lds + QOFF + row * 512 + ((ch ^ (row & 15)) << 4)) = v;
        }
        u32x4 kr[2], vr[2];
#pragma unroll
        for (int j = 0; j < 2; ++j) {
            const int id = tid + 512 * j, key = id >> 5, ch = id & 31;
            kr[j] = *(const u32x4*)(KM + ((size_t)b * 256 + key) * 1024 + h * 256 + ch * 8);
            vr[j] = *(const u32x4*)(VM + ((size_t)b * 256 + key) * 1024 + h * 256 + ch * 8);
        }
#pragma unroll
        for (int j = 0; j < 2; ++j) {
            const int id = tid + 512 * j, key = id >> 5, ch = id & 31;
            *(LAS u32x4*)(lds + KOFF + key * 512 + ((ch ^ (key & 15)) << 4)) = kr[j];
            *(LAS u32x4*)(lds + VOFF + (ch >> 2) * 2048 + key * 64 + (ch & 3) * 16) = vr[j];
        }
        __syncthreads();
        f32x16 O[4];
#pragma unroll
        for (int e = 0; e < 4; ++e)
#pragma unroll
            for (int i = 0; i < 16; ++i) O[e][i] = 0.f;
        float mrun = -1e30f, lsum = 0.f;
        const LAS unsigned char* qp = lds + QOFF + (32 * qb + r) * 512;
        for (int t = 0; t < 8; ++t) {
            const int buf = t & 1;
            if (t + 1 < 8) {
#pragma unroll
                for (int j = 0; j < 2; ++j) {
                    const int id = tid + 512 * j, key = id >> 5, ch = id & 31;
                    kr[j] = *(const u32x4*)(KM + ((size_t)b * 256 + 32 * (t + 1) + key) * 1024 + h * 256 + ch * 8);
                    vr[j] = *(const u32x4*)(VM + ((size_t)b * 256 + 32 * (t + 1) + key) * 1024 + h * 256 + ch * 8);
                }
            }
            const LAS unsigned char* kp = lds + KOFF + buf * 16384 + r * 512;
            const LAS unsigned char* vp = lds + VOFF + buf * 16384 + (4 * eh) * 2048 + vlane;
            f32x16 S;
#pragma unroll
            for (int i = 0; i < 16; ++i) S[i] = 0.f;
#pragma unroll 4
            for (int ks = 0; ks < 16; ++ks) {
                const int sl = ((2 * ks + hh) ^ (r & 15)) << 4;
                const bf16x8 a = *(const LAS bf16x8*)(kp + sl);
                const bf16x8 q = *(const LAS bf16x8*)(qp + sl);
                S = mfma32(a, q, S);
            }
            const float mx = half_max(max16(S));
            const float mnew = fmaxf(mrun, mx), alpha = __builtin_amdgcn_exp2f(mrun - mnew);
            mrun = mnew;
            float ps = 0.f;
#pragma unroll
            for (int i = 0; i < 16; ++i) { S[i] = __builtin_amdgcn_exp2f(S[i] - mnew); ps += S[i]; }
            lsum = lsum * alpha + ps;
#pragma unroll
            for (int e = 0; e < 4; ++e)
#pragma unroll
                for (int i = 0; i < 16; ++i) O[e][i] *= alpha;
            const bf16x8 P0 = pfrag(S, 0), P1 = pfrag(S, 1);
#pragma unroll
            for (int e = 0; e < 4; ++e) {
                const bf16x8 v0 = cat8(tr_read(vp + e * 2048), tr_read(vp + e * 2048 + 512));
                const bf16x8 v1 = cat8(tr_read(vp + e * 2048 + 1024), tr_read(vp + e * 2048 + 1536));
                O[e] = mfma32(v0, P0, O[e]);
                O[e] = mfma32(v1, P1, O[e]);
            }
            if (t + 1 < 8) {
#pragma unroll
                for (int j = 0; j < 2; ++j) {
                    const int id = tid + 512 * j, key = id >> 5, ch = id & 31;
                    *(LAS u32x4*)(lds + KOFF + (buf ^ 1) * 16384 + key * 512 + ((ch ^ (key & 15)) << 4)) = kr[j];
                    *(LAS u32x4*)(lds + VOFF + (buf ^ 1) * 16384 + (ch >> 2) * 2048 + key * 64 + (ch & 3) * 16) = vr[j];
                }
            }
            __syncthreads();
        }
        const float inv = 1.f / half_sum(lsum);
        LAS unsigned char* stg = lds + wave * 16384;
#pragma unroll
        for (int e = 0; e < 4; ++e)
#pragma unroll
            for (int g4 = 0; g4 < 4; ++g4) {
                u32x2 w; w.x = cvtpk(O[e][4 * g4 + 0] * inv, O[e][4 * g4 + 1] * inv); w.y = cvtpk(O[e][4 * g4 + 2] * inv, O[e][4 * g4 + 3] * inv);
                *(LAS u32x2*)(stg + r * 272 + (32 * e + 8 * g4 + 4 * hh) * 2) = w;
            }
        WAVE_SYNC();
#pragma unroll
        for (int i = 0; i < 8; ++i) {
            const int row = i * 4 + (lane >> 4), ch = lane & 15;
            const u32x4 v = *(const LAS u32x4*)(stg + row * 272 + ch * 16);
            *(u32x4*)(OX + (qrow0 + 32 * qb + row) * 1024 + h * 256 + 128 * eh + ch * 8) = v;
        }
        __syncthreads();
    }
}

constexpr float QSCALE = 0.125f * 1.4426950408889634f;
namespace pg8 {
struct EpiIn {
    static constexpr bool PERM = false, AFTER_DRAIN = false;
    bf16_t* ZX; bf16_t* Qb; bf16_t* Kb; bf16_t* Vb; float* okf; float* ovf; float* oconv;
    __device__ __forceinline__ void operator()(const f32x4 (&acc)[2][2][4][2], const Unit& u, int wr, int wc, int fr, int fq) const {
        const int row0 = u.pm * BM + wr * 64 + fr, pn = u.pn;
        if (pn < 6) {
#pragma unroll
            for (int ai = 0; ai < 2; ++ai)
#pragma unroll
                for (int m = 0; m < 4; ++m) {
                    const int row = row0 + ai * HALF + m * 16; const int t = row & 8191;
#pragma unroll
                    for (int bj = 0; bj < 2; ++bj)
#pragma unroll
                        for (int n = 0; n < 2; ++n) {
                            const f32x4 v = acc[ai][bj][m][n]; const int col = pn * BM + bj * HALF + wc * 32 + n * 16 + 4 * fq;
                            u32x2 w; w.x = cvt_pk_bf16(v[0], v[1]); w.y = cvt_pk_bf16(v[2], v[3]);
                            *(u32x2*)(ZX + (size_t)row * 1536 + col) = w;
                            if (pn >= 2 && t >= 8189) *(f32x4*)(oconv + (size_t)((row >> 13) * 3 + (t - 8189)) * 1024 + (col - 512)) = v;
                        }
                }
        } else if (pn < 10) {
            const bool isk = pn >= 8;
            const int g = wc & 1;
            float inv[4];
#pragma unroll
            for (int i = 0; i < 4; ++i) inv[i] = __builtin_amdgcn_exp2f(-(float)(16 * g + 4 * fq + i) * (13.287712379549449f / 32.f)) * 0.15915494309189535f;
#pragma unroll
            for (int ai = 0; ai < 2; ++ai)
#pragma unroll
                for (int m = 0; m < 4; ++m) {
                    const int row = row0 + ai * HALF + m * 16; const float pos = (float)(row & 8191);
                    float cs[4], sn[4];
#pragma unroll
                    for (int i = 0; i < 4; ++i) { float rev = pos * inv[i]; rev -= floorf(rev); sn[i] = __builtin_amdgcn_sinf(rev); cs[i] = __builtin_amdgcn_cosf(rev); }
#pragma unroll
                    for (int bj = 0; bj < 2; ++bj) {
                        const int cl = (pn & 1) * BM + bj * HALF + wc * 32;
                        const f32x4 x1 = acc[ai][bj][m][0], x2 = acc[ai][bj][m][1];
                        f32x4 o1, o2;
#pragma unroll
                        for (int i = 0; i < 4; ++i) { o1[i] = x1[i] * cs[i] - x2[i] * sn[i]; o2[i] = x2[i] * cs[i] + x1[i] * sn[i]; }
                        if (isk) {
                            float* kf = okf + (size_t)row * 512 + (cl >> 6) * 64 + 16 * g + 4 * fq;
                            *(f32x4*)kf = o1; *(f32x4*)(kf + 32) = o2;
                            u32x2 w; w.x = cvt_pk_bf16(o1[0], o1[1]); w.y = cvt_pk_bf16(o1[2], o1[3]);
                            *(u32x2*)(Kb + (size_t)row * 512 + cl + 4 * fq) = w;
                            w.x = cvt_pk_bf16(o2[0], o2[1]); w.y = cvt_pk_bf16(o2[2], o2[3]);
                            *(u32x2*)(Kb + (size_t)row * 512 + cl + 16 + 4 * fq) = w;
                        } else {
                            o1 = o1 * QSCALE; o2 = o2 * QSCALE;
                            u32x2 w; w.x = cvt_pk_bf16(o1[0], o1[1]); w.y = cvt_pk_bf16(o1[2], o1[3]);
                            *(u32x2*)(Qb + (size_t)row * 512 + cl + 4 * fq) = w;
                            w.x = cvt_pk_bf16(o2[0], o2[1]); w.y = cvt_pk_bf16(o2[2], o2[3]);
                            *(u32x2*)(Qb + (size_t)row * 512 + cl + 16 + 4 * fq) = w;
                        }
                    }
                }
        } else {
#pragma unroll
            for (int ai = 0; ai < 2; ++ai)
#pragma unroll
                for (int m = 0; m < 4; ++m) {
                    const int row = row0 + ai * HALF + m * 16;
#pragma unroll
                    for (int bj = 0; bj < 2; ++bj)
#pragma unroll
                        for (int n = 0; n < 2; ++n) {
                            const f32x4 v = acc[ai][bj][m][n]; const int col = (pn - 10) * BM + bj * HALF + wc * 32 + n * 16 + 4 * fq;
                            *(f32x4*)(ovf + (size_t)row * 512 + col) = v;
                            u32x2 w; w.x = cvt_pk_bf16(v[0], v[1]); w.y = cvt_pk_bf16(v[2], v[3]);
                            *(u32x2*)(Vb + (size_t)row * 512 + col) = w;
                        }
                }
        }
    }
};
}

DEV void phase_prep_mix(const FP& p, LAS unsigned char* lds, int gw, int ngw, int wave, int lane) {
    LAS float* scr = (LAS float*)(lds + wave * 16384);
    constexpr int I_IN = 16 * 97, I_OUT = 16 * 32;
    for (int it = gw; it < I_IN + I_OUT; it += ngw) {
        if (it < I_IN) transpose_item(p.in[9], 1024, 3080, (bf16_t*)(p.ws + WS_W_IN), it, scr, lane, RmIn{});
        else transpose_item(p.in[21], 1024, 1024, (bf16_t*)(p.ws + WS_W_OUT), it - I_IN, scr, lane, RmPlain{0});
    }
    __syncthreads();
    LAS float* wdt = (LAS float*)lds;
    for (int i = threadIdx.x; i < 8192; i += 512) wdt[i] = p.in[9][(size_t)(i >> 3) * 3080 + 1536 + (i & 7)];
    __syncthreads();
    const float* x = p.in[0]; const float* g = p.in[27]; bf16_t* xn = (bf16_t*)(p.ws + WS_XN); float* dtv = (float*)(p.ws + WS_DTV);
    const float bias = p.in[12][lane & 7];
    for (int r = gw; r < MP; r += ngw) {
        f32x4 h[4]; float ss = 0.f;
#pragma unroll
        for (int j = 0; j < 4; ++j) { h[j] = ((const f32x4*)(x + (size_t)r * 1024))[lane + 64 * j]; ss += h[j].x * h[j].x + h[j].y * h[j].y + h[j].z * h[j].z + h[j].w * h[j].w; }
        const float rs = rsqrtf(wave_sum(ss) * (1.f / 1024.f) + 1e-6f);
        float d[8];
#pragma unroll
        for (int k = 0; k < 8; ++k) d[k] = 0.f;
#pragma unroll
        for (int j = 0; j < 4; ++j) {
            const f32x4 gg = ((const f32x4*)g)[lane + 64 * j]; h[j] = h[j] * rs * gg;
            u32x2 w; w.x = pk2(h[j].x, h[j].y); w.y = pk2(h[j].z, h[j].w);
            ((u32x2*)(xn + (size_t)r * 1024))[lane + 64 * j] = w;
#pragma unroll
            for (int i = 0; i < 4; ++i) {
                const LAS f32x4* wp = (const LAS f32x4*)(wdt + (4 * (lane + 64 * j) + i) * 8);
                const f32x4 w0 = wp[0], w1 = wp[1]; const float hv = h[j][i];
                d[0] += hv * w0.x; d[1] += hv * w0.y; d[2] += hv * w0.z; d[3] += hv * w0.w; d[4] += hv * w1.x; d[5] += hv * w1.y; d[6] += hv * w1.z; d[7] += hv * w1.w;
            }
        }
#pragma unroll
        for (int k = 0; k < 8; ++k) d[k] = wave_sum(d[k]);
        float mine = d[0];
#pragma unroll
        for (int k = 1; k < 8; ++k) mine = ((lane & 7) == k) ? d[k] : mine;
        const float xx = mine + bias;
        if (lane < 8) dtv[(size_t)r * 8 + lane] = (xx > 20.f) ? xx : log1pf(expf(xx));
    }
    __syncthreads();
}
DEV void phase_inproj(const FP& p, LAS unsigned char* lds, int G, int bid) {
    pg8::Gemm g{(const bf16_t*)(p.ws + WS_XN), (const bf16_t*)(p.ws + WS_W_IN), MP, 3072, 1024};
    pg8::StaticOrder S; S.init(MP, 3072, G, bid);
    pg8::EpiIn E{(bf16_t*)(p.ws + WS_ZX), (bf16_t*)(p.ws + WS_Q), (bf16_t*)(p.ws + WS_K), (bf16_t*)(p.ws + WS_V), p.out + 16908288, p.out + 25296896, p.out + 33816576};
    pg8::gemm_phase<pg8::EpiIn, pg8::StaticOrder, true, true>(lds, g, S, E);
}
DEV void phase_outproj(const FP& p, LAS unsigned char* lds, int G, int bid) {
    pg8::Gemm g{(const bf16_t*)(p.ws + WS_CAT), (const bf16_t*)(p.ws + WS_W_OUT), MP, 1024, 1024};
    pg8::StaticOrder S; S.init(MP, 1024, G, bid);
    pg8::EpiBf16<0> E{(bf16_t*)(p.ws + WS_RAW), 1024, nullptr, 0, 0, 1.f};
    pg8::gemm_phase<pg8::EpiBf16<0>, pg8::StaticOrder, true, true>(lds, g, S, E);
}

DEV float ssd_tables(const FP& p, LAS float* tdt, LAS float* tac, size_t row0, int h, int lane) {
    const float dt = ((const float*)(p.ws + WS_DTV))[(row0 + lane) * 8 + h];
    const float a = -expf(p.in[13][h]);
    float v = dt * a;
#pragma unroll
    for (int o = 1; o < 64; o <<= 1) { const float t = __shfl_up(v, o); if (lane >= o) v += t; }
    tdt[lane * 8 + h] = dt; tac[lane * 8 + h] = v;
    return __shfl(v, 63);
}
template <class F> DEV void ssd_conv8(const FP& p, size_t row0, int col0, int l0, F emit) {
    const bf16_t* ZX = (const bf16_t*)(p.ws + WS_ZX);
    const float* cw = p.in[10]; const float* cb = p.in[11];
    f32x4 w[4][2], bias[2];
#pragma unroll
    for (int j = 0; j < 4; ++j) { w[j][0] = *(const f32x4*)(cw + j * 1024 + col0); w[j][1] = *(const f32x4*)(cw + j * 1024 + col0 + 4); }
    bias[0] = *(const f32x4*)(cb + col0); bias[1] = *(const f32x4*)(cb + col0 + 4);
    const int t0 = (int)(row0 & 8191);
    f32x4 u[4][2];
#pragma unroll
    for (int j = 0; j < 3; ++j) {
        const int l = l0 - 3 + j;
        if (t0 + l >= 0) {
            const u32x4 r = *(const u32x4*)(ZX + (row0 + l) * 1536 + 512 + col0);
            u[j][0] = (f32x4){bflo(r.x), bfhi(r.x), bflo(r.y), bfhi(r.y)}; u[j][1] = (f32x4){bflo(r.z), bfhi(r.z), bflo(r.w), bfhi(r.w)};
        } else { u[j][0] = (f32x4){0.f, 0.f, 0.f, 0.f}; u[j][1] = u[j][0]; }
    }
#pragma unroll
    for (int i = 0; i < 16; ++i) {
        const int l = l0 + i;
        const u32x4 r = *(const u32x4*)(ZX + (row0 + l) * 1536 + 512 + col0);
        u[3][0] = (f32x4){bflo(r.x), bfhi(r.x), bflo(r.y), bfhi(r.y)}; u[3][1] = (f32x4){bflo(r.z), bfhi(r.z), bflo(r.w), bfhi(r.w)};
        f32x4 a0 = bias[0] + w[0][0] * u[0][0] + w[1][0] * u[1][0] + w[2][0] * u[2][0] + w[3][0] * u[3][0];
        f32x4 a1 = bias[1] + w[0][1] * u[0][1] + w[1][1] * u[1][1] + w[2][1] * u[2][1] + w[3][1] * u[3][1];
#pragma unroll
        for (int k = 0; k < 4; ++k) { a0[k] = fast_silu(a0[k]); a1[k] = fast_silu(a1[k]); }
        emit(l, a0, a1);
        u[0][0] = u[1][0]; u[0][1] = u[1][1]; u[1][0] = u[2][0]; u[1][1] = u[2][1]; u[2][0] = u[3][0]; u[2][1] = u[3][1];
    }
}
constexpr int S_XS = 0, S_B = 65536, S_C = 98304, S_TDT = 131072, S_TAC = 133120, S_SSQ = 135168;
DEV int trlane(int lane) { return ((lane & 15) >> 2) * 64 + 32 * ((lane >> 4) & 1) + 8 * (lane & 3); }

DEV void phase_ssd1(const FP& p, LAS unsigned char* lds, int G, int bid) {
    const int tid = threadIdx.x, lane = tid & 63, wave = __builtin_amdgcn_readfirstlane(tid >> 6), hh = lane >> 5;
    LAS float* tdt = (LAS float*)(lds + S_TDT); LAS float* tac = (LAS float*)(lds + S_TAC);
    bf16_t* ST = (bf16_t*)(p.ws + WS_ST); float* cdec = (float*)(p.ws + WS_CDEC);
    for (int u = bid; u < 256; u += G) {
        const int b = u >> 7, c = u & 127; const size_t row0 = (size_t)b * 8192 + (size_t)c * 64;
        const float tot = ssd_tables(p, tdt, tac, row0, wave, lane);
        if (lane == 0) cdec[u * 8 + wave] = expf(tot);
        __syncthreads();
        { const int i = tid; const float t63 = tac[63 * 8 + (i & 7)]; const float s = tdt[i] * expf(t63 - tac[i]); __syncthreads(); tdt[i] = s; }
        __syncthreads();
        if (tid < 384) {
            const int cg = tid >> 2, tq = tid & 3, col0 = cg * 8;
            ssd_conv8(p, row0, col0, tq * 16, [&](int l, f32x4 a0, f32x4 a1) {
                u32x4 w;
                if (cg < 64) {
                    const int h = cg >> 3, pp = col0 & 63; const float s = tdt[l * 8 + h];
                    a0 = a0 * s; a1 = a1 * s;
                    w.x = pk2(a0[0], a0[1]); w.y = pk2(a0[2], a0[3]); w.z = pk2(a1[0], a1[1]); w.w = pk2(a1[2], a1[3]);
                    *(LAS u32x4*)(lds + S_XS + h * 8192 + (pp >> 5) * 4096 + l * 64 + (pp & 31) * 2) = w;
                } else {
                    const int n = col0 - 512, g = n >> 7, nn = n & 127;
                    w.x = pk2(a0[0], a0[1]); w.y = pk2(a0[2], a0[3]); w.z = pk2(a1[0], a1[1]); w.w = pk2(a1[2], a1[3]);
                    *(LAS u32x4*)(lds + S_B + g * 16384 + (nn >> 5) * 4096 + l * 64 + (nn & 31) * 2) = w;
                }
            });
        }
        __syncthreads();
        const int h = wave, g = h >> 2;
        const LAS unsigned char* xa = lds + S_XS + h * 8192 + hh * 512 + trlane(lane);
        const LAS unsigned char* ba = lds + S_B + g * 16384 + hh * 512 + trlane(lane);
        bf16_t* sp = ST + ((size_t)u * 8 + h) * 8192;
#pragma unroll 1
        for (int nh = 0; nh < 2; ++nh) {
            f32x16 acc[2][2];
#pragma unroll
            for (int a = 0; a < 2; ++a)
#pragma unroll
                for (int n = 0; n < 2; ++n)
#pragma unroll
                    for (int i = 0; i < 16; ++i) acc[a][n][i] = 0.f;
#pragma unroll 2
            for (int s = 0; s < 4; ++s) {
                bf16x8 af[2], bfr[2];
#pragma unroll
                for (int a = 0; a < 2; ++a) af[a] = cat8(tr_read(xa + a * 4096 + s * 1024), tr_read(xa + a * 4096 + s * 1024 + 256));
#pragma unroll
                for (int n = 0; n < 2; ++n) bfr[n] = cat8(tr_read(ba + (2 * nh + n) * 4096 + s * 1024), tr_read(ba + (2 * nh + n) * 4096 + s * 1024 + 256));
#pragma unroll
                for (int a = 0; a < 2; ++a)
#pragma unroll
                    for (int n = 0; n < 2; ++n) acc[a][n] = mfma32(af[a], bfr[n], acc[a][n]);
            }
#pragma unroll
            for (int a = 0; a < 2; ++a)
#pragma unroll
                for (int n = 0; n < 2; ++n)
#pragma unroll
                    for (int i = 0; i < 16; ++i) {
                        const int pr = 32 * a + (i & 3) + 8 * (i >> 2) + 4 * hh;
                        sp[pr * 128 + 32 * (2 * nh + n) + (lane & 31)] = (bf16_t)f2bf(acc[a][n][i]);
                    }
        }
        __syncthreads();
    }
}

DEV void phase_ssd2(const FP& p, int G, int bid) {
    const int tid = threadIdx.x;
    unsigned* ST = (unsigned*)(p.ws + WS_ST); const float* cdec = (const float*)(p.ws + WS_CDEC); float* pssm = p.out + 33685504;
    for (int blk = bid; blk < 128; blk += G) {
        const int idx = blk * 512 + tid;
        const int n2 = idx & 63, pr = (idx >> 6) & 63, h = (idx >> 12) & 7, b = idx >> 15;
        float s0 = 0.f, s1 = 0.f;
        for (int c0 = 0; c0 < 128; c0 += 16) {
            unsigned v[16];
#pragma unroll
            for (int j = 0; j < 16; ++j) v[j] = ST[(((size_t)(b * 128 + c0 + j) * 8 + h) * 64 + pr) * 64 + n2];
#pragma unroll
            for (int j = 0; j < 16; ++j) {
                const float dc = cdec[(b * 128 + c0 + j) * 8 + h];
                ST[(((size_t)(b * 128 + c0 + j) * 8 + h) * 64 + pr) * 64 + n2] = pk2(s0, s1);
                s0 = s0 * dc + bflo(v[j]); s1 = s1 * dc + bfhi(v[j]);
            }
        }
        float2 o; o.x = s0; o.y = s1;
        ((float2*)pssm)[(((size_t)b * 8 + h) * 64 + pr) * 64 + n2] = o;
    }
}

DEV void phase_ssd3(const FP& p, LAS unsigned char* lds, int G, int bid) {
    LAS float* tdt = (LAS float*)(lds + S_TDT); LAS float* tac = (LAS float*)(lds + S_TAC); LAS float* ssq = (LAS float*)(lds + S_SSQ);
    const bf16_t* ST = (const bf16_t*)(p.ws + WS_ST); const bf16_t* ZX = (const bf16_t*)(p.ws + WS_ZX); bf16_t* CAT = (bf16_t*)(p.ws + WS_CAT);
    for (int u = bid; u < 256; u += G) {
        int tid = threadIdx.x; asm volatile("" : "+v"(tid));
        const int lane = tid & 63, wave = __builtin_amdgcn_readfirstlane(tid >> 6), r = lane & 31, hh = lane >> 5;
        const int b = u >> 7, c = u & 127; const size_t row0 = (size_t)b * 8192 + (size_t)c * 64;
        (void)ssd_tables(p, tdt, tac, row0, wave, lane);
        {
            const int cg = tid >> 2, tq = tid & 3, col0 = cg * 8;
            ssd_conv8(p, row0, col0, tq * 16, [&](int l, f32x4 a0, f32x4 a1) {
                u32x4 w; w.x = pk2(a0[0], a0[1]); w.y = pk2(a0[2], a0[3]); w.z = pk2(a1[0], a1[1]); w.w = pk2(a1[2], a1[3]);
                if (cg < 64) {
                    const int h = cg >> 3, pp = col0 & 63;
                    *(LAS u32x4*)(lds + S_XS + h * 8192 + (pp >> 5) * 4096 + l * 64 + (pp & 31) * 2) = w;
                } else {
                    const int n = (col0 - 512) & 255, g = n >> 7, ch = (n & 127) >> 3;
                    *(LAS u32x4*)(lds + (col0 < 768 ? S_B : S_C) + g * 16384 + l * 256 + ((ch ^ (l & 15)) << 4)) = w;
                }
            });
        }
        __syncthreads();
        const int h = wave, g = h >> 2;
        f32x16 Y[2][2];
#pragma unroll
        for (int a = 0; a < 2; ++a)
#pragma unroll
            for (int l2 = 0; l2 < 2; ++l2)
#pragma unroll
                for (int i = 0; i < 16; ++i) Y[a][l2][i] = 0.f;
        const LAS unsigned char* cp = lds + S_C + g * 16384 + r * 256;
        const LAS unsigned char* bp = lds + S_B + g * 16384 + r * 256;
        const bf16_t* pv = ST + ((size_t)u * 8 + h) * 8192 + (size_t)r * 128 + 8 * hh;
#pragma unroll 2
        for (int ks = 0; ks < 8; ++ks) {
            const int sl = ((2 * ks + hh) ^ (r & 15)) << 4;
            const bf16x8 c0 = *(const LAS bf16x8*)(cp + sl), c1 = *(const LAS bf16x8*)(cp + 32 * 256 + sl);
            const bf16x8 p0 = *(const bf16x8*)(pv + 16 * ks), p1 = *(const bf16x8*)(pv + 32 * 128 + 16 * ks);
            Y[0][0] = mfma32(p0, c0, Y[0][0]); Y[0][1] = mfma32(p0, c1, Y[0][1]);
            Y[1][0] = mfma32(p1, c0, Y[1][0]); Y[1][1] = mfma32(p1, c1, Y[1][1]);
        }
        float acl[2];
#pragma unroll
        for (int l2 = 0; l2 < 2; ++l2) {
            acl[l2] = tac[(32 * l2 + r) * 8 + h]; const float e = expf(acl[l2]);
#pragma unroll
            for (int a = 0; a < 2; ++a)
#pragma unroll
                for (int i = 0; i < 16; ++i) Y[a][l2][i] *= e;
        }
        __builtin_amdgcn_sched_barrier(0);
        const LAS unsigned char* xa = lds + S_XS + h * 8192 + hh * 256 + trlane(lane);
#pragma unroll
        for (int lb = 0; lb < 2; ++lb)
#pragma unroll
            for (int sb = 0; sb <= lb; ++sb) {
                f32x16 T;
#pragma unroll
                for (int i = 0; i < 16; ++i) T[i] = 0.f;
#pragma unroll 2
                for (int ks = 0; ks < 8; ++ks) {
                    const int sl = ((2 * ks + hh) ^ (r & 15)) << 4;
                    const bf16x8 bb = *(const LAS bf16x8*)(bp + sb * 32 * 256 + sl), cc = *(const LAS bf16x8*)(cp + lb * 32 * 256 + sl);
                    T = mfma32(bb, cc, T);
                }
#pragma unroll
                for (int i = 0; i < 16; ++i) {
                    const int s = 32 * sb + (i & 3) + 8 * (i >> 2) + 4 * hh;
                    const float f = tdt[s * 8 + h] * __builtin_amdgcn_exp2f(1.4426950408889634f * fminf(acl[lb] - tac[s * 8 + h], 0.f));
                    T[i] = (s <= 32 * lb + r) ? T[i] * f : 0.f;
                }
                const bf16x8 P0 = pfrag(T, 0), P1 = pfrag(T, 1);
#pragma unroll
                for (int a = 0; a < 2; ++a) {
                    const bf16x8 x0 = cat8(tr_read(xa + a * 4096 + (2 * sb) * 1024), tr_read(xa + a * 4096 + (2 * sb) * 1024 + 512));
                    const bf16x8 x1 = cat8(tr_read(xa + a * 4096 + (2 * sb + 1) * 1024), tr_read(xa + a * 4096 + (2 * sb + 1) * 1024 + 512));
                    Y[a][lb] = mfma32(x0, P0, Y[a][lb]);
                    Y[a][lb] = mfma32(x1, P1, Y[a][lb]);
                }
            }
        __builtin_amdgcn_sched_barrier(0);
        const float Dh = p.in[14][h];
        float sq[2] = {0.f, 0.f};
#pragma unroll
        for (int a = 0; a < 2; ++a)
#pragma unroll
            for (int l2 = 0; l2 < 2; ++l2) {
                const int l = 32 * l2 + r;
#pragma unroll
                for (int g4 = 0; g4 < 4; ++g4) {
                    const int pp = 8 * g4 + 4 * hh;
                    const u32x2 xw = *(const LAS u32x2*)(lds + S_XS + h * 8192 + a * 4096 + l * 64 + pp * 2);
                    const u32x2 zw = *(const u32x2*)(ZX + (row0 + l) * 1536 + h * 64 + 32 * a + pp);
                    const float xv[4] = {bflo(xw.x), bfhi(xw.x), bflo(xw.y), bfhi(xw.y)}, zv[4] = {bflo(zw.x), bfhi(zw.x), bflo(zw.y), bfhi(zw.y)};
#pragma unroll
                    for (int i = 0; i < 4; ++i) { const float v = (Y[a][l2][4 * g4 + i] + Dh * xv[i]) * fast_silu(zv[i]); Y[a][l2][4 * g4 + i] = v; sq[l2] += v * v; }
                }
            }
#pragma unroll
        for (int l2 = 0; l2 < 2; ++l2) { sq[l2] = half_sum(sq[l2]); if (hh == 0) ssq[(h * 2 + l2) * 32 + r] = sq[l2]; }
        __syncthreads();
        float rs[2];
#pragma unroll
        for (int l2 = 0; l2 < 2; ++l2) {
            float t = 0.f;
#pragma unroll
            for (int k = 0; k < 4; ++k) t += ssq[((4 * g + k) * 2 + l2) * 32 + r];
            rs[l2] = rsqrtf(t * (1.f / 256.f) + 1e-5f);
        }
#pragma unroll
        for (int a = 0; a < 2; ++a)
#pragma unroll
            for (int g4 = 0; g4 < 4; ++g4) {
                const int pcol = h * 64 + 32 * a + 8 * g4 + 4 * hh;
                const f32x4 w = *(const f32x4*)(p.in[15] + pcol);
#pragma unroll
                for (int l2 = 0; l2 < 2; ++l2) {
                    u32x2 o; o.x = cvtpk(Y[a][l2][4 * g4 + 0] * rs[l2] * w[0], Y[a][l2][4 * g4 + 1] * rs[l2] * w[1]);
                    o.y = cvtpk(Y[a][l2][4 * g4 + 2] * rs[l2] * w[2], Y[a][l2][4 * g4 + 3] * rs[l2] * w[3]);
                    *(u32x2*)(CAT + (row0 + 32 * l2 + r) * 1024 + pcol) = o;
                }
            }
        __syncthreads();
    }
}

DEV void phase_attn(const FP& p, LAS unsigned char* lds, int G, int bid) {
    const int tid0 = threadIdx.x, lane0 = tid0 & 63;
    const bf16_t* Qg = (const bf16_t*)(p.ws + WS_Q); const bf16_t* Kg = (const bf16_t*)(p.ws + WS_K); const bf16_t* Vg = (const bf16_t*)(p.ws + WS_V);
    bf16_t* CAT = (bf16_t*)(p.ws + WS_CAT);
    const float lam_init = 0.2f;
    const float lam = expf(wave_sum(p.in[16][lane0] * p.in[17][lane0])) - expf(wave_sum(p.in[18][lane0] * p.in[19][lane0])) + lam_init;
    LAS float* subw = (LAS float*)(lds + 131072);
    if (tid0 < 128) subw[tid0] = p.in[20][tid0];
    for (int pu = bid; pu < 256; pu += G) {
        const int bh = pu & 7, b = bh >> 2, h = bh & 3, pr = pu >> 3;
        for (int half = 0; half < 2; ++half) {
            int tid = threadIdx.x; asm volatile("" : "+v"(tid));
            const int lane = tid & 63, wave = __builtin_amdgcn_readfirstlane(tid >> 6), r = lane & 31, hh = lane >> 5, qb = wave & 3, c = wave >> 2;
            const int vlane = (4 * hh) * 64 + trlane(lane);
            const int jq = half ? 63 - pr : pr;
            const size_t rowb = (size_t)b * 8192; const int q0 = jq * 128;
            const int ntb = 2 * jq + 2, myn = 2 * jq + (qb >> 1) + 1;
            bf16x8 qf[4];
#pragma unroll
            for (int ks = 0; ks < 4; ++ks) qf[ks] = *(const bf16x8*)(Qg + (rowb + q0 + 32 * qb + r) * 512 + h * 128 + c * 64 + 16 * ks + 8 * hh);
            u32x4 kr[2], vr[2];
#pragma unroll
            for (int j = 0; j < 2; ++j) {
                const int id = tid + 512 * j, key = id >> 4, ch = id & 15;
                kr[j] = *(const u32x4*)(Kg + (rowb + key) * 512 + h * 128 + ch * 8);
                vr[j] = *(const u32x4*)(Vg + (rowb + key) * 512 + h * 128 + ch * 8);
            }
#pragma unroll
            for (int j = 0; j < 2; ++j) {
                const int id = tid + 512 * j, key = id >> 4, ch = id & 15;
                *(LAS u32x4*)(lds + (ch >> 3) * 8192 + key * 128 + (((ch & 7) ^ ((key >> 1) & 7)) << 4)) = kr[j];
                *(LAS u32x4*)(lds + 16384 + (ch >> 2) * 4096 + key * 64 + (ch & 3) * 16) = vr[j];
            }
            __syncthreads();
            f32x16 O[4];
#pragma unroll
            for (int e = 0; e < 4; ++e)
#pragma unroll
                for (int i = 0; i < 16; ++i) O[e][i] = 0.f;
            float mrun = -1e30f, lsum = 0.f;
            for (int t = 0; t < ntb; ++t) {
                const int buf = t & 1;
                if (t + 1 < ntb) {
#pragma unroll
                    for (int j = 0; j < 2; ++j) {
                        const int id = tid + 512 * j, key = id >> 4, ch = id & 15;
                        kr[j] = *(const u32x4*)(Kg + (rowb + 64 * (t + 1) + key) * 512 + h * 128 + ch * 8);
                        vr[j] = *(const u32x4*)(Vg + (rowb + 64 * (t + 1) + key) * 512 + h * 128 + ch * 8);
                    }
                }
                if (t < myn) {
                    const LAS unsigned char* kp = lds + buf * 32768 + c * 8192 + r * 128;
                    const LAS unsigned char* vp = lds + buf * 32768 + 16384 + vlane;
                    f32x16 S0, S1;
#pragma unroll
                    for (int i = 0; i < 16; ++i) { S0[i] = 0.f; S1[i] = 0.f; }
#pragma unroll
                    for (int ks = 0; ks < 4; ++ks) {
                        const int sl = ((2 * ks + hh) ^ ((r >> 1) & 7)) << 4;
                        const bf16x8 a0 = *(const LAS bf16x8*)(kp + sl), a1 = *(const LAS bf16x8*)(kp + 32 * 128 + sl);
                        S0 = mfma32(a0, qf[ks], S0); S1 = mfma32(a1, qf[ks], S1);
                    }
                    const float mx = half_max(fmaxf(max16(S0), max16(S1)));
                    const float mnew = fmaxf(mrun, mx), alpha = __builtin_amdgcn_exp2f(mrun - mnew);
                    mrun = mnew;
                    float ps = 0.f;
#pragma unroll
                    for (int i = 0; i < 16; ++i) { S0[i] = __builtin_amdgcn_exp2f(S0[i] - mnew); S1[i] = __builtin_amdgcn_exp2f(S1[i] - mnew); ps += S0[i] + S1[i]; }
                    lsum = lsum * alpha + ps;
#pragma unroll
                    for (int e = 0; e < 4; ++e)
#pragma unroll
                        for (int i = 0; i < 16; ++i) O[e][i] *= alpha;
                    const bf16x8 P0 = pfrag(S0, 0), P1 = pfrag(S0, 1), P2 = pfrag(S1, 0), P3 = pfrag(S1, 1);
#pragma unroll
                    for (int e = 0; e < 4; ++e) {
                        const bf16x8 v0 = cat8(tr_read(vp + e * 4096), tr_read(vp + e * 4096 + 512));
                        const bf16x8 v1 = cat8(tr_read(vp + e * 4096 + 1024), tr_read(vp + e * 4096 + 1536));
                        const bf16x8 v2 = cat8(tr_read(vp + e * 4096 + 2048), tr_read(vp + e * 4096 + 2560));
                        const bf16x8 v3 = cat8(tr_read(vp + e * 4096 + 3072), tr_read(vp + e * 4096 + 3584));
                        O[e] = mfma32(v0, P0, O[e]); O[e] = mfma32(v1, P1, O[e]); O[e] = mfma32(v2, P2, O[e]); O[e] = mfma32(v3, P3, O[e]);
                        if (e & 1) __builtin_amdgcn_sched_barrier(0);
                    }
                }
                if (t + 1 < ntb) {
#pragma unroll
                    for (int j = 0; j < 2; ++j) {
                        const int id = tid + 512 * j, key = id >> 4, ch = id & 15;
                        *(LAS u32x4*)(lds + (buf ^ 1) * 32768 + (ch >> 3) * 8192 + key * 128 + (((ch & 7) ^ ((key >> 1) & 7)) << 4)) = kr[j];
                        *(LAS u32x4*)(lds + (buf ^ 1) * 32768 + 16384 + (ch >> 2) * 4096 + key * 64 + (ch & 3) * 16) = vr[j];
                    }
                }
                __syncthreads();
            }
            const float inv = 1.f / half_sum(lsum);
            LAS float* xch = (LAS float*)(lds + qb * 16384);
            if (c == 1) {
                const float f = -lam * inv;
#pragma unroll
                for (int e = 0; e < 4; ++e)
#pragma unroll
                    for (int i = 0; i < 16; ++i) xch[(e * 16 + i) * 64 + lane] = O[e][i] * f;
            }
            __syncthreads();
            if (c == 0) {
                float ss = 0.f;
#pragma unroll
                for (int e = 0; e < 4; ++e)
#pragma unroll
                    for (int i = 0; i < 16; ++i) { const float v = O[e][i] * inv + xch[(e * 16 + i) * 64 + lane]; O[e][i] = v; ss += v * v; }
                ss = half_sum(ss);
                const float rs = rsqrtf(ss * (1.f / 128.f) + 1e-5f) * (1.f - lam_init);
                WAVE_SYNC();
                LAS unsigned char* stg = lds + qb * 16384;
#pragma unroll
                for (int e = 0; e < 4; ++e)
#pragma unroll
                    for (int g4 = 0; g4 < 4; ++g4) {
                        const int e0 = 32 * e + 8 * g4 + 4 * hh;
                        const f32x4 w = *(const LAS f32x4*)(subw + e0);
                        u32x2 o; o.x = cvtpk(O[e][4 * g4 + 0] * rs * w[0], O[e][4 * g4 + 1] * rs * w[1]); o.y = cvtpk(O[e][4 * g4 + 2] * rs * w[2], O[e][4 * g4 + 3] * rs * w[3]);
                        *(LAS u32x2*)(stg + r * 272 + e0 * 2) = o;
                    }
                WAVE_SYNC();
#pragma unroll
                for (int i = 0; i < 8; ++i) {
                    const int row = i * 4 + (lane >> 4), ch = lane & 15;
                    const u32x4 v = *(const LAS u32x4*)(stg + row * 272 + ch * 16);
                    *(u32x4*)(CAT + (rowb + q0 + 32 * qb + row) * 1024 + 512 + h * 128 + ch * 8) = v;
                }
            }
            __syncthreads();
        }
    }
}

constexpr int NS = 128;
constexpr size_t SB_XN = 0, SB_Z = 256 * 1024, SB_XBC = 512 * 1024, SB_Q = 1024 * 1024, SB_DTV = 1280 * 1024, SB_YPRE = 1536 * 1024, SB_CAT = 1792 * 1024, SB_MIX = 2048 * 1024,
                 SB_QX = 2560 * 1024, SB_OX = 3072 * 1024, SB_HID = 3328 * 1024, SB_AML = 4096 * 1024, SB_XML = 4608 * 1024, SB_XO = 5 * MiB, SB_AO = 8 * MiB;
constexpr int N_ATILE = 33;

template <class Epi>
DEV void s_gemm(const bf16_t* A, const bf16_t* Bt, int N, int K, LAS unsigned char* lds, int bid, int G, int rot, const Epi& E) {
    int tid = threadIdx.x; asm volatile("" : "+v"(tid));
    const int lane = tid & 63, wave = __builtin_amdgcn_readfirstlane(tid >> 6), r = lane & 31, hh = lane >> 5, mb = wave & 3, kh = wave >> 2;
    const int nun = N >> 5;
    for (int u = (bid + G - rot) % G; u < nun; u += G) {
        const int n0 = u * 32;
        const bf16_t* ap = A + (size_t)(32 * mb + r) * K + kh * (K >> 1) + 16 * hh;
        const bf16_t* bp = Bt + (size_t)(n0 + r) * K + kh * (K >> 1) + 16 * hh;
        f32x16 acc;
#pragma unroll
        for (int i = 0; i < 16; ++i) acc[i] = 0.f;
        const int nit = K >> 6;
#pragma unroll 4
        for (int j = 0; j < nit; ++j) {
            const bf16x8 a0 = *(const bf16x8*)(ap + 32 * j), a1 = *(const bf16x8*)(ap + 32 * j + 8);
            const bf16x8 b0 = *(const bf16x8*)(bp + 32 * j), b1 = *(const bf16x8*)(bp + 32 * j + 8);
            acc = mfma32(b0, a0, acc); acc = mfma32(b1, a1, acc);
        }
        LAS float* red = (LAS float*)lds + mb * 1024;
        if (kh == 1) {
#pragma unroll
            for (int i = 0; i < 16; ++i) red[i * 64 + lane] = acc[i];
        }
        __syncthreads();
        if (kh == 0) {
#pragma unroll
            for (int i = 0; i < 16; ++i) acc[i] += red[i * 64 + lane];
            E(acc, 32 * mb + r, n0, hh);
        }
        __syncthreads();
    }
}
struct EpiSF32 {
    float* C; int ldc; float scale;
    __device__ __forceinline__ void operator()(const f32x16& acc, int m, int n0, int hh) const {
#pragma unroll
        for (int g4 = 0; g4 < 4; ++g4) { f32x4 v = {acc[4 * g4] * scale, acc[4 * g4 + 1] * scale, acc[4 * g4 + 2] * scale, acc[4 * g4 + 3] * scale}; *(f32x4*)(C + (size_t)m * ldc + n0 + 8 * g4 + 4 * hh) = v; }
    }
};
struct EpiSSwiglu {
    bf16_t* H;
    __device__ __forceinline__ void operator()(const f32x16& acc, int m, int n0, int hh) const {
#pragma unroll
        for (int g4 = 0; g4 < 2; ++g4) {
            u32x2 w; w.x = cvtpk(fast_silu(acc[4 * g4]) * acc[4 * g4 + 8], fast_silu(acc[4 * g4 + 1]) * acc[4 * g4 + 9]);
            w.y = cvtpk(fast_silu(acc[4 * g4 + 2]) * acc[4 * g4 + 10], fast_silu(acc[4 * g4 + 3]) * acc[4 * g4 + 11]);
            *(u32x2*)(H + (size_t)m * 2816 + 16 * (n0 >> 5) + 8 * g4 + 4 * hh) = w;
        }
    }
};
struct EpiSIn {
    float *z, *xbc, *q, *ok, *ov, *oconv;
    __device__ __forceinline__ void operator()(const f32x16& acc, int m, int n0, int hh) const {
        const int t = m & 15, b = m >> 4;
        if (n0 < 1536) {
#pragma unroll
            for (int g4 = 0; g4 < 4; ++g4) {
                const f32x4 v = {acc[4 * g4], acc[4 * g4 + 1], acc[4 * g4 + 2], acc[4 * g4 + 3]}; const int col = n0 + 8 * g4 + 4 * hh;
                if (n0 < 512) *(f32x4*)(z + (size_t)m * 512 + col) = v;
                else { *(f32x4*)(xbc + (size_t)m * 1024 + col - 512) = v; if (t >= 13) *(f32x4*)(oconv + (size_t)(b * 3 + t - 13) * 1024 + col - 512) = v; }
            }
        } else if (n0 < 2560) {
            const bool isk = n0 >= 2048; const int cl = (n0 - (isk ? 2048 : 1536)), u64 = cl >> 6, g = (cl >> 5) & 1;
            const float pos = (float)(2048 + t);
            float* dst = (isk ? ok : q) + (size_t)m * 512 + u64 * 64;
#pragma unroll
            for (int g4 = 0; g4 < 2; ++g4) {
                f32x4 o1, o2;
#pragma unroll
                for (int i = 0; i < 4; ++i) {
                    const int d0 = 16 * g + 8 * g4 + 4 * hh + i;
                    float rev = pos * (__builtin_amdgcn_exp2f(-(float)d0 * (13.287712379549449f / 32.f)) * 0.15915494309189535f); rev -= floorf(rev);
                    const float sn = __builtin_amdgcn_sinf(rev), cs = __builtin_amdgcn_cosf(rev);
                    const float x1 = acc[4 * g4 + i], x2 = acc[4 * g4 + 8 + i];
                    o1[i] = x1 * cs - x2 * sn; o2[i] = x2 * cs + x1 * sn;
                }
                const int d0 = 16 * g + 8 * g4 + 4 * hh;
                *(f32x4*)(dst + d0) = o1; *(f32x4*)(dst + d0 + 32) = o2;
            }
        } else {
#pragma unroll
            for (int g4 = 0; g4 < 4; ++g4) { const f32x4 v = {acc[4 * g4], acc[4 * g4 + 1], acc[4 * g4 + 2], acc[4 * g4 + 3]}; *(f32x4*)(ov + (size_t)m * 512 + n0 - 2560 + 8 * g4 + 4 * hh) = v; }
        }
    }
};

DEV void s_row(const FP& p, const float* raw, const float* hin, const float* gpost, float* hout, const float* gpre, bf16_t* xn, float* dtv, int bid, int G, int rot) {
    const int lane = threadIdx.x & 63, wave = __builtin_amdgcn_readfirstlane(threadIdx.x >> 6);
    const int blk = (bid + G - rot) % G;
    for (int r = blk + G * wave; r < NS; r += 8 * G) {
        f32x4 h[4];
#pragma unroll
        for (int j = 0; j < 4; ++j) h[j] = ((const f32x4*)(hin + (size_t)r * 1024))[lane + 64 * j];
        if (raw) {
            f32x4 v[4]; float ss = 0.f;
#pragma unroll
            for (int j = 0; j < 4; ++j) { v[j] = ((const f32x4*)(raw + (size_t)r * 1024))[lane + 64 * j]; ss += v[j].x * v[j].x + v[j].y * v[j].y + v[j].z * v[j].z + v[j].w * v[j].w; }
            const float rs = rsqrtf(wave_sum(ss) * (1.f / 1024.f) + 1e-6f);
#pragma unroll
            for (int j = 0; j < 4; ++j) { const f32x4 g = ((const f32x4*)gpost)[lane + 64 * j]; h[j] += v[j] * rs * g; }
        }
        if (hout) {
#pragma unroll
            for (int j = 0; j < 4; ++j) ((f32x4*)(hout + (size_t)r * 1024))[lane + 64 * j] = h[j];
        }
        if (gpre) {
            float ss = 0.f;
#pragma unroll
            for (int j = 0; j < 4; ++j) ss += h[j].x * h[j].x + h[j].y * h[j].y + h[j].z * h[j].z + h[j].w * h[j].w;
            const float rs = rsqrtf(wave_sum(ss) * (1.f / 1024.f) + 1e-6f);
            float d[8];
#pragma unroll
            for (int k = 0; k < 8; ++k) d[k] = 0.f;
#pragma unroll
            for (int j = 0; j < 4; ++j) {
                const f32x4 g = ((const f32x4*)gpre)[lane + 64 * j]; const f32x4 o = h[j] * rs * g;
                u32x2 w; w.x = pk2(o.x, o.y); w.y = pk2(o.z, o.w);
                ((u32x2*)(xn + (size_t)r * 1024))[lane + 64 * j] = w;
                if (dtv) {
#pragma unroll
                    for (int i = 0; i < 4; ++i) {
                        const float* wp = p.in[9] + (size_t)(4 * (lane + 64 * j) + i) * 3080 + 1536;
                        const f32x4 w0 = *(const f32x4*)wp, w1 = *(const f32x4*)(wp + 4); const float hv = o[i];
                        d[0] += hv * w0.x; d[1] += hv * w0.y; d[2] += hv * w0.z; d[3] += hv * w0.w; d[4] += hv * w1.x; d[5] += hv * w1.y; d[6] += hv * w1.z; d[7] += hv * w1.w;
                    }
                }
            }
            if (dtv) {
#pragma unroll
                for (int k = 0; k < 8; ++k) d[k] = wave_sum(d[k]);
                float mine = d[0];
#pragma unroll
                for (int k = 1; k < 8; ++k) mine = ((lane & 7) == k) ? d[k] : mine;
                const float xx = mine + p.in[12][lane & 7];
                if (lane < 8) dtv[(size_t)r * 8 + lane] = (xx > 20.f) ? xx : log1pf(expf(xx));
            }
        }
    }
}

DEV void s_ssd(const FP& p, LAS unsigned char* lds, int bid, int G, int rot) {
    const int tid = threadIdx.x;
    const float* xbc = (const float*)(p.ws + WS_SMP + SB_XBC); const float* zb = (const float*)(p.ws + WS_SMP + SB_Z); const float* dtv = (const float*)(p.ws + WS_SMP + SB_DTV);
    float* ypre = (float*)(p.ws + WS_SMP + SB_YPRE); float* s_ssm = p.out + 35002368;
    const float* cbuf = p.in[5]; const float* cw = p.in[10]; const float* cb = p.in[11];
    LAS float* act = (LAS float*)lds;
    for (int item = (bid + G - rot) % G; item < 64; item += G) {
        const int b = item >> 3, h = item & 7, g = h >> 2;
        for (int e = tid; e < 16 * 320; e += 512) {
            const int t = e / 320, cc = e % 320;
            const int col = (cc < 64) ? h * 64 + cc : (cc < 192 ? 512 + g * 128 + (cc - 64) : 768 + g * 128 + (cc - 192));
            float a = cb[col];
#pragma unroll
            for (int j = 0; j < 4; ++j) {
                const int tt = t - 3 + j;
                const float u = (tt >= 0) ? xbc[(size_t)(b * 16 + tt) * 1024 + col] : cbuf[(size_t)(b * 3 + tt + 3) * 1024 + col];
                a += cw[j * 1024 + col] * u;
            }
            act[e] = a / (1.f + expf(-a));
        }
        __syncthreads();
        const int pp = tid >> 3, seg = tid & 7;
        float hs[16];
        const size_t sbase = ((size_t)(b * 8 + h) * 64 + pp) * 128 + seg * 16;
#pragma unroll
        for (int i = 0; i < 16; ++i) hs[i] = p.in[4][sbase + i];
        const float a = -expf(p.in[13][h]), D = p.in[14][h];
        for (int t = 0; t < 16; ++t) {
            const float dt = dtv[(b * 16 + t) * 8 + h];
            const float x = act[t * 320 + pp];
            const float dA = expf(dt * a), coef = dt * x;
            float y = 0.f;
#pragma unroll
            for (int i = 0; i < 16; ++i) { hs[i] = dA * hs[i] + coef * act[t * 320 + 64 + seg * 16 + i]; y += act[t * 320 + 192 + seg * 16 + i] * hs[i]; }
            y += __shfl_xor(y, 1); y += __shfl_xor(y, 2); y += __shfl_xor(y, 4);
            if (seg == 0) { const float zz = zb[(size_t)(b * 16 + t) * 512 + h * 64 + pp]; ypre[(size_t)(b * 16 + t) * 512 + h * 64 + pp] = (y + D * x) * (zz / (1.f + expf(-zz))); }
        }
#pragma unroll
        for (int i = 0; i < 16; ++i) s_ssm[sbase + i] = hs[i];
        __syncthreads();
    }
}

DEV void s_attn_part(const FP& p, LAS unsigned char* lds, int bid, int G) {
    const int lane = threadIdx.x & 63, wave = __builtin_amdgcn_readfirstlane(threadIdx.x >> 6);
    const float* q = (const float*)(p.ws + WS_SMP + SB_Q); const float* kn = p.out + 34871296; const float* vn = p.out + 34936832; const float* kp = p.in[2]; const float* vp = p.in[3];
    float* aml = (float*)(p.ws + WS_SMP + SB_AML); float* ao = (float*)(p.ws + WS_SMP + SB_AO);
    LAS float* qs = (LAS float*)(lds + wave * 16384);
    for (int it = bid + G * wave; it < 32 * N_ATILE; it += 8 * G) {
        const int bh = it / N_ATILE, tile = it % N_ATILE, b = bh >> 2, h = bh & 3;
        WAVE_SYNC();
#pragma unroll
        for (int i = 0; i < 8; ++i) { const int idx = lane + 64 * i, qi = idx >> 5, j4 = idx & 31; ((LAS f32x4*)qs)[idx] = *(const f32x4*)(q + (size_t)(b * 16 + qi) * 512 + h * 128 + j4 * 4); }
        WAVE_SYNC();
        const int kk = tile * 64 + lane; const bool valid = kk < 2064; const int kc = valid ? kk : 2063;
        const float* krow = (kc < 2048) ? kp + (((size_t)b * 2048 + kc) * 4 + h) * 128 : kn + (((size_t)b * 16 + (kc - 2048)) * 4 + h) * 128;
        float s[16][2];
#pragma unroll
        for (int qi = 0; qi < 16; ++qi) { s[qi][0] = 0.f; s[qi][1] = 0.f; }
#pragma unroll
        for (int c = 0; c < 2; ++c)
#pragma unroll 2
            for (int d4 = 0; d4 < 16; ++d4) {
                const f32x4 kv = ((const f32x4*)krow)[c * 16 + d4];
#pragma unroll
                for (int qi = 0; qi < 16; ++qi) { const f32x4 qv = ((const LAS f32x4*)qs)[qi * 32 + c * 16 + d4]; s[qi][c] += kv.x * qv.x + kv.y * qv.y + kv.z * qv.z + kv.w * qv.w; }
            }
        WAVE_SYNC();
#pragma unroll
        for (int qi = 0; qi < 16; ++qi)
#pragma unroll
            for (int c = 0; c < 2; ++c) {
                const float sv = valid ? s[qi][c] * 0.125f : -1e30f;
                const float m = wave_max(sv), pp = valid ? expf(sv - m) : 0.f, l = wave_sum(pp);
                qs[(qi * 2 + c) * 64 + lane] = pp;
                if (lane == 0) { aml[((size_t)it * 32 + qi * 2 + c) * 2] = m; aml[((size_t)it * 32 + qi * 2 + c) * 2 + 1] = l; }
            }
        WAVE_SYNC();
        float O[32][2];
#pragma unroll
        for (int i = 0; i < 32; ++i) { O[i][0] = 0.f; O[i][1] = 0.f; }
        int nk = 2064 - tile * 64; if (nk > 64) nk = 64;
        for (int j = 0; j < nk; ++j) {
            const int kj = tile * 64 + j;
            const float* vrow = (kj < 2048) ? vp + (((size_t)b * 2048 + kj) * 4 + h) * 128 : vn + (((size_t)b * 16 + (kj - 2048)) * 4 + h) * 128;
            const float2 v = ((const float2*)vrow)[lane];
#pragma unroll
            for (int i = 0; i < 32; ++i) { const float pv = qs[i * 64 + j]; O[i][0] += pv * v.x; O[i][1] += pv * v.y; }
        }
#pragma unroll
        for (int i = 0; i < 32; ++i) { float2 o; o.x = O[i][0]; o.y = O[i][1]; ((float2*)(ao + ((size_t)it * 32 + i) * 128))[lane] = o; }
    }
}
DEV void s_attn_comb(const FP& p, int bid, int G, int rot) {
    const int lane = threadIdx.x & 63, wave = __builtin_amdgcn_readfirstlane(threadIdx.x >> 6);
    const float* aml = (const float*)(p.ws + WS_SMP + SB_AML); const float* ao = (const float*)(p.ws + WS_SMP + SB_AO); const float* ypre = (const float*)(p.ws + WS_SMP + SB_YPRE);
    bf16_t* cat = (bf16_t*)(p.ws + WS_SMP + SB_CAT);
    const float lam_init = 0.2f;
    const float lam = expf(wave_sum(p.in[16][lane] * p.in[17][lane])) - expf(wave_sum(p.in[18][lane] * p.in[19][lane])) + lam_init;
    const int blk = (bid + G - rot) % G;
    for (int it = blk + G * wave; it < 512 + 256; it += 8 * G) {
        if (it < 512) {
            const int bh = it >> 4, qi = it & 15, b = bh >> 2, h = bh & 3;
            float o[2][2];
#pragma unroll
            for (int c = 0; c < 2; ++c) {
                const float mj = (lane < N_ATILE) ? aml[((size_t)(bh * N_ATILE + lane) * 32 + qi * 2 + c) * 2] : -1e30f;
                const float lj = (lane < N_ATILE) ? aml[((size_t)(bh * N_ATILE + lane) * 32 + qi * 2 + c) * 2 + 1] : 0.f;
                const float M = wave_max(mj), wj = expf(mj - M), L = wave_sum(lj * wj);
                float ax = 0.f, ay = 0.f;
                for (int j = 0; j < N_ATILE; ++j) {
                    const float w = __shfl(wj, j);
                    const float2 v = ((const float2*)(ao + ((size_t)(bh * N_ATILE + j) * 32 + qi * 2 + c) * 128))[lane];
                    ax += w * v.x; ay += w * v.y;
                }
                o[c][0] = ax / L; o[c][1] = ay / L;
            }
            const float ox = o[0][0] - lam * o[1][0], oy = o[0][1] - lam * o[1][1];
            const float ms = wave_sum(ox * ox + oy * oy) * (1.f / 128.f);
            const float rs = rsqrtf(ms + 1e-5f) * (1.f - lam_init);
            const float2 w = ((const float2*)p.in[20])[lane];
            ((unsigned*)(cat + (size_t)(b * 16 + qi) * 1024 + 512 + h * 128))[lane] = pk2(ox * rs * w.x, oy * rs * w.y);
        } else {
            const int i2 = it - 512, row = i2 >> 1, g = i2 & 1;
            const f32x4 v = ((const f32x4*)(ypre + (size_t)row * 512 + g * 256))[lane];
            const float rs = rsqrtf(wave_sum(v.x * v.x + v.y * v.y + v.z * v.z + v.w * v.w) * (1.f / 256.f) + 1e-5f);
            const f32x4 ww = ((const f32x4*)(p.in[15] + g * 256))[lane];
            u32x2 o; o.x = pk2(v.x * rs * ww.x, v.y * rs * ww.y); o.y = pk2(v.z * rs * ww.z, v.w * rs * ww.w);
            ((u32x2*)(cat + (size_t)row * 1024 + g * 256))[lane] = o;
        }
    }
}
DEV void s_xattn_part(const FP& p, LAS unsigned char* lds, int bid, int G, int rot) {
    const int lane = threadIdx.x & 63, wave = __builtin_amdgcn_readfirstlane(threadIdx.x >> 6);
    const float* qx = (const float*)(p.ws + WS_SMP + SB_QX); const float* mk = p.in[6]; const float* mv = p.in[7];
    float* xml = (float*)(p.ws + WS_SMP + SB_XML); float* xo = (float*)(p.ws + WS_SMP + SB_XO);
    LAS float* qs = (LAS float*)(lds + wave * 16384);
    const int blk = (bid + G - rot) % G;
    for (int it = blk + G * wave; it < 128; it += 8 * G) {
        const int bh = it >> 2, tile = it & 3, b = bh >> 2, h = bh & 3;
        WAVE_SYNC();
#pragma unroll
        for (int i = 0; i < 16; ++i) { const int idx = lane + 64 * i, qi = idx >> 6, j4 = idx & 63; ((LAS f32x4*)qs)[idx] = *(const f32x4*)(qx + (size_t)(b * 16 + qi) * 1024 + h * 256 + j4 * 4); }
        WAVE_SYNC();
        const float* krow = mk + (((size_t)b * 256 + tile * 64 + lane) * 4 + h) * 256;
        float s[16];
#pragma unroll
        for (int qi = 0; qi < 16; ++qi) s[qi] = 0.f;
#pragma unroll 2
        for (int d4 = 0; d4 < 64; ++d4) {
            const f32x4 kv = ((const f32x4*)krow)[d4];
#pragma unroll
            for (int qi = 0; qi < 16; ++qi) { const f32x4 qv = ((const LAS f32x4*)qs)[qi * 64 + d4]; s[qi] += kv.x * qv.x + kv.y * qv.y + kv.z * qv.z + kv.w * qv.w; }
        }
        WAVE_SYNC();
#pragma unroll
        for (int qi = 0; qi < 16; ++qi) {
            const float sv = s[qi] * 0.0625f, m = wave_max(sv), pp = expf(sv - m), l = wave_sum(pp);
            qs[qi * 64 + lane] = pp;
            if (lane == 0) { xml[((size_t)it * 16 + qi) * 2] = m; xml[((size_t)it * 16 + qi) * 2 + 1] = l; }
        }
        WAVE_SYNC();
        f32x4 O[16];
#pragma unroll
        for (int i = 0; i < 16; ++i) O[i] = (f32x4){0.f, 0.f, 0.f, 0.f};
        for (int j = 0; j < 64; ++j) {
            const f32x4 v = ((const f32x4*)(mv + (((size_t)b * 256 + tile * 64 + j) * 4 + h) * 256))[lane];
#pragma unroll
            for (int i = 0; i < 16; ++i) O[i] += v * qs[i * 64 + j];
        }
#pragma unroll
        for (int i = 0; i < 16; ++i) ((f32x4*)(xo + ((size_t)it * 16 + i) * 256))[lane] = O[i];
    }
}
DEV void s_xattn_comb(const FP& p, int bid, int G, int rot) {
    const int lane = threadIdx.x & 63, wave = __builtin_amdgcn_readfirstlane(threadIdx.x >> 6);
    const float* xml = (const float*)(p.ws + WS_SMP + SB_XML); const float* xo = (const float*)(p.ws + WS_SMP + SB_XO);
    bf16_t* ox = (bf16_t*)(p.ws + WS_SMP + SB_OX);
    const int blk = (bid + G - rot) % G;
    for (int it = blk + G * wave; it < 512; it += 8 * G) {
        const int bh = it >> 4, qi = it & 15, b = bh >> 2, h = bh & 3;
        float m[4], l[4];
#pragma unroll
        for (int j = 0; j < 4; ++j) { m[j] = xml[((size_t)(bh * 4 + j) * 16 + qi) * 2]; l[j] = xml[((size_t)(bh * 4 + j) * 16 + qi) * 2 + 1]; }
        const float M = fmaxf(fmaxf(m[0], m[1]), fmaxf(m[2], m[3]));
        float L = 0.f; f32x4 acc = {0.f, 0.f, 0.f, 0.f};
#pragma unroll
        for (int j = 0; j < 4; ++j) { const float w = expf(m[j] - M); L += l[j] * w; acc += ((const f32x4*)(xo + ((size_t)(bh * 4 + j) * 16 + qi) * 256))[lane] * w; }
        const float il = 1.f / L;
        u32x2 o; o.x = pk2(acc.x * il, acc.y * il); o.y = pk2(acc.z * il, acc.w * il);
        ((u32x2*)(ox + (size_t)(b * 16 + qi) * 1024 + h * 256))[lane] = o;
    }
}

namespace cg = cooperative_groups;
__global__ void __launch_bounds__(512, 2) k_mega(FP p) {
    extern __shared__ __attribute__((aligned(16))) unsigned char lds_raw[];
    LAS unsigned char* lds = (LAS unsigned char*)lds_raw;
    cg::grid_group grid = cg::this_grid();
    const int tid = threadIdx.x, lane = tid & 63, wave = __builtin_amdgcn_readfirstlane(tid >> 6);
    const int G = gridDim.x, bid = blockIdx.x, gw = bid * 8 + wave, ngw = G * 8;
    float* y = p.out; float* ys = p.out + 16777216; const float* xs = p.in[1];
    unsigned char* sb = p.ws + WS_SMP;
    phase_prep_x(p, lds, gw, ngw, wave, lane); phase_prep_ffn(p, lds, gw, ngw, wave, lane); phase_prep_mix(p, lds, gw, ngw, wave, lane);
    s_row(p, nullptr, xs, nullptr, nullptr, p.in[27], (bf16_t*)(sb + SB_XN), (float*)(sb + SB_DTV), bid, G, 0);
    grid.sync();
    phase_inproj(p, lds, G, bid);
    s_gemm((const bf16_t*)(sb + SB_XN), (const bf16_t*)(p.ws + WS_W_IN), 3072, 1024, lds, bid, G, 0,
           EpiSIn{(float*)(sb + SB_Z), (float*)(sb + SB_XBC), (float*)(sb + SB_Q), p.out + 34871296, p.out + 34936832, p.out + 35526656});
    grid.sync();
    phase_ssd1(p, lds, G, bid);
    phase_memkv(p, lds, G, bid);
    s_ssd(p, lds, bid, G, 64);
    s_attn_part(p, lds, bid, G);
    grid.sync();
    phase_ssd2(p, G, bid);
    phase_attn(p, lds, G, bid);
    s_attn_comb(p, bid, G, 0);
    grid.sync();
    phase_ssd3(p, lds, G, bid);
    s_gemm((const bf16_t*)(sb + SB_CAT), (const bf16_t*)(p.ws + WS_W_OUT), 1024, 1024, lds, bid, G, 0, EpiSF32{(float*)(sb + SB_MIX), 1024, 1.f});
    grid.sync();
    phase_outproj(p, lds, G, bid);
    s_row(p, (const float*)(sb + SB_MIX), xs, p.in[28], ys, p.in[29], (bf16_t*)(sb + SB_XN), nullptr, bid, G, 0);
    grid.sync();
    row_phase((const bf16_t*)(p.ws + WS_RAW), p.in[0], p.in[28], y, p.in[29], (bf16_t*)(p.ws + WS_XN), MP, gw, ngw, lane);
    s_gemm((const bf16_t*)(sb + SB_XN), (const bf16_t*)(p.ws + WS_W_Q), 1024, 1024, lds, bid, G, 0, EpiSF32{(float*)(sb + SB_QX), 1024, 1.f});
    grid.sync();
    phase_wq(p, lds, G, bid);
    s_xattn_part(p, lds, bid, G, 0);
    grid.sync();
    phase_xattn(p, lds, G, bid);
    s_xattn_comb(p, bid, G, 0);
    grid.sync();
    phase_wo(p, lds, G, bid);
    s_gemm((const bf16_t*)(sb + SB_OX), (const bf16_t*)(p.ws + WS_W_O), 1024, 1024, lds, bid, G, 0, EpiSF32{(float*)(sb + SB_MIX), 1024, 1.f});
    grid.sync();
    row_phase((const bf16_t*)(p.ws + WS_RAW), y, p.in[30], y, p.in[31], (bf16_t*)(p.ws + WS_XN), MP, gw, ngw, lane);
    s_row(p, (const float*)(sb + SB_MIX), ys, p.in[30], ys, p.in[31], (bf16_t*)(sb + SB_XN), nullptr, bid, G, 0);
    grid.sync();
    phase_ffn_gu(p, lds, G, bid);
    s_gemm((const bf16_t*)(sb + SB_XN), (const bf16_t*)(p.ws + WS_W_GU), 5632, 1024, lds, bid, G, 0, EpiSSwiglu{(bf16_t*)(sb + SB_HID)});
    grid.sync();
    phase_ffn_down(p, lds, G, bid);
    s_gemm((const bf16_t*)(sb + SB_HID), (const bf16_t*)(p.ws + WS_W_DOWN), 1024, 2816, lds, bid, G, 0, EpiSF32{(float*)(sb + SB_MIX), 1024, 1.f});
    grid.sync();
    row_phase((const bf16_t*)(p.ws + WS_RAW), y, p.in[32], y, nullptr, nullptr, MP, gw, ngw, lane);
    s_row(p, (const float*)(sb + SB_MIX), ys, p.in[32], ys, nullptr, nullptr, nullptr, bid, G, 0);
}

extern "C" void kernel_launch(void* const* d_in, const int* in_sizes, int n_in, void* d_out, int out_size, void* d_ws, size_t ws_size, hipStream_t stream) {
    static int grid = 0;
    if (!grid) {
        int dev = 0, cus = 0, per_cu = 0;
        (void)hipGetDevice(&dev);
        (void)hipDeviceGetAttribute(&cus, hipDeviceAttributeMultiprocessorCount, dev);
        (void)hipFuncSetAttribute((const void*)k_mega, hipFuncAttributeMaxDynamicSharedMemorySize, LDS_BYTES);
        (void)hipOccupancyMaxActiveBlocksPerMultiprocessor(&per_cu, (const void*)k_mega, 512, LDS_BYTES);
        if (per_cu < 1) per_cu = 1;
        grid = cus * per_cu;
        if (grid > 256) grid = 256;
        if (n_in != 36 || ws_size < 256 * MiB) fprintf(stderr, "kernel_launch: unexpected n_in %d / ws_size %zu\n", n_in, ws_size);
    }
    FP p{};
    for (int i = 0; i < 36; ++i) p.in[i] = (const float*)d_in[i];
    p.out = (float*)d_out; p.ws = (unsigned char*)d_ws;
    void* args[] = {&p};
    hipError_t e = hipLaunchCooperativeKernel((const void*)k_mega, dim3(grid), dim3(512), args, LDS_BYTES, stream);
    if (e != hipSuccess) fprintf(stderr, "cooperative launch failed: %s (grid %d)\n", hipGetErrorString(e), grid);
}
```

```cpp
#include <hip/hip_runtime.h>
#include <cstdint>
#include <cstdio>
#include <hip/hip_cooperative_groups.h>

#define DEV static __device__ __forceinline__
#define LAS __attribute__((address_space(3)))
#define WAVE_SYNC() asm volatile("s_waitcnt lgkmcnt(0)" ::: "memory")

DEV float wave_sum(float v) {
#pragma unroll
    for (int o = 32; o > 0; o >>= 1) v += __shfl_xor(v, o);
    return v;
}
DEV float wave_max(float v) {
#pragma unroll
    for (int o = 32; o > 0; o >>= 1) v = fmaxf(v, __shfl_xor(v, o));
    return v;
}
typedef float nf4 __attribute__((ext_vector_type(4)));
DEV float4 lds_ld4(const LAS float* p) { const nf4 v = *(const LAS nf4*)p; float4 r; r.x = v[0]; r.y = v[1]; r.z = v[2]; r.w = v[3]; return r; }
DEV float silu_f(float x) { return x / (1.f + expf(-x)); }


typedef unsigned short bf16_t;
typedef float f32x4 __attribute__((ext_vector_type(4)));
typedef float f32x16 __attribute__((ext_vector_type(16)));
typedef short bf16x8 __attribute__((ext_vector_type(8)));
typedef short s16x4 __attribute__((ext_vector_type(4)));
typedef unsigned u32x4 __attribute__((ext_vector_type(4)));
typedef unsigned u32x2 __attribute__((ext_vector_type(2)));

constexpr size_t MiB = 1u << 20;
constexpr size_t WS_W_IN = 0, WS_W_OUT = 6 * MiB, WS_W_Q = 8 * MiB, WS_W_KV = 10 * MiB, WS_W_O = 14 * MiB, WS_W_GU = 16 * MiB, WS_W_DOWN = 27 * MiB;
constexpr size_t WS_CTL = 33 * MiB, WS_DTV = 34 * MiB, WS_CDEC = 34 * MiB + 512 * 1024, WS_MN = 35 * MiB;
constexpr size_t WS_XN = 36 * MiB, WS_CAT = 68 * MiB, WS_QX = 68 * MiB, WS_Q = 100 * MiB, WS_K = 116 * MiB, WS_RAW = 100 * MiB;
constexpr size_t WS_ZX = 132 * MiB, WS_OX = 132 * MiB, WS_V = 180 * MiB, WS_ST = 196 * MiB, WS_HID = 132 * MiB, WS_KM = 228 * MiB, WS_VM = 229 * MiB, WS_SMP = 230 * MiB;
constexpr int MP = 16384;
constexpr int LDS_BYTES = 147456;

DEV unsigned f2bf(float f) { unsigned u = __builtin_bit_cast(unsigned, f); return (u + 0x7fffu + ((u >> 16) & 1u)) >> 16; }
DEV unsigned pk2(float lo, float hi) { return f2bf(lo) | (f2bf(hi) << 16); }
DEV float bflo(unsigned w) { return __builtin_bit_cast(float, w << 16); }
DEV float bfhi(unsigned w) { return __builtin_bit_cast(float, w & 0xffff0000u); }
DEV float fast_silu(float x) { return x * __builtin_amdgcn_rcpf(1.f + __builtin_amdgcn_exp2f(-1.4426950408889634f * x)); }

struct FP {
    const float* in[36];
    float* out;
    unsigned char* ws;
};

template <class RowMap>
DEV void transpose_item(const float* W, int K, int N, bf16_t* WT, int item, LAS float* scr, int lane, RowMap rm) {
    const int nblk = (N + 31) / 32, kb = item / nblk, nb = item % nblk, k0 = 64 * kb, n0 = 32 * nb;
    const int ncol = n0 + (lane & 31);
#pragma unroll 8
    for (int i = 0; i < 32; ++i) { const int kk = 2 * i + (lane >> 5); scr[kk * 33 + (lane & 31)] = (ncol < N) ? W[(size_t)(k0 + kk) * N + ncol] : 0.f; }
    WAVE_SYNC();
    const int c = lane & 7;
#pragma unroll
    for (int j = 0; j < 4; ++j) {
        const int n = (lane >> 3) + 8 * j; const LAS float* s = scr + (8 * c) * 33 + n;
        const int src = n0 + n; const int dst = (src < N) ? rm(src) : -1;
        u32x4 o; o.x = pk2(s[0 * 33], s[1 * 33]); o.y = pk2(s[2 * 33], s[3 * 33]); o.z = pk2(s[4 * 33], s[5 * 33]); o.w = pk2(s[6 * 33], s[7 * 33]);
        if (dst >= 0) *(u32x4*)(WT + (size_t)dst * K + k0 + 8 * c) = o;
    }
    WAVE_SYNC();
}
struct RmPlain { int off; __device__ __forceinline__ int operator()(int n) const { return off + n; } };
struct RmGU { int up; __device__ __forceinline__ int operator()(int n) const { return 32 * (n >> 4) + 16 * up + (n & 15); } };
struct RmIn {
    __device__ __forceinline__ int operator()(int n) const {
        if (n < 1536) return n;
        if (n < 1544) return -1;
        const int m = n - 1544;
        if (m < 1024) { const int u = m >> 6, d = m & 63; return 1536 + 64 * u + 32 * ((d & 31) >> 4) + 16 * (d >> 5) + (d & 15); }
        return 1536 + m;
    }
};

DEV void row_phase(const bf16_t* raw, const float* hin, const float* gpost, float* hout, const float* gpre, bf16_t* xn, int M, int gw, int ngw, int lane) {
    for (int r = gw; r < M; r += ngw) {
        f32x4 h[4];
#pragma unroll
        for (int j = 0; j < 4; ++j) h[j] = ((const f32x4*)(hin + (size_t)r * 1024))[lane + 64 * j];
        if (raw) {
            f32x4 v[4]; float ss = 0.f;
#pragma unroll
            for (int j = 0; j < 4; ++j) {
                const u32x2 w = ((const u32x2*)(raw + (size_t)r * 1024))[lane + 64 * j];
                v[j] = (f32x4){bflo(w.x), bfhi(w.x), bflo(w.y), bfhi(w.y)};
                ss += v[j].x * v[j].x + v[j].y * v[j].y + v[j].z * v[j].z + v[j].w * v[j].w;
            }
            const float rs = rsqrtf(wave_sum(ss) * (1.f / 1024.f) + 1e-6f);
#pragma unroll
            for (int j = 0; j < 4; ++j) { const f32x4 g = ((const f32x4*)gpost)[lane + 64 * j]; h[j] += v[j] * rs * g; }
        }
        if (hout) {
#pragma unroll
            for (int j = 0; j < 4; ++j) ((f32x4*)(hout + (size_t)r * 1024))[lane + 64 * j] = h[j];
        }
        if (gpre) {
            float ss = 0.f;
#pragma unroll
            for (int j = 0; j < 4; ++j) ss += h[j].x * h[j].x + h[j].y * h[j].y + h[j].z * h[j].z + h[j].w * h[j].w;
            const float rs = rsqrtf(wave_sum(ss) * (1.f / 1024.f) + 1e-6f);
#pragma unroll
            for (int j = 0; j < 4; ++j) {
                const f32x4 g = ((const f32x4*)gpre)[lane + 64 * j]; const f32x4 o = h[j] * rs * g;
                u32x2 w; w.x = pk2(o.x, o.y); w.y = pk2(o.z, o.w);
                ((u32x2*)(xn + (size_t)r * 1024))[lane + 64 * j] = w;
            }
        }
    }
}


#define RLX_AGENT __ATOMIC_RELAXED, __HIP_MEMORY_SCOPE_AGENT
#define LDS_WAIT() asm volatile("s_waitcnt lgkmcnt(0)" ::: "memory")
#define VM_WAIT() asm volatile("s_waitcnt vmcnt(0)" ::: "memory")
__device__ __forceinline__ unsigned long long rt() { return __builtin_amdgcn_s_memrealtime(); }
#define XB_TMO      128
#define XB_XCNT(j)  (256  + 64 * (j))
#define XB_XSUB(j)  (1280 + 64 * (j))
#define XB_XGEN(j)  (2304 + 64 * (j))
#define XB_TOP      3328
#define XB_TOPGEN   3392
#define XCD_BAR_WORDS 3456
#define XB_SPIN_CAP (1u << 18)

__device__ __forceinline__ unsigned xb_ld(unsigned* p)              { return __hip_atomic_load(p, __ATOMIC_RELAXED, __HIP_MEMORY_SCOPE_AGENT); }
__device__ __forceinline__ unsigned xb_add(unsigned* p, unsigned v) { return __hip_atomic_fetch_add(p, v, __ATOMIC_RELAXED, __HIP_MEMORY_SCOPE_AGENT); }
__device__ __forceinline__ unsigned xb_xcc_id() { return (unsigned)__builtin_amdgcn_s_getreg((3 << 11) | 20) & 0xFu; }
#define XB_SPIN(cond, bar) do { unsigned _sp = 0; while (cond) { __builtin_amdgcn_s_sleep(1); \
    if ((++_sp & 255u) == 0u) { if (xb_ld(&(bar)[XB_TMO])) break; if (_sp > XB_SPIN_CAP) { atomicAdd(&(bar)[XB_TMO], 1u); break; } } } } while (0)

struct XcdBarrier {
    unsigned* bar; unsigned x;
    volatile LAS unsigned* st;
};

__device__ __forceinline__ XcdBarrier xcd_barrier_post(unsigned* bar, volatile LAS unsigned* st) {
    XcdBarrier b; b.bar = bar; b.x = xb_xcc_id(); b.st = st;
    if (threadIdx.x == 0) (void)xb_add(&bar[XB_XCNT(b.x)], 1u);
    return b;
}
__device__ __forceinline__ void xcd_barrier_complete(unsigned* bar, unsigned x, unsigned& nloc, unsigned& nx) {
    const unsigned G = gridDim.x * gridDim.y * gridDim.z;
    unsigned sum, cnt, mine, sp = 0u;
    for (;;) {
        sum = 0u; cnt = 0u; mine = 0u;
#pragma unroll
        for (unsigned j = 0; j < 16; ++j) { const unsigned c = xb_ld(&bar[XB_XCNT(j)]); sum += c; cnt += (c > 0u) ? 1u : 0u; mine = (j == x) ? c : mine; }
        if (sum == G) break;
        __builtin_amdgcn_s_sleep(1);
        if ((++sp & 255u) == 0u) { if (xb_ld(&bar[XB_TMO])) break; if (sp > XB_SPIN_CAP) { atomicAdd(&bar[XB_TMO], 1u); break; } }
    }
    nloc = mine > 0u ? mine : 1u; nx = cnt > 0u ? cnt : 1u;
}

__device__ __forceinline__ void xcd_barrier(const XcdBarrier& b) {
    asm volatile("s_waitcnt vmcnt(0)" ::: "memory");
    __syncthreads();
    if (threadIdx.x == 0) {
        unsigned* bar = b.bar;
        __builtin_amdgcn_s_waitcnt(0);
        unsigned nloc = b.st[0], nx = b.st[1];
        if (nloc == 0u) { xcd_barrier_complete(bar, b.x, nloc, nx); b.st[0] = nloc; b.st[1] = nx; }
        const unsigned old = xb_add(&bar[XB_XSUB(b.x)], 1u);
        const unsigned gen = old / nloc;
        if (old + 1u == (gen + 1u) * nloc) {
            __builtin_amdgcn_fence(__ATOMIC_RELEASE, "agent");
            asm volatile("s_waitcnt vmcnt(0)" ::: "memory");
            const unsigned og = xb_add(&bar[XB_TOP], 1u);
            const unsigned tg = og / nx;
            if (og + 1u == (tg + 1u) * nx) xb_add(&bar[XB_TOPGEN], 1u);
            else XB_SPIN(xb_ld(&bar[XB_TOPGEN]) == tg, bar);
            __builtin_amdgcn_fence(__ATOMIC_ACQUIRE, "agent");
            xb_add(&bar[XB_XGEN(b.x)], 1u);
            asm volatile("s_waitcnt vmcnt(0)" ::: "memory");
        } else {
            XB_SPIN(xb_ld(&bar[XB_XGEN(b.x)]) == gen, bar);
            __builtin_amdgcn_fence(__ATOMIC_ACQUIRE, "agent");
            asm volatile("s_waitcnt vmcnt(0)" ::: "memory");
        }
    }
    __syncthreads();
}
namespace pg8 {
#define PG8_LAS __attribute__((address_space(3)))
typedef unsigned short bf16_t;
typedef short bf16x8 __attribute__((ext_vector_type(8)));
typedef float f32x4 __attribute__((ext_vector_type(4)));
typedef unsigned u32x4 __attribute__((ext_vector_type(4)));
constexpr int BM = 256, BK = 64, HALF = 128, HTB = HALF * BK * 2  , STAGE_BYTES = 8 * HTB, NXCD = 8, WGM = 8;

__host__ __device__ __forceinline__ int lds_byte(int r, int c) { const int st = (r >> 4) * 2 + (c >> 5), rr = r & 15, cc = c & 31, ob = rr * 64 + cc * 2; return st * 1024 + (ob ^ (((ob >> 9) & 1) << 5)); }
__host__ __device__ __forceinline__ void stage_rc(int b, int& R, int& C) { const int st = b / 1024, sb = b % 1024, swz = sb ^ (((sb >> 9) & 1) << 5); R = (st >> 1) * 16 + swz / 64; C = (st & 1) * 32 + (swz % 64) / 2; }
__host__ __device__ __forceinline__ int perm32(int rho) { const int n = rho >> 4, i = rho & 15; return 8 * (i >> 2) + 4 * n + (i & 3); }

struct Unit { int pm, pn; };
struct Gemm { const bf16_t* A; const bf16_t* Bt; int M, N, K; };

struct StaticOrder {
    int nM, nN, nwg, G, c;
    __host__ __device__ void init(int M, int N, int G_, int c_) { nM = M / BM; nN = N / BM; nwg = nM * nN; G = G_; c = c_; }
    __host__ __device__ bool next(int i, Unit& u) const {
        const long L = (long)i * G + c; if (L >= nwg) return false;
        int wgid = (int)L; { const int q = nwg / NXCD, r = nwg % NXCD, xcd = wgid % NXCD, off = wgid / NXCD; wgid = (xcd < r ? xcd * (q + 1) : r * (q + 1) + (xcd - r) * q) + off; }
        const int nig = WGM * nN, gid = wgid / nig, fm = gid * WGM, gsz = (nM - fm) < WGM ? (nM - fm) : WGM;
        u.pm = fm + ((wgid % nig) % gsz); u.pn = (wgid % nig) / gsz; return true;
    }
    __device__ __forceinline__ void a_ready(const Unit&) const {}
    __device__ __forceinline__ void done(const Unit&) const {}
};

__device__ __forceinline__ unsigned cvt_pk_bf16(float lo, float hi) { unsigned r; asm volatile("v_cvt_pk_bf16_f32 %0, %1, %2" : "=v"(r) : "v"(lo), "v"(hi)); return r; }
typedef float f32x2 __attribute__((ext_vector_type(2)));
__device__ __forceinline__ f32x2 gelu_pk(f32x2 v) {
    const f32x2 av = __builtin_elementwise_abs(v), d = av * 0.2316418882f + 1.0f;
    f32x2 t; t.x = __builtin_amdgcn_rcpf(d.x); t.y = __builtin_amdgcn_rcpf(d.y);
    f32x2 q = t * 0.5307027145f + (-0.7265760135f); q = q * t + 0.7107068705f; q = q * t + (-0.142248368f); q = q * t + 0.127414796f; q = q * t;
    const f32x2 s = (v * v) * (-0.72134752044f);
    f32x2 e; e.x = __builtin_amdgcn_exp2f(s.x); e.y = __builtin_amdgcn_exp2f(s.y);
    const f32x2 m = v * (q * e), r = v - m;
    f32x2 o; o.x = v.x < 0.f ? m.x : r.x; o.y = v.y < 0.f ? m.y : r.y; return o;
}

template <int ACT  > struct EpiBf16 {
    static constexpr bool PERM = true, AFTER_DRAIN = false; static_assert(ACT == 0 || ACT == 1, "EpiBf16: ACT is 0 (none) or 1 (gelu_pk)");
    bf16_t* O; int ldc; const float* bias; int split_cols; size_t split_stride; float scale0;
    __device__ __forceinline__ void operator()(const f32x4 (&acc)[2][2][4][2], const Unit& u, int wr, int wc, int fr, int fq) const {
        const int row0 = u.pm * BM + wr * 64 + fr; int colt = u.pn * BM; bf16_t* base = O;
        float sc = 1.f; if (split_cols) { const int t = colt / split_cols; base += (size_t)t * split_stride; colt -= t * split_cols; if (t == 0) sc = scale0; }
        const int col0 = colt + wc * 32 + 8 * fq, bcol0 = u.pn * BM + wc * 32 + 8 * fq;
        f32x4 bv[2][2];
#pragma unroll
        for (int bj = 0; bj < 2; ++bj)
#pragma unroll
            for (int n = 0; n < 2; ++n) bv[bj][n] = bias ? *(const f32x4*)(bias + bcol0 + bj * HALF + 4 * n) : (f32x4){0.f, 0.f, 0.f, 0.f};
#pragma unroll
        for (int ai = 0; ai < 2; ++ai)
#pragma unroll
            for (int m = 0; m < 4; ++m) { bf16_t* rowp = base + (size_t)(row0 + ai * HALF + m * 16) * ldc + col0;
#pragma unroll
                for (int bj = 0; bj < 2; ++bj) { f32x4 v0 = acc[ai][bj][m][0] + bv[bj][0], v1 = acc[ai][bj][m][1] + bv[bj][1];
                    if (ACT == 1) { f32x2 a = gelu_pk((f32x2){v0[0], v0[1]}), b = gelu_pk((f32x2){v0[2], v0[3]}), c = gelu_pk((f32x2){v1[0], v1[1]}), d = gelu_pk((f32x2){v1[2], v1[3]});
                        v0 = (f32x4){a.x, a.y, b.x, b.y}; v1 = (f32x4){c.x, c.y, d.x, d.y}; }
                    v0 = v0 * sc; v1 = v1 * sc; u32x4 w; w.x = cvt_pk_bf16(v0[0], v0[1]); w.y = cvt_pk_bf16(v0[2], v0[3]); w.z = cvt_pk_bf16(v1[0], v1[1]); w.w = cvt_pk_bf16(v1[2], v1[3]);
                    *(u32x4*)(rowp + bj * HALF) = w; } }
    }
};
template <class Epi, class Sched, bool ALIGN_EPI = false, bool SP2 = false>
__device__ __forceinline__ void gemm_phase(PG8_LAS unsigned char* lds, const Gemm g, const Sched& S, const Epi& E) {
    int tid_l = threadIdx.x; asm volatile("" : "+v"(tid_l));
    const int tid = tid_l, wid = __builtin_amdgcn_readfirstlane(tid >> 6), lane = tid & 63, wr = wid >> 2, wc = wid & 3, fr = lane & 15, fq = lane >> 4;
    const int K = g.K, nt = K / BK;
    unsigned voffA[2], voffB[2];
#pragma unroll
    for (int i = 0; i < 2; ++i) { int R, C; stage_rc(tid * 16 + i * 8192, R, C); const int Rb = Epi::PERM ? ((R & ~31) + perm32(R & 31)) : R;
        voffA[i] = (unsigned)(R * K + C) * 2u; voffB[i] = (unsigned)(Rb * K + C) * 2u; }
    const size_t kstep = (size_t)(BK * 2);
    const size_t hstep = (size_t)HALF * K * 2;
    const size_t tstep = 2 * hstep;
    const unsigned ldsw = (unsigned)wid * 1024u;
    const int aoff = lds_byte(wr * 64 + fr, fq * 8), boff = lds_byte(wc * 32 + fr, fq * 8);
#define PG8_SA(b, h) (((b) * 2 + (h)) * HTB)
#define PG8_SB(b, h) ((4 + (b) * 2 + (h)) * HTB)
#define PG8_STAGE(bufoff, gbase, voff) do { _Pragma("unroll") for (int _i = 0; _i < 2; ++_i) \
        __builtin_amdgcn_global_load_lds((const unsigned*)((const char*)(gbase) + (voff)[_i]), (PG8_LAS unsigned*)(lds + (bufoff) + ldsw + _i * 8192), 16, 0, 0); } while (0)
#define PG8_LDA(dst, b, h) do { _Pragma("unroll") for (int m = 0; m < 4; ++m) _Pragma("unroll") for (int k = 0; k < 2; ++k) dst[m][k] = *(const PG8_LAS bf16x8*)(lds + PG8_SA(b, h) + aoff + m * 2048 + k * 1024); } while (0)
#define PG8_LDB(dst, b, h) do { _Pragma("unroll") for (int n = 0; n < 2; ++n) _Pragma("unroll") for (int k = 0; k < 2; ++k) dst[n][k] = *(const PG8_LAS bf16x8*)(lds + PG8_SB(b, h) + boff + n * 2048 + k * 1024); } while (0)
#define PG8_MMA(ai, bj, At, Bt) do { __builtin_amdgcn_s_setprio(1); _Pragma("unroll") for (int m = 0; m < 4; ++m) _Pragma("unroll") for (int n = 0; n < 2; ++n) _Pragma("unroll") for (int k = 0; k < 2; ++k) \
        acc[ai][bj][m][n] = __builtin_amdgcn_mfma_f32_16x16x32_bf16(Bt[n][k], At[m][k], acc[ai][bj][m][n], 0, 0, 0); __builtin_amdgcn_s_setprio(0); } while (0)
#define PG8_WAIT_V(n) asm volatile("s_waitcnt vmcnt(" #n ")" ::: "memory")
#define PG8_WAIT_L(n) asm volatile("s_waitcnt lgkmcnt(" #n ")" ::: "memory")
#define PG8_BAR __builtin_amdgcn_s_barrier()
#define PG8_SCHED __builtin_amdgcn_sched_barrier(0)
    Unit cur, nxt; int ui = 0;
    if (!S.next(0, cur)) return;
    f32x4 acc[2][2][4][2];
#pragma unroll
    for (int a = 0; a < 2; ++a)
#pragma unroll
        for (int b = 0; b < 2; ++b)
#pragma unroll
            for (int m = 0; m < 4; ++m)
#pragma unroll
                for (int n = 0; n < 2; ++n) acc[a][b][m][n] = (f32x4){0.f, 0.f, 0.f, 0.f};
    bf16x8 At[4][2], B0[2][2], B1[2][2];
    const char* cA = (const char*)g.A + (size_t)cur.pm * tstep; const char* cB = (const char*)g.Bt + (size_t)cur.pn * tstep;
    S.a_ready(cur);
    if constexpr (SP2) {
        PG8_STAGE(PG8_SB(0, 0), cB, voffB); PG8_STAGE(PG8_SB(0, 1), cB + hstep, voffB); PG8_STAGE(PG8_SA(0, 0), cA, voffA); PG8_STAGE(PG8_SA(0, 1), cA + hstep, voffA);
        if (wr == 1) PG8_BAR;
        PG8_WAIT_V(2); PG8_BAR;
        PG8_STAGE(PG8_SB(1, 0), cB + kstep, voffB); PG8_STAGE(PG8_SA(1, 0), cA + kstep, voffA); PG8_STAGE(PG8_SB(1, 1), cB + hstep + kstep, voffB);
        PG8_WAIT_V(6); PG8_BAR;
    } else {
        PG8_STAGE(PG8_SB(0, 0), cB, voffB); PG8_STAGE(PG8_SA(0, 0), cA, voffA); PG8_STAGE(PG8_SB(0, 1), cB + hstep, voffB); PG8_STAGE(PG8_SA(0, 1), cA + hstep, voffA);
        if (wr == 1) PG8_BAR;
        PG8_WAIT_V(4); PG8_BAR;
        PG8_STAGE(PG8_SB(1, 0), cB + kstep, voffB); PG8_STAGE(PG8_SA(1, 0), cA + kstep, voffA); PG8_STAGE(PG8_SB(1, 1), cB + hstep + kstep, voffB);
        PG8_WAIT_V(6); PG8_BAR;
    }
    for (;;) {
        const bool has_next = S.next(ui + 1, nxt);
        const char* nA = has_next ? (const char*)g.A + (size_t)nxt.pm * tstep : cA; const char* nB = has_next ? (const char*)g.Bt + (size_t)nxt.pn * tstep : cB;
        for (int t = 0; t < nt; t += 2) {
            const bool last = (t == nt - 2);
            const char* a1 = cA + (size_t)(t + 1) * kstep;
            const char* a2 = last ? nA : cA + (size_t)(t + 2) * kstep; const char* b2 = last ? nB : cB + (size_t)(t + 2) * kstep;
            const char* a3 = a2 + kstep; const char* b3 = b2 + kstep;
            if (last && has_next) S.a_ready(nxt);
            if constexpr (SP2) {
            PG8_LDB(B0, 0, 0); PG8_LDB(B1, 0, 1); PG8_SCHED; PG8_LDA(At, 0, 0); PG8_STAGE(PG8_SA(1, 1), a1 + hstep, voffA);
            PG8_WAIT_V(8); PG8_WAIT_L(0); PG8_BAR; PG8_MMA(0, 0, At, B0); PG8_MMA(0, 1, At, B1); PG8_BAR; PG8_SCHED;
            PG8_LDA(At, 0, 1); PG8_STAGE(PG8_SB(0, 0), b2, voffB); PG8_STAGE(PG8_SB(0, 1), b2 + hstep, voffB); PG8_STAGE(PG8_SA(0, 0), a2, voffA);
            PG8_WAIT_V(8); PG8_WAIT_L(0); PG8_BAR; PG8_MMA(1, 0, At, B0); PG8_MMA(1, 1, At, B1); PG8_BAR; PG8_SCHED;
            PG8_LDB(B0, 1, 0); PG8_LDB(B1, 1, 1); PG8_SCHED; PG8_LDA(At, 1, 0); PG8_STAGE(PG8_SA(0, 1), a2 + hstep, voffA);
            PG8_WAIT_V(8); PG8_WAIT_L(0); PG8_BAR; PG8_MMA(0, 0, At, B0); PG8_MMA(0, 1, At, B1); PG8_BAR; PG8_SCHED;
            PG8_LDA(At, 1, 1); PG8_STAGE(PG8_SB(1, 0), b3, voffB); PG8_STAGE(PG8_SB(1, 1), b3 + hstep, voffB); PG8_STAGE(PG8_SA(1, 0), a3, voffA);
            PG8_WAIT_V(8); PG8_WAIT_L(0); PG8_BAR; PG8_MMA(1, 0, At, B0); PG8_MMA(1, 1, At, B1); PG8_BAR; PG8_SCHED;
            } else {
            PG8_LDB(B0, 0, 0); PG8_SCHED; PG8_LDA(At, 0, 0); PG8_STAGE(PG8_SA(1, 1), a1 + hstep, voffA);
            PG8_WAIT_L(8); PG8_BAR; PG8_WAIT_L(0); PG8_MMA(0, 0, At, B0); PG8_BAR; PG8_SCHED;
            PG8_LDB(B1, 0, 1); PG8_STAGE(PG8_SB(0, 0), b2, voffB);
            PG8_BAR; PG8_WAIT_L(0); PG8_MMA(0, 1, At, B1); PG8_BAR;
            PG8_LDA(At, 0, 1); PG8_STAGE(PG8_SA(0, 0), a2, voffA);
            PG8_BAR; PG8_WAIT_L(0); PG8_MMA(1, 0, At, B0); PG8_BAR; PG8_SCHED;
            PG8_STAGE(PG8_SB(0, 1), b2 + hstep, voffB);
            PG8_WAIT_V(6); PG8_BAR; PG8_MMA(1, 1, At, B1); PG8_BAR;
            PG8_LDB(B0, 1, 0); PG8_SCHED; PG8_LDA(At, 1, 0); PG8_STAGE(PG8_SA(0, 1), a2 + hstep, voffA);
            PG8_WAIT_L(8); PG8_BAR; PG8_WAIT_L(0); PG8_MMA(0, 0, At, B0); PG8_BAR; PG8_SCHED;
            PG8_LDB(B1, 1, 1); PG8_STAGE(PG8_SB(1, 0), b3, voffB);
            PG8_BAR; PG8_WAIT_L(0); PG8_MMA(0, 1, At, B1); PG8_BAR;
            PG8_LDA(At, 1, 1); PG8_STAGE(PG8_SA(1, 0), a3, voffA);
            PG8_BAR; PG8_WAIT_L(0); PG8_MMA(1, 0, At, B0); PG8_BAR; PG8_SCHED;
            PG8_STAGE(PG8_SB(1, 1), b3 + hstep, voffB);
            PG8_WAIT_V(6); PG8_BAR; PG8_MMA(1, 1, At, B1); PG8_BAR;
            }
        }
        if constexpr (ALIGN_EPI) { if (wr == 0) PG8_BAR; }
        if constexpr (!Epi::AFTER_DRAIN) { E(acc, cur, wr, wc, fr, fq); S.done(cur); }
        if (!has_next) break;
#pragma unroll
        for (int a = 0; a < 2; ++a)
#pragma unroll
            for (int b = 0; b < 2; ++b)
#pragma unroll
                for (int m = 0; m < 4; ++m)
#pragma unroll
                    for (int n = 0; n < 2; ++n) acc[a][b][m][n] = (f32x4){0.f, 0.f, 0.f, 0.f};
        cur = nxt; cA = nA; cB = nB; ++ui;
        if constexpr (ALIGN_EPI) { if (wr == 1) PG8_BAR; }
    }
    PG8_WAIT_V(0);
    if constexpr (!ALIGN_EPI) { if (wr == 0) PG8_BAR; }
    PG8_BAR;
    if constexpr (Epi::AFTER_DRAIN) { E.fused(acc, cur, wr, wc, fr, fq, lds, wid, lane); S.done(cur); }
#undef PG8_SA
#undef PG8_SB
#undef PG8_STAGE
#undef PG8_LDA
#undef PG8_LDB
#undef PG8_MMA
#undef PG8_WAIT_V
#undef PG8_WAIT_L
#undef PG8_BAR
#undef PG8_SCHED
}
}

namespace pg8 {
struct EpiSwiglu {
    static constexpr bool PERM = false, AFTER_DRAIN = false;
    bf16_t* O; int ldo;
    __device__ __forceinline__ void operator()(const f32x4 (&acc)[2][2][4][2], const Unit& u, int wr, int wc, int fr, int fq) const {
        const int row0 = u.pm * BM + wr * 64 + fr;
#pragma unroll
        for (int ai = 0; ai < 2; ++ai)
#pragma unroll
            for (int m = 0; m < 4; ++m) {
                bf16_t* rowp = O + (size_t)(row0 + ai * HALF + m * 16) * ldo;
#pragma unroll
                for (int bj = 0; bj < 2; ++bj) {
                    const int grp = u.pn * 8 + bj * 4 + wc;
                    const f32x4 g = acc[ai][bj][m][0], up = acc[ai][bj][m][1];
                    const float h0 = fast_silu(g[0]) * up[0], h1 = fast_silu(g[1]) * up[1], h2 = fast_silu(g[2]) * up[2], h3 = fast_silu(g[3]) * up[3];
                    u32x2 w; w.x = cvt_pk_bf16(h0, h1); w.y = cvt_pk_bf16(h2, h3);
                    *(u32x2*)(rowp + grp * 16 + 4 * fq) = w;
                }
            }
    }
};
}

DEV void phase_prep_ffn(const FP& p, LAS unsigned char* lds, int gw, int ngw, int wave, int lane) {
    LAS float* scr = (LAS float*)(lds + wave * 16384);
    const float *wg = p.in[33], *wu = p.in[34], *wd = p.in[35];
    bf16_t* GU = (bf16_t*)(p.ws + WS_W_GU); bf16_t* DN = (bf16_t*)(p.ws + WS_W_DOWN);
    constexpr int I_G = 16 * 88, I_D = 44 * 32;
    for (int it = gw; it < 2 * I_G + I_D; it += ngw) {
        int r = it;
        if (r < I_G) { transpose_item(wg, 1024, 2816, GU, r, scr, lane, RmGU{0}); continue; } r -= I_G;
        if (r < I_G) { transpose_item(wu, 1024, 2816, GU, r, scr, lane, RmGU{1}); continue; } r -= I_G;
        transpose_item(wd, 2816, 1024, DN, r, scr, lane, RmPlain{0});
    }
}
DEV void phase_ffn_gu(const FP& p, LAS unsigned char* lds, int G, int bid) {
    pg8::Gemm g{(const bf16_t*)(p.ws + WS_XN), (const bf16_t*)(p.ws + WS_W_GU), MP, 5632, 1024};
    pg8::StaticOrder S; S.init(MP, 5632, G, bid);
    pg8::EpiSwiglu E{(bf16_t*)(p.ws + WS_HID), 2816};
    pg8::gemm_phase<pg8::EpiSwiglu, pg8::StaticOrder, true, true>(lds, g, S, E);
}
DEV void phase_ffn_down(const FP& p, LAS unsigned char* lds, int G, int bid) {
    pg8::Gemm g{(const bf16_t*)(p.ws + WS_HID), (const bf16_t*)(p.ws + WS_W_DOWN), MP, 1024, 2816};
    pg8::StaticOrder S; S.init(MP, 1024, G, bid);
    pg8::EpiBf16<0> E{(bf16_t*)(p.ws + WS_RAW), 1024, nullptr, 0, 0, 1.f};
    pg8::gemm_phase<pg8::EpiBf16<0>, pg8::StaticOrder, true, true>(lds, g, S, E);
}

typedef short v4i16_t __attribute__((ext_vector_type(4)));
typedef float f32x2_t __attribute__((ext_vector_type(2)));
typedef __bf16 bf16x2_t __attribute__((ext_vector_type(2)));
DEV unsigned cvtpk(float lo, float hi) { f32x2_t v = {lo, hi}; bf16x2_t b = __builtin_convertvector(v, bf16x2_t); return __builtin_bit_cast(unsigned, b); }
DEV f32x16 mfma32(bf16x8 a, bf16x8 b, f32x16 c) { return __builtin_amdgcn_mfma_f32_32x32x16_bf16(a, b, c, 0, 0, 0); }
DEV s16x4 tr_read(LAS const unsigned char* p) { return __builtin_bit_cast(s16x4, __builtin_amdgcn_ds_read_tr16_b64_v4i16((LAS v4i16_t*)p)); }
DEV bf16x8 cat8(s16x4 lo, s16x4 hi) { return (bf16x8){lo[0], lo[1], lo[2], lo[3], hi[0], hi[1], hi[2], hi[3]}; }
DEV float half_max(float v) { auto rr = __builtin_amdgcn_permlane32_swap(__float_as_uint(v), __float_as_uint(v), false, false); return fmaxf(__uint_as_float(rr[0]), __uint_as_float(rr[1])); }
DEV float half_sum(float v) { auto rr = __builtin_amdgcn_permlane32_swap(__float_as_uint(v), __float_as_uint(v), false, false); return __uint_as_float(rr[0]) + __uint_as_float(rr[1]); }
DEV bf16x8 pfrag(const f32x16& S, int s) {
    u32x4 w;
    if (s == 0) { w.x = cvtpk(S[0], S[1]); w.y = cvtpk(S[2], S[3]); w.z = cvtpk(S[4], S[5]); w.w = cvtpk(S[6], S[7]); }
    else { w.x = cvtpk(S[8], S[9]); w.y = cvtpk(S[10], S[11]); w.z = cvtpk(S[12], S[13]); w.w = cvtpk(S[14], S[15]); }
    return __builtin_bit_cast(bf16x8, w);
}
DEV float max16(const f32x16& S) {
    float a = fmaxf(fmaxf(S[0], S[1]), fmaxf(S[2], S[3])), b = fmaxf(fmaxf(S[4], S[5]), fmaxf(S[6], S[7]));
    float c = fmaxf(fmaxf(S[8], S[9]), fmaxf(S[10], S[11])), d = fmaxf(fmaxf(S[12], S[13]), fmaxf(S[14], S[15]));
    return fmaxf(fmaxf(a, b), fmaxf(c, d));
}

namespace pg8 {
struct EpiMemKV {
    static constexpr bool PERM = false, AFTER_DRAIN = false;
    float* ok; float* ov; bf16_t* bk; bf16_t* bv;
    __device__ __forceinline__ void operator()(const f32x4 (&acc)[2][2][4][2], const Unit& u, int wr, int wc, int fr, int fq) const {
        const int row0 = u.pm * BM + wr * 64 + fr; const bool isv = u.pn >= 4; const int colt = (u.pn & 3) * BM + wc * 32 + 4 * fq;
        float* of = isv ? ov : ok; bf16_t* ob = isv ? bv : bk;
#pragma unroll
        for (int ai = 0; ai < 2; ++ai)
#pragma unroll
            for (int m = 0; m < 4; ++m) {
                const size_t ro = (size_t)(row0 + ai * HALF + m * 16) * 1024;
#pragma unroll
                for (int bj = 0; bj < 2; ++bj)
#pragma unroll
                    for (int n = 0; n < 2; ++n) {
                        const f32x4 v = acc[ai][bj][m][n]; const int col = colt + bj * HALF + n * 16;
                        *(f32x4*)(of + ro + col) = v;
                        u32x2 w; w.x = cvt_pk_bf16(v[0], v[1]); w.y = cvt_pk_bf16(v[2], v[3]);
                        *(u32x2*)(ob + ro + col) = w;
                    }
            }
    }
};
}

DEV void phase_prep_x(const FP& p, LAS unsigned char* lds, int gw, int ngw, int wave, int lane) {
    LAS float* scr = (LAS float*)(lds + wave * 16384);
    constexpr int I_S = 16 * 32;
    for (int it = gw; it < 4 * I_S; it += ngw) {
        int r = it;
        if (r < I_S) { transpose_item(p.in[23], 1024, 1024, (bf16_t*)(p.ws + WS_W_Q), r, scr, lane, RmPlain{0}); continue; } r -= I_S;
        if (r < I_S) { transpose_item(p.in[24], 1024, 1024, (bf16_t*)(p.ws + WS_W_KV), r, scr, lane, RmPlain{0}); continue; } r -= I_S;
        if (r < I_S) { transpose_item(p.in[25], 1024, 1024, (bf16_t*)(p.ws + WS_W_KV), r, scr, lane, RmPlain{1024}); continue; } r -= I_S;
        transpose_item(p.in[26], 1024, 1024, (bf16_t*)(p.ws + WS_W_O), r, scr, lane, RmPlain{0});
    }
    row_phase(nullptr, p.in[8], nullptr, nullptr, p.in[22], (bf16_t*)(p.ws + WS_MN), 512, gw, ngw, lane);
}
DEV void phase_memkv(const FP& p, LAS unsigned char* lds, int G, int bid) {
    pg8::Gemm g{(const bf16_t*)(p.ws + WS_MN), (const bf16_t*)(p.ws + WS_W_KV), 512, 2048, 1024};
    pg8::StaticOrder S; S.init(512, 2048, G, bid);
    pg8::EpiMemKV E{p.out + 33822720, p.out + 34347008, (bf16_t*)(p.ws + WS_KM), (bf16_t*)(p.ws + WS_VM)};
    pg8::gemm_phase<pg8::EpiMemKV, pg8::StaticOrder, true, true>(lds, g, S, E);
}
DEV void phase_wq(const FP& p, LAS unsigned char* lds, int G, int bid) {
    pg8::Gemm g{(const bf16_t*)(p.ws + WS_XN), (const bf16_t*)(p.ws + WS_W_Q), MP, 1024, 1024};
    pg8::StaticOrder S; S.init(MP, 1024, G, bid);
    pg8::EpiBf16<0> E{(bf16_t*)(p.ws + WS_QX), 1024, nullptr, 1024, 0, 0.0625f * 1.4426950408889634f};
    pg8::gemm_phase<pg8::EpiBf16<0>, pg8::StaticOrder, true, true>(lds, g, S, E);
}
DEV void phase_wo(const FP& p, LAS unsigned char* lds, int G, int bid) {
    pg8::Gemm g{(const bf16_t*)(p.ws + WS_OX), (const bf16_t*)(p.ws + WS_W_O), MP, 1024, 1024};
    pg8::StaticOrder S; S.init(MP, 1024, G, bid);
    pg8::EpiBf16<0> E{(bf16_t*)(p.ws + WS_RAW), 1024, nullptr, 0, 0, 1.f};
    pg8::gemm_phase<pg8::EpiBf16<0>, pg8::StaticOrder, true, true>(lds, g, S, E);
}

DEV void phase_xattn(const FP& p, LAS unsigned char* lds, int G, int bid) {
    const int tid = threadIdx.x, lane = tid & 63, wave = __builtin_amdgcn_readfirstlane(tid >> 6), r = lane & 31, hh = lane >> 5, qb = wave & 3, eh = wave >> 2;
    const bf16_t* QX = (const bf16_t*)(p.ws + WS_QX); const bf16_t* KM = (const bf16_t*)(p.ws + WS_KM); const bf16_t* VM = (const bf16_t*)(p.ws + WS_VM);
    bf16_t* OX = (bf16_t*)(p.ws + WS_OX);
    constexpr int QOFF = 0, KOFF = 65536, VOFF = 98304;
    const int vlane = (4 * hh + ((lane & 15) >> 2)) * 64 + 32 * ((lane >> 4) & 1) + 8 * (lane & 3);
    for (int u = bid; u < 512; u += G) {
        const int bh = u & 7, b = bh >> 2, h = bh & 3, qblk = u >> 3;
        const size_t qrow0 = (size_t)b * 8192 + (size_t)qblk * 128;
#pragma unroll
        for (int j = 0; j < 8; ++j) {
            const int id = tid + 512 * j, row = id >> 5, ch = id & 31;
            const u32x4 v = *(const u32x4*)(QX + (qrow0 + row) * 1024 + h * 256 + ch * 8);
            *(LAS u32x4*)(lds + QOFF + row * 512 + ((ch ^ (row & 15)) << 4)) = v;
        }
        u32x4 kr[2], vr[2];
#pragma unroll
        for (int j = 0; j < 2; ++j) {
            const int id = tid + 512 * j, key = id >> 5, ch = id & 31;
            kr[j] = *(const u32x4*)(KM + ((size_t)b * 256 + key) * 1024 + h * 256 + ch * 8);
            vr[j] = *(const u32x4*)(VM + ((size_t)b * 256 + key) * 1024 + h * 256 + ch * 8);
        }
#pragma unroll
        for (int j = 0; j < 2; ++j) {
            const int id = tid + 512 * j, key = id >> 5, ch = id & 31;
            *(LAS u32x4*)(lds + KOFF + key * 512 + ((ch ^ (key & 15)) << 4)) = kr[j];
            *(LAS u32x4*)(lds + VOFF + (ch >> 2) * 2048 + key * 64 + (ch & 3) * 16) = vr[j];
        }
        __syncthreads();
        f32x16 O[4];
#pragma unroll
        for (int e = 0; e < 4; ++e)
#pragma unroll
            for (int i = 0; i < 16; ++i) O[e][i] = 0.f;
        float mrun = -1e30f, lsum = 0.f;
        const LAS unsigned char* qp = lds + QOFF + (32 * qb + r) * 512;
        for (int t = 0; t < 8; ++t) {
            const int buf = t & 1;
            if (t + 1 < 8) {
#pragma unroll
                for (int j = 0; j < 2; ++j) {
                    const int id = tid + 512 * j, key = id >> 5, ch = id & 31;
                    kr[j] = *(const u32x4*)(KM + ((size_t)b * 256 + 32 * (t + 1) + key) * 1024 + h * 256 + ch * 8);
                    vr[j] = *(const u32x4*)(VM + ((size_t)b * 256 + 32 * (t + 1) + key) * 1024 + h * 256 + ch * 8);
                }
            }
            const LAS unsigned char* kp = lds + KOFF + buf * 16384 + r * 512;
            const LAS unsigned char* vp = lds + VOFF + buf * 16384 + (4 * eh) * 2048 + vlane;
            f32x16 S;
#pragma unroll
            for (int i = 0; i < 16; ++i) S[i] = 0.f;
#pragma unroll 4
            for (int ks = 0; ks < 16; ++ks) {
                const int sl = ((2 * ks + hh) ^ (r & 15)) << 4;
                const bf16x8 a = *(const LAS bf16x8*)(kp + sl);
                const bf16x8 q = *(const LAS bf16x8*)(qp + sl);
                S = mfma32(a, q, S);
            }
            const float mx = half_max(max16(S));
            const float mnew = fmaxf(mrun, mx), alpha = __builtin_amdgcn_exp2f(mrun - mnew);
            mrun = mnew;
            float ps = 0.f;
#pragma unroll
            for (int i = 0; i < 16; ++i) { S[i] = __builtin_amdgcn_exp2f(S[i] - mnew); ps += S[i]; }
            lsum = lsum * alpha + ps;
#pragma unroll
            for (int e = 0; e < 4; ++e)
#pragma unroll
                for (int i = 0; i < 16; ++i) O[e][i] *= alpha;
            const bf16x8 P0 = pfrag(S, 0), P1 = pfrag(S, 1);
#pragma unroll
            for (int e = 0; e < 4; ++e) {
                const bf16x8 v0 = cat8(tr_read(vp + e * 2048), tr_read(vp + e * 2048 + 512));
                const bf16x8 v1 = cat8(tr_read(vp + e * 2048 + 1024), tr_read(vp + e * 2048 + 1536));
                O[e] = mfma32(v0, P0, O[e]);
                O[e] = mfma32(v1, P1, O[e]);
            }
            if (t + 1 < 8) {
#pragma unroll
                for (int j = 0; j < 2; ++j) {
                    const int id = tid + 512 * j, key = id >> 5, ch = id & 31;
                    *(LAS u32x4*)(lds + KOFF + (buf ^ 1) * 16384 + key * 512 + ((ch ^ (key & 15)) << 4)) = kr[j];
                    *(LAS u32x4*)(lds + VOFF + (buf ^ 1) * 16384 + (ch >> 2) * 2048 + key * 64 + (ch & 3) * 16) = vr[j];
                }
            }
            __syncthreads();
        }
        const float inv = 1.f / half_sum(lsum);
        LAS unsigned char* stg = lds + wave * 16384;
#pragma unroll
        for (int e = 0; e < 4; ++e)
#pragma unroll
            for (int g4 = 0; g4 < 4; ++g4) {
                u32x2 w; w.x = cvtpk(O[e][4 * g4 + 0] * inv, O[e][4 * g4 + 1] * inv); w.y = cvtpk(O[e][4 * g4 + 2] * inv, O[e][4 * g4 + 3] * inv);
                *(LAS u32x2*)(stg + r * 272 + (32 * e + 8 * g4 + 4 * hh) * 2) = w;
            }
        WAVE_SYNC();
#pragma unroll
        for (int i = 0; i < 8; ++i) {
            const int row = i * 4 + (lane >> 4), ch = lane & 15;
            const u32x4 v = *(const LAS u32x4*)(stg + row * 272 + ch * 16);
            *(u32x4*)(OX + (qrow0 + 32 * qb + row) * 1024 + h * 256 + 128 * eh + ch * 8) = v;
        }
        __syncthreads();
    }
}

constexpr float QSCALE = 0.125f * 1.4426950408889634f;
namespace pg8 {
struct EpiIn {
    static constexpr bool PERM = false, AFTER_DRAIN = false;
    bf16_t* ZX; bf16_t* Qb; bf16_t* Kb; bf16_t* Vb; float* okf; float* ovf; float* oconv;
    __device__ __forceinline__ void operator()(const f32x4 (&acc)[2][2][4][2], const Unit& u, int wr, int wc, int fr, int fq) const {
        const int row0 = u.pm * BM + wr * 64 + fr, pn = u.pn;
        if (pn < 6) {
#pragma unroll
            for (int ai = 0; ai < 2; ++ai)
#pragma unroll
                for (int m = 0; m < 4; ++m) {
                    const int row = row0 + ai * HALF + m * 16; const int t = row & 8191;
#pragma unroll
                    for (int bj = 0; bj < 2; ++bj)
#pragma unroll
                        for (int n = 0; n < 2; ++n) {
                            const f32x4 v = acc[ai][bj][m][n]; const int col = pn * BM + bj * HALF + wc * 32 + n * 16 + 4 * fq;
                            u32x2 w; w.x = cvt_pk_bf16(v[0], v[1]); w.y = cvt_pk_bf16(v[2], v[3]);
                            *(u32x2*)(ZX + (size_t)row * 1536 + col) = w;
                            if (pn >= 2 && t >= 8189) *(f32x4*)(oconv + (size_t)((row >> 13) * 3 + (t - 8189)) * 1024 + (col - 512)) = v;
                        }
                }
        } else if (pn < 10) {
            const bool isk = pn >= 8;
            const int g = wc & 1;
            float inv[4];
#pragma unroll
            for (int i = 0; i < 4; ++i) inv[i] = __builtin_amdgcn_exp2f(-(float)(16 * g + 4 * fq + i) * (13.287712379549449f / 32.f)) * 0.15915494309189535f;
#pragma unroll
            for (int ai = 0; ai < 2; ++ai)
#pragma unroll
                for (int m = 0; m < 4; ++m) {
                    const int row = row0 + ai * HALF + m * 16; const float pos = (float)(row & 8191);
                    float cs[4], sn[4];
#pragma unroll
                    for (int i = 0; i < 4; ++i) { float rev = pos * inv[i]; rev -= floorf(rev); sn[i] = __builtin_amdgcn_sinf(rev); cs[i] = __builtin_amdgcn_cosf(rev); }
#pragma unroll
                    for (int bj = 0; bj < 2; ++bj) {
                        const int cl = (pn & 1) * BM + bj * HALF + wc * 32;
                        const f32x4 x1 = acc[ai][bj][m][0], x2 = acc[ai][bj][m][1];
                        f32x4 o1, o2;
#pragma unroll
                        for (int i = 0; i < 4; ++i) { o1[i] = x1[i] * cs[i] - x2[i] * sn[i]; o2[i] = x2[i] * cs[i] + x1[i] * sn[i]; }
                        if (isk) {
                            float* kf = okf + (size_t)row * 512 + (cl >> 6) * 64 + 16 * g + 4 * fq;
                            *(f32x4*)kf = o1; *(f32x4*)(kf + 32) = o2;
                            u32x2 w; w.x = cvt_pk_bf16(o1[0], o1[1]); w.y = cvt_pk_bf16(o1[2], o1[3]);
                            *(u32x2*)(Kb + (size_t)row * 512 + cl + 4 * fq) = w;
                            w.x = cvt_pk_bf16(o2[0], o2[1]); w.y = cvt_pk_bf16(o2[2], o2[3]);
                            *(u32x2*)(Kb + (size_t)row * 512 + cl + 16 + 4 * fq) = w;
                        } else {
                            o1 = o1 * QSCALE; o2 = o2 * QSCALE;
                            u32x2 w; w.x = cvt_pk_bf16(o1[0], o1[1]); w.y = cvt_pk_bf16(o1[2], o1[3]);
                            *(u32x2*)(Qb + (size_t)row * 512 + cl + 4 * fq) = w;
                            w.x = cvt_pk_bf16(o2[0], o2[1]); w.y = cvt_pk_bf16(o2[2], o2[3]);
                            *(u32x2*)(Qb + (size_t)row * 512 + cl + 16 + 4 * fq) = w;
                        }
                    }
                }
        } else {
#pragma unroll
            for (int ai = 0; ai < 2; ++ai)
#pragma unroll
                for (int m = 0; m < 4; ++m) {
                    const int row = row0 + ai * HALF + m * 16;
#pragma unroll
                    for (int bj = 0; bj < 2; ++bj)
#pragma unroll
                        for (int n = 0; n < 2; ++n) {
                            const f32x4 v = acc[ai][bj][m][n]; const int col = (pn - 10) * BM + bj * HALF + wc * 32 + n * 16 + 4 * fq;
                            *(f32x4*)(ovf + (size_t)row * 512 + col) = v;
                            u32x2 w; w.x = cvt_pk_bf16(v[0], v[1]); w.y = cvt_pk_bf16(v[2], v[3]);
                            *(u32x2*)(Vb + (size_t)row * 512 + col) = w;
                        }
                }
        }
    }
};
}

DEV void phase_prep_mix(const FP& p, LAS unsigned char* lds, int gw, int ngw, int wave, int lane) {
    LAS float* scr = (LAS float*)(lds + wave * 16384);
    constexpr int I_IN = 16 * 97, I_OUT = 16 * 32;
    for (int it = gw; it < I_IN + I_OUT; it += ngw) {
        if (it < I_IN) transpose_item(p.in[9], 1024, 3080, (bf16_t*)(p.ws + WS_W_IN), it, scr, lane, RmIn{});
        else transpose_item(p.in[21], 1024, 1024, (bf16_t*)(p.ws + WS_W_OUT), it - I_IN, scr, lane, RmPlain{0});
    }
    __syncthreads();
    LAS float* wdt = (LAS float*)lds;
    for (int i = threadIdx.x; i < 8192; i += 512) wdt[i] = p.in[9][(size_t)(i >> 3) * 3080 + 1536 + (i & 7)];
    __syncthreads();
    const float* x = p.in[0]; const float* g = p.in[27]; bf16_t* xn = (bf16_t*)(p.ws + WS_XN); float* dtv = (float*)(p.ws + WS_DTV);
    const float bias = p.in[12][lane & 7];
    for (int r = gw; r < MP; r += ngw) {
        f32x4 h[4]; float ss = 0.f;
#pragma unroll
        for (int j = 0; j < 4; ++j) { h[j] = ((const f32x4*)(x + (size_t)r * 1024))[lane + 64 * j]; ss += h[j].x * h[j].x + h[j].y * h[j].y + h[j].z * h[j].z + h[j].w * h[j].w; }
        const float rs = rsqrtf(wave_sum(ss) * (1.f / 1024.f) + 1e-6f);
        float d[8];
#pragma unroll
        for (int k = 0; k < 8; ++k) d[k] = 0.f;
#pragma unroll
        for (int j = 0; j < 4; ++j) {
            const f32x4 gg = ((const f32x4*)g)[lane + 64 * j]; h[j] = h[j] * rs * gg;
            u32x2 w; w.x = pk2(h[j].x, h[j].y); w.y = pk2(h[j].z, h[j].w);
            ((u32x2*)(xn + (size_t)r * 1024))[lane + 64 * j] = w;
#pragma unroll
            for (int i = 0; i < 4; ++i) {
                const LAS f32x4* wp = (const LAS f32x4*)(wdt + (4 * (lane + 64 * j) + i) * 8);
                const f32x4 w0 = wp[0], w1 = wp[1]; const float hv = h[j][i];
                d[0] += hv * w0.x; d[1] += hv * w0.y; d[2] += hv * w0.z; d[3] += hv * w0.w; d[4] += hv * w1.x; d[5] += hv * w1.y; d[6] += hv * w1.z; d[7] += hv * w1.w;
            }
        }
#pragma unroll
        for (int k = 0; k < 8; ++k) d[k] = wave_sum(d[k]);
        float mine = d[0];
#pragma unroll
        for (int k = 1; k < 8; ++k) mine = ((lane & 7) == k) ? d[k] : mine;
        const float xx = mine + bias;
        if (lane < 8) dtv[(size_t)r * 8 + lane] = (xx > 20.f) ? xx : log1pf(expf(xx));
    }
    __syncthreads();
}
DEV void phase_inproj(const FP& p, LAS unsigned char* lds, int G, int bid) {
    pg8::Gemm g{(const bf16_t*)(p.ws + WS_XN), (const bf16_t*)(p.ws + WS_W_IN), MP, 3072, 1024};
    pg8::StaticOrder S; S.init(MP, 3072, G, bid);
    pg8::EpiIn E{(bf16_t*)(p.ws + WS_ZX), (bf16_t*)(p.ws + WS_Q), (bf16_t*)(p.ws + WS_K), (bf16_t*)(p.ws + WS_V), p.out + 16908288, p.out + 25296896, p.out + 33816576};
    pg8::gemm_phase<pg8::EpiIn, pg8::StaticOrder, true, true>(lds, g, S, E);
}
DEV void phase_outproj(const FP& p, LAS unsigned char* lds, int G, int bid) {
    pg8::Gemm g{(const bf16_t*)(p.ws + WS_CAT), (const bf16_t*)(p.ws + WS_W_OUT), MP, 1024, 1024};
    pg8::StaticOrder S; S.init(MP, 1024, G, bid);
    pg8::EpiBf16<0> E{(bf16_t*)(p.ws + WS_RAW), 1024, nullptr, 0, 0, 1.f};
    pg8::gemm_phase<pg8::EpiBf16<0>, pg8::StaticOrder, true, true>(lds, g, S, E);
}

DEV float ssd_tables(const FP& p, LAS float* tdt, LAS float* tac, size_t row0, int h, int lane) {
    const float dt = ((const float*)(p.ws + WS_DTV))[(row0 + lane) * 8 + h];
    const float a = -expf(p.in[13][h]);
    float v = dt * a;
#pragma unroll
    for (int o = 1; o < 64; o <<= 1) { const float t = __shfl_up(v, o); if (lane >= o) v += t; }
    tdt[lane * 8 + h] = dt; tac[lane * 8 + h] = v;
    return __shfl(v, 63);
}
template <class F> DEV void ssd_conv8(const FP& p, size_t row0, int col0, int l0, F emit) {
    const bf16_t* ZX = (const bf16_t*)(p.ws + WS_ZX);
    const float* cw = p.in[10]; const float* cb = p.in[11];
    f32x4 w[4][2], bias[2];
#pragma unroll
    for (int j = 0; j < 4; ++j) { w[j][0] = *(const f32x4*)(cw + j * 1024 + col0); w[j][1] = *(const f32x4*)(cw + j * 1024 + col0 + 4); }
    bias[0] = *(const f32x4*)(cb + col0); bias[1] = *(const f32x4*)(cb + col0 + 4);
    const int t0 = (int)(row0 & 8191);
    f32x4 u[4][2];
#pragma unroll
    for (int j = 0; j < 3; ++j) {
        const int l = l0 - 3 + j;
        if (t0 + l >= 0) {
            const u32x4 r = *(const u32x4*)(ZX + (row0 + l) * 1536 + 512 + col0);
            u[j][0] = (f32x4){bflo(r.x), bfhi(r.x), bflo(r.y), bfhi(r.y)}; u[j][1] = (f32x4){bflo(r.z), bfhi(r.z), bflo(r.w), bfhi(r.w)};
        } else { u[j][0] = (f32x4){0.f, 0.f, 0.f, 0.f}; u[j][1] = u[j][0]; }
    }
#pragma unroll
    for (int i = 0; i < 16; ++i) {
        const int l = l0 + i;
        const u32x4 r = *(const u32x4*)(ZX + (row0 + l) * 1536 + 512 + col0);
        u[3][0] = (f32x4){bflo(r.x), bfhi(r.x), bflo(r.y), bfhi(r.y)}; u[3][1] = (f32x4){bflo(r.z), bfhi(r.z), bflo(r.w), bfhi(r.w)};
        f32x4 a0 = bias[0] + w[0][0] * u[0][0] + w[1][0] * u[1][0] + w[2][0] * u[2][0] + w[3][0] * u[3][0];
        f32x4 a1 = bias[1] + w[0][1] * u[0][1] + w[1][1] * u[1][1] + w[2][1] * u[2][1] + w[3][1] * u[3][1];
#pragma unroll
        for (int k = 0; k < 4; ++k) { a0[k] = fast_silu(a0[k]); a1[k] = fast_silu(a1[k]); }
        emit(l, a0, a1);
        u[0][0] = u[1][0]; u[0][1] = u[1][1]; u[1][0] = u[2][0]; u[1][1] = u[2][1]; u[2][0] = u[3][0]; u[2][1] = u[3][1];
    }
}
constexpr int S_XS = 0, S_B = 65536, S_C = 98304, S_TDT = 131072, S_TAC = 133120, S_SSQ = 135168;
DEV int trlane(int lane) { return ((lane & 15) >> 2) * 64 + 32 * ((lane >> 4) & 1) + 8 * (lane & 3); }

DEV void phase_ssd1(const FP& p, LAS unsigned char* lds, int G, int bid) {
    const int tid = threadIdx.x, lane = tid & 63, wave = __builtin_amdgcn_readfirstlane(tid >> 6), hh = lane >> 5;
    LAS float* tdt = (LAS float*)(lds + S_TDT); LAS float* tac = (LAS float*)(lds + S_TAC);
    bf16_t* ST = (bf16_t*)(p.ws + WS_ST); float* cdec = (float*)(p.ws + WS_CDEC);
    for (int u = bid; u < 256; u += G) {
        const int b = u >> 7, c = u & 127; const size_t row0 = (size_t)b * 8192 + (size_t)c * 64;
        const float tot = ssd_tables(p, tdt, tac, row0, wave, lane);
        if (lane == 0) cdec[u * 8 + wave] = expf(tot);
        __syncthreads();
        { const int i = tid; const float t63 = tac[63 * 8 + (i & 7)]; const float s = tdt[i] * expf(t63 - tac[i]); __syncthreads(); tdt[i] = s; }
        __syncthreads();
        if (tid < 384) {
            const int cg = tid >> 2, tq = tid & 3, col0 = cg * 8;
            ssd_conv8(p, row0, col0, tq * 16, [&](int l, f32x4 a0, f32x4 a1) {
                u32x4 w;
                if (cg < 64) {
                    const int h = cg >> 3, pp = col0 & 63; const float s = tdt[l * 8 + h];
                    a0 = a0 * s; a1 = a1 * s;
                    w.x = pk2(a0[0], a0[1]); w.y = pk2(a0[2], a0[3]); w.z = pk2(a1[0], a1[1]); w.w = pk2(a1[2], a1[3]);
                    *(LAS u32x4*)(lds + S_XS + h * 8192 + (pp >> 5) * 4096 + l * 64 + (pp & 31) * 2) = w;
                } else {
                    const int n = col0 - 512, g = n >> 7, nn = n & 127;
                    w.x = pk2(a0[0], a0[1]); w.y = pk2(a0[2], a0[3]); w.z = pk2(a1[0], a1[1]); w.w = pk2(a1[2], a1[3]);
                    *(LAS u32x4*)(lds + S_B + g * 16384 + (nn >> 5) * 4096 + l * 64 + (nn & 31) * 2) = w;
                }
            });
        }
        __syncthreads();
        const int h = wave, g = h >> 2;
        const LAS unsigned char* xa = lds + S_XS + h * 8192 + hh * 512 + trlane(lane);
        const LAS unsigned char* ba = lds + S_B + g * 16384 + hh * 512 + trlane(lane);
        bf16_t* sp = ST + ((size_t)u * 8 + h) * 8192;
#pragma unroll 1
        for (int nh = 0; nh < 2; ++nh) {
            f32x16 acc[2][2];
#pragma unroll
            for (int a = 0; a < 2; ++a)
#pragma unroll
                for (int n = 0; n < 2; ++n)
#pragma unroll
                    for (int i = 0; i < 16; ++i) acc[a][n][i] = 0.f;
#pragma unroll 2
            for (int s = 0; s < 4; ++s) {
                bf16x8 af[2], bfr[2];
#pragma unroll
                for (int a = 0; a < 2; ++a) af[a] = cat8(tr_read(xa + a * 4096 + s * 1024), tr_read(xa + a * 4096 + s * 1024 + 256));
#pragma unroll
                for (int n = 0; n < 2; ++n) bfr[n] = cat8(tr_read(ba + (2 * nh + n) * 4096 + s * 1024), tr_read(ba + (2 * nh + n) * 4096 + s * 1024 + 256));
#pragma unroll
                for (int a = 0; a < 2; ++a)
#pragma unroll
                    for (int n = 0; n < 2; ++n) acc[a][n] = mfma32(af[a], bfr[n], acc[a][n]);
            }
#pragma unroll
            for (int a = 0; a < 2; ++a)
#pragma unroll
                for (int n = 0; n < 2; ++n)
#pragma unroll
                    for (int i = 0; i < 16; ++i) {
                        const int pr = 32 * a + (i & 3) + 8 * (i >> 2) + 4 * hh;
                        sp[pr * 128 + 32 * (2 * nh + n) + (lane & 31)] = (bf16_t)f2bf(acc[a][n][i]);
                    }
        }
        __syncthreads();
    }
}

DEV void phase_ssd2(const FP& p, int G, int bid) {
    const int tid = threadIdx.x;
    unsigned* ST = (unsigned*)(p.ws + WS_ST); const float* cdec = (const float*)(p.ws + WS_CDEC); float* pssm = p.out + 33685504;
    for (int blk = bid; blk < 128; blk += G) {
        const int idx = blk * 512 + tid;
        const int n2 = idx & 63, pr = (idx >> 6) & 63, h = (idx >> 12) & 7, b = idx >> 15;
        float s0 = 0.f, s1 = 0.f;
        for (int c0 = 0; c0 < 128; c0 += 16) {
            unsigned v[16];
#pragma unroll
            for (int j = 0; j < 16; ++j) v[j] = ST[(((size_t)(b * 128 + c0 + j) * 8 + h) * 64 + pr) * 64 + n2];
#pragma unroll
            for (int j = 0; j < 16; ++j) {
                const float dc = cdec[(b * 128 + c0 + j) * 8 + h];
                ST[(((size_t)(b * 128 + c0 + j) * 8 + h) * 64 + pr) * 64 + n2] = pk2(s0, s1);
                s0 = s0 * dc + bflo(v[j]); s1 = s1 * dc + bfhi(v[j]);
            }
        }
        float2 o; o.x = s0; o.y = s1;
        ((float2*)pssm)[(((size_t)b * 8 + h) * 64 + pr) * 64 + n2] = o;
    }
}

DEV void phase_ssd3(const FP& p, LAS unsigned char* lds, int G, int bid) {
    LAS float* tdt = (LAS float*)(lds + S_TDT); LAS float* tac = (LAS float*)(lds + S_TAC); LAS float* ssq = (LAS float*)(lds + S_SSQ);
    const bf16_t* ST = (const bf16_t*)(p.ws + WS_ST); const bf16_t* ZX = (const bf16_t*)(p.ws + WS_ZX); bf16_t* CAT = (bf16_t*)(p.ws + WS_CAT);
    for (int u = bid; u < 256; u += G) {
        int tid = threadIdx.x; asm volatile("" : "+v"(tid));
        const int lane = tid & 63, wave = __builtin_amdgcn_readfirstlane(tid >> 6), r = lane & 31, hh = lane >> 5;
        const int b = u >> 7, c = u & 127; const size_t row0 = (size_t)b * 8192 + (size_t)c * 64;
        (void)ssd_tables(p, tdt, tac, row0, wave, lane);
        {
            const int cg = tid >> 2, tq = tid & 3, col0 = cg * 8;
            ssd_conv8(p, row0, col0, tq * 16, [&](int l, f32x4 a0, f32x4 a1) {
                u32x4 w; w.x = pk2(a0[0], a0[1]); w.y = pk2(a0[2], a0[3]); w.z = pk2(a1[0], a1[1]); w.w = pk2(a1[2], a1[3]);
                if (cg < 64) {
                    const int h = cg >> 3, pp = col0 & 63;
                    *(LAS u32x4*)(lds + S_XS + h * 8192 + (pp >> 5) * 4096 + l * 64 + (pp & 31) * 2) = w;
                } else {
                    const int n = (col0 - 512) & 255, g = n >> 7, ch = (n & 127) >> 3;
                    *(LAS u32x4*)(lds + (col0 < 768 ? S_B : S_C) + g * 16384 + l * 256 + ((ch ^ (l & 15)) << 4)) = w;
                }
            });
        }
        __syncthreads();
        const int h = wave, g = h >> 2;
        f32x16 Y[2][2];
#pragma unroll
        for (int a = 0; a < 2; ++a)
#pragma unroll
            for (int l2 = 0; l2 < 2; ++l2)
#pragma unroll
                for (int i = 0; i < 16; ++i) Y[a][l2][i] = 0.f;
        const LAS unsigned char* cp = lds + S_C + g * 16384 + r * 256;
        const LAS unsigned char* bp = lds + S_B + g * 16384 + r * 256;
        const bf16_t* pv = ST + ((size_t)u * 8 + h) * 8192 + (size_t)r * 128 + 8 * hh;
#pragma unroll 2
        for (int ks = 0; ks < 8; ++ks) {
            const int sl = ((2 * ks + hh) ^ (r & 15)) << 4;
            const bf16x8 c0 = *(const LAS bf16x8*)(cp + sl), c1 = *(const LAS bf16x8*)(cp + 32 * 256 + sl);
            const bf16x8 p0 = *(const bf16x8*)(pv + 16 * ks), p1 = *(const bf16x8*)(pv + 32 * 128 + 16 * ks);
            Y[0][0] = mfma32(p0, c0, Y[0][0]); Y[0][1] = mfma32(p0, c1, Y[0][1]);
            Y[1][0] = mfma32(p1, c0, Y[1][0]); Y[1][1] = mfma32(p1, c1, Y[1][1]);
        }
        float acl[2];
#pragma unroll
        for (int l2 = 0; l2 < 2; ++l2) {
            acl[l2] = tac[(32 * l2 + r) * 8 + h]; const float e = expf(acl[l2]);
#pragma unroll
            for (int a = 0; a < 2; ++a)
#pragma unroll
                for (int i = 0; i < 16; ++i) Y[a][l2][i] *= e;
        }
        __builtin_amdgcn_sched_barrier(0);
        const LAS unsigned char* xa = lds + S_XS + h * 8192 + hh * 256 + trlane(lane);
#pragma unroll
        for (int lb = 0; lb < 2; ++lb)
#pragma unroll
            for (int sb = 0; sb <= lb; ++sb) {
                f32x16 T;
#pragma unroll
                for (int i = 0; i < 16; ++i) T[i] = 0.f;
#pragma unroll 2
                for (int ks = 0; ks < 8; ++ks) {
                    const int sl = ((2 * ks + hh) ^ (r & 15)) << 4;
                    const bf16x8 bb = *(const LAS bf16x8*)(bp + sb * 32 * 256 + sl), cc = *(const LAS bf16x8*)(cp + lb * 32 * 256 + sl);
                    T = mfma32(bb, cc, T);
                }
#pragma unroll
                for (int i = 0; i < 16; ++i) {
                    const int s = 32 * sb + (i & 3) + 8 * (i >> 2) + 4 * hh;
                    const float f = tdt[s * 8 + h] * __builtin_amdgcn_exp2f(1.4426950408889634f * fminf(acl[lb] - tac[s * 8 + h], 0.f));
                    T[i] = (s <= 32 * lb + r) ? T[i] * f : 0.f;
                }
                const bf16x8 P0 = pfrag(T, 0), P1 = pfrag(T, 1);
#pragma unroll
                for (int a = 0; a < 2; ++a) {
                    const bf16x8 x0 = cat8(tr_read(xa + a * 4096 + (2 * sb) * 1024), tr_read(xa + a * 4096 + (2 * sb) * 1024 + 512));
                    const bf16x8 x1 = cat8(tr_read(xa + a * 4096 + (2 * sb + 1) * 1024), tr_read(xa + a * 4096 + (2 * sb + 1) * 1024 + 512));
                    Y[a][lb] = mfma32(x0, P0, Y[a][lb]);
                    Y[a][lb] = mfma32(x1, P1, Y[a][lb]);
                }
            }
        __builtin_amdgcn_sched_barrier(0);
        const float Dh = p.in[14][h];
        float sq[2] = {0.f, 0.f};
#pragma unroll
        for (int a = 0; a < 2; ++a)
#pragma unroll
            for (int l2 = 0; l2 < 2; ++l2) {
                const int l = 32 * l2 + r;
#pragma unroll
                for (int g4 = 0; g4 < 4; ++g4) {
                    const int pp = 8 * g4 + 4 * hh;
                    const u32x2 xw = *(const LAS u32x2*)(lds + S_XS + h * 8192 + a * 4096 + l * 64 + pp * 2);
                    const u32x2 zw = *(const u32x2*)(ZX + (row0 + l) * 1536 + h * 64 + 32 * a + pp);
                    const float xv[4] = {bflo(xw.x), bfhi(xw.x), bflo(xw.y), bfhi(xw.y)}, zv[4] = {bflo(zw.x), bfhi(zw.x), bflo(zw.y), bfhi(zw.y)};
#pragma unroll
                    for (int i = 0; i < 4; ++i) { const float v = (Y[a][l2][4 * g4 + i] + Dh * xv[i]) * fast_silu(zv[i]); Y[a][l2][4 * g4 + i] = v; sq[l2] += v * v; }
                }
            }
#pragma unroll
        for (int l2 = 0; l2 < 2; ++l2) { sq[l2] = half_sum(sq[l2]); if (hh == 0) ssq[(h * 2 + l2) * 32 + r] = sq[l2]; }
        __syncthreads();
        float rs[2];
#pragma unroll
        for (int l2 = 0; l2 < 2; ++l2) {
            float t = 0.f;
#pragma unroll
            for (int k = 0; k < 4; ++k) t += ssq[((4 * g + k) * 2 + l2) * 32 + r];
            rs[l2] = rsqrtf(t * (1.f / 256.f) + 1e-5f);
        }
#pragma unroll
        for (int a = 0; a < 2; ++a)
#pragma unroll
            for (int g4 = 0; g4 < 4; ++g4) {
                const int pcol = h * 64 + 32 * a + 8 * g4 + 4 * hh;
                const f32x4 w = *(const f32x4*)(p.in[15] + pcol);
#pragma unroll
                for (int l2 = 0; l2 < 2; ++l2) {
                    u32x2 o; o.x = cvtpk(Y[a][l2][4 * g4 + 0] * rs[l2] * w[0], Y[a][l2][4 * g4 + 1] * rs[l2] * w[1]);
                    o.y = cvtpk(Y[a][l2][4 * g4 + 2] * rs[l2] * w[2], Y[a][l2][4 * g4 + 3] * rs[l2] * w[3]);
                    *(u32x2*)(CAT + (row0 + 32 * l2 + r) * 1024 + pcol) = o;
                }
            }
        __syncthreads();
    }
}

DEV void phase_attn(const FP& p, LAS unsigned char* lds, int G, int bid) {
    const int tid0 = threadIdx.x, lane0 = tid0 & 63;
    const bf16_t* Qg = (const bf16_t*)(p.ws + WS_Q); const bf16_t* Kg = (const bf16_t*)(p.ws + WS_K); const bf16_t* Vg = (const bf16_t*)(p.ws + WS_V);
    bf16_t* CAT = (bf16_t*)(p.ws + WS_CAT);
    const float lam_init = 0.2f;
    const float lam = expf(wave_sum(p.in[16][lane0] * p.in[17][lane0])) - expf(wave_sum(p.in[18][lane0] * p.in[19][lane0])) + lam_init;
    LAS float* subw = (LAS float*)(lds + 131072);
    if (tid0 < 128) subw[tid0] = p.in[20][tid0];
    for (int pu = bid; pu < 256; pu += G) {
        const int bh = pu & 7, b = bh >> 2, h = bh & 3, pr = pu >> 3;
        for (int half = 0; half < 2; ++half) {
            int tid = threadIdx.x; asm volatile("" : "+v"(tid));
            const int lane = tid & 63, wave = __builtin_amdgcn_readfirstlane(tid >> 6), r = lane & 31, hh = lane >> 5, qb = wave & 3, c = wave >> 2;
            const int vlane = (4 * hh) * 64 + trlane(lane);
            const int jq = half ? 63 - pr : pr;
            const size_t rowb = (size_t)b * 8192; const int q0 = jq * 128;
            const int ntb = 2 * jq + 2, myn = 2 * jq + (qb >> 1) + 1;
            bf16x8 qf[4];
#pragma unroll
            for (int ks = 0; ks < 4; ++ks) qf[ks] = *(const bf16x8*)(Qg + (rowb + q0 + 32 * qb + r) * 512 + h * 128 + c * 64 + 16 * ks + 8 * hh);
            u32x4 kr[2], vr[2];
#pragma unroll
            for (int j = 0; j < 2; ++j) {
                const int id = tid + 512 * j, key = id >> 4, ch = id & 15;
                kr[j] = *(const u32x4*)(Kg + (rowb + key) * 512 + h * 128 + ch * 8);
                vr[j] = *(const u32x4*)(Vg + (rowb + key) * 512 + h * 128 + ch * 8);
            }
#pragma unroll
            for (int j = 0; j < 2; ++j) {
                const int id = tid + 512 * j, key = id >> 4, ch = id & 15;
                *(LAS u32x4*)(lds + (ch >> 3) * 8192 + key * 128 + (((ch & 7) ^ ((key >> 1) & 7)) << 4)) = kr[j];
                *(LAS u32x4*)(lds + 16384 + (ch >> 2) * 4096 + key * 64 + (ch & 3) * 16) = vr[j];
            }
            __syncthreads();
            f32x16 O[4];
#pragma unroll
            for (int e = 0; e < 4; ++e)
#pragma unroll
                for (int i = 0; i < 16; ++i) O[e][i] = 0.f;
            float mrun = -1e30f, lsum = 0.f;
            for (int t = 0; t < ntb; ++t) {
                const int buf = t & 1;
                if (t + 1 < ntb) {
#pragma unroll
                    for (int j = 0; j < 2; ++j) {
                        const int id = tid + 512 * j, key = id >> 4, ch = id & 15;
                        kr[j] = *(const u32x4*)(Kg + (rowb + 64 * (t + 1) + key) * 512 + h * 128 + ch * 8);
                        vr[j] = *(const u32x4*)(Vg + (rowb + 64 * (t + 1) + key) * 512 + h * 128 + ch * 8);
                    }
                }
                if (t < myn) {
                    const LAS unsigned char* kp = lds + buf * 32768 + c * 8192 + r * 128;
                    const LAS unsigned char* vp = lds + buf * 32768 + 16384 + vlane;
                    f32x16 S0, S1;
#pragma unroll
                    for (int i = 0; i < 16; ++i) { S0[i] = 0.f; S1[i] = 0.f; }
#pragma unroll
                    for (int ks = 0; ks < 4; ++ks) {
                        const int sl = ((2 * ks + hh) ^ ((r >> 1) & 7)) << 4;
                        const bf16x8 a0 = *(const LAS bf16x8*)(kp + sl), a1 = *(const LAS bf16x8*)(kp + 32 * 128 + sl);
                        S0 = mfma32(a0, qf[ks], S0); S1 = mfma32(a1, qf[ks], S1);
                    }
                    const float mx = half_max(fmaxf(max16(S0), max16(S1)));
                    const float mnew = fmaxf(mrun, mx), alpha = __builtin_amdgcn_exp2f(mrun - mnew);
                    mrun = mnew;
                    float ps = 0.f;
#pragma unroll
                    for (int i = 0; i < 16; ++i) { S0[i] = __builtin_amdgcn_exp2f(S0[i] - mnew); S1[i] = __builtin_amdgcn_exp2f(S1[i] - mnew); ps += S0[i] + S1[i]; }
                    lsum = lsum * alpha + ps;
#pragma unroll
                    for (int e = 0; e < 4; ++e)
#pragma unroll
                        for (int i = 0; i < 16; ++i) O[e][i] *= alpha;
                    const bf16x8 P0 = pfrag(S0, 0), P1 = pfrag(S0, 1), P2 = pfrag(S1, 0), P3 = pfrag(S1, 1);
#pragma unroll
                    for (int e = 0; e < 4; ++e) {
                        const bf16x8 v0 = cat8(tr_read(vp + e * 4096), tr_read(vp + e * 4096 + 512));
                        const bf16x8 v1 = cat8(tr_read(vp + e * 4096 + 1024), tr_read(vp + e * 4096 + 1536));
                        const bf16x8 v2 = cat8(tr_read(vp + e * 4096 + 2048), tr_read(vp + e * 4096 + 2560));
                        const bf16x8 v3 = cat8(tr_read(vp + e * 4096 + 3072), tr_read(vp + e * 4096 + 3584));
                        O[e] = mfma32(v0, P0, O[e]); O[e] = mfma32(v1, P1, O[e]); O[e] = mfma32(v2, P2, O[e]); O[e] = mfma32(v3, P3, O[e]);
                        if (e & 1) __builtin_amdgcn_sched_barrier(0);
                    }
                }
                if (t + 1 < ntb) {
#pragma unroll
                    for (int j = 0; j < 2; ++j) {
                        const int id = tid + 512 * j, key = id >> 4, ch = id & 15;
                        *(LAS u32x4*)(lds + (buf ^ 1) * 32768 + (ch >> 3) * 8192 + key * 128 + (((ch & 7) ^ ((key >> 1) & 7)) << 4)) = kr[j];
                        *(LAS u32x4*)(lds + (buf ^ 1) * 32768 + 16384 + (ch >> 2) * 4096 + key * 64 + (ch & 3) * 16) = vr[j];
                    }
                }
                __syncthreads();
            }
            const float inv = 1.f / half_sum(lsum);
            LAS float* xch = (LAS float*)(lds + qb * 16384);
            if (c == 1) {
                const float f = -lam * inv;
#pragma unroll
                for (int e = 0; e < 4; ++e)
#pragma unroll
                    for (int i = 0; i < 16; ++i) xch[(e * 16 + i) * 64 + lane] = O[e][i] * f;
            }
            __syncthreads();
            if (c == 0) {
                float ss = 0.f;
#pragma unroll
                for (int e = 0; e < 4; ++e)
#pragma unroll
                    for (int i = 0; i < 16; ++i) { const float v = O[e][i] * inv + xch[(e * 16 + i) * 64 + lane]; O[e][i] = v; ss += v * v; }
                ss = half_sum(ss);
                const float rs = rsqrtf(ss * (1.f / 128.f) + 1e-5f) * (1.f - lam_init);
                WAVE_SYNC();
                LAS unsigned char* stg = lds + qb * 16384;
#pragma unroll
                for (int e = 0; e < 4; ++e)
#pragma unroll
                    for (int g4 = 0; g4 < 4; ++g4) {
                        const int e0 = 32 * e + 8 * g4 + 4 * hh;
                        const f32x4 w = *(const LAS f32x4*)(subw + e0);
                        u32x2 o; o.x = cvtpk(O[e][4 * g4 + 0] * rs * w[0], O[e][4 * g4 + 1] * rs * w[1]); o.y = cvtpk(O[e][4 * g4 + 2] * rs * w[2], O[e][4 * g4 + 3] * rs * w[3]);
                        *(LAS u32x2*)(stg + r * 272 + e0 * 2) = o;
                    }
                WAVE_SYNC();
#pragma unroll
                for (int i = 0; i < 8; ++i) {
                    const int row = i * 4 + (lane >> 4), ch = lane & 15;
                    const u32x4 v = *(const LAS u32x4*)(stg + row * 272 + ch * 16);
                    *(u32x4*)(CAT + (rowb + q0 + 32 * qb + row) * 1024 + 512 + h * 128 + ch * 8) = v;
                }
            }
            __syncthreads();
        }
    }
}

constexpr int NS = 128;
constexpr size_t SB_XN = 0, SB_Z = 256 * 1024, SB_XBC = 512 * 1024, SB_Q = 1024 * 1024, SB_DTV = 1280 * 1024, SB_YPRE = 1536 * 1024, SB_CAT = 1792 * 1024, SB_MIX = 2048 * 1024,
                 SB_QX = 2560 * 1024, SB_OX = 3072 * 1024, SB_HID = 3328 * 1024, SB_AML = 4096 * 1024, SB_XML = 4608 * 1024, SB_XO = 5 * MiB, SB_AO = 8 * MiB;
constexpr int N_ATILE = 33;

template <class Epi>
DEV void s_gemm(const bf16_t* A, const bf16_t* Bt, int N, int K, LAS unsigned char* lds, int bid, int G, int rot, const Epi& E) {
    int tid = threadIdx.x; asm volatile("" : "+v"(tid));
    const int lane = tid & 63, wave = __builtin_amdgcn_readfirstlane(tid >> 6), r = lane & 31, hh = lane >> 5, mb = wave & 3, kh = wave >> 2;
    const int nun = N >> 5;
    for (int u = (bid + G - rot) % G; u < nun; u += G) {
        const int n0 = u * 32;
        const bf16_t* ap = A + (size_t)(32 * mb + r) * K + kh * (K >> 1) + 16 * hh;
        const bf16_t* bp = Bt + (size_t)(n0 + r) * K + kh * (K >> 1) + 16 * hh;
        f32x16 acc;
#pragma unroll
        for (int i = 0; i < 16; ++i) acc[i] = 0.f;
        const int nit = K >> 6;
#pragma unroll 4
        for (int j = 0; j < nit; ++j) {
            const bf16x8 a0 = *(const bf16x8*)(ap + 32 * j), a1 = *(const bf16x8*)(ap + 32 * j + 8);
            const bf16x8 b0 = *(const bf16x8*)(bp + 32 * j), b1 = *(const bf16x8*)(bp + 32 * j + 8);
            acc = mfma32(b0, a0, acc); acc = mfma32(b1, a1, acc);
        }
        LAS float* red = (LAS float*)lds + mb * 1024;
        if (kh == 1) {
#pragma unroll
            for (int i = 0; i < 16; ++i) red[i * 64 + lane] = acc[i];
        }
        __syncthreads();
        if (kh == 0) {
#pragma unroll
            for (int i = 0; i < 16; ++i) acc[i] += red[i * 64 + lane];
            E(acc, 32 * mb + r, n0, hh);
        }
        __syncthreads();
    }
}
struct EpiSF32 {
    float* C; int ldc; float scale;
    __device__ __forceinline__ void operator()(const f32x16& acc, int m, int n0, int hh) const {
#pragma unroll
        for (int g4 = 0; g4 < 4; ++g4) { f32x4 v = {acc[4 * g4] * scale, acc[4 * g4 + 1] * scale, acc[4 * g4 + 2] * scale, acc[4 * g4 + 3] * scale}; *(f32x4*)(C + (size_t)m * ldc + n0 + 8 * g4 + 4 * hh) = v; }
    }
};
struct EpiSSwiglu {
    bf16_t* H;
    __device__ __forceinline__ void operator()(const f32x16& acc, int m, int n0, int hh) const {
#pragma unroll
        for (int g4 = 0; g4 < 2; ++g4) {
            u32x2 w; w.x = cvtpk(fast_silu(acc[4 * g4]) * acc[4 * g4 + 8], fast_silu(acc[4 * g4 + 1]) * acc[4 * g4 + 9]);
            w.y = cvtpk(fast_silu(acc[4 * g4 + 2]) * acc[4 * g4 + 10], fast_silu(acc[4 * g4 + 3]) * acc[4 * g4 + 11]);
            *(u32x2*)(H + (size_t)m * 2816 + 16 * (n0 >> 5) + 8 * g4 + 4 * hh) = w;
        }
    }
};
struct EpiSIn {
    float *z, *xbc, *q, *ok, *ov, *oconv;
    __device__ __forceinline__ void operator()(const f32x16& acc, int m, int n0, int hh) const {
        const int t = m & 15, b = m >> 4;
        if (n0 < 1536) {
#pragma unroll
            for (int g4 = 0; g4 < 4; ++g4) {
                const f32x4 v = {acc[4 * g4], acc[4 * g4 + 1], acc[4 * g4 + 2], acc[4 * g4 + 3]}; const int col = n0 + 8 * g4 + 4 * hh;
                if (n0 < 512) *(f32x4*)(z + (size_t)m * 512 + col) = v;
                else { *(f32x4*)(xbc + (size_t)m * 1024 + col - 512) = v; if (t >= 13) *(f32x4*)(oconv + (size_t)(b * 3 + t - 13) * 1024 + col - 512) = v; }
            }
        } else if (n0 < 2560) {
            const bool isk = n0 >= 2048; const int cl = (n0 - (isk ? 2048 : 1536)), u64 = cl >> 6, g = (cl >> 5) & 1;
            const float pos = (float)(2048 + t);
            float* dst = (isk ? ok : q) + (size_t)m * 512 + u64 * 64;
#pragma unroll
            for (int g4 = 0; g4 < 2; ++g4) {
                f32x4 o1, o2;
#pragma unroll
                for (int i = 0; i < 4; ++i) {
                    const int d0 = 16 * g + 8 * g4 + 4 * hh + i;
                    float rev = pos * (__builtin_amdgcn_exp2f(-(float)d0 * (13.287712379549449f / 32.f)) * 0.15915494309189535f); rev -= floorf(rev);
                    const float sn = __builtin_amdgcn_sinf(rev), cs = __builtin_amdgcn_cosf(rev);
                    const float x1 = acc[4 * g4 + i], x2 = acc[4 * g4 + 8 + i];
                    o1[i] = x1 * cs - x2 * sn; o2[i] = x2 * cs + x1 * sn;
                }
                const int d0 = 16 * g + 8 * g4 + 4 * hh;
                *(f32x4*)(dst + d0) = o1; *(f32x4*)(dst + d0 + 32) = o2;
            }
        } else {
#pragma unroll
            for (int g4 = 0; g4 < 4; ++g4) { const f32x4 v = {acc[4 * g4], acc[4 * g4 + 1], acc[4 * g4 + 2], acc[4 * g4 + 3]}; *(f32x4*)(ov + (size_t)m * 512 + n0 - 2560 + 8 * g4 + 4 * hh) = v; }
        }
    }
};

DEV void s_row(const FP& p, const float* raw, const float* hin, const float* gpost, float* hout, const float* gpre, bf16_t* xn, float* dtv, int bid, int G, int rot) {
    const int lane = threadIdx.x & 63, wave = __builtin_amdgcn_readfirstlane(threadIdx.x >> 6);
    const int blk = (bid + G - rot) % G;
    for (int r = blk + G * wave; r < NS; r += 8 * G) {
        f32x4 h[4];
#pragma unroll
        for (int j = 0; j < 4; ++j) h[j] = ((const f32x4*)(hin + (size_t)r * 1024))[lane + 64 * j];
        if (raw) {
            f32x4 v[4]; float ss = 0.f;
#pragma unroll
            for (int j = 0; j < 4; ++j) { v[j] = ((const f32x4*)(raw + (size_t)r * 1024))[lane + 64 * j]; ss += v[j].x * v[j].x + v[j].y * v[j].y + v[j].z * v[j].z + v[j].w * v[j].w; }
            const float rs = rsqrtf(wave_sum(ss) * (1.f / 1024.f) + 1e-6f);
#pragma unroll
            for (int j = 0; j < 4; ++j) { const f32x4 g = ((const f32x4*)gpost)[lane + 64 * j]; h[j] += v[j] * rs * g; }
        }
        if (hout) {
#pragma unroll
            for (int j = 0; j < 4; ++j) ((f32x4*)(hout + (size_t)r * 1024))[lane + 64 * j] = h[j];
        }
        if (gpre) {
            float ss = 0.f;
#pragma unroll
            for (int j = 0; j < 4; ++j) ss += h[j].x * h[j].x + h[j].y * h[j].y + h[j].z * h[j].z + h[j].w * h[j].w;
            const float rs = rsqrtf(wave_sum(ss) * (1.f / 1024.f) + 1e-6f);
            float d[8];
#pragma unroll
            for (int k = 0; k < 8; ++k) d[k] = 0.f;
#pragma unroll
            for (int j = 0; j < 4; ++j) {
                const f32x4 g = ((const f32x4*)gpre)[lane + 64 * j]; const f32x4 o = h[j] * rs * g;
                u32x2 w; w.x = pk2(o.x, o.y); w.y = pk2(o.z, o.w);
                ((u32x2*)(xn + (size_t)r * 1024))[lane + 64 * j] = w;
                if (dtv) {
#pragma unroll
                    for (int i = 0; i < 4; ++i) {
                        const float* wp = p.in[9] + (size_t)(4 * (lane + 64 * j) + i) * 3080 + 1536;
                        const f32x4 w0 = *(const f32x4*)wp, w1 = *(const f32x4*)(wp + 4); const float hv = o[i];
                        d[0] += hv * w0.x; d[1] += hv * w0.y; d[2] += hv * w0.z; d[3] += hv * w0.w; d[4] += hv * w1.x; d[5] += hv * w1.y; d[6] += hv * w1.z; d[7] += hv * w1.w;
                    }
                }
            }
            if (dtv) {
#pragma unroll
                for (int k = 0; k < 8; ++k) d[k] = wave_sum(d[k]);
                float mine = d[0];
#pragma unroll
                for (int k = 1; k < 8; ++k) mine = ((lane & 7) == k) ? d[k] : mine;
                const float xx = mine + p.in[12][lane & 7];
                if (lane < 8) dtv[(size_t)r * 8 + lane] = (xx > 20.f) ? xx : log1pf(expf(xx));
            }
        }
    }
}

DEV void s_ssd(const FP& p, LAS unsigned char* lds, int bid, int G, int rot) {
    const int tid = threadIdx.x;
    const float* xbc = (const float*)(p.ws + WS_SMP + SB_XBC); const float* zb = (const float*)(p.ws + WS_SMP + SB_Z); const float* dtv = (const float*)(p.ws + WS_SMP + SB_DTV);
    float* ypre = (float*)(p.ws + WS_SMP + SB_YPRE); float* s_ssm = p.out + 35002368;
    const float* cbuf = p.in[5]; const float* cw = p.in[10]; const float* cb = p.in[11];
    LAS float* act = (LAS float*)lds;
    for (int item = (bid + G - rot) % G; item < 64; item += G) {
        const int b = item >> 3, h = item & 7, g = h >> 2;
        for (int e = tid; e < 16 * 320; e += 512) {
            const int t = e / 320, cc = e % 320;
            const int col = (cc < 64) ? h * 64 + cc : (cc < 192 ? 512 + g * 128 + (cc - 64) : 768 + g * 128 + (cc - 192));
            float a = cb[col];
#pragma unroll
            for (int j = 0; j < 4; ++j) {
                const int tt = t - 3 + j;
                const float u = (tt >= 0) ? xbc[(size_t)(b * 16 + tt) * 1024 + col] : cbuf[(size_t)(b * 3 + tt + 3) * 1024 + col];
                a += cw[j * 1024 + col] * u;
            }
            act[e] = a / (1.f + expf(-a));
        }
        __syncthreads();
        const int pp = tid >> 3, seg = tid & 7;
        float hs[16];
        const size_t sbase = ((size_t)(b * 8 + h) * 64 + pp) * 128 + seg * 16;
#pragma unroll
        for (int i = 0; i < 16; ++i) hs[i] = p.in[4][sbase + i];
        const float a = -expf(p.in[13][h]), D = p.in[14][h];
        for (int t = 0; t < 16; ++t) {
            const float dt = dtv[(b * 16 + t) * 8 + h];
            const float x = act[t * 320 + pp];
            const float dA = expf(dt * a), coef = dt * x;
            float y = 0.f;
#pragma unroll
            for (int i = 0; i < 16; ++i) { hs[i] = dA * hs[i] + coef * act[t * 320 + 64 + seg * 16 + i]; y += act[t * 320 + 192 + seg * 16 + i] * hs[i]; }
            y += __shfl_xor(y, 1); y += __shfl_xor(y, 2); y += __shfl_xor(y, 4);
            if (seg == 0) { const float zz = zb[(size_t)(b * 16 + t) * 512 + h * 64 + pp]; ypre[(size_t)(b * 16 + t) * 512 + h * 64 + pp] = (y + D * x) * (zz / (1.f + expf(-zz))); }
        }
#pragma unroll
        for (int i = 0; i < 16; ++i) s_ssm[sbase + i] = hs[i];
        __syncthreads();
    }
}

DEV void s_attn_part(const FP& p, LAS unsigned char* lds, int bid, int G) {
    const int lane = threadIdx.x & 63, wave = __builtin_amdgcn_readfirstlane(threadIdx.x >> 6);
    const float* q = (const float*)(p.ws + WS_SMP + SB_Q); const float* kn = p.out + 34871296; const float* vn = p.out + 34936832; const float* kp = p.in[2]; const float* vp = p.in[3];
    float* aml = (float*)(p.ws + WS_SMP + SB_AML); float* ao = (float*)(p.ws + WS_SMP + SB_AO);
    LAS float* qs = (LAS float*)(lds + wave * 16384);
    for (int it = bid + G * wave; it < 32 * N_ATILE; it += 8 * G) {
        const int bh = it / N_ATILE, tile = it % N_ATILE, b = bh >> 2, h = bh & 3;
        WAVE_SYNC();
#pragma unroll
        for (int i = 0; i < 8; ++i) { const int idx = lane + 64 * i, qi = idx >> 5, j4 = idx & 31; ((LAS f32x4*)qs)[idx] = *(const f32x4*)(q + (size_t)(b * 16 + qi) * 512 + h * 128 + j4 * 4); }
        WAVE_SYNC();
        const int kk = tile * 64 + lane; const bool valid = kk < 2064; const int kc = valid ? kk : 2063;
        const float* krow = (kc < 2048) ? kp + (((size_t)b * 2048 + kc) * 4 + h) * 128 : kn + (((size_t)b * 16 + (kc - 2048)) * 4 + h) * 128;
        float s[16][2];
#pragma unroll
        for (int qi = 0; qi < 16; ++qi) { s[qi][0] = 0.f; s[qi][1] = 0.f; }
#pragma unroll
        for (int c = 0; c < 2; ++c)
#pragma unroll 2
            for (int d4 = 0; d4 < 16; ++d4) {
                const f32x4 kv = ((const f32x4*)krow)[c * 16 + d4];
#pragma unroll
                for (int qi = 0; qi < 16; ++qi) { const f32x4 qv = ((const LAS f32x4*)qs)[qi * 32 + c * 16 + d4]; s[qi][c] += kv.x * qv.x + kv.y * qv.y + kv.z * qv.z + kv.w * qv.w; }
            }
        WAVE_SYNC();
#pragma unroll
        for (int qi = 0; qi < 16; ++qi)
#pragma unroll
            for (int c = 0; c < 2; ++c) {
                const float sv = valid ? s[qi][c] * 0.125f : -1e30f;
                const float m = wave_max(sv), pp = valid ? expf(sv - m) : 0.f, l = wave_sum(pp);
                qs[(qi * 2 + c) * 64 + lane] = pp;
                if (lane == 0) { aml[((size_t)it * 32 + qi * 2 + c) * 2] = m; aml[((size_t)it * 32 + qi * 2 + c) * 2 + 1] = l; }
            }
        WAVE_SYNC();
        float O[32][2];
#pragma unroll
        for (int i = 0; i < 32; ++i) { O[i][0] = 0.f; O[i][1] = 0.f; }
        int nk = 2064 - tile * 64; if (nk > 64) nk = 64;
        for (int j = 0; j < nk; ++j) {
            const int kj = tile * 64 + j;
            const float* vrow = (kj < 2048) ? vp + (((size_t)b * 2048 + kj) * 4 + h) * 128 : vn + (((size_t)b * 16 + (kj - 2048)) * 4 + h) * 128;
            const float2 v = ((const float2*)vrow)[lane];
#pragma unroll
            for (int i = 0; i < 32; ++i) { const float pv = qs[i * 64 + j]; O[i][0] += pv * v.x; O[i][1] += pv * v.y; }
        }
#pragma unroll
        for (int i = 0; i < 32; ++i) { float2 o; o.x = O[i][0]; o.y = O[i][1]; ((float2*)(ao + ((size_t)it * 32 + i) * 128))[lane] = o; }
    }
}
DEV void s_attn_comb(const FP& p, int bid, int G, int rot) {
    const int lane = threadIdx.x & 63, wave = __builtin_amdgcn_readfirstlane(threadIdx.x >> 6);
    const float* aml = (const float*)(p.ws + WS_SMP + SB_AML); const float* ao = (const float*)(p.ws + WS_SMP + SB_AO); const float* ypre = (const float*)(p.ws + WS_SMP + SB_YPRE);
    bf16_t* cat = (bf16_t*)(p.ws + WS_SMP + SB_CAT);
    const float lam_init = 0.2f;
    const float lam = expf(wave_sum(p.in[16][lane] * p.in[17][lane])) - expf(wave_sum(p.in[18][lane] * p.in[19][lane])) + lam_init;
    const int blk = (bid + G - rot) % G;
    for (int it = blk + G * wave; it < 512 + 256; it += 8 * G) {
        if (it < 512) {
            const int bh = it >> 4, qi = it & 15, b = bh >> 2, h = bh & 3;
            float o[2][2];
#pragma unroll
            for (int c = 0; c < 2; ++c) {
                const float mj = (lane < N_ATILE) ? aml[((size_t)(bh * N_ATILE + lane) * 32 + qi * 2 + c) * 2] : -1e30f;
                const float lj = (lane < N_ATILE) ? aml[((size_t)(bh * N_ATILE + lane) * 32 + qi * 2 + c) * 2 + 1] : 0.f;
                const float M = wave_max(mj), wj = expf(mj - M), L = wave_sum(lj * wj);
                float ax = 0.f, ay = 0.f;
                for (int j = 0; j < N_ATILE; ++j) {
                    const float w = __shfl(wj, j);
                    const float2 v = ((const float2*)(ao + ((size_t)(bh * N_ATILE + j) * 32 + qi * 2 + c) * 128))[lane];
                    ax += w * v.x; ay += w * v.y;
                }
                o[c][0] = ax / L; o[c][1] = ay / L;
            }
            const float ox = o[0][0] - lam * o[1][0], oy = o[0][1] - lam * o[1][1];
            const float ms = wave_sum(ox * ox + oy * oy) * (1.f / 128.f);
            const float rs = rsqrtf(ms + 1e-5f) * (1.f - lam_init);
            const float2 w = ((const float2*)p.in[20])[lane];
            ((unsigned*)(cat + (size_t)(b * 16 + qi) * 1024 + 512 + h * 128))[lane] = pk2(ox * rs * w.x, oy * rs * w.y);
        } else {
            const int i2 = it - 512, row = i2 >> 1, g = i2 & 1;
            const f32x4 v = ((const f32x4*)(ypre + (size_t)row * 512 + g * 256))[lane];
            const float rs = rsqrtf(wave_sum(v.x * v.x + v.y * v.y + v.z * v.z + v.w * v.w) * (1.f / 256.f) + 1e-5f);
            const f32x4 ww = ((const f32x4*)(p.in[15] + g * 256))[lane];
            u32x2 o; o.x = pk2(v.x * rs * ww.x, v.y * rs * ww.y); o.y = pk2(v.z * rs * ww.z, v.w * rs * ww.w);
            ((u32x2*)(cat + (size_t)row * 1024 + g * 256))[lane] = o;
        }
    }
}
DEV void s_xattn_part(const FP& p, LAS unsigned char* lds, int bid, int G, int rot) {
    const int lane = threadIdx.x & 63, wave = __builtin_amdgcn_readfirstlane(threadIdx.x >> 6);
    const float* qx = (const float*)(p.ws + WS_SMP + SB_QX); const float* mk = p.in[6]; const float* mv = p.in[7];
    float* xml = (float*)(p.ws + WS_SMP + SB_XML); float* xo = (float*)(p.ws + WS_SMP + SB_XO);
    LAS float* qs = (LAS float*)(lds + wave * 16384);
    const int blk = (bid + G - rot) % G;
    for (int it = blk + G * wave; it < 128; it += 8 * G) {
        const int bh = it >> 2, tile = it & 3, b = bh >> 2, h = bh & 3;
        WAVE_SYNC();
#pragma unroll
        for (int i = 0; i < 16; ++i) { const int idx = lane + 64 * i, qi = idx >> 6, j4 = idx & 63; ((LAS f32x4*)qs)[idx] = *(const f32x4*)(qx + (size_t)(b * 16 + qi) * 1024 + h * 256 + j4 * 4); }
        WAVE_SYNC();
        const float* krow = mk + (((size_t)b * 256 + tile * 64 + lane) * 4 + h) * 256;
        float s[16];
#pragma unroll
        for (int qi = 0; qi < 16; ++qi) s[qi] = 0.f;
#pragma unroll 2
        for (int d4 = 0; d4 < 64; ++d4) {
            const f32x4 kv = ((const f32x4*)krow)[d4];
#pragma unroll
            for (int qi = 0; qi < 16; ++qi) { const f32x4 qv = ((const LAS f32x4*)qs)[qi * 64 + d4]; s[qi] += kv.x * qv.x + kv.y * qv.y + kv.z * qv.z + kv.w * qv.w; }
        }
        WAVE_SYNC();
#pragma unroll
        for (int qi = 0; qi < 16; ++qi) {
            const float sv = s[qi] * 0.0625f, m = wave_max(sv), pp = expf(sv - m), l = wave_sum(pp);
            qs[qi * 64 + lane] = pp;
            if (lane == 0) { xml[((size_t)it * 16 + qi) * 2] = m; xml[((size_t)it * 16 + qi) * 2 + 1] = l; }
        }
        WAVE_SYNC();
        f32x4 O[16];
#pragma unroll
        for (int i = 0; i < 16; ++i) O[i] = (f32x4){0.f, 0.f, 0.f, 0.f};
        for (int j = 0; j < 64; ++j) {
            const f32x4 v = ((const f32x4*)(mv + (((size_t)b * 256 + tile * 64 + j) * 4 + h) * 256))[lane];
#pragma unroll
            for (int i = 0; i < 16; ++i) O[i] += v * qs[i * 64 + j];
        }
#pragma unroll
        for (int i = 0; i < 16; ++i) ((f32x4*)(xo + ((size_t)it * 16 + i) * 256))[lane] = O[i];
    }
}
DEV void s_xattn_comb(const FP& p, int bid, int G, int rot) {
    const int lane = threadIdx.x & 63, wave = __builtin_amdgcn_readfirstlane(threadIdx.x >> 6);
    const float* xml = (const float*)(p.ws + WS_SMP + SB_XML); const float* xo = (const float*)(p.ws + WS_SMP + SB_XO);
    bf16_t* ox = (bf16_t*)(p.ws + WS_SMP + SB_OX);
    const int blk = (bid + G - rot) % G;
    for (int it = blk + G * wave; it < 512; it += 8 * G) {
        const int bh = it >> 4, qi = it & 15, b = bh >> 2, h = bh & 3;
        float m[4], l[4];
#pragma unroll
        for (int j = 0; j < 4; ++j) { m[j] = xml[((size_t)(bh * 4 + j) * 16 + qi) * 2]; l[j] = xml[((size_t)(bh * 4 + j) * 16 + qi) * 2 + 1]; }
        const float M = fmaxf(fmaxf(m[0], m[1]), fmaxf(m[2], m[3]));
        float L = 0.f; f32x4 acc = {0.f, 0.f, 0.f, 0.f};
#pragma unroll
        for (int j = 0; j < 4; ++j) { const float w = expf(m[j] - M); L += l[j] * w; acc += ((const f32x4*)(xo + ((size_t)(bh * 4 + j) * 16 + qi) * 256))[lane] * w; }
        const float il = 1.f / L;
        u32x2 o; o.x = pk2(acc.x * il, acc.y * il); o.y = pk2(acc.z * il, acc.w * il);
        ((u32x2*)(ox + (size_t)(b * 16 + qi) * 1024 + h * 256))[lane] = o;
    }
}

namespace cg = cooperative_groups;
__global__ void __launch_bounds__(512, 2) k_mega(FP p) {
    extern __shared__ __attribute__((aligned(16))) unsigned char lds_raw[];
    LAS unsigned char* lds = (LAS unsigned char*)lds_raw;
    cg::grid_group grid = cg::this_grid();
    const int tid = threadIdx.x, lane = tid & 63, wave = __builtin_amdgcn_readfirstlane(tid >> 6);
    const int G = gridDim.x, bid = blockIdx.x, gw = bid * 8 + wave, ngw = G * 8;
    float* y = p.out; float* ys = p.out + 16777216; const float* xs = p.in[1];
    unsigned char* sb = p.ws + WS_SMP;
    volatile LAS unsigned* MISC = (volatile LAS unsigned*)(lds + LDS_BYTES - 64);
    if (tid < 16) MISC[tid] = 0u;
    __syncthreads();
    XcdBarrier bar = xcd_barrier_post((unsigned*)(p.ws + WS_CTL), MISC);
    phase_prep_x(p, lds, gw, ngw, wave, lane); phase_prep_ffn(p, lds, gw, ngw, wave, lane); phase_prep_mix(p, lds, gw, ngw, wave, lane);
    s_row(p, nullptr, xs, nullptr, nullptr, p.in[27], (bf16_t*)(sb + SB_XN), (float*)(sb + SB_DTV), bid, G, 0);
    grid.sync();
    phase_inproj(p, lds, G, bid);
    s_gemm((const bf16_t*)(sb + SB_XN), (const bf16_t*)(p.ws + WS_W_IN), 3072, 1024, lds, bid, G, 0,
           EpiSIn{(float*)(sb + SB_Z), (float*)(sb + SB_XBC), (float*)(sb + SB_Q), p.out + 34871296, p.out + 34936832, p.out + 35526656});
    xcd_barrier(bar);
    phase_ssd1(p, lds, G, bid);
    phase_memkv(p, lds, G, bid);
    s_ssd(p, lds, bid, G, 64);
    s_attn_part(p, lds, bid, G);
    xcd_barrier(bar);
    phase_ssd2(p, G, bid);
    phase_attn(p, lds, G, bid);
    s_attn_comb(p, bid, G, 0);
    xcd_barrier(bar);
    phase_ssd3(p, lds, G, bid);
    s_gemm((const bf16_t*)(sb + SB_CAT), (const bf16_t*)(p.ws + WS_W_OUT), 1024, 1024, lds, bid, G, 0, EpiSF32{(float*)(sb + SB_MIX), 1024, 1.f});
    xcd_barrier(bar);
    phase_outproj(p, lds, G, bid);
    s_row(p, (const float*)(sb + SB_MIX), xs, p.in[28], ys, p.in[29], (bf16_t*)(sb + SB_XN), nullptr, bid, G, 0);
    xcd_barrier(bar);
    row_phase((const bf16_t*)(p.ws + WS_RAW), p.in[0], p.in[28], y, p.in[29], (bf16_t*)(p.ws + WS_XN), MP, gw, ngw, lane);
    s_gemm((const bf16_t*)(sb + SB_XN), (const bf16_t*)(p.ws + WS_W_Q), 1024, 1024, lds, bid, G, 0, EpiSF32{(float*)(sb + SB_QX), 1024, 1.f});
    xcd_barrier(bar);
    phase_wq(p, lds, G, bid);
    s_xattn_part(p, lds, bid, G, 0);
    xcd_barrier(bar);
    phase_xattn(p, lds, G, bid);
    s_xattn_comb(p, bid, G, 0);
    xcd_barrier(bar);
    phase_wo(p, lds, G, bid);
    s_gemm((const bf16_t*)(sb + SB_OX), (const bf16_t*)(p.ws + WS_W_O), 1024, 1024, lds, bid, G, 0, EpiSF32{(float*)(sb + SB_MIX), 1024, 1.f});
    xcd_barrier(bar);
    row_phase((const bf16_t*)(p.ws + WS_RAW), y, p.in[30], y, p.in[31], (bf16_t*)(p.ws + WS_XN), MP, gw, ngw, lane);
    s_row(p, (const float*)(sb + SB_MIX), ys, p.in[30], ys, p.in[31], (bf16_t*)(sb + SB_XN), nullptr, bid, G, 0);
    xcd_barrier(bar);
    phase_ffn_gu(p, lds, G, bid);
    s_gemm((const bf16_t*)(sb + SB_XN), (const bf16_t*)(p.ws + WS_W_GU), 5632, 1024, lds, bid, G, 0, EpiSSwiglu{(bf16_t*)(sb + SB_HID)});
    xcd_barrier(bar);
    phase_ffn_down(p, lds, G, bid);
    s_gemm((const bf16_t*)(sb + SB_HID), (const bf16_t*)(p.ws + WS_W_DOWN), 1024, 2816, lds, bid, G, 0, EpiSF32{(float*)(sb + SB_MIX), 1024, 1.f});
    xcd_barrier(bar);
    row_phase((const bf16_t*)(p.ws + WS_RAW), y, p.in[32], y, nullptr, nullptr, MP, gw, ngw, lane);
    s_row(p, (const float*)(sb + SB_MIX), ys, p.in[32], ys, nullptr, nullptr, nullptr, bid, G, 0);
}

extern "C" void kernel_launch(void* const* d_in, const int* in_sizes, int n_in, void* d_out, int out_size, void* d_ws, size_t ws_size, hipStream_t stream) {
    static int grid = 0;
    if (!grid) {
        int dev = 0, cus = 0, per_cu = 0;
        (void)hipGetDevice(&dev);
        (void)hipDeviceGetAttribute(&cus, hipDeviceAttributeMultiprocessorCount, dev);
        (void)hipFuncSetAttribute((const void*)k_mega, hipFuncAttributeMaxDynamicSharedMemorySize, LDS_BYTES);
        (void)hipOccupancyMaxActiveBlocksPerMultiprocessor(&per_cu, (const void*)k_mega, 512, LDS_BYTES);
        if (per_cu < 1) per_cu = 1;
        grid = cus * per_cu;
        if (grid > 256) grid = 256;
        if (n_in != 36 || ws_size < 256 * MiB) fprintf(stderr, "kernel_launch: unexpected n_in %d / ws_size %zu\n", n_in, ws_size);
    }
    (void)hipMemsetAsync((unsigned char*)d_ws + WS_CTL, 0, 16384, stream);
    FP p{};
    for (int i = 0; i < 36; ++i) p.in[i] = (const float*)d_in[i];
    p.out = (float*)d_out; p.ws = (unsigned char*)d_ws;
    void* args[] = {&p};
    hipError_t e = hipLaunchCooperativeKernel((const void*)k_mega, dim3(grid), dim3(512), args, LDS_BYTES, stream);
    if (e != hipSuccess) fprintf(stderr, "cooperative launch failed: %s (grid %d)\n", hipGetErrorString(e), grid);
}
```

```cpp
#include <hip/hip_runtime.h>
#include <cstdint>
#include <cstdio>
#include <hip/hip_cooperative_groups.h>

#define DEV static __device__ __forceinline__
#define LAS __attribute__((address_space(3)))
#define WAVE_SYNC() asm volatile("s_waitcnt lgkmcnt(0)" ::: "memory")

DEV float wave_sum(float v) {
#pragma unroll
    for (int o = 32; o > 0; o >>= 1) v += __shfl_xor(v, o);
    return v;
}
DEV float wave_max(float v) {
#pragma unroll
    for (int o = 32; o > 0; o >>= 1) v = fmaxf(v, __shfl_xor(v, o));
    return v;
}
typedef float nf4 __attribute__((ext_vector_type(4)));
DEV float4 lds_ld4(const LAS float* p) { const nf4 v = *(const LAS nf4*)p; float4 r; r.x = v[0]; r.y = v[1]; r.z = v[2]; r.w = v[3]; return r; }
DEV float silu_f(float x) { return x / (1.f + expf(-x)); }


typedef unsigned short bf16_t;
typedef float f32x4 __attribute__((ext_vector_type(4)));
typedef float f32x16 __attribute__((ext_vector_type(16)));
typedef short bf16x8 __attribute__((ext_vector_type(8)));
typedef short s16x4 __attribute__((ext_vector_type(4)));
typedef unsigned u32x4 __attribute__((ext_vector_type(4)));
typedef unsigned u32x2 __attribute__((ext_vector_type(2)));

constexpr size_t MiB = 1u << 20;
constexpr size_t WS_W_IN = 0, WS_W_OUT = 6 * MiB, WS_W_Q = 8 * MiB, WS_W_KV = 10 * MiB, WS_W_O = 14 * MiB, WS_W_GU = 16 * MiB, WS_W_DOWN = 27 * MiB;
constexpr size_t WS_CTL = 33 * MiB, WS_DTV = 34 * MiB, WS_CDEC = 34 * MiB + 512 * 1024, WS_MN = 35 * MiB;
constexpr size_t WS_XN = 36 * MiB, WS_CAT = 68 * MiB, WS_QX = 68 * MiB, WS_Q = 100 * MiB, WS_K = 116 * MiB, WS_RAW = 100 * MiB;
constexpr size_t WS_ZX = 132 * MiB, WS_OX = 132 * MiB, WS_V = 180 * MiB, WS_ST = 196 * MiB, WS_HID = 132 * MiB, WS_KM = 228 * MiB, WS_VM = 229 * MiB, WS_SMP = 230 * MiB;
constexpr int MP = 16384;
constexpr int LDS_BYTES = 147456;

DEV unsigned f2bf(float f) { unsigned u = __builtin_bit_cast(unsigned, f); return (u + 0x7fffu + ((u >> 16) & 1u)) >> 16; }
DEV unsigned pk2(float lo, float hi) { return f2bf(lo) | (f2bf(hi) << 16); }
DEV float bflo(unsigned w) { return __builtin_bit_cast(float, w << 16); }
DEV float bfhi(unsigned w) { return __builtin_bit_cast(float, w & 0xffff0000u); }
DEV float fast_silu(float x) { return x * __builtin_amdgcn_rcpf(1.f + __builtin_amdgcn_exp2f(-1.4426950408889634f * x)); }

struct FP {
    const float* in[36];
    float* out;
    unsigned char* ws;
};

template <class RowMap>
DEV void transpose_item(const float* W, int K, int N, bf16_t* WT, int item, LAS float* scr, int lane, RowMap rm) {
    const int nblk = (N + 31) / 32, kb = item / nblk, nb = item % nblk, k0 = 64 * kb, n0 = 32 * nb;
    const int ncol = n0 + (lane & 31);
#pragma unroll 8
    for (int i = 0; i < 32; ++i) { const int kk = 2 * i + (lane >> 5); scr[kk * 33 + (lane & 31)] = (ncol < N) ? W[(size_t)(k0 + kk) * N + ncol] : 0.f; }
    WAVE_SYNC();
    const int c = lane & 7;
#pragma unroll
    for (int j = 0; j < 4; ++j) {
        const int n = (lane >> 3) + 8 * j; const LAS float* s = scr + (8 * c) * 33 + n;
        const int src = n0 + n; const int dst = (src < N) ? rm(src) : -1;
        u32x4 o; o.x = pk2(s[0 * 33], s[1 * 33]); o.y = pk2(s[2 * 33], s[3 * 33]); o.z = pk2(s[4 * 33], s[5 * 33]); o.w = pk2(s[6 * 33], s[7 * 33]);
        if (dst >= 0) *(u32x4*)(WT + (size_t)dst * K + k0 + 8 * c) = o;
    }
    WAVE_SYNC();
}
struct RmPlain { int off; __device__ __forceinline__ int operator()(int n) const { return off + n; } };
struct RmGU { int up; __device__ __forceinline__ int operator()(int n) const { return 32 * (n >> 4) + 16 * up + (n & 15); } };
struct RmIn {
    __device__ __forceinline__ int operator()(int n) const {
        if (n < 1536) return n;
        if (n < 1544) return -1;
        const int m = n - 1544;
        if (m < 1024) { const int u = m >> 6, d = m & 63; return 1536 + 64 * u + 32 * ((d & 31) >> 4) + 16 * (d >> 5) + (d & 15); }
        return 1536 + m;
    }
};

DEV void row_phase(const bf16_t* raw, const float* hin, const float* gpost, float* hout, const float* gpre, bf16_t* xn, int M, int gw, int ngw, int lane) {
    for (int r = gw; r < M; r += ngw) {
        f32x4 h[4];
#pragma unroll
        for (int j = 0; j < 4; ++j) h[j] = ((const f32x4*)(hin + (size_t)r * 1024))[lane + 64 * j];
        if (raw) {
            f32x4 v[4]; float ss = 0.f;
#pragma unroll
            for (int j = 0; j < 4; ++j) {
                const u32x2 w = ((const u32x2*)(raw + (size_t)r * 1024))[lane + 64 * j];
                v[j] = (f32x4){bflo(w.x), bfhi(w.x), bflo(w.y), bfhi(w.y)};
                ss += v[j].x * v[j].x + v[j].y * v[j].y + v[j].z * v[j].z + v[j].w * v[j].w;
            }
            const float rs = rsqrtf(wave_sum(ss) * (1.f / 1024.f) + 1e-6f);
#pragma unroll
            for (int j = 0; j < 4; ++j) { const f32x4 g = ((const f32x4*)gpost)[lane + 64 * j]; h[j] += v[j] * rs * g; }
        }
        if (hout) {
#pragma unroll
            for (int j = 0; j < 4; ++j) ((f32x4*)(hout + (size_t)r * 1024))[lane + 64 * j] = h[j];
        }
        if (gpre) {
            float ss = 0.f;
#pragma unroll
            for (int j = 0; j < 4; ++j) ss += h[j].x * h[j].x + h[j].y * h[j].y + h[j].z * h[j].z + h[j].w * h[j].w;
            const float rs = rsqrtf(wave_sum(ss) * (1.f / 1024.f) + 1e-6f);
#pragma unroll
            for (int j = 0; j < 4; ++j) {
                const f32x4 g = ((const f32x4*)gpre)[lane + 64 * j]; const f32x4 o = h[j] * rs * g;
                u32x2 w; w.x = pk2(o.x, o.y); w.y = pk2(o.z, o.w);
                ((u32x2*)(xn + (size_t)r * 1024))[lane + 64 * j] = w;
            }
        }
    }
}


#define RLX_AGENT __ATOMIC_RELAXED, __HIP_MEMORY_SCOPE_AGENT
#define LDS_WAIT() asm volatile("s_waitcnt lgkmcnt(0)" ::: "memory")
#define VM_WAIT() asm volatile("s_waitcnt vmcnt(0)" ::: "memory")
__device__ __forceinline__ unsigned long long rt() { return __builtin_amdgcn_s_memrealtime(); }
#define XB_TMO      128
#define XB_XCNT(j)  (256  + 64 * (j))
#define XB_XSUB(j)  (1280 + 64 * (j))
#define XB_XGEN(j)  (2304 + 64 * (j))
#define XB_TOP      3328
#define XB_TOPGEN   3392
#define XCD_BAR_WORDS 3456
#define XB_SPIN_CAP (1u << 18)

__device__ __forceinline__ unsigned xb_ld(unsigned* p)              { return __hip_atomic_load(p, __ATOMIC_RELAXED, __HIP_MEMORY_SCOPE_AGENT); }
__device__ __forceinline__ unsigned xb_add(unsigned* p, unsigned v) { return __hip_atomic_fetch_add(p, v, __ATOMIC_RELAXED, __HIP_MEMORY_SCOPE_AGENT); }
__device__ __forceinline__ unsigned xb_xcc_id() { return (unsigned)__builtin_amdgcn_s_getreg((3 << 11) | 20) & 0xFu; }
#define XB_SPIN(cond, bar) do { unsigned _sp = 0; while (cond) { __builtin_amdgcn_s_sleep(1); \
    if ((++_sp & 255u) == 0u) { if (xb_ld(&(bar)[XB_TMO])) break; if (_sp > XB_SPIN_CAP) { atomicAdd(&(bar)[XB_TMO], 1u); break; } } } } while (0)

struct XcdBarrier {
    unsigned* bar; unsigned x; unsigned total;
    volatile LAS unsigned* st;
};

__device__ __forceinline__ XcdBarrier xcd_barrier_post(unsigned* bar, volatile LAS unsigned* st, unsigned total = 0u) {
    XcdBarrier b; b.bar = bar; b.x = xb_xcc_id(); b.st = st; b.total = total;
    if (threadIdx.x == 0) (void)xb_add(&bar[XB_XCNT(b.x)], 1u);
    return b;
}
__device__ __forceinline__ void xcd_barrier_complete(unsigned* bar, unsigned x, unsigned& nloc, unsigned& nx, unsigned total) {
    const unsigned G = total ? total : gridDim.x * gridDim.y * gridDim.z;
    unsigned sum, cnt, mine, sp = 0u;
    for (;;) {
        sum = 0u; cnt = 0u; mine = 0u;
#pragma unroll
        for (unsigned j = 0; j < 16; ++j) { const unsigned c = xb_ld(&bar[XB_XCNT(j)]); sum += c; cnt += (c > 0u) ? 1u : 0u; mine = (j == x) ? c : mine; }
        if (sum == G) break;
        __builtin_amdgcn_s_sleep(1);
        if ((++sp & 255u) == 0u) { if (xb_ld(&bar[XB_TMO])) break; if (sp > XB_SPIN_CAP) { atomicAdd(&bar[XB_TMO], 1u); break; } }
    }
    nloc = mine > 0u ? mine : 1u; nx = cnt > 0u ? cnt : 1u;
}

__device__ __forceinline__ void xcd_barrier(const XcdBarrier& b) {
    asm volatile("s_waitcnt vmcnt(0)" ::: "memory");
    __syncthreads();
    if (threadIdx.x == 0) {
        unsigned* bar = b.bar;
        __builtin_amdgcn_s_waitcnt(0);
        unsigned nloc = b.st[0], nx = b.st[1];
        if (nloc == 0u) { xcd_barrier_complete(bar, b.x, nloc, nx, b.total); b.st[0] = nloc; b.st[1] = nx; }
        const unsigned old = xb_add(&bar[XB_XSUB(b.x)], 1u);
        const unsigned gen = old / nloc;
        if (old + 1u == (gen + 1u) * nloc) {
            __builtin_amdgcn_fence(__ATOMIC_RELEASE, "agent");
            asm volatile("s_waitcnt vmcnt(0)" ::: "memory");
            const unsigned og = xb_add(&bar[XB_TOP], 1u);
            const unsigned tg = og / nx;
            if (og + 1u == (tg + 1u) * nx) xb_add(&bar[XB_TOPGEN], 1u);
            else XB_SPIN(xb_ld(&bar[XB_TOPGEN]) == tg, bar);
            __builtin_amdgcn_fence(__ATOMIC_ACQUIRE, "agent");
            xb_add(&bar[XB_XGEN(b.x)], 1u);
            asm volatile("s_waitcnt vmcnt(0)" ::: "memory");
        } else {
            XB_SPIN(xb_ld(&bar[XB_XGEN(b.x)]) == gen, bar);
            __builtin_amdgcn_fence(__ATOMIC_ACQUIRE, "agent");
            asm volatile("s_waitcnt vmcnt(0)" ::: "memory");
        }
    }
    __syncthreads();
}
namespace pg8 {
#define PG8_LAS __attribute__((address_space(3)))
typedef unsigned short bf16_t;
typedef short bf16x8 __attribute__((ext_vector_type(8)));
typedef float f32x4 __attribute__((ext_vector_type(4)));
typedef unsigned u32x4 __attribute__((ext_vector_type(4)));
constexpr int BM = 256, BK = 64, HALF = 128, HTB = HALF * BK * 2  , STAGE_BYTES = 8 * HTB, NXCD = 8, WGM = 8;

__host__ __device__ __forceinline__ int lds_byte(int r, int c) { const int st = (r >> 4) * 2 + (c >> 5), rr = r & 15, cc = c & 31, ob = rr * 64 + cc * 2; return st * 1024 + (ob ^ (((ob >> 9) & 1) << 5)); }
__host__ __device__ __forceinline__ void stage_rc(int b, int& R, int& C) { const int st = b / 1024, sb = b % 1024, swz = sb ^ (((sb >> 9) & 1) << 5); R = (st >> 1) * 16 + swz / 64; C = (st & 1) * 32 + (swz % 64) / 2; }
__host__ __device__ __forceinline__ int perm32(int rho) { const int n = rho >> 4, i = rho & 15; return 8 * (i >> 2) + 4 * n + (i & 3); }

struct Unit { int pm, pn; };
struct Gemm { const bf16_t* A; const bf16_t* Bt; int M, N, K; };

struct StaticOrder {
    int nM, nN, nwg, G, c;
    __host__ __device__ void init(int M, int N, int G_, int c_) { nM = M / BM; nN = N / BM; nwg = nM * nN; G = G_; c = c_; }
    __host__ __device__ bool next(int i, Unit& u) const {
        const long L = (long)i * G + c; if (L >= nwg) return false;
        int wgid = (int)L; { const int q = nwg / NXCD, r = nwg % NXCD, xcd = wgid % NXCD, off = wgid / NXCD; wgid = (xcd < r ? xcd * (q + 1) : r * (q + 1) + (xcd - r) * q) + off; }
        const int nig = WGM * nN, gid = wgid / nig, fm = gid * WGM, gsz = (nM - fm) < WGM ? (nM - fm) : WGM;
        u.pm = fm + ((wgid % nig) % gsz); u.pn = (wgid % nig) / gsz; return true;
    }
    __device__ __forceinline__ void a_ready(const Unit&) const {}
    __device__ __forceinline__ void done(const Unit&) const {}
};

__device__ __forceinline__ unsigned cvt_pk_bf16(float lo, float hi) { unsigned r; asm volatile("v_cvt_pk_bf16_f32 %0, %1, %2" : "=v"(r) : "v"(lo), "v"(hi)); return r; }
typedef float f32x2 __attribute__((ext_vector_type(2)));
__device__ __forceinline__ f32x2 gelu_pk(f32x2 v) {
    const f32x2 av = __builtin_elementwise_abs(v), d = av * 0.2316418882f + 1.0f;
    f32x2 t; t.x = __builtin_amdgcn_rcpf(d.x); t.y = __builtin_amdgcn_rcpf(d.y);
    f32x2 q = t * 0.5307027145f + (-0.7265760135f); q = q * t + 0.7107068705f; q = q * t + (-0.142248368f); q = q * t + 0.127414796f; q = q * t;
    const f32x2 s = (v * v) * (-0.72134752044f);
    f32x2 e; e.x = __builtin_amdgcn_exp2f(s.x); e.y = __builtin_amdgcn_exp2f(s.y);
    const f32x2 m = v * (q * e), r = v - m;
    f32x2 o; o.x = v.x < 0.f ? m.x : r.x; o.y = v.y < 0.f ? m.y : r.y; return o;
}

template <int ACT  > struct EpiBf16 {
    static constexpr bool PERM = true, AFTER_DRAIN = false; static_assert(ACT == 0 || ACT == 1, "EpiBf16: ACT is 0 (none) or 1 (gelu_pk)");
    bf16_t* O; int ldc; const float* bias; int split_cols; size_t split_stride; float scale0;
    __device__ __forceinline__ void operator()(const f32x4 (&acc)[2][2][4][2], const Unit& u, int wr, int wc, int fr, int fq) const {
        const int row0 = u.pm * BM + wr * 64 + fr; int colt = u.pn * BM; bf16_t* base = O;
        float sc = 1.f; if (split_cols) { const int t = colt / split_cols; base += (size_t)t * split_stride; colt -= t * split_cols; if (t == 0) sc = scale0; }
        const int col0 = colt + wc * 32 + 8 * fq, bcol0 = u.pn * BM + wc * 32 + 8 * fq;
        f32x4 bv[2][2];
#pragma unroll
        for (int bj = 0; bj < 2; ++bj)
#pragma unroll
            for (int n = 0; n < 2; ++n) bv[bj][n] = bias ? *(const f32x4*)(bias + bcol0 + bj * HALF + 4 * n) : (f32x4){0.f, 0.f, 0.f, 0.f};
#pragma unroll
        for (int ai = 0; ai < 2; ++ai)
#pragma unroll
            for (int m = 0; m < 4; ++m) { bf16_t* rowp = base + (size_t)(row0 + ai * HALF + m * 16) * ldc + col0;
#pragma unroll
                for (int bj = 0; bj < 2; ++bj) { f32x4 v0 = acc[ai][bj][m][0] + bv[bj][0], v1 = acc[ai][bj][m][1] + bv[bj][1];
                    if (ACT == 1) { f32x2 a = gelu_pk((f32x2){v0[0], v0[1]}), b = gelu_pk((f32x2){v0[2], v0[3]}), c = gelu_pk((f32x2){v1[0], v1[1]}), d = gelu_pk((f32x2){v1[2], v1[3]});
                        v0 = (f32x4){a.x, a.y, b.x, b.y}; v1 = (f32x4){c.x, c.y, d.x, d.y}; }
                    v0 = v0 * sc; v1 = v1 * sc; u32x4 w; w.x = cvt_pk_bf16(v0[0], v0[1]); w.y = cvt_pk_bf16(v0[2], v0[3]); w.z = cvt_pk_bf16(v1[0], v1[1]); w.w = cvt_pk_bf16(v1[2], v1[3]);
                    *(u32x4*)(rowp + bj * HALF) = w; } }
    }
};
template <class Epi, class Sched, bool ALIGN_EPI = false, bool SP2 = false>
__device__ __forceinline__ void gemm_phase(PG8_LAS unsigned char* lds, const Gemm g, const Sched& S, const Epi& E) {
    int tid_l = threadIdx.x; asm volatile("" : "+v"(tid_l));
    const int tid = tid_l, wid = __builtin_amdgcn_readfirstlane(tid >> 6), lane = tid & 63, wr = wid >> 2, wc = wid & 3, fr = lane & 15, fq = lane >> 4;
    const int K = g.K, nt = K / BK;
    unsigned voffA[2], voffB[2];
#pragma unroll
    for (int i = 0; i < 2; ++i) { int R, C; stage_rc(tid * 16 + i * 8192, R, C); const int Rb = Epi::PERM ? ((R & ~31) + perm32(R & 31)) : R;
        voffA[i] = (unsigned)(R * K + C) * 2u; voffB[i] = (unsigned)(Rb * K + C) * 2u; }
    const size_t kstep = (size_t)(BK * 2);
    const size_t hstep = (size_t)HALF * K * 2;
    const size_t tstep = 2 * hstep;
    const unsigned ldsw = (unsigned)wid * 1024u;
    const int aoff = lds_byte(wr * 64 + fr, fq * 8), boff = lds_byte(wc * 32 + fr, fq * 8);
#define PG8_SA(b, h) (((b) * 2 + (h)) * HTB)
#define PG8_SB(b, h) ((4 + (b) * 2 + (h)) * HTB)
#define PG8_STAGE(bufoff, gbase, voff) do { _Pragma("unroll") for (int _i = 0; _i < 2; ++_i) \
        __builtin_amdgcn_global_load_lds((const unsigned*)((const char*)(gbase) + (voff)[_i]), (PG8_LAS unsigned*)(lds + (bufoff) + ldsw + _i * 8192), 16, 0, 0); } while (0)
#define PG8_LDA(dst, b, h) do { _Pragma("unroll") for (int m = 0; m < 4; ++m) _Pragma("unroll") for (int k = 0; k < 2; ++k) dst[m][k] = *(const PG8_LAS bf16x8*)(lds + PG8_SA(b, h) + aoff + m * 2048 + k * 1024); } while (0)
#define PG8_LDB(dst, b, h) do { _Pragma("unroll") for (int n = 0; n < 2; ++n) _Pragma("unroll") for (int k = 0; k < 2; ++k) dst[n][k] = *(const PG8_LAS bf16x8*)(lds + PG8_SB(b, h) + boff + n * 2048 + k * 1024); } while (0)
#define PG8_MMA(ai, bj, At, Bt) do { __builtin_amdgcn_s_setprio(1); _Pragma("unroll") for (int m = 0; m < 4; ++m) _Pragma("unroll") for (int n = 0; n < 2; ++n) _Pragma("unroll") for (int k = 0; k < 2; ++k) \
        acc[ai][bj][m][n] = __builtin_amdgcn_mfma_f32_16x16x32_bf16(Bt[n][k], At[m][k], acc[ai][bj][m][n], 0, 0, 0); __builtin_amdgcn_s_setprio(0); } while (0)
#define PG8_WAIT_V(n) asm volatile("s_waitcnt vmcnt(" #n ")" ::: "memory")
#define PG8_WAIT_L(n) asm volatile("s_waitcnt lgkmcnt(" #n ")" ::: "memory")
#define PG8_BAR __builtin_amdgcn_s_barrier()
#define PG8_SCHED __builtin_amdgcn_sched_barrier(0)
    Unit cur, nxt; int ui = 0;
    if (!S.next(0, cur)) return;
    f32x4 acc[2][2][4][2];
#pragma unroll
    for (int a = 0; a < 2; ++a)
#pragma unroll
        for (int b = 0; b < 2; ++b)
#pragma unroll
            for (int m = 0; m < 4; ++m)
#pragma unroll
                for (int n = 0; n < 2; ++n) acc[a][b][m][n] = (f32x4){0.f, 0.f, 0.f, 0.f};
    bf16x8 At[4][2], B0[2][2], B1[2][2];
    const char* cA = (const char*)g.A + (size_t)cur.pm * tstep; const char* cB = (const char*)g.Bt + (size_t)cur.pn * tstep;
    S.a_ready(cur);
    if constexpr (SP2) {
        PG8_STAGE(PG8_SB(0, 0), cB, voffB); PG8_STAGE(PG8_SB(0, 1), cB + hstep, voffB); PG8_STAGE(PG8_SA(0, 0), cA, voffA); PG8_STAGE(PG8_SA(0, 1), cA + hstep, voffA);
        if (wr == 1) PG8_BAR;
        PG8_WAIT_V(2); PG8_BAR;
        PG8_STAGE(PG8_SB(1, 0), cB + kstep, voffB); PG8_STAGE(PG8_SA(1, 0), cA + kstep, voffA); PG8_STAGE(PG8_SB(1, 1), cB + hstep + kstep, voffB);
        PG8_WAIT_V(6); PG8_BAR;
    } else {
        PG8_STAGE(PG8_SB(0, 0), cB, voffB); PG8_STAGE(PG8_SA(0, 0), cA, voffA); PG8_STAGE(PG8_SB(0, 1), cB + hstep, voffB); PG8_STAGE(PG8_SA(0, 1), cA + hstep, voffA);
        if (wr == 1) PG8_BAR;
        PG8_WAIT_V(4); PG8_BAR;
        PG8_STAGE(PG8_SB(1, 0), cB + kstep, voffB); PG8_STAGE(PG8_SA(1, 0), cA + kstep, voffA); PG8_STAGE(PG8_SB(1, 1), cB + hstep + kstep, voffB);
        PG8_WAIT_V(6); PG8_BAR;
    }
    for (;;) {
        const bool has_next = S.next(ui + 1, nxt);
        const char* nA = has_next ? (const char*)g.A + (size_t)nxt.pm * tstep : cA; const char* nB = has_next ? (const char*)g.Bt + (size_t)nxt.pn * tstep : cB;
        for (int t = 0; t < nt; t += 2) {
            const bool last = (t == nt - 2);
            const char* a1 = cA + (size_t)(t + 1) * kstep;
            const char* a2 = last ? nA : cA + (size_t)(t + 2) * kstep; const char* b2 = last ? nB : cB + (size_t)(t + 2) * kstep;
            const char* a3 = a2 + kstep; const char* b3 = b2 + kstep;
            if (last && has_next) S.a_ready(nxt);
            if constexpr (SP2) {
            PG8_LDB(B0, 0, 0); PG8_LDB(B1, 0, 1); PG8_SCHED; PG8_LDA(At, 0, 0); PG8_STAGE(PG8_SA(1, 1), a1 + hstep, voffA);
            PG8_WAIT_V(8); PG8_WAIT_L(0); PG8_BAR; PG8_MMA(0, 0, At, B0); PG8_MMA(0, 1, At, B1); PG8_BAR; PG8_SCHED;
            PG8_LDA(At, 0, 1); PG8_STAGE(PG8_SB(0, 0), b2, voffB); PG8_STAGE(PG8_SB(0, 1), b2 + hstep, voffB); PG8_STAGE(PG8_SA(0, 0), a2, voffA);
            PG8_WAIT_V(8); PG8_WAIT_L(0); PG8_BAR; PG8_MMA(1, 0, At, B0); PG8_MMA(1, 1, At, B1); PG8_BAR; PG8_SCHED;
            PG8_LDB(B0, 1, 0); PG8_LDB(B1, 1, 1); PG8_SCHED; PG8_LDA(At, 1, 0); PG8_STAGE(PG8_SA(0, 1), a2 + hstep, voffA);
            PG8_WAIT_V(8); PG8_WAIT_L(0); PG8_BAR; PG8_MMA(0, 0, At, B0); PG8_MMA(0, 1, At, B1); PG8_BAR; PG8_SCHED;
            PG8_LDA(At, 1, 1); PG8_STAGE(PG8_SB(1, 0), b3, voffB); PG8_STAGE(PG8_SB(1, 1), b3 + hstep, voffB); PG8_STAGE(PG8_SA(1, 0), a3, voffA);
            PG8_WAIT_V(8); PG8_WAIT_L(0); PG8_BAR; PG8_MMA(1, 0, At, B0); PG8_MMA(1, 1, At, B1); PG8_BAR; PG8_SCHED;
            } else {
            PG8_LDB(B0, 0, 0); PG8_SCHED; PG8_LDA(At, 0, 0); PG8_STAGE(PG8_SA(1, 1), a1 + hstep, voffA);
            PG8_WAIT_L(8); PG8_BAR; PG8_WAIT_L(0); PG8_MMA(0, 0, At, B0); PG8_BAR; PG8_SCHED;
            PG8_LDB(B1, 0, 1); PG8_STAGE(PG8_SB(0, 0), b2, voffB);
            PG8_BAR; PG8_WAIT_L(0); PG8_MMA(0, 1, At, B1); PG8_BAR;
            PG8_LDA(At, 0, 1); PG8_STAGE(PG8_SA(0, 0), a2, voffA);
            PG8_BAR; PG8_WAIT_L(0); PG8_MMA(1, 0, At, B0); PG8_BAR; PG8_SCHED;
            PG8_STAGE(PG8_SB(0, 1), b2 + hstep, voffB);
            PG8_WAIT_V(6); PG8_BAR; PG8_MMA(1, 1, At, B1); PG8_BAR;
            PG8_LDB(B0, 1, 0); PG8_SCHED; PG8_LDA(At, 1, 0); PG8_STAGE(PG8_SA(0, 1), a2 + hstep, voffA);
            PG8_WAIT_L(8); PG8_BAR; PG8_WAIT_L(0); PG8_MMA(0, 0, At, B0); PG8_BAR; PG8_SCHED;
            PG8_LDB(B1, 1, 1); PG8_STAGE(PG8_SB(1, 0), b3, voffB);
            PG8_BAR; PG8_WAIT_L(0); PG8_MMA(0, 1, At, B1); PG8_BAR;
            PG8_LDA(At, 1, 1); PG8_STAGE(PG8_SA(1, 0), a3, voffA);
            PG8_BAR; PG8_WAIT_L(0); PG8_MMA(1, 0, At, B0); PG8_BAR; PG8_SCHED;
            PG8_STAGE(PG8_SB(1, 1), b3 + hstep, voffB);
            PG8_WAIT_V(6); PG8_BAR; PG8_MMA(1, 1, At, B1); PG8_BAR;
            }
        }
        if constexpr (ALIGN_EPI) { if (wr == 0) PG8_BAR; }
        if constexpr (!Epi::AFTER_DRAIN) { E(acc, cur, wr, wc, fr, fq); S.done(cur); }
        if (!has_next) break;
#pragma unroll
        for (int a = 0; a < 2; ++a)
#pragma unroll
            for (int b = 0; b < 2; ++b)
#pragma unroll
                for (int m = 0; m < 4; ++m)
#pragma unroll
                    for (int n = 0; n < 2; ++n) acc[a][b][m][n] = (f32x4){0.f, 0.f, 0.f, 0.f};
        cur = nxt; cA = nA; cB = nB; ++ui;
        if constexpr (ALIGN_EPI) { if (wr == 1) PG8_BAR; }
    }
    PG8_WAIT_V(0);
    if constexpr (!ALIGN_EPI) { if (wr == 0) PG8_BAR; }
    PG8_BAR;
    if constexpr (Epi::AFTER_DRAIN) { E.fused(acc, cur, wr, wc, fr, fq, lds, wid, lane); S.done(cur); }
#undef PG8_SA
#undef PG8_SB
#undef PG8_STAGE
#undef PG8_LDA
#undef PG8_LDB
#undef PG8_MMA
#undef PG8_WAIT_V
#undef PG8_WAIT_L
#undef PG8_BAR
#undef PG8_SCHED
}
}

namespace pg8 {
struct EpiSwiglu {
    static constexpr bool PERM = false, AFTER_DRAIN = false;
    bf16_t* O; int ldo;
    __device__ __forceinline__ void operator()(const f32x4 (&acc)[2][2][4][2], const Unit& u, int wr, int wc, int fr, int fq) const {
        const int row0 = u.pm * BM + wr * 64 + fr;
#pragma unroll
        for (int ai = 0; ai < 2; ++ai)
#pragma unroll
            for (int m = 0; m < 4; ++m) {
                bf16_t* rowp = O + (size_t)(row0 + ai * HALF + m * 16) * ldo;
#pragma unroll
                for (int bj = 0; bj < 2; ++bj) {
                    const int grp = u.pn * 8 + bj * 4 + wc;
                    const f32x4 g = acc[ai][bj][m][0], up = acc[ai][bj][m][1];
                    const float h0 = fast_silu(g[0]) * up[0], h1 = fast_silu(g[1]) * up[1], h2 = fast_silu(g[2]) * up[2], h3 = fast_silu(g[3]) * up[3];
                    u32x2 w; w.x = cvt_pk_bf16(h0, h1); w.y = cvt_pk_bf16(h2, h3);
                    *(u32x2*)(rowp + grp * 16 + 4 * fq) = w;
                }
            }
    }
};
}

DEV void phase_prep_ffn(const FP& p, LAS unsigned char* lds, int gw, int ngw, int wave, int lane) {
    LAS float* scr = (LAS float*)(lds + wave * 16384);
    const float *wg = p.in[33], *wu = p.in[34], *wd = p.in[35];
    bf16_t* GU = (bf16_t*)(p.ws + WS_W_GU); bf16_t* DN = (bf16_t*)(p.ws + WS_W_DOWN);
    constexpr int I_G = 16 * 88, I_D = 44 * 32;
    for (int it = gw; it < 2 * I_G + I_D; it += ngw) {
        int r = it;
        if (r < I_G) { transpose_item(wg, 1024, 2816, GU, r, scr, lane, RmGU{0}); continue; } r -= I_G;
        if (r < I_G) { transpose_item(wu, 1024, 2816, GU, r, scr, lane, RmGU{1}); continue; } r -= I_G;
        transpose_item(wd, 2816, 1024, DN, r, scr, lane, RmPlain{0});
    }
}
DEV void phase_ffn_gu(const FP& p, LAS unsigned char* lds, int G, int bid) {
    pg8::Gemm g{(const bf16_t*)(p.ws + WS_XN), (const bf16_t*)(p.ws + WS_W_GU), MP, 5632, 1024};
    pg8::StaticOrder S; S.init(MP, 5632, G, bid);
    pg8::EpiSwiglu E{(bf16_t*)(p.ws + WS_HID), 2816};
    pg8::gemm_phase<pg8::EpiSwiglu, pg8::StaticOrder, true, true>(lds, g, S, E);
}
DEV void phase_ffn_down(const FP& p, LAS unsigned char* lds, int G, int bid) {
    pg8::Gemm g{(const bf16_t*)(p.ws + WS_HID), (const bf16_t*)(p.ws + WS_W_DOWN), MP, 1024, 2816};
    pg8::StaticOrder S; S.init(MP, 1024, G, bid);
    pg8::EpiBf16<0> E{(bf16_t*)(p.ws + WS_RAW), 1024, nullptr, 0, 0, 1.f};
    pg8::gemm_phase<pg8::EpiBf16<0>, pg8::StaticOrder, true, true>(lds, g, S, E);
}

typedef short v4i16_t __attribute__((ext_vector_type(4)));
typedef float f32x2_t __attribute__((ext_vector_type(2)));
typedef __bf16 bf16x2_t __attribute__((ext_vector_type(2)));
DEV unsigned cvtpk(float lo, float hi) { f32x2_t v = {lo, hi}; bf16x2_t b = __builtin_convertvector(v, bf16x2_t); return __builtin_bit_cast(unsigned, b); }
DEV f32x16 mfma32(bf16x8 a, bf16x8 b, f32x16 c) { return __builtin_amdgcn_mfma_f32_32x32x16_bf16(a, b, c, 0, 0, 0); }
DEV s16x4 tr_read(LAS const unsigned char* p) { return __builtin_bit_cast(s16x4, __builtin_amdgcn_ds_read_tr16_b64_v4i16((LAS v4i16_t*)p)); }
DEV bf16x8 cat8(s16x4 lo, s16x4 hi) { return (bf16x8){lo[0], lo[1], lo[2], lo[3], hi[0], hi[1], hi[2], hi[3]}; }
DEV float half_max(float v) { auto rr = __builtin_amdgcn_permlane32_swap(__float_as_uint(v), __float_as_uint(v), false, false); return fmaxf(__uint_as_float(rr[0]), __uint_as_float(rr[1])); }
DEV float half_sum(float v) { auto rr = __builtin_amdgcn_permlane32_swap(__float_as_uint(v), __float_as_uint(v), false, false); return __uint_as_float(rr[0]) + __uint_as_float(rr[1]); }
DEV bf16x8 pfrag(const f32x16& S, int s) {
    u32x4 w;
    if (s == 0) { w.x = cvtpk(S[0], S[1]); w.y = cvtpk(S[2], S[3]); w.z = cvtpk(S[4], S[5]); w.w = cvtpk(S[6], S[7]); }
    else { w.x = cvtpk(S[8], S[9]); w.y = cvtpk(S[10], S[11]); w.z = cvtpk(S[12], S[13]); w.w = cvtpk(S[14], S[15]); }
    return __builtin_bit_cast(bf16x8, w);
}
DEV float max16(const f32x16& S) {
    float a = fmaxf(fmaxf(S[0], S[1]), fmaxf(S[2], S[3])), b = fmaxf(fmaxf(S[4], S[5]), fmaxf(S[6], S[7]));
    float c = fmaxf(fmaxf(S[8], S[9]), fmaxf(S[10], S[11])), d = fmaxf(fmaxf(S[12], S[13]), fmaxf(S[14], S[15]));
    return fmaxf(fmaxf(a, b), fmaxf(c, d));
}

namespace pg8 {
struct EpiMemKV {
    static constexpr bool PERM = false, AFTER_DRAIN = false;
    float* ok; float* ov; bf16_t* bk; bf16_t* bv;
    __device__ __forceinline__ void operator()(const f32x4 (&acc)[2][2][4][2], const Unit& u, int wr, int wc, int fr, int fq) const {
        const int row0 = u.pm * BM + wr * 64 + fr; const bool isv = u.pn >= 4; const int colt = (u.pn & 3) * BM + wc * 32 + 4 * fq;
        float* of = isv ? ov : ok; bf16_t* ob = isv ? bv : bk;
#pragma unroll
        for (int ai = 0; ai < 2; ++ai)
#pragma unroll
            for (int m = 0; m < 4; ++m) {
                const size_t ro = (size_t)(row0 + ai * HALF + m * 16) * 1024;
#pragma unroll
                for (int bj = 0; bj < 2; ++bj)
#pragma unroll
                    for (int n = 0; n < 2; ++n) {
                        const f32x4 v = acc[ai][bj][m][n]; const int col = colt + bj * HALF + n * 16;
                        *(f32x4*)(of + ro + col) = v;
                        u32x2 w; w.x = cvt_pk_bf16(v[0], v[1]); w.y = cvt_pk_bf16(v[2], v[3]);
                        *(u32x2*)(ob + ro + col) = w;
                    }
            }
    }
};
}

DEV void phase_prep_x(const FP& p, LAS unsigned char* lds, int gw, int ngw, int wave, int lane) {
    LAS float* scr = (LAS float*)(lds + wave * 16384);
    constexpr int I_S = 16 * 32;
    for (int it = gw; it < 4 * I_S; it += ngw) {
        int r = it;
        if (r < I_S) { transpose_item(p.in[23], 1024, 1024, (bf16_t*)(p.ws + WS_W_Q), r, scr, lane, RmPlain{0}); continue; } r -= I_S;
        if (r < I_S) { transpose_item(p.in[24], 1024, 1024, (bf16_t*)(p.ws + WS_W_KV), r, scr, lane, RmPlain{0}); continue; } r -= I_S;
        if (r < I_S) { transpose_item(p.in[25], 1024, 1024, (bf16_t*)(p.ws + WS_W_KV), r, scr, lane, RmPlain{1024}); continue; } r -= I_S;
        transpose_item(p.in[26], 1024, 1024, (bf16_t*)(p.ws + WS_W_O), r, scr, lane, RmPlain{0});
    }
    row_phase(nullptr, p.in[8], nullptr, nullptr, p.in[22], (bf16_t*)(p.ws + WS_MN), 512, gw, ngw, lane);
}
DEV void phase_memkv(const FP& p, LAS unsigned char* lds, int G, int bid) {
    pg8::Gemm g{(const bf16_t*)(p.ws + WS_MN), (const bf16_t*)(p.ws + WS_W_KV), 512, 2048, 1024};
    pg8::StaticOrder S; S.init(512, 2048, G, bid);
    pg8::EpiMemKV E{p.out + 33822720, p.out + 34347008, (bf16_t*)(p.ws + WS_KM), (bf16_t*)(p.ws + WS_VM)};
    pg8::gemm_phase<pg8::EpiMemKV, pg8::StaticOrder, true, true>(lds, g, S, E);
}
DEV void phase_wq(const FP& p, LAS unsigned char* lds, int G, int bid) {
    pg8::Gemm g{(const bf16_t*)(p.ws + WS_XN), (const bf16_t*)(p.ws + WS_W_Q), MP, 1024, 1024};
    pg8::StaticOrder S; S.init(MP, 1024, G, bid);
    pg8::EpiBf16<0> E{(bf16_t*)(p.ws + WS_QX), 1024, nullptr, 1024, 0, 0.0625f * 1.4426950408889634f};
    pg8::gemm_phase<pg8::EpiBf16<0>, pg8::StaticOrder, true, true>(lds, g, S, E);
}
DEV void phase_wo(const FP& p, LAS unsigned char* lds, int G, int bid) {
    pg8::Gemm g{(const bf16_t*)(p.ws + WS_OX), (const bf16_t*)(p.ws + WS_W_O), MP, 1024, 1024};
    pg8::StaticOrder S; S.init(MP, 1024, G, bid);
    pg8::EpiBf16<0> E{(bf16_t*)(p.ws + WS_RAW), 1024, nullptr, 0, 0, 1.f};
    pg8::gemm_phase<pg8::EpiBf16<0>, pg8::StaticOrder, true, true>(lds, g, S, E);
}

DEV void phase_xattn(const FP& p, LAS unsigned char* lds, int G, int bid) {
    const int tid = threadIdx.x, lane = tid & 63, wave = __builtin_amdgcn_readfirstlane(tid >> 6), r = lane & 31, hh = lane >> 5, qb = wave & 3, eh = wave >> 2;
    const bf16_t* QX = (const bf16_t*)(p.ws + WS_QX); const bf16_t* KM = (const bf16_t*)(p.ws + WS_KM); const bf16_t* VM = (const bf16_t*)(p.ws + WS_VM);
    bf16_t* OX = (bf16_t*)(p.ws + WS_OX);
    constexpr int QOFF = 0, KOFF = 65536, VOFF = 98304;
    const int vlane = (4 * hh + ((lane & 15) >> 2)) * 64 + 32 * ((lane >> 4) & 1) + 8 * (lane & 3);
    for (int u = bid; u < 512; u += G) {
        const int bh = u & 7, b = bh >> 2, h = bh & 3, qblk = u >> 3;
        const size_t qrow0 = (size_t)b * 8192 + (size_t)qblk * 128;
#pragma unroll
        for (int j = 0; j < 8; ++j) {
            const int id = tid + 512 * j, row = id >> 5, ch = id & 31;
            const u32x4 v = *(const u32x4*)(QX + (qrow0 + row) * 1024 + h * 256 + ch * 8);
            *(LAS u32x4*)(lds + QOFF + row * 512 + ((ch ^ (row & 15)) << 4)) = v;
        }
        u32x4 kr[2], vr[2];
#pragma unroll
        for (int j = 0; j < 2; ++j) {
            const int id = tid + 512 * j, key = id >> 5, ch = id & 31;
            kr[j] = *(const u32x4*)(KM + ((size_t)b * 256 + key) * 1024 + h * 256 + ch * 8);
            vr[j] = *(const u32x4*)(VM + ((size_t)b * 256 + key) * 1024 + h * 256 + ch * 8);
        }
#pragma unroll
        for (int j = 0; j < 2; ++j) {
            const int id = tid + 512 * j, key = id >> 5, ch = id & 31;
            *(LAS u32x4*)(lds + KOFF + key * 512 + ((ch ^ (key & 15)) << 4)) = kr[j];
            *(LAS u32x4*)(lds + VOFF + (ch >> 2) * 2048 + key * 64 + (ch & 3) * 16) = vr[j];
        }
        __syncthreads();
        f32x16 O[4];
#pragma unroll
        for (int e = 0; e < 4; ++e)
#pragma unroll
            for (int i = 0; i < 16; ++i) O[e][i] = 0.f;
        float mrun = -1e30f, lsum = 0.f;
        const LAS unsigned char* qp = lds + QOFF + (32 * qb + r) * 512;
        for (int t = 0; t < 8; ++t) {
            const int buf = t & 1;
            if (t + 1 < 8) {
#pragma unroll
                for (int j = 0; j < 2; ++j) {
                    const int id = tid + 512 * j, key = id >> 5, ch = id & 31;
                    kr[j] = *(const u32x4*)(KM + ((size_t)b * 256 + 32 * (t + 1) + key) * 1024 + h * 256 + ch * 8);
                    vr[j] = *(const u32x4*)(VM + ((size_t)b * 256 + 32 * (t + 1) + key) * 1024 + h * 256 + ch * 8);
                }
            }
            const LAS unsigned char* kp = lds + KOFF + buf * 16384 + r * 512;
            const LAS unsigned char* vp = lds + VOFF + buf * 16384 + (4 * eh) * 2048 + vlane;
            f32x16 S;
#pragma unroll
            for (int i = 0; i < 16; ++i) S[i] = 0.f;
#pragma unroll 4
            for (int ks = 0; ks < 16; ++ks) {
                const int sl = ((2 * ks + hh) ^ (r & 15)) << 4;
                const bf16x8 a = *(const LAS bf16x8*)(kp + sl);
                const bf16x8 q = *(const LAS bf16x8*)(qp + sl);
                S = mfma32(a, q, S);
            }
            const float mx = half_max(max16(S));
            const float mnew = fmaxf(mrun, mx), alpha = __builtin_amdgcn_exp2f(mrun - mnew);
            mrun = mnew;
            float ps = 0.f;
#pragma unroll
            for (int i = 0; i < 16; ++i) { S[i] = __builtin_amdgcn_exp2f(S[i] - mnew); ps += S[i]; }
            lsum = lsum * alpha + ps;
#pragma unroll
            for (int e = 0; e < 4; ++e)
#pragma unroll
                for (int i = 0; i < 16; ++i) O[e][i] *= alpha;
            const bf16x8 P0 = pfrag(S, 0), P1 = pfrag(S, 1);
#pragma unroll
            for (int e = 0; e < 4; ++e) {
                const bf16x8 v0 = cat8(tr_read(vp + e * 2048), tr_read(vp + e * 2048 + 512));
                const bf16x8 v1 = cat8(tr_read(vp + e * 2048 + 1024), tr_read(vp + e * 2048 + 1536));
                O[e] = mfma32(v0, P0, O[e]);
                O[e] = mfma32(v1, P1, O[e]);
            }
            if (t + 1 < 8) {
#pragma unroll
                for (int j = 0; j < 2; ++j) {
                    const int id = tid + 512 * j, key = id >> 5, ch = id & 31;
                    *(LAS u32x4*)(lds + KOFF + (buf ^ 1) * 16384 + key * 512 + ((ch ^ (key & 15)) << 4)) = kr[j];
                    *(LAS u32x4*)(lds + VOFF + (buf ^ 1) * 16384 + (ch >> 2) * 2048 + key * 64 + (ch & 3) * 16) = vr[j];
                }
            }
            __syncthreads();
        }
        const float inv = 1.f / half_sum(lsum);
        LAS unsigned char* stg = lds + wave * 16384;
#pragma unroll
        for (int e = 0; e < 4; ++e)
#pragma unroll
            for (int g4 = 0; g4 < 4; ++g4) {
                u32x2 w; w.x = cvtpk(O[e][4 * g4 + 0] * inv, O[e][4 * g4 + 1] * inv); w.y = cvtpk(O[e][4 * g4 + 2] * inv, O[e][4 * g4 + 3] * inv);
                *(LAS u32x2*)(stg + r * 272 + (32 * e + 8 * g4 + 4 * hh) * 2) = w;
            }
        WAVE_SYNC();
#pragma unroll
        for (int i = 0; i < 8; ++i) {
            const int row = i * 4 + (lane >> 4), ch = lane & 15;
            const u32x4 v = *(const LAS u32x4*)(stg + row * 272 + ch * 16);
            *(u32x4*)(OX + (qrow0 + 32 * qb + row) * 1024 + h * 256 + 128 * eh + ch * 8) = v;
        }
        __syncthreads();
    }
}

constexpr float QSCALE = 0.125f * 1.4426950408889634f;
namespace pg8 {
struct EpiIn {
    static constexpr bool PERM = false, AFTER_DRAIN = false;
    bf16_t* ZX; bf16_t* Qb; bf16_t* Kb; bf16_t* Vb; float* okf; float* ovf; float* oconv;
    __device__ __forceinline__ void operator()(const f32x4 (&acc)[2][2][4][2], const Unit& u, int wr, int wc, int fr, int fq) const {
        const int row0 = u.pm * BM + wr * 64 + fr, pn = u.pn;
        if (pn < 6) {
#pragma unroll
            for (int ai = 0; ai < 2; ++ai)
#pragma unroll
                for (int m = 0; m < 4; ++m) {
                    const int row = row0 + ai * HALF + m * 16; const int t = row & 8191;
#pragma unroll
                    for (int bj = 0; bj < 2; ++bj)
#pragma unroll
                        for (int n = 0; n < 2; ++n) {
                            const f32x4 v = acc[ai][bj][m][n]; const int col = pn * BM + bj * HALF + wc * 32 + n * 16 + 4 * fq;
                            u32x2 w; w.x = cvt_pk_bf16(v[0], v[1]); w.y = cvt_pk_bf16(v[2], v[3]);
                            *(u32x2*)(ZX + (size_t)row * 1536 + col) = w;
                            if (pn >= 2 && t >= 8189) *(f32x4*)(oconv + (size_t)((row >> 13) * 3 + (t - 8189)) * 1024 + (col - 512)) = v;
                        }
                }
        } else if (pn < 10) {
            const bool isk = pn >= 8;
            const int g = wc & 1;
            float inv[4];
#pragma unroll
            for (int i = 0; i < 4; ++i) inv[i] = __builtin_amdgcn_exp2f(-(float)(16 * g + 4 * fq + i) * (13.287712379549449f / 32.f)) * 0.15915494309189535f;
#pragma unroll
            for (int ai = 0; ai < 2; ++ai)
#pragma unroll
                for (int m = 0; m < 4; ++m) {
                    const int row = row0 + ai * HALF + m * 16; const float pos = (float)(row & 8191);
                    float cs[4], sn[4];
#pragma unroll
                    for (int i = 0; i < 4; ++i) { float rev = pos * inv[i]; rev -= floorf(rev); sn[i] = __builtin_amdgcn_sinf(rev); cs[i] = __builtin_amdgcn_cosf(rev); }
#pragma unroll
                    for (int bj = 0; bj < 2; ++bj) {
                        const int cl = (pn & 1) * BM + bj * HALF + wc * 32;
                        const f32x4 x1 = acc[ai][bj][m][0], x2 = acc[ai][bj][m][1];
                        f32x4 o1, o2;
#pragma unroll
                        for (int i = 0; i < 4; ++i) { o1[i] = x1[i] * cs[i] - x2[i] * sn[i]; o2[i] = x2[i] * cs[i] + x1[i] * sn[i]; }
                        if (isk) {
                            float* kf = okf + (size_t)row * 512 + (cl >> 6) * 64 + 16 * g + 4 * fq;
                            *(f32x4*)kf = o1; *(f32x4*)(kf + 32) = o2;
                            u32x2 w; w.x = cvt_pk_bf16(o1[0], o1[1]); w.y = cvt_pk_bf16(o1[2], o1[3]);
                            *(u32x2*)(Kb + (size_t)row * 512 + cl + 4 * fq) = w;
                            w.x = cvt_pk_bf16(o2[0], o2[1]); w.y = cvt_pk_bf16(o2[2], o2[3]);
                            *(u32x2*)(Kb + (size_t)row * 512 + cl + 16 + 4 * fq) = w;
                        } else {
                            o1 = o1 * QSCALE; o2 = o2 * QSCALE;
                            u32x2 w; w.x = cvt_pk_bf16(o1[0], o1[1]); w.y = cvt_pk_bf16(o1[2], o1[3]);
                            *(u32x2*)(Qb + (size_t)row * 512 + cl + 4 * fq) = w;
                            w.x = cvt_pk_bf16(o2[0], o2[1]); w.y = cvt_pk_bf16(o2[2], o2[3]);
                            *(u32x2*)(Qb + (size_t)row * 512 + cl + 16 + 4 * fq) = w;
                        }
                    }
                }
        } else {
#pragma unroll
            for (int ai = 0; ai < 2; ++ai)
#pragma unroll
                for (int m = 0; m < 4; ++m) {
                    const int row = row0 + ai * HALF + m * 16;
#pragma unroll
                    for (int bj = 0; bj < 2; ++bj)
#pragma unroll
                        for (int n = 0; n < 2; ++n) {
                            const f32x4 v = acc[ai][bj][m][n]; const int col = (pn - 10) * BM + bj * HALF + wc * 32 + n * 16 + 4 * fq;
                            *(f32x4*)(ovf + (size_t)row * 512 + col) = v;
                            u32x2 w; w.x = cvt_pk_bf16(v[0], v[1]); w.y = cvt_pk_bf16(v[2], v[3]);
                            *(u32x2*)(Vb + (size_t)row * 512 + col) = w;
                        }
                }
        }
    }
};
}

DEV void phase_prep_mix(const FP& p, LAS unsigned char* lds, int gw, int ngw, int wave, int lane) {
    LAS float* scr = (LAS float*)(lds + wave * 16384);
    constexpr int I_IN = 16 * 97, I_OUT = 16 * 32;
    for (int it = gw; it < I_IN + I_OUT; it += ngw) {
        if (it < I_IN) transpose_item(p.in[9], 1024, 3080, (bf16_t*)(p.ws + WS_W_IN), it, scr, lane, RmIn{});
        else transpose_item(p.in[21], 1024, 1024, (bf16_t*)(p.ws + WS_W_OUT), it - I_IN, scr, lane, RmPlain{0});
    }
    __syncthreads();
    LAS float* wdt = (LAS float*)lds;
    for (int i = threadIdx.x; i < 8192; i += 512) wdt[i] = p.in[9][(size_t)(i >> 3) * 3080 + 1536 + (i & 7)];
    __syncthreads();
    const float* x = p.in[0]; const float* g = p.in[27]; bf16_t* xn = (bf16_t*)(p.ws + WS_XN); float* dtv = (float*)(p.ws + WS_DTV);
    const float bias = p.in[12][lane & 7];
    for (int r = gw; r < MP; r += ngw) {
        f32x4 h[4]; float ss = 0.f;
#pragma unroll
        for (int j = 0; j < 4; ++j) { h[j] = ((const f32x4*)(x + (size_t)r * 1024))[lane + 64 * j]; ss += h[j].x * h[j].x + h[j].y * h[j].y + h[j].z * h[j].z + h[j].w * h[j].w; }
        const float rs = rsqrtf(wave_sum(ss) * (1.f / 1024.f) + 1e-6f);
        float d[8];
#pragma unroll
        for (int k = 0; k < 8; ++k) d[k] = 0.f;
#pragma unroll
        for (int j = 0; j < 4; ++j) {
            const f32x4 gg = ((const f32x4*)g)[lane + 64 * j]; h[j] = h[j] * rs * gg;
            u32x2 w; w.x = pk2(h[j].x, h[j].y); w.y = pk2(h[j].z, h[j].w);
            ((u32x2*)(xn + (size_t)r * 1024))[lane + 64 * j] = w;
#pragma unroll
            for (int i = 0; i < 4; ++i) {
                const LAS f32x4* wp = (const LAS f32x4*)(wdt + (4 * (lane + 64 * j) + i) * 8);
                const f32x4 w0 = wp[0], w1 = wp[1]; const float hv = h[j][i];
                d[0] += hv * w0.x; d[1] += hv * w0.y; d[2] += hv * w0.z; d[3] += hv * w0.w; d[4] += hv * w1.x; d[5] += hv * w1.y; d[6] += hv * w1.z; d[7] += hv * w1.w;
            }
        }
#pragma unroll
        for (int k = 0; k < 8; ++k) d[k] = wave_sum(d[k]);
        float mine = d[0];
#pragma unroll
        for (int k = 1; k < 8; ++k) mine = ((lane & 7) == k) ? d[k] : mine;
        const float xx = mine + bias;
        if (lane < 8) dtv[(size_t)r * 8 + lane] = (xx > 20.f) ? xx : log1pf(expf(xx));
    }
    __syncthreads();
}
DEV void phase_inproj(const FP& p, LAS unsigned char* lds, int G, int bid) {
    pg8::Gemm g{(const bf16_t*)(p.ws + WS_XN), (const bf16_t*)(p.ws + WS_W_IN), MP, 3072, 1024};
    pg8::StaticOrder S; S.init(MP, 3072, G, bid);
    pg8::EpiIn E{(bf16_t*)(p.ws + WS_ZX), (bf16_t*)(p.ws + WS_Q), (bf16_t*)(p.ws + WS_K), (bf16_t*)(p.ws + WS_V), p.out + 16908288, p.out + 25296896, p.out + 33816576};
    pg8::gemm_phase<pg8::EpiIn, pg8::StaticOrder, true, true>(lds, g, S, E);
}
DEV void phase_outproj(const FP& p, LAS unsigned char* lds, int G, int bid) {
    pg8::Gemm g{(const bf16_t*)(p.ws + WS_CAT), (const bf16_t*)(p.ws + WS_W_OUT), MP, 1024, 1024};
    pg8::StaticOrder S; S.init(MP, 1024, G, bid);
    pg8::EpiBf16<0> E{(bf16_t*)(p.ws + WS_RAW), 1024, nullptr, 0, 0, 1.f};
    pg8::gemm_phase<pg8::EpiBf16<0>, pg8::StaticOrder, true, true>(lds, g, S, E);
}

DEV float ssd_tables(const FP& p, LAS float* tdt, LAS float* tac, size_t row0, int h, int lane) {
    const float dt = ((const float*)(p.ws + WS_DTV))[(row0 + lane) * 8 + h];
    const float a = -expf(p.in[13][h]);
    float v = dt * a;
#pragma unroll
    for (int o = 1; o < 64; o <<= 1) { const float t = __shfl_up(v, o); if (lane >= o) v += t; }
    tdt[lane * 8 + h] = dt; tac[lane * 8 + h] = v;
    return __shfl(v, 63);
}
template <class F> DEV void ssd_conv8(const FP& p, size_t row0, int col0, int l0, F emit) {
    const bf16_t* ZX = (const bf16_t*)(p.ws + WS_ZX);
    const float* cw = p.in[10]; const float* cb = p.in[11];
    f32x4 w[4][2], bias[2];
#pragma unroll
    for (int j = 0; j < 4; ++j) { w[j][0] = *(const f32x4*)(cw + j * 1024 + col0); w[j][1] = *(const f32x4*)(cw + j * 1024 + col0 + 4); }
    bias[0] = *(const f32x4*)(cb + col0); bias[1] = *(const f32x4*)(cb + col0 + 4);
    const int t0 = (int)(row0 & 8191);
    f32x4 u[4][2];
#pragma unroll
    for (int j = 0; j < 3; ++j) {
        const int l = l0 - 3 + j;
        if (t0 + l >= 0) {
            const u32x4 r = *(const u32x4*)(ZX + (row0 + l) * 1536 + 512 + col0);
            u[j][0] = (f32x4){bflo(r.x), bfhi(r.x), bflo(r.y), bfhi(r.y)}; u[j][1] = (f32x4){bflo(r.z), bfhi(r.z), bflo(r.w), bfhi(r.w)};
        } else { u[j][0] = (f32x4){0.f, 0.f, 0.f, 0.f}; u[j][1] = u[j][0]; }
    }
#pragma unroll
    for (int i = 0; i < 16; ++i) {
        const int l = l0 + i;
        const u32x4 r = *(const u32x4*)(ZX + (row0 + l) * 1536 + 512 + col0);
        u[3][0] = (f32x4){bflo(r.x), bfhi(r.x), bflo(r.y), bfhi(r.y)}; u[3][1] = (f32x4){bflo(r.z), bfhi(r.z), bflo(r.w), bfhi(r.w)};
        f32x4 a0 = bias[0] + w[0][0] * u[0][0] + w[1][0] * u[1][0] + w[2][0] * u[2][0] + w[3][0] * u[3][0];
        f32x4 a1 = bias[1] + w[0][1] * u[0][1] + w[1][1] * u[1][1] + w[2][1] * u[2][1] + w[3][1] * u[3][1];
#pragma unroll
        for (int k = 0; k < 4; ++k) { a0[k] = fast_silu(a0[k]); a1[k] = fast_silu(a1[k]); }
        emit(l, a0, a1);
        u[0][0] = u[1][0]; u[0][1] = u[1][1]; u[1][0] = u[2][0]; u[1][1] = u[2][1]; u[2][0] = u[3][0]; u[2][1] = u[3][1];
    }
}
constexpr int S_XS = 0, S_B = 65536, S_C = 98304, S_TDT = 131072, S_TAC = 133120, S_SSQ = 135168;
DEV int trlane(int lane) { return ((lane & 15) >> 2) * 64 + 32 * ((lane >> 4) & 1) + 8 * (lane & 3); }

DEV void phase_ssd1(const FP& p, LAS unsigned char* lds, int G, int bid) {
    const int tid = threadIdx.x, lane = tid & 63, wave = __builtin_amdgcn_readfirstlane(tid >> 6), hh = lane >> 5;
    LAS float* tdt = (LAS float*)(lds + S_TDT); LAS float* tac = (LAS float*)(lds + S_TAC);
    bf16_t* ST = (bf16_t*)(p.ws + WS_ST); float* cdec = (float*)(p.ws + WS_CDEC);
    for (int u = bid; u < 256; u += G) {
        const int b = u >> 7, c = u & 127; const size_t row0 = (size_t)b * 8192 + (size_t)c * 64;
        const float tot = ssd_tables(p, tdt, tac, row0, wave, lane);
        if (lane == 0) cdec[u * 8 + wave] = expf(tot);
        __syncthreads();
        { const int i = tid; const float t63 = tac[63 * 8 + (i & 7)]; const float s = tdt[i] * expf(t63 - tac[i]); __syncthreads(); tdt[i] = s; }
        __syncthreads();
        if (tid < 384) {
            const int cg = tid >> 2, tq = tid & 3, col0 = cg * 8;
            ssd_conv8(p, row0, col0, tq * 16, [&](int l, f32x4 a0, f32x4 a1) {
                u32x4 w;
                if (cg < 64) {
                    const int h = cg >> 3, pp = col0 & 63; const float s = tdt[l * 8 + h];
                    a0 = a0 * s; a1 = a1 * s;
                    w.x = pk2(a0[0], a0[1]); w.y = pk2(a0[2], a0[3]); w.z = pk2(a1[0], a1[1]); w.w = pk2(a1[2], a1[3]);
                    *(LAS u32x4*)(lds + S_XS + h * 8192 + (pp >> 5) * 4096 + l * 64 + (pp & 31) * 2) = w;
                } else {
                    const int n = col0 - 512, g = n >> 7, nn = n & 127;
                    w.x = pk2(a0[0], a0[1]); w.y = pk2(a0[2], a0[3]); w.z = pk2(a1[0], a1[1]); w.w = pk2(a1[2], a1[3]);
                    *(LAS u32x4*)(lds + S_B + g * 16384 + (nn >> 5) * 4096 + l * 64 + (nn & 31) * 2) = w;
                }
            });
        }
        __syncthreads();
        const int h = wave, g = h >> 2;
        const LAS unsigned char* xa = lds + S_XS + h * 8192 + hh * 512 + trlane(lane);
        const LAS unsigned char* ba = lds + S_B + g * 16384 + hh * 512 + trlane(lane);
        bf16_t* sp = ST + ((size_t)u * 8 + h) * 8192;
#pragma unroll 1
        for (int nh = 0; nh < 2; ++nh) {
            f32x16 acc[2][2];
#pragma unroll
            for (int a = 0; a < 2; ++a)
#pragma unroll
                for (int n = 0; n < 2; ++n)
#pragma unroll
                    for (int i = 0; i < 16; ++i) acc[a][n][i] = 0.f;
#pragma unroll 2
            for (int s = 0; s < 4; ++s) {
                bf16x8 af[2], bfr[2];
#pragma unroll
                for (int a = 0; a < 2; ++a) af[a] = cat8(tr_read(xa + a * 4096 + s * 1024), tr_read(xa + a * 4096 + s * 1024 + 256));
#pragma unroll
                for (int n = 0; n < 2; ++n) bfr[n] = cat8(tr_read(ba + (2 * nh + n) * 4096 + s * 1024), tr_read(ba + (2 * nh + n) * 4096 + s * 1024 + 256));
#pragma unroll
                for (int a = 0; a < 2; ++a)
#pragma unroll
                    for (int n = 0; n < 2; ++n) acc[a][n] = mfma32(af[a], bfr[n], acc[a][n]);
            }
#pragma unroll
            for (int a = 0; a < 2; ++a)
#pragma unroll
                for (int n = 0; n < 2; ++n)
#pragma unroll
                    for (int i = 0; i < 16; ++i) {
                        const int pr = 32 * a + (i & 3) + 8 * (i >> 2) + 4 * hh;
                        sp[pr * 128 + 32 * (2 * nh + n) + (lane & 31)] = (bf16_t)f2bf(acc[a][n][i]);
                    }
        }
        __syncthreads();
    }
}

DEV void ssd2_item(const FP& p, int blk) {
    const int tid = threadIdx.x;
    unsigned* ST = (unsigned*)(p.ws + WS_ST); const float* cdec = (const float*)(p.ws + WS_CDEC); float* pssm = p.out + 33685504;
    const int idx = blk * 512 + tid;
    const int n2 = idx & 63, pr = (idx >> 6) & 63, h = (idx >> 12) & 7, b = idx >> 15;
    float s0 = 0.f, s1 = 0.f;
    for (int c0 = 0; c0 < 128; c0 += 32) {
        unsigned v[32];
#pragma unroll
        for (int j = 0; j < 32; ++j) v[j] = ST[(((size_t)(b * 128 + c0 + j) * 8 + h) * 64 + pr) * 64 + n2];
#pragma unroll
        for (int j = 0; j < 32; ++j) {
            const float dc = cdec[(b * 128 + c0 + j) * 8 + h];
            ST[(((size_t)(b * 128 + c0 + j) * 8 + h) * 64 + pr) * 64 + n2] = pk2(s0, s1);
            s0 = s0 * dc + bflo(v[j]); s1 = s1 * dc + bfhi(v[j]);
        }
    }
    float2 o; o.x = s0; o.y = s1;
    ((float2*)pssm)[(((size_t)b * 8 + h) * 64 + pr) * 64 + n2] = o;
}
DEV void phase_ssd2(const FP& p, int G, int bid) { for (int blk = bid; blk < 128; blk += G) ssd2_item(p, blk); }

DEV void phase_ssd3(const FP& p, LAS unsigned char* lds, int G, int bid) {
    LAS float* tdt = (LAS float*)(lds + S_TDT); LAS float* tac = (LAS float*)(lds + S_TAC); LAS float* ssq = (LAS float*)(lds + S_SSQ);
    const bf16_t* ST = (const bf16_t*)(p.ws + WS_ST); const bf16_t* ZX = (const bf16_t*)(p.ws + WS_ZX); bf16_t* CAT = (bf16_t*)(p.ws + WS_CAT);
    for (int u = bid; u < 256; u += G) {
        int tid = threadIdx.x; asm volatile("" : "+v"(tid));
        const int lane = tid & 63, wave = __builtin_amdgcn_readfirstlane(tid >> 6), r = lane & 31, hh = lane >> 5;
        const int b = u >> 7, c = u & 127; const size_t row0 = (size_t)b * 8192 + (size_t)c * 64;
        (void)ssd_tables(p, tdt, tac, row0, wave, lane);
        {
            const int cg = tid >> 2, tq = tid & 3, col0 = cg * 8;
            ssd_conv8(p, row0, col0, tq * 16, [&](int l, f32x4 a0, f32x4 a1) {
                u32x4 w; w.x = pk2(a0[0], a0[1]); w.y = pk2(a0[2], a0[3]); w.z = pk2(a1[0], a1[1]); w.w = pk2(a1[2], a1[3]);
                if (cg < 64) {
                    const int h = cg >> 3, pp = col0 & 63;
                    *(LAS u32x4*)(lds + S_XS + h * 8192 + (pp >> 5) * 4096 + l * 64 + (pp & 31) * 2) = w;
                } else {
                    const int n = (col0 - 512) & 255, g = n >> 7, ch = (n & 127) >> 3;
                    *(LAS u32x4*)(lds + (col0 < 768 ? S_B : S_C) + g * 16384 + l * 256 + ((ch ^ (l & 15)) << 4)) = w;
                }
            });
        }
        __syncthreads();
        const int h = wave, g = h >> 2;
        f32x16 Y[2][2];
#pragma unroll
        for (int a = 0; a < 2; ++a)
#pragma unroll
            for (int l2 = 0; l2 < 2; ++l2)
#pragma unroll
                for (int i = 0; i < 16; ++i) Y[a][l2][i] = 0.f;
        const LAS unsigned char* cp = lds + S_C + g * 16384 + r * 256;
        const LAS unsigned char* bp = lds + S_B + g * 16384 + r * 256;
        const bf16_t* pv = ST + ((size_t)u * 8 + h) * 8192 + (size_t)r * 128 + 8 * hh;
#pragma unroll 2
        for (int ks = 0; ks < 8; ++ks) {
            const int sl = ((2 * ks + hh) ^ (r & 15)) << 4;
            const bf16x8 c0 = *(const LAS bf16x8*)(cp + sl), c1 = *(const LAS bf16x8*)(cp + 32 * 256 + sl);
            const bf16x8 p0 = *(const bf16x8*)(pv + 16 * ks), p1 = *(const bf16x8*)(pv + 32 * 128 + 16 * ks);
            Y[0][0] = mfma32(p0, c0, Y[0][0]); Y[0][1] = mfma32(p0, c1, Y[0][1]);
            Y[1][0] = mfma32(p1, c0, Y[1][0]); Y[1][1] = mfma32(p1, c1, Y[1][1]);
        }
        float acl[2];
#pragma unroll
        for (int l2 = 0; l2 < 2; ++l2) {
            acl[l2] = tac[(32 * l2 + r) * 8 + h]; const float e = expf(acl[l2]);
#pragma unroll
            for (int a = 0; a < 2; ++a)
#pragma unroll
                for (int i = 0; i < 16; ++i) Y[a][l2][i] *= e;
        }
        __builtin_amdgcn_sched_barrier(0);
        const LAS unsigned char* xa = lds + S_XS + h * 8192 + hh * 256 + trlane(lane);
#pragma unroll
        for (int lb = 0; lb < 2; ++lb)
#pragma unroll
            for (int sb = 0; sb <= lb; ++sb) {
                f32x16 T;
#pragma unroll
                for (int i = 0; i < 16; ++i) T[i] = 0.f;
#pragma unroll 2
                for (int ks = 0; ks < 8; ++ks) {
                    const int sl = ((2 * ks + hh) ^ (r & 15)) << 4;
                    const bf16x8 bb = *(const LAS bf16x8*)(bp + sb * 32 * 256 + sl), cc = *(const LAS bf16x8*)(cp + lb * 32 * 256 + sl);
                    T = mfma32(bb, cc, T);
                }
#pragma unroll
                for (int i = 0; i < 16; ++i) {
                    const int s = 32 * sb + (i & 3) + 8 * (i >> 2) + 4 * hh;
                    const float f = tdt[s * 8 + h] * __builtin_amdgcn_exp2f(1.4426950408889634f * fminf(acl[lb] - tac[s * 8 + h], 0.f));
                    T[i] = (s <= 32 * lb + r) ? T[i] * f : 0.f;
                }
                const bf16x8 P0 = pfrag(T, 0), P1 = pfrag(T, 1);
#pragma unroll
                for (int a = 0; a < 2; ++a) {
                    const bf16x8 x0 = cat8(tr_read(xa + a * 4096 + (2 * sb) * 1024), tr_read(xa + a * 4096 + (2 * sb) * 1024 + 512));
                    const bf16x8 x1 = cat8(tr_read(xa + a * 4096 + (2 * sb + 1) * 1024), tr_read(xa + a * 4096 + (2 * sb + 1) * 1024 + 512));
                    Y[a][lb] = mfma32(x0, P0, Y[a][lb]);
                    Y[a][lb] = mfma32(x1, P1, Y[a][lb]);
                }
            }
        __builtin_amdgcn_sched_barrier(0);
        const float Dh = p.in[14][h];
        float sq[2] = {0.f, 0.f};
#pragma unroll
        for (int a = 0; a < 2; ++a)
#pragma unroll
            for (int l2 = 0; l2 < 2; ++l2) {
                const int l = 32 * l2 + r;
#pragma unroll
                for (int g4 = 0; g4 < 4; ++g4) {
                    const int pp = 8 * g4 + 4 * hh;
                    const u32x2 xw = *(const LAS u32x2*)(lds + S_XS + h * 8192 + a * 4096 + l * 64 + pp * 2);
                    const u32x2 zw = *(const u32x2*)(ZX + (row0 + l) * 1536 + h * 64 + 32 * a + pp);
                    const float xv[4] = {bflo(xw.x), bfhi(xw.x), bflo(xw.y), bfhi(xw.y)}, zv[4] = {bflo(zw.x), bfhi(zw.x), bflo(zw.y), bfhi(zw.y)};
#pragma unroll
                    for (int i = 0; i < 4; ++i) { const float v = (Y[a][l2][4 * g4 + i] + Dh * xv[i]) * fast_silu(zv[i]); Y[a][l2][4 * g4 + i] = v; sq[l2] += v * v; }
                }
            }
#pragma unroll
        for (int l2 = 0; l2 < 2; ++l2) { sq[l2] = half_sum(sq[l2]); if (hh == 0) ssq[(h * 2 + l2) * 32 + r] = sq[l2]; }
        __syncthreads();
        float rs[2];
#pragma unroll
        for (int l2 = 0; l2 < 2; ++l2) {
            float t = 0.f;
#pragma unroll
            for (int k = 0; k < 4; ++k) t += ssq[((4 * g + k) * 2 + l2) * 32 + r];
            rs[l2] = rsqrtf(t * (1.f / 256.f) + 1e-5f);
        }
#pragma unroll
        for (int a = 0; a < 2; ++a)
#pragma unroll
            for (int g4 = 0; g4 < 4; ++g4) {
                const int pcol = h * 64 + 32 * a + 8 * g4 + 4 * hh;
                const f32x4 w = *(const f32x4*)(p.in[15] + pcol);
#pragma unroll
                for (int l2 = 0; l2 < 2; ++l2) {
                    u32x2 o; o.x = cvtpk(Y[a][l2][4 * g4 + 0] * rs[l2] * w[0], Y[a][l2][4 * g4 + 1] * rs[l2] * w[1]);
                    o.y = cvtpk(Y[a][l2][4 * g4 + 2] * rs[l2] * w[2], Y[a][l2][4 * g4 + 3] * rs[l2] * w[3]);
                    *(u32x2*)(CAT + (row0 + 32 * l2 + r) * 1024 + pcol) = o;
                }
            }
        __syncthreads();
    }
}

struct AttnCtx { float lam; };
DEV AttnCtx attn_setup(const FP& p, LAS unsigned char* lds) {
    const int tid0 = threadIdx.x, lane0 = tid0 & 63;
    AttnCtx c; c.lam = expf(wave_sum(p.in[16][lane0] * p.in[17][lane0])) - expf(wave_sum(p.in[18][lane0] * p.in[19][lane0])) + 0.2f;
    LAS float* subw = (LAS float*)(lds + 131072);
    if (tid0 < 128) subw[tid0] = p.in[20][tid0];
    return c;
}
DEV void attn_unit(const FP& p, LAS unsigned char* lds, const AttnCtx& ctx, int bh, int jq) {
    const bf16_t* Qg = (const bf16_t*)(p.ws + WS_Q); const bf16_t* Kg = (const bf16_t*)(p.ws + WS_K); const bf16_t* Vg = (const bf16_t*)(p.ws + WS_V);
    bf16_t* CAT = (bf16_t*)(p.ws + WS_CAT);
    const float lam_init = 0.2f, lam = ctx.lam;
    LAS float* subw = (LAS float*)(lds + 131072);
    const int b = bh >> 2, h = bh & 3;
    {
    int tid = threadIdx.x; asm volatile("" : "+v"(tid));
    const int lane = tid & 63, wave = __builtin_amdgcn_readfirstlane(tid >> 6), r = lane & 31, hh = lane >> 5, qb = wave & 3, c = wave >> 2;
    const int vlane = (4 * hh) * 64 + trlane(lane);
    const size_t rowb = (size_t)b * 8192; const int q0 = jq * 128;
    const int ntb = 2 * jq + 2, myn = 2 * jq + (qb >> 1) + 1;
    bf16x8 qf[4];
#pragma unroll
    for (int ks = 0; ks < 4; ++ks) qf[ks] = *(const bf16x8*)(Qg + (rowb + q0 + 32 * qb + r) * 512 + h * 128 + c * 64 + 16 * ks + 8 * hh);
    u32x4 kr[2], vr[2];
#pragma unroll
    for (int j = 0; j < 2; ++j) {
        const int id = tid + 512 * j, key = id >> 4, ch = id & 15;
        kr[j] = *(const u32x4*)(Kg + (rowb + key) * 512 + h * 128 + ch * 8);
        vr[j] = *(const u32x4*)(Vg + (rowb + key) * 512 + h * 128 + ch * 8);
    }
#pragma unroll
    for (int j = 0; j < 2; ++j) {
        const int id = tid + 512 * j, key = id >> 4, ch = id & 15;
        *(LAS u32x4*)(lds + (ch >> 3) * 8192 + key * 128 + (((ch & 7) ^ ((key >> 1) & 7)) << 4)) = kr[j];
        *(LAS u32x4*)(lds + 16384 + (ch >> 2) * 4096 + key * 64 + (ch & 3) * 16) = vr[j];
    }
    __syncthreads();
    f32x16 O[4];
#pragma unroll
    for (int e = 0; e < 4; ++e)
#pragma unroll
        for (int i = 0; i < 16; ++i) O[e][i] = 0.f;
    float mrun = -1e30f, lsum = 0.f;
    for (int t = 0; t < ntb; ++t) {
        const int buf = t & 1;
        if (t + 1 < ntb) {
#pragma unroll
            for (int j = 0; j < 2; ++j) {
                const int id = tid + 512 * j, key = id >> 4, ch = id & 15;
                kr[j] = *(const u32x4*)(Kg + (rowb + 64 * (t + 1) + key) * 512 + h * 128 + ch * 8);
                vr[j] = *(const u32x4*)(Vg + (rowb + 64 * (t + 1) + key) * 512 + h * 128 + ch * 8);
            }
        }
        if (t < myn) {
            const LAS unsigned char* kp = lds + buf * 32768 + c * 8192 + r * 128;
            const LAS unsigned char* vp = lds + buf * 32768 + 16384 + vlane;
            f32x16 S0, S1;
#pragma unroll
            for (int i = 0; i < 16; ++i) { S0[i] = 0.f; S1[i] = 0.f; }
#pragma unroll
            for (int ks = 0; ks < 4; ++ks) {
                const int sl = ((2 * ks + hh) ^ ((r >> 1) & 7)) << 4;
                const bf16x8 a0 = *(const LAS bf16x8*)(kp + sl), a1 = *(const LAS bf16x8*)(kp + 32 * 128 + sl);
                S0 = mfma32(a0, qf[ks], S0); S1 = mfma32(a1, qf[ks], S1);
            }
            const float mx = half_max(fmaxf(max16(S0), max16(S1)));
            const float mnew = fmaxf(mrun, mx), alpha = __builtin_amdgcn_exp2f(mrun - mnew);
            mrun = mnew;
            float ps = 0.f;
#pragma unroll
            for (int i = 0; i < 16; ++i) { S0[i] = __builtin_amdgcn_exp2f(S0[i] - mnew); S1[i] = __builtin_amdgcn_exp2f(S1[i] - mnew); ps += S0[i] + S1[i]; }
            lsum = lsum * alpha + ps;
#pragma unroll
            for (int e = 0; e < 4; ++e)
#pragma unroll
                for (int i = 0; i < 16; ++i) O[e][i] *= alpha;
            const bf16x8 P0 = pfrag(S0, 0), P1 = pfrag(S0, 1), P2 = pfrag(S1, 0), P3 = pfrag(S1, 1);
#pragma unroll
            for (int e = 0; e < 4; ++e) {
                const bf16x8 v0 = cat8(tr_read(vp + e * 4096), tr_read(vp + e * 4096 + 512));
                const bf16x8 v1 = cat8(tr_read(vp + e * 4096 + 1024), tr_read(vp + e * 4096 + 1536));
                const bf16x8 v2 = cat8(tr_read(vp + e * 4096 + 2048), tr_read(vp + e * 4096 + 2560));
                const bf16x8 v3 = cat8(tr_read(vp + e * 4096 + 3072), tr_read(vp + e * 4096 + 3584));
                O[e] = mfma32(v0, P0, O[e]); O[e] = mfma32(v1, P1, O[e]); O[e] = mfma32(v2, P2, O[e]); O[e] = mfma32(v3, P3, O[e]);
                if (e & 1) __builtin_amdgcn_sched_barrier(0);
            }
        }
        if (t + 1 < ntb) {
#pragma unroll
            for (int j = 0; j < 2; ++j) {
                const int id = tid + 512 * j, key = id >> 4, ch = id & 15;
                *(LAS u32x4*)(lds + (buf ^ 1) * 32768 + (ch >> 3) * 8192 + key * 128 + (((ch & 7) ^ ((key >> 1) & 7)) << 4)) = kr[j];
                *(LAS u32x4*)(lds + (buf ^ 1) * 32768 + 16384 + (ch >> 2) * 4096 + key * 64 + (ch & 3) * 16) = vr[j];
            }
        }
        __syncthreads();
    }
    const float inv = 1.f / half_sum(lsum);
    LAS float* xch = (LAS float*)(lds + qb * 16384);
    if (c == 1) {
        const float f = -lam * inv;
#pragma unroll
        for (int e = 0; e < 4; ++e)
#pragma unroll
            for (int i = 0; i < 16; ++i) xch[(e * 16 + i) * 64 + lane] = O[e][i] * f;
    }
    __syncthreads();
    if (c == 0) {
        float ss = 0.f;
#pragma unroll
        for (int e = 0; e < 4; ++e)
#pragma unroll
            for (int i = 0; i < 16; ++i) { const float v = O[e][i] * inv + xch[(e * 16 + i) * 64 + lane]; O[e][i] = v; ss += v * v; }
        ss = half_sum(ss);
        const float rs = rsqrtf(ss * (1.f / 128.f) + 1e-5f) * (1.f - lam_init);
        WAVE_SYNC();
        LAS unsigned char* stg = lds + qb * 16384;
#pragma unroll
        for (int e = 0; e < 4; ++e)
#pragma unroll
            for (int g4 = 0; g4 < 4; ++g4) {
                const int e0 = 32 * e + 8 * g4 + 4 * hh;
                const f32x4 w = *(const LAS f32x4*)(subw + e0);
                u32x2 o; o.x = cvtpk(O[e][4 * g4 + 0] * rs * w[0], O[e][4 * g4 + 1] * rs * w[1]); o.y = cvtpk(O[e][4 * g4 + 2] * rs * w[2], O[e][4 * g4 + 3] * rs * w[3]);
                *(LAS u32x2*)(stg + r * 272 + e0 * 2) = o;
            }
        WAVE_SYNC();
#pragma unroll
        for (int i = 0; i < 8; ++i) {
            const int row = i * 4 + (lane >> 4), ch = lane & 15;
            const u32x4 v = *(const LAS u32x4*)(stg + row * 272 + ch * 16);
            *(u32x4*)(CAT + (rowb + q0 + 32 * qb + row) * 1024 + 512 + h * 128 + ch * 8) = v;
        }
    }
    __syncthreads();
    }
}
DEV void phase_attn(const FP& p, LAS unsigned char* lds, int G, int bid) {
    const AttnCtx ctx = attn_setup(p, lds);
    for (int pu = bid; pu < 256; pu += G) {
        const int bh = pu & 7, pr = pu >> 3;
        attn_unit(p, lds, ctx, bh, pr);
        attn_unit(p, lds, ctx, bh, 63 - pr);
    }
}

constexpr int NS = 128;
constexpr size_t SB_XN = 0, SB_Z = 256 * 1024, SB_XBC = 512 * 1024, SB_Q = 1024 * 1024, SB_DTV = 1280 * 1024, SB_YPRE = 1536 * 1024, SB_CAT = 1792 * 1024, SB_MIX = 2048 * 1024,
                 SB_QX = 2560 * 1024, SB_OX = 3072 * 1024, SB_HID = 3328 * 1024, SB_AML = 4096 * 1024, SB_XML = 4608 * 1024, SB_XO = 5 * MiB, SB_AO = 8 * MiB;
constexpr int N_ATILE = 33;

template <class Epi>
DEV void s_gemm(const bf16_t* A, const bf16_t* Bt, int N, int K, LAS unsigned char* lds, int bid, int G, int rot, const Epi& E) {
    int tid = threadIdx.x; asm volatile("" : "+v"(tid));
    const int lane = tid & 63, wave = __builtin_amdgcn_readfirstlane(tid >> 6), r = lane & 31, hh = lane >> 5;
    const int nun = 4 * (N >> 5), kw = K >> 3, nit = kw >> 5;
    for (int u = (bid + G - rot) % G; u < nun; u += G) {
        const int mb = u & 3, n0 = (u >> 2) * 32;
        const bf16_t* ap = A + (size_t)(32 * mb + r) * K + wave * kw + 16 * hh;
        const bf16_t* bp = Bt + (size_t)(n0 + r) * K + wave * kw + 16 * hh;
        f32x16 acc;
#pragma unroll
        for (int i = 0; i < 16; ++i) acc[i] = 0.f;
#pragma unroll 4
        for (int j = 0; j < nit; ++j) {
            const bf16x8 a0 = *(const bf16x8*)(ap + 32 * j), a1 = *(const bf16x8*)(ap + 32 * j + 8);
            const bf16x8 b0 = *(const bf16x8*)(bp + 32 * j), b1 = *(const bf16x8*)(bp + 32 * j + 8);
            acc = mfma32(b0, a0, acc); acc = mfma32(b1, a1, acc);
        }
        LAS float* red = (LAS float*)lds;
        if (wave != 0) {
#pragma unroll
            for (int i = 0; i < 16; ++i) red[wave * 1024 + i * 64 + lane] = acc[i];
        }
        __syncthreads();
        if (wave == 0) {
#pragma unroll
            for (int w = 1; w < 8; ++w)
#pragma unroll
                for (int i = 0; i < 16; ++i) acc[i] += red[w * 1024 + i * 64 + lane];
            E(acc, 32 * mb + r, n0, hh);
        }
        __syncthreads();
    }
}
struct EpiSF32 {
    float* C; int ldc; float scale;
    __device__ __forceinline__ void operator()(const f32x16& acc, int m, int n0, int hh) const {
#pragma unroll
        for (int g4 = 0; g4 < 4; ++g4) { f32x4 v = {acc[4 * g4] * scale, acc[4 * g4 + 1] * scale, acc[4 * g4 + 2] * scale, acc[4 * g4 + 3] * scale}; *(f32x4*)(C + (size_t)m * ldc + n0 + 8 * g4 + 4 * hh) = v; }
    }
};
struct EpiSSwiglu {
    bf16_t* H;
    __device__ __forceinline__ void operator()(const f32x16& acc, int m, int n0, int hh) const {
#pragma unroll
        for (int g4 = 0; g4 < 2; ++g4) {
            u32x2 w; w.x = cvtpk(fast_silu(acc[4 * g4]) * acc[4 * g4 + 8], fast_silu(acc[4 * g4 + 1]) * acc[4 * g4 + 9]);
            w.y = cvtpk(fast_silu(acc[4 * g4 + 2]) * acc[4 * g4 + 10], fast_silu(acc[4 * g4 + 3]) * acc[4 * g4 + 11]);
            *(u32x2*)(H + (size_t)m * 2816 + 16 * (n0 >> 5) + 8 * g4 + 4 * hh) = w;
        }
    }
};
struct EpiSIn {
    float *z, *xbc, *q, *ok, *ov, *oconv;
    __device__ __forceinline__ void operator()(const f32x16& acc, int m, int n0, int hh) const {
        const int t = m & 15, b = m >> 4;
        if (n0 < 1536) {
#pragma unroll
            for (int g4 = 0; g4 < 4; ++g4) {
                const f32x4 v = {acc[4 * g4], acc[4 * g4 + 1], acc[4 * g4 + 2], acc[4 * g4 + 3]}; const int col = n0 + 8 * g4 + 4 * hh;
                if (n0 < 512) *(f32x4*)(z + (size_t)m * 512 + col) = v;
                else { *(f32x4*)(xbc + (size_t)m * 1024 + col - 512) = v; if (t >= 13) *(f32x4*)(oconv + (size_t)(b * 3 + t - 13) * 1024 + col - 512) = v; }
            }
        } else if (n0 < 2560) {
            const bool isk = n0 >= 2048; const int cl = (n0 - (isk ? 2048 : 1536)), u64 = cl >> 6, g = (cl >> 5) & 1;
            const float pos = (float)(2048 + t);
            float* dst = (isk ? ok : q) + (size_t)m * 512 + u64 * 64;
#pragma unroll
            for (int g4 = 0; g4 < 2; ++g4) {
                f32x4 o1, o2;
#pragma unroll
                for (int i = 0; i < 4; ++i) {
                    const int d0 = 16 * g + 8 * g4 + 4 * hh + i;
                    float rev = pos * (__builtin_amdgcn_exp2f(-(float)d0 * (13.287712379549449f / 32.f)) * 0.15915494309189535f); rev -= floorf(rev);
                    const float sn = __builtin_amdgcn_sinf(rev), cs = __builtin_amdgcn_cosf(rev);
                    const float x1 = acc[4 * g4 + i], x2 = acc[4 * g4 + 8 + i];
                    o1[i] = x1 * cs - x2 * sn; o2[i] = x2 * cs + x1 * sn;
                }
                const int d0 = 16 * g + 8 * g4 + 4 * hh;
                *(f32x4*)(dst + d0) = o1; *(f32x4*)(dst + d0 + 32) = o2;
            }
        } else {
#pragma unroll
            for (int g4 = 0; g4 < 4; ++g4) { const f32x4 v = {acc[4 * g4], acc[4 * g4 + 1], acc[4 * g4 + 2], acc[4 * g4 + 3]}; *(f32x4*)(ov + (size_t)m * 512 + n0 - 2560 + 8 * g4 + 4 * hh) = v; }
        }
    }
};

DEV void s_row(const FP& p, const float* raw, const float* hin, const float* gpost, float* hout, const float* gpre, bf16_t* xn, float* dtv, int bid, int G, int rot) {
    const int lane = threadIdx.x & 63, wave = __builtin_amdgcn_readfirstlane(threadIdx.x >> 6);
    const int blk = (bid + G - rot) % G;
    for (int r = blk + G * wave; r < NS; r += 8 * G) {
        f32x4 h[4];
#pragma unroll
        for (int j = 0; j < 4; ++j) h[j] = ((const f32x4*)(hin + (size_t)r * 1024))[lane + 64 * j];
        if (raw) {
            f32x4 v[4]; float ss = 0.f;
#pragma unroll
            for (int j = 0; j < 4; ++j) { v[j] = ((const f32x4*)(raw + (size_t)r * 1024))[lane + 64 * j]; ss += v[j].x * v[j].x + v[j].y * v[j].y + v[j].z * v[j].z + v[j].w * v[j].w; }
            const float rs = rsqrtf(wave_sum(ss) * (1.f / 1024.f) + 1e-6f);
#pragma unroll
            for (int j = 0; j < 4; ++j) { const f32x4 g = ((const f32x4*)gpost)[lane + 64 * j]; h[j] += v[j] * rs * g; }
        }
        if (hout) {
#pragma unroll
            for (int j = 0; j < 4; ++j) ((f32x4*)(hout + (size_t)r * 1024))[lane + 64 * j] = h[j];
        }
        if (gpre) {
            float ss = 0.f;
#pragma unroll
            for (int j = 0; j < 4; ++j) ss += h[j].x * h[j].x + h[j].y * h[j].y + h[j].z * h[j].z + h[j].w * h[j].w;
            const float rs = rsqrtf(wave_sum(ss) * (1.f / 1024.f) + 1e-6f);
            float d[8];
#pragma unroll
            for (int k = 0; k < 8; ++k) d[k] = 0.f;
#pragma unroll
            for (int j = 0; j < 4; ++j) {
                const f32x4 g = ((const f32x4*)gpre)[lane + 64 * j]; const f32x4 o = h[j] * rs * g;
                u32x2 w; w.x = pk2(o.x, o.y); w.y = pk2(o.z, o.w);
                ((u32x2*)(xn + (size_t)r * 1024))[lane + 64 * j] = w;
                if (dtv) {
#pragma unroll
                    for (int i = 0; i < 4; ++i) {
                        const float* wp = p.in[9] + (size_t)(4 * (lane + 64 * j) + i) * 3080 + 1536;
                        const f32x4 w0 = *(const f32x4*)wp, w1 = *(const f32x4*)(wp + 4); const float hv = o[i];
                        d[0] += hv * w0.x; d[1] += hv * w0.y; d[2] += hv * w0.z; d[3] += hv * w0.w; d[4] += hv * w1.x; d[5] += hv * w1.y; d[6] += hv * w1.z; d[7] += hv * w1.w;
                    }
                }
            }
            if (dtv) {
#pragma unroll
                for (int k = 0; k < 8; ++k) d[k] = wave_sum(d[k]);
                float mine = d[0];
#pragma unroll
                for (int k = 1; k < 8; ++k) mine = ((lane & 7) == k) ? d[k] : mine;
                const float xx = mine + p.in[12][lane & 7];
                if (lane < 8) dtv[(size_t)r * 8 + lane] = (xx > 20.f) ? xx : log1pf(expf(xx));
            }
        }
    }
}

DEV void s_ssd(const FP& p, LAS unsigned char* lds, int bid, int G, int rot) {
    const int tid = threadIdx.x;
    const float* xbc = (const float*)(p.ws + WS_SMP + SB_XBC); const float* zb = (const float*)(p.ws + WS_SMP + SB_Z); const float* dtv = (const float*)(p.ws + WS_SMP + SB_DTV);
    float* ypre = (float*)(p.ws + WS_SMP + SB_YPRE); float* s_ssm = p.out + 35002368;
    const float* cbuf = p.in[5]; const float* cw = p.in[10]; const float* cb = p.in[11];
    LAS float* act = (LAS float*)lds;
    for (int item = (bid + G - rot) % G; item < 64; item += G) {
        const int b = item >> 3, h = item & 7, g = h >> 2;
        for (int e = tid; e < 16 * 320; e += 512) {
            const int t = e / 320, cc = e % 320;
            const int col = (cc < 64) ? h * 64 + cc : (cc < 192 ? 512 + g * 128 + (cc - 64) : 768 + g * 128 + (cc - 192));
            float a = cb[col];
#pragma unroll
            for (int j = 0; j < 4; ++j) {
                const int tt = t - 3 + j;
                const float u = (tt >= 0) ? xbc[(size_t)(b * 16 + tt) * 1024 + col] : cbuf[(size_t)(b * 3 + tt + 3) * 1024 + col];
                a += cw[j * 1024 + col] * u;
            }
            act[e] = a / (1.f + expf(-a));
        }
        __syncthreads();
        const int pp = tid >> 3, seg = tid & 7;
        float hs[16];
        const size_t sbase = ((size_t)(b * 8 + h) * 64 + pp) * 128 + seg * 16;
#pragma unroll
        for (int i = 0; i < 16; ++i) hs[i] = p.in[4][sbase + i];
        const float a = -expf(p.in[13][h]), D = p.in[14][h];
#pragma unroll 1
        for (int t = 0; t < 16; ++t) {
            const float dt = dtv[(b * 16 + t) * 8 + h];
            const float zz = zb[(size_t)(b * 16 + t) * 512 + h * 64 + pp];
            const float x = act[t * 320 + pp];
            const float dA = expf(dt * a), coef = dt * x;
            float y = 0.f;
#pragma unroll
            for (int i = 0; i < 16; ++i) { hs[i] = dA * hs[i] + coef * act[t * 320 + 64 + seg * 16 + i]; y += act[t * 320 + 192 + seg * 16 + i] * hs[i]; }
            y += __shfl_xor(y, 1); y += __shfl_xor(y, 2); y += __shfl_xor(y, 4);
            if (seg == 0) ypre[(size_t)(b * 16 + t) * 512 + h * 64 + pp] = (y + D * x) * (zz / (1.f + expf(-zz)));
        }
#pragma unroll
        for (int i = 0; i < 16; ++i) s_ssm[sbase + i] = hs[i];
        __syncthreads();
    }
}

DEV bf16x8 cvt8(const float* p, float sc) {
    const f32x4 a = *(const f32x4*)p, b = *(const f32x4*)(p + 4);
    u32x4 w; w.x = cvtpk(a.x * sc, a.y * sc); w.y = cvtpk(a.z * sc, a.w * sc); w.z = cvtpk(b.x * sc, b.y * sc); w.w = cvtpk(b.z * sc, b.w * sc);
    return __builtin_bit_cast(bf16x8, w);
}
DEV void s_attn_part(const FP& p, LAS unsigned char* lds, int bid, int G) {
    const int lane = threadIdx.x & 63, wave = __builtin_amdgcn_readfirstlane(threadIdx.x >> 6), r = lane & 31, hh = lane >> 5;
    const float* q = (const float*)(p.ws + WS_SMP + SB_Q); const float* kn = p.out + 34871296; const float* vn = p.out + 34936832; const float* kp = p.in[2]; const float* vp = p.in[3];
    float* aml = (float*)(p.ws + WS_SMP + SB_AML); float* ao = (float*)(p.ws + WS_SMP + SB_AO);
    for (int it = bid + G * wave; it < 32 * N_ATILE; it += 8 * G) {
        const int bh = it / N_ATILE, tile = it % N_ATILE, b = bh >> 2, h = bh & 3;
        f32x16 S[2][2];
#pragma unroll
        for (int c = 0; c < 2; ++c)
#pragma unroll
            for (int sub = 0; sub < 2; ++sub)
#pragma unroll
                for (int i = 0; i < 16; ++i) S[c][sub][i] = 0.f;
        const float* qrow = q + (size_t)(b * 16 + (r & 15)) * 512 + h * 128 + 8 * hh;
#pragma unroll
        for (int sub = 0; sub < 2; ++sub) {
            int kk = tile * 64 + sub * 32 + r; if (kk > 2063) kk = 2063;
            const float* krow = ((kk < 2048) ? kp + (((size_t)b * 2048 + kk) * 4 + h) * 128 : kn + (((size_t)b * 16 + (kk - 2048)) * 4 + h) * 128) + 8 * hh;
#pragma unroll
            for (int c = 0; c < 2; ++c)
#pragma unroll
                for (int ks = 0; ks < 4; ++ks) S[c][sub] = mfma32(cvt8(krow + c * 64 + 16 * ks, 1.f), cvt8(qrow + c * 64 + 16 * ks, QSCALE), S[c][sub]);
        }
        bf16x8 P[2][4];
#pragma unroll
        for (int c = 0; c < 2; ++c) {
            float mx = -1e30f;
#pragma unroll
            for (int sub = 0; sub < 2; ++sub)
#pragma unroll
                for (int i = 0; i < 16; ++i) {
                    const int key = tile * 64 + sub * 32 + (i & 3) + 8 * (i >> 2) + 4 * hh;
                    if (key > 2063) S[c][sub][i] = -1e30f;
                    mx = fmaxf(mx, S[c][sub][i]);
                }
            mx = half_max(mx);
            float l = 0.f;
#pragma unroll
            for (int sub = 0; sub < 2; ++sub)
#pragma unroll
                for (int i = 0; i < 16; ++i) { S[c][sub][i] = __builtin_amdgcn_exp2f(S[c][sub][i] - mx); l += S[c][sub][i]; }
            l = half_sum(l);
            if (lane < 16) { aml[((size_t)it * 32 + lane * 2 + c) * 2] = mx * 0.6931471805599453f; aml[((size_t)it * 32 + lane * 2 + c) * 2 + 1] = l; }
            P[c][0] = pfrag(S[c][0], 0); P[c][1] = pfrag(S[c][0], 1); P[c][2] = pfrag(S[c][1], 0); P[c][3] = pfrag(S[c][1], 1);
        }
#pragma unroll 1
        for (int eb = 0; eb < 4; ++eb) {
            f32x16 O0, O1;
#pragma unroll
            for (int i = 0; i < 16; ++i) { O0[i] = 0.f; O1[i] = 0.f; }
#pragma unroll
            for (int st = 0; st < 4; ++st) {
                float vv[8];
#pragma unroll
                for (int jj = 0; jj < 8; ++jj) {
                    int kj = tile * 64 + 16 * st + 8 * (jj >> 2) + 4 * hh + (jj & 3); if (kj > 2063) kj = 2063;
                    const float* vrow = (kj < 2048) ? vp + (((size_t)b * 2048 + kj) * 4 + h) * 128 : vn + (((size_t)b * 16 + (kj - 2048)) * 4 + h) * 128;
                    vv[jj] = vrow[eb * 32 + r];
                }
                u32x4 w; w.x = cvtpk(vv[0], vv[1]); w.y = cvtpk(vv[2], vv[3]); w.z = cvtpk(vv[4], vv[5]); w.w = cvtpk(vv[6], vv[7]);
                const bf16x8 vf = __builtin_bit_cast(bf16x8, w);
                O0 = mfma32(vf, P[0][st], O0); O1 = mfma32(vf, P[1][st], O1);
            }
            if (r < 16) {
#pragma unroll
                for (int g4 = 0; g4 < 4; ++g4) {
                    const int e0 = eb * 32 + 8 * g4 + 4 * hh;
                    *(f32x4*)(ao + ((size_t)it * 32 + r * 2 + 0) * 128 + e0) = (f32x4){O0[4 * g4], O0[4 * g4 + 1], O0[4 * g4 + 2], O0[4 * g4 + 3]};
                    *(f32x4*)(ao + ((size_t)it * 32 + r * 2 + 1) * 128 + e0) = (f32x4){O1[4 * g4], O1[4 * g4 + 1], O1[4 * g4 + 2], O1[4 * g4 + 3]};
                }
            }
        }
    }
}
DEV void s_attn_comb(const FP& p, int bid, int G, int rot) {
    const int lane = threadIdx.x & 63, wave = __builtin_amdgcn_readfirstlane(threadIdx.x >> 6);
    const float* aml = (const float*)(p.ws + WS_SMP + SB_AML); const float* ao = (const float*)(p.ws + WS_SMP + SB_AO); const float* ypre = (const float*)(p.ws + WS_SMP + SB_YPRE);
    bf16_t* cat = (bf16_t*)(p.ws + WS_SMP + SB_CAT);
    const float lam_init = 0.2f;
    const float lam = expf(wave_sum(p.in[16][lane] * p.in[17][lane])) - expf(wave_sum(p.in[18][lane] * p.in[19][lane])) + lam_init;
    const int blk = (bid + G - rot) % G;
    for (int it = blk + G * wave; it < 512 + 256; it += 8 * G) {
        if (it < 512) {
            const int bh = it >> 4, qi = it & 15, b = bh >> 2, h = bh & 3;
            float o[2][2];
#pragma unroll
            for (int c = 0; c < 2; ++c) {
                const float mj = (lane < N_ATILE) ? aml[((size_t)(bh * N_ATILE + lane) * 32 + qi * 2 + c) * 2] : -1e30f;
                const float lj = (lane < N_ATILE) ? aml[((size_t)(bh * N_ATILE + lane) * 32 + qi * 2 + c) * 2 + 1] : 0.f;
                const float M = wave_max(mj), wj = expf(mj - M), L = wave_sum(lj * wj);
                float ax = 0.f, ay = 0.f;
#pragma unroll 11
                for (int j = 0; j < N_ATILE; ++j) {
                    const float w = __shfl(wj, j);
                    const float2 v = ((const float2*)(ao + ((size_t)(bh * N_ATILE + j) * 32 + qi * 2 + c) * 128))[lane];
                    ax += w * v.x; ay += w * v.y;
                }
                o[c][0] = ax / L; o[c][1] = ay / L;
            }
            const float ox = o[0][0] - lam * o[1][0], oy = o[0][1] - lam * o[1][1];
            const float ms = wave_sum(ox * ox + oy * oy) * (1.f / 128.f);
            const float rs = rsqrtf(ms + 1e-5f) * (1.f - lam_init);
            const float2 w = ((const float2*)p.in[20])[lane];
            ((unsigned*)(cat + (size_t)(b * 16 + qi) * 1024 + 512 + h * 128))[lane] = pk2(ox * rs * w.x, oy * rs * w.y);
        } else {
            const int i2 = it - 512, row = i2 >> 1, g = i2 & 1;
            const f32x4 v = ((const f32x4*)(ypre + (size_t)row * 512 + g * 256))[lane];
            const float rs = rsqrtf(wave_sum(v.x * v.x + v.y * v.y + v.z * v.z + v.w * v.w) * (1.f / 256.f) + 1e-5f);
            const f32x4 ww = ((const f32x4*)(p.in[15] + g * 256))[lane];
            u32x2 o; o.x = pk2(v.x * rs * ww.x, v.y * rs * ww.y); o.y = pk2(v.z * rs * ww.z, v.w * rs * ww.w);
            ((u32x2*)(cat + (size_t)row * 1024 + g * 256))[lane] = o;
        }
    }
}
DEV void s_xattn_part(const FP& p, LAS unsigned char* lds, int bid, int G, int rot) {
    const int lane = threadIdx.x & 63, wave = __builtin_amdgcn_readfirstlane(threadIdx.x >> 6), r = lane & 31, hh = lane >> 5;
    const float* qx = (const float*)(p.ws + WS_SMP + SB_QX); const float* mk = p.in[6]; const float* mv = p.in[7];
    float* xml = (float*)(p.ws + WS_SMP + SB_XML); float* xo = (float*)(p.ws + WS_SMP + SB_XO);
    const int blk = (bid + G - rot) % G;
    for (int it = blk + G * wave; it < 128; it += 8 * G) {
        const int bh = it >> 2, tile = it & 3, b = bh >> 2, h = bh & 3;
        f32x16 S[2];
#pragma unroll
        for (int sub = 0; sub < 2; ++sub)
#pragma unroll
            for (int i = 0; i < 16; ++i) S[sub][i] = 0.f;
        const float* qrow = qx + (size_t)(b * 16 + (r & 15)) * 1024 + h * 256 + 8 * hh;
#pragma unroll 4
        for (int ks = 0; ks < 16; ++ks) {
            const bf16x8 qf = cvt8(qrow + 16 * ks, 0.0625f * 1.4426950408889634f);
#pragma unroll
            for (int sub = 0; sub < 2; ++sub) {
                const float* krow = mk + (((size_t)b * 256 + tile * 64 + sub * 32 + r) * 4 + h) * 256 + 8 * hh;
                S[sub] = mfma32(cvt8(krow + 16 * ks, 1.f), qf, S[sub]);
            }
        }
        float mx = half_max(fmaxf(max16(S[0]), max16(S[1])));
        float l = 0.f;
#pragma unroll
        for (int sub = 0; sub < 2; ++sub)
#pragma unroll
            for (int i = 0; i < 16; ++i) { S[sub][i] = __builtin_amdgcn_exp2f(S[sub][i] - mx); l += S[sub][i]; }
        l = half_sum(l);
        if (lane < 16) { xml[((size_t)it * 16 + lane) * 2] = mx * 0.6931471805599453f; xml[((size_t)it * 16 + lane) * 2 + 1] = l; }
        bf16x8 P[4];
        P[0] = pfrag(S[0], 0); P[1] = pfrag(S[0], 1); P[2] = pfrag(S[1], 0); P[3] = pfrag(S[1], 1);
#pragma unroll 1
        for (int eb = 0; eb < 8; ++eb) {
            f32x16 O;
#pragma unroll
            for (int i = 0; i < 16; ++i) O[i] = 0.f;
#pragma unroll
            for (int st = 0; st < 4; ++st) {
                float vv[8];
#pragma unroll
                for (int jj = 0; jj < 8; ++jj) {
                    const int kj = tile * 64 + 16 * st + 8 * (jj >> 2) + 4 * hh + (jj & 3);
                    vv[jj] = mv[(((size_t)b * 256 + kj) * 4 + h) * 256 + eb * 32 + r];
                }
                u32x4 w; w.x = cvtpk(vv[0], vv[1]); w.y = cvtpk(vv[2], vv[3]); w.z = cvtpk(vv[4], vv[5]); w.w = cvtpk(vv[6], vv[7]);
                O = mfma32(__builtin_bit_cast(bf16x8, w), P[st], O);
            }
            if (r < 16) {
#pragma unroll
                for (int g4 = 0; g4 < 4; ++g4) *(f32x4*)(xo + ((size_t)it * 16 + r) * 256 + eb * 32 + 8 * g4 + 4 * hh) = (f32x4){O[4 * g4], O[4 * g4 + 1], O[4 * g4 + 2], O[4 * g4 + 3]};
            }
        }
    }
}
DEV void s_xattn_comb(const FP& p, int bid, int G, int rot) {
    const int lane = threadIdx.x & 63, wave = __builtin_amdgcn_readfirstlane(threadIdx.x >> 6);
    const float* xml = (const float*)(p.ws + WS_SMP + SB_XML); const float* xo = (const float*)(p.ws + WS_SMP + SB_XO);
    bf16_t* ox = (bf16_t*)(p.ws + WS_SMP + SB_OX);
    const int blk = (bid + G - rot) % G;
    for (int it = blk + G * wave; it < 512; it += 8 * G) {
        const int bh = it >> 4, qi = it & 15, b = bh >> 2, h = bh & 3;
        float m[4], l[4];
#pragma unroll
        for (int j = 0; j < 4; ++j) { m[j] = xml[((size_t)(bh * 4 + j) * 16 + qi) * 2]; l[j] = xml[((size_t)(bh * 4 + j) * 16 + qi) * 2 + 1]; }
        const float M = fmaxf(fmaxf(m[0], m[1]), fmaxf(m[2], m[3]));
        float L = 0.f; f32x4 acc = {0.f, 0.f, 0.f, 0.f};
#pragma unroll
        for (int j = 0; j < 4; ++j) { const float w = expf(m[j] - M); L += l[j] * w; acc += ((const f32x4*)(xo + ((size_t)(bh * 4 + j) * 16 + qi) * 256))[lane] * w; }
        const float il = 1.f / L;
        u32x2 o; o.x = pk2(acc.x * il, acc.y * il); o.y = pk2(acc.z * il, acc.w * il);
        ((u32x2*)(ox + (size_t)(b * 16 + qi) * 1024 + h * 256))[lane] = o;
    }
}

namespace cg = cooperative_groups;


DEV unsigned long long rf64(unsigned long long v) {
    const unsigned lo = __builtin_amdgcn_readfirstlane((unsigned)v), hi = __builtin_amdgcn_readfirstlane((unsigned)(v >> 32));
    return ((unsigned long long)hi << 32) | lo;
}
DEV FP fp_from_lds(const LAS unsigned long long* tab) {
    asm volatile("" ::: "memory");
    FP q;
#pragma unroll
    for (int i = 0; i < 36; ++i) q.in[i] = (const float*)rf64(tab[i]);
    q.out = (float*)rf64(tab[36]); q.ws = (unsigned char*)rf64(tab[37]);
    return q;
}

constexpr int CW_TEAM = 8192, CW_QUEUE = 4160;
constexpr int TEAM = 64;
DEV void sample_chain(const FP& p, LAS unsigned char* lds, int tb, int T, const XcdBarrier& tbar) {
    unsigned char* sb = p.ws + WS_SMP;
    float* ys = p.out + 16777216; const float* xs = p.in[1];
    s_gemm((const bf16_t*)(sb + SB_XN), (const bf16_t*)(p.ws + WS_W_IN), 3072, 1024, lds, tb, T, 0,
           EpiSIn{(float*)(sb + SB_Z), (float*)(sb + SB_XBC), (float*)(sb + SB_Q), p.out + 34871296, p.out + 34936832, p.out + 35526656});
    xcd_barrier(tbar);
    s_ssd(p, lds, tb, T, 0);
    s_attn_part(p, lds, tb, T);
    xcd_barrier(tbar);
    s_attn_comb(p, tb, T, 0);
    xcd_barrier(tbar);
    s_gemm((const bf16_t*)(sb + SB_CAT), (const bf16_t*)(p.ws + WS_W_OUT), 1024, 1024, lds, tb, T, 0, EpiSF32{(float*)(sb + SB_MIX), 1024, 1.f});
    xcd_barrier(tbar);
    s_row(p, (const float*)(sb + SB_MIX), xs, p.in[28], ys, p.in[29], (bf16_t*)(sb + SB_XN), nullptr, tb, T, 0);
    xcd_barrier(tbar);
    s_gemm((const bf16_t*)(sb + SB_XN), (const bf16_t*)(p.ws + WS_W_Q), 1024, 1024, lds, tb, T, 0, EpiSF32{(float*)(sb + SB_QX), 1024, 1.f});
    xcd_barrier(tbar);
    s_xattn_part(p, lds, tb, T, 0);
    xcd_barrier(tbar);
    s_xattn_comb(p, tb, T, 0);
    xcd_barrier(tbar);
    s_gemm((const bf16_t*)(sb + SB_OX), (const bf16_t*)(p.ws + WS_W_O), 1024, 1024, lds, tb, T, 0, EpiSF32{(float*)(sb + SB_MIX), 1024, 1.f});
    xcd_barrier(tbar);
    s_row(p, (const float*)(sb + SB_MIX), ys, p.in[30], ys, p.in[31], (bf16_t*)(sb + SB_XN), nullptr, tb, T, 0);
    xcd_barrier(tbar);
    s_gemm((const bf16_t*)(sb + SB_XN), (const bf16_t*)(p.ws + WS_W_GU), 5632, 1024, lds, tb, T, 0, EpiSSwiglu{(bf16_t*)(sb + SB_HID)});
    xcd_barrier(tbar);
    s_gemm((const bf16_t*)(sb + SB_HID), (const bf16_t*)(p.ws + WS_W_DOWN), 1024, 2816, lds, tb, T, 0, EpiSF32{(float*)(sb + SB_MIX), 1024, 1.f});
    xcd_barrier(tbar);
    s_row(p, (const float*)(sb + SB_MIX), ys, p.in[32], ys, nullptr, nullptr, nullptr, tb, T, 0);
    __syncthreads();
}
DEV void p3_queue(const FP& p, LAS unsigned char* lds, int bid) {
    unsigned* qh = (unsigned*)(p.ws + WS_CTL) + CW_QUEUE;
    volatile LAS int* slot = (volatile LAS int*)(lds + LDS_BYTES - 32);
    const AttnCtx ctx = attn_setup(p, lds);
    for (;;) {
        __syncthreads();
        if (threadIdx.x == 0) {
            int u = -1;
            for (int k = 0; k < 8 && u < 0; ++k) {
                const int q = (bid + k) & 7;
                const unsigned v = __hip_atomic_fetch_add(qh + 64 * q, 1u, __ATOMIC_RELAXED, __HIP_MEMORY_SCOPE_AGENT);
                if (v < 80u) u = q * 80 + (int)v;
            }
            slot[0] = u;
        }
        __syncthreads();
        const int u = slot[0];
        if (u < 0) break;
        const int q = u / 80, v = u % 80;
        if (v < 16) ssd2_item(p, q * 16 + v);
        else attn_unit(p, lds, ctx, q, 63 - (v - 16));
    }
}
__global__ void __launch_bounds__(512, 2) k_mega(FP p0) {
    extern __shared__ __attribute__((aligned(16))) unsigned char lds_raw[];
    LAS unsigned char* lds = (LAS unsigned char*)lds_raw;
    cg::grid_group grid = cg::this_grid();
    const int G = gridDim.x, bid = blockIdx.x, ngw = G * 8;
#define IDS() int tid_ = threadIdx.x; asm volatile("" : "+v"(tid_)); const int lane = tid_ & 63, wave = __builtin_amdgcn_readfirstlane(tid_ >> 6), gw = bid * 8 + wave; (void)lane; (void)gw
    LAS unsigned long long* tab = (LAS unsigned long long*)(lds + LDS_BYTES - 512);
    if (threadIdx.x < 36) tab[threadIdx.x] = (unsigned long long)p0.in[threadIdx.x];
    if (threadIdx.x == 36) tab[36] = (unsigned long long)p0.out;
    if (threadIdx.x == 37) tab[37] = (unsigned long long)p0.ws;
#define PH(...) do { const FP p = fp_from_lds(tab); float* y = p.out; unsigned char* sb = p.ws + WS_SMP; (void)y; (void)sb; __VA_ARGS__ } while (0)
    volatile LAS unsigned* MISC = (volatile LAS unsigned*)(lds + LDS_BYTES - 64);
    if (threadIdx.x < 16) MISC[threadIdx.x] = 0u;
    __syncthreads();
    XcdBarrier bar = xcd_barrier_post((unsigned*)(p0.ws + WS_CTL), MISC);
    PH( { IDS(); phase_prep_x(p, lds, gw, ngw, wave, lane); phase_prep_ffn(p, lds, gw, ngw, wave, lane); phase_prep_mix(p, lds, gw, ngw, wave, lane); } );
    PH( s_row(p, nullptr, p.in[1], nullptr, nullptr, p.in[27], (bf16_t*)(sb + SB_XN), (float*)(sb + SB_DTV), bid, G, 0); );
    grid.sync();
    PH( phase_inproj(p, lds, G, bid); );
    xcd_barrier(bar);
    PH( phase_ssd1(p, lds, G, bid); );
    PH( phase_memkv(p, lds, G, bid); );
    xcd_barrier(bar);
    PH( { const int T = (G >= 2 * TEAM) ? TEAM : 1; if (bid >= G - T) { XcdBarrier tbar = xcd_barrier_post((unsigned*)(p.ws + WS_CTL) + CW_TEAM, (volatile LAS unsigned*)(lds + LDS_BYTES - 48), (unsigned)T); sample_chain(p, lds, bid - (G - T), T, tbar); } } );
    PH( p3_queue(p, lds, bid); );
    xcd_barrier(bar);
    PH( phase_ssd3(p, lds, G, bid); );
    xcd_barrier(bar);
    PH( phase_outproj(p, lds, G, bid); );
    xcd_barrier(bar);
    PH( { IDS(); row_phase((const bf16_t*)(p.ws + WS_RAW), p.in[0], p.in[28], y, p.in[29], (bf16_t*)(p.ws + WS_XN), MP, gw, ngw, lane); } );
    xcd_barrier(bar);
    PH( phase_wq(p, lds, G, bid); );
    xcd_barrier(bar);
    PH( phase_xattn(p, lds, G, bid); );
    xcd_barrier(bar);
    PH( phase_wo(p, lds, G, bid); );
    xcd_barrier(bar);
    PH( { IDS(); row_phase((const bf16_t*)(p.ws + WS_RAW), y, p.in[30], y, p.in[31], (bf16_t*)(p.ws + WS_XN), MP, gw, ngw, lane); } );
    xcd_barrier(bar);
    PH( phase_ffn_gu(p, lds, G, bid); );
    xcd_barrier(bar);
    PH( phase_ffn_down(p, lds, G, bid); );
    xcd_barrier(bar);
    PH( { IDS(); row_phase((const bf16_t*)(p.ws + WS_RAW), y, p.in[32], y, nullptr, nullptr, MP, gw, ngw, lane); } );
}

extern "C" void kernel_launch(void* const* d_in, const int* in_sizes, int n_in, void* d_out, int out_size, void* d_ws, size_t ws_size, hipStream_t stream) {
    static int grid = 0;
    if (!grid) {
        int dev = 0, cus = 0, per_cu = 0;
        (void)hipGetDevice(&dev);
        (void)hipDeviceGetAttribute(&cus, hipDeviceAttributeMultiprocessorCount, dev);
        (void)hipFuncSetAttribute((const void*)k_mega, hipFuncAttributeMaxDynamicSharedMemorySize, LDS_BYTES);
        (void)hipOccupancyMaxActiveBlocksPerMultiprocessor(&per_cu, (const void*)k_mega, 512, LDS_BYTES);
        if (per_cu < 1) per_cu = 1;
        grid = cus * per_cu;
        if (grid > 256) grid = 256;
        if (n_in != 36 || ws_size < 256 * MiB) fprintf(stderr, "kernel_launch: unexpected n_in %d / ws_size %zu\n", n_in, ws_size);
    }
    (void)hipMemsetAsync((unsigned char*)d_ws + WS_CTL, 0, 65536, stream);
    FP p{};
    for (int i = 0; i < 36; ++i) p.in[i] = (const float*)d_in[i];
    p.out = (float*)d_out; p.ws = (unsigned char*)d_ws;
    void* args[] = {&p};
    hipError_t e = hipLaunchCooperativeKernel((const void*)k_mega, dim3(grid), dim3(512), args, LDS_BYTES, stream);
    if (e != hipSuccess) fprintf(stderr, "cooperative launch failed: %s (grid %d)\n", hipGetErrorString(e), grid);
}
```

```cpp
#include <hip/hip_runtime.h>
#include <cstdint>
#include <cstdio>
#include <hip/hip_cooperative_groups.h>

#define DEV static __device__ __forceinline__
#define LAS __attribute__((address_space(3)))
#define WAVE_SYNC() asm volatile("s_waitcnt lgkmcnt(0)" ::: "memory")

DEV float wave_sum(float v) {
#pragma unroll
    for (int o = 32; o > 0; o >>= 1) v += __shfl_xor(v, o);
    return v;
}
DEV float wave_max(float v) {
#pragma unroll
    for (int o = 32; o > 0; o >>= 1) v = fmaxf(v, __shfl_xor(v, o));
    return v;
}
typedef float nf4 __attribute__((ext_vector_type(4)));
DEV float4 lds_ld4(const LAS float* p) { const nf4 v = *(const LAS nf4*)p; float4 r; r.x = v[0]; r.y = v[1]; r.z = v[2]; r.w = v[3]; return r; }
DEV float silu_f(float x) { return x / (1.f + expf(-x)); }


typedef unsigned short bf16_t;
typedef float f32x4 __attribute__((ext_vector_type(4)));
typedef float f32x16 __attribute__((ext_vector_type(16)));
typedef short bf16x8 __attribute__((ext_vector_type(8)));
typedef short s16x4 __attribute__((ext_vector_type(4)));
typedef unsigned u32x4 __attribute__((ext_vector_type(4)));
typedef unsigned u32x2 __attribute__((ext_vector_type(2)));

constexpr size_t MiB = 1u << 20;
constexpr size_t WS_W_IN = 0, WS_W_OUT = 6 * MiB, WS_W_Q = 8 * MiB, WS_W_KV = 10 * MiB, WS_W_O = 14 * MiB, WS_W_GU = 16 * MiB, WS_W_DOWN = 27 * MiB;
constexpr size_t WS_CTL = 33 * MiB, WS_DTV = 34 * MiB, WS_CDEC = 34 * MiB + 512 * 1024, WS_MN = 35 * MiB;
constexpr size_t WS_XN = 36 * MiB, WS_CAT = 68 * MiB, WS_QX = 68 * MiB, WS_Q = 100 * MiB, WS_K = 116 * MiB, WS_RAW = 100 * MiB;
constexpr size_t WS_ZX = 132 * MiB, WS_OX = 132 * MiB, WS_V = 180 * MiB, WS_ST = 196 * MiB, WS_HID = 132 * MiB, WS_KM = 228 * MiB, WS_VM = 229 * MiB, WS_SMP = 230 * MiB;
constexpr int MP = 16384;
constexpr int LDS_BYTES = 147456;

DEV unsigned f2bf(float f) { unsigned u = __builtin_bit_cast(unsigned, f); return (u + 0x7fffu + ((u >> 16) & 1u)) >> 16; }
DEV unsigned pk2(float lo, float hi) { return f2bf(lo) | (f2bf(hi) << 16); }
DEV float bflo(unsigned w) { return __builtin_bit_cast(float, w << 16); }
DEV float bfhi(unsigned w) { return __builtin_bit_cast(float, w & 0xffff0000u); }
DEV float fast_silu(float x) { return x * __builtin_amdgcn_rcpf(1.f + __builtin_amdgcn_exp2f(-1.4426950408889634f * x)); }

struct FP {
    const float* in[36];
    float* out;
    unsigned char* ws;
};

template <class RowMap>
DEV void transpose_item(const float* W, int K, int N, bf16_t* WT, int item, LAS float* scr, int lane, RowMap rm) {
    const int nblk = (N + 31) / 32, kb = item / nblk, nb = item % nblk, k0 = 64 * kb, n0 = 32 * nb;
    const int ncol = n0 + (lane & 31);
#pragma unroll 8
    for (int i = 0; i < 32; ++i) { const int kk = 2 * i + (lane >> 5); scr[kk * 33 + (lane & 31)] = (ncol < N) ? W[(size_t)(k0 + kk) * N + ncol] : 0.f; }
    WAVE_SYNC();
    const int c = lane & 7;
#pragma unroll
    for (int j = 0; j < 4; ++j) {
        const int n = (lane >> 3) + 8 * j; const LAS float* s = scr + (8 * c) * 33 + n;
        const int src = n0 + n; const int dst = (src < N) ? rm(src) : -1;
        u32x4 o; o.x = pk2(s[0 * 33], s[1 * 33]); o.y = pk2(s[2 * 33], s[3 * 33]); o.z = pk2(s[4 * 33], s[5 * 33]); o.w = pk2(s[6 * 33], s[7 * 33]);
        if (dst >= 0) *(u32x4*)(WT + (size_t)dst * K + k0 + 8 * c) = o;
    }
    WAVE_SYNC();
}
struct RmPlain { int off; __device__ __forceinline__ int operator()(int n) const { return off + n; } };
struct RmGU { int up; __device__ __forceinline__ int operator()(int n) const { return 32 * (n >> 4) + 16 * up + (n & 15); } };
struct RmIn {
    __device__ __forceinline__ int operator()(int n) const {
        if (n < 1536) return n;
        if (n < 1544) return -1;
        const int m = n - 1544;
        if (m < 1024) { const int u = m >> 6, d = m & 63; return 1536 + 64 * u + 32 * ((d & 31) >> 4) + 16 * (d >> 5) + (d & 15); }
        return 1536 + m;
    }
};

DEV void row_phase(const bf16_t* raw, const float* hin, const float* gpost, float* hout, const float* gpre, bf16_t* xn, int M, int gw, int ngw, int lane) {
    for (int r = gw; r < M; r += ngw) {
        f32x4 h[4];
#pragma unroll
        for (int j = 0; j < 4; ++j) h[j] = ((const f32x4*)(hin + (size_t)r * 1024))[lane + 64 * j];
        if (raw) {
            f32x4 v[4]; float ss = 0.f;
#pragma unroll
            for (int j = 0; j < 4; ++j) {
                const u32x2 w = ((const u32x2*)(raw + (size_t)r * 1024))[lane + 64 * j];
                v[j] = (f32x4){bflo(w.x), bfhi(w.x), bflo(w.y), bfhi(w.y)};
                ss += v[j].x * v[j].x + v[j].y * v[j].y + v[j].z * v[j].z + v[j].w * v[j].w;
            }
            const float rs = rsqrtf(wave_sum(ss) * (1.f / 1024.f) + 1e-6f);
#pragma unroll
            for (int j = 0; j < 4; ++j) { const f32x4 g = ((const f32x4*)gpost)[lane + 64 * j]; h[j] += v[j] * rs * g; }
        }
        if (hout) {
#pragma unroll
            for (int j = 0; j < 4; ++j) ((f32x4*)(hout + (size_t)r * 1024))[lane + 64 * j] = h[j];
        }
        if (gpre) {
            float ss = 0.f;
#pragma unroll
            for (int j = 0; j < 4; ++j) ss += h[j].x * h[j].x + h[j].y * h[j].y + h[j].z * h[j].z + h[j].w * h[j].w;
            const float rs = rsqrtf(wave_sum(ss) * (1.f / 1024.f) + 1e-6f);
#pragma unroll
            for (int j = 0; j < 4; ++j) {
                const f32x4 g = ((const f32x4*)gpre)[lane + 64 * j]; const f32x4 o = h[j] * rs * g;
                u32x2 w; w.x = pk2(o.x, o.y); w.y = pk2(o.z, o.w);
                ((u32x2*)(xn + (size_t)r * 1024))[lane + 64 * j] = w;
            }
        }
    }
}


#define RLX_AGENT __ATOMIC_RELAXED, __HIP_MEMORY_SCOPE_AGENT
#define LDS_WAIT() asm volatile("s_waitcnt lgkmcnt(0)" ::: "memory")
#define VM_WAIT() asm volatile("s_waitcnt vmcnt(0)" ::: "memory")
__device__ __forceinline__ unsigned long long rt() { return __builtin_amdgcn_s_memrealtime(); }
#define XB_TMO      128
#define XB_XCNT(j)  (256  + 64 * (j))
#define XB_XSUB(j)  (1280 + 64 * (j))
#define XB_XGEN(j)  (2304 + 64 * (j))
#define XB_TOP      3328
#define XB_TOPGEN   3392
#define XCD_BAR_WORDS 3456
#define XB_SPIN_CAP (1u << 18)

__device__ __forceinline__ unsigned xb_ld(unsigned* p)              { return __hip_atomic_load(p, __ATOMIC_RELAXED, __HIP_MEMORY_SCOPE_AGENT); }
__device__ __forceinline__ unsigned xb_add(unsigned* p, unsigned v) { return __hip_atomic_fetch_add(p, v, __ATOMIC_RELAXED, __HIP_MEMORY_SCOPE_AGENT); }
__device__ __forceinline__ unsigned xb_xcc_id() { return (unsigned)__builtin_amdgcn_s_getreg((3 << 11) | 20) & 0xFu; }
#define XB_SPIN(cond, bar) do { unsigned _sp = 0; while (cond) { __builtin_amdgcn_s_sleep(1); \
    if ((++_sp & 255u) == 0u) { if (xb_ld(&(bar)[XB_TMO])) break; if (_sp > XB_SPIN_CAP) { atomicAdd(&(bar)[XB_TMO], 1u); break; } } } } while (0)

struct XcdBarrier {
    unsigned* bar; unsigned x; unsigned total;
    volatile LAS unsigned* st;
};

__device__ __forceinline__ XcdBarrier xcd_barrier_post(unsigned* bar, volatile LAS unsigned* st, unsigned total = 0u) {
    XcdBarrier b; b.bar = bar; b.x = xb_xcc_id(); b.st = st; b.total = total;
    if (threadIdx.x == 0) (void)xb_add(&bar[XB_XCNT(b.x)], 1u);
    return b;
}
__device__ __forceinline__ void xcd_barrier_complete(unsigned* bar, unsigned x, unsigned& nloc, unsigned& nx, unsigned total) {
    const unsigned G = total ? total : gridDim.x * gridDim.y * gridDim.z;
    unsigned sum, cnt, mine, sp = 0u;
    for (;;) {
        sum = 0u; cnt = 0u; mine = 0u;
#pragma unroll
        for (unsigned j = 0; j < 16; ++j) { const unsigned c = xb_ld(&bar[XB_XCNT(j)]); sum += c; cnt += (c > 0u) ? 1u : 0u; mine = (j == x) ? c : mine; }
        if (sum == G) break;
        __builtin_amdgcn_s_sleep(1);
        if ((++sp & 255u) == 0u) { if (xb_ld(&bar[XB_TMO])) break; if (sp > XB_SPIN_CAP) { atomicAdd(&bar[XB_TMO], 1u); break; } }
    }
    nloc = mine > 0u ? mine : 1u; nx = cnt > 0u ? cnt : 1u;
}

__device__ __forceinline__ void xcd_barrier(const XcdBarrier& b) {
    asm volatile("s_waitcnt vmcnt(0)" ::: "memory");
    __syncthreads();
    if (threadIdx.x == 0) {
        unsigned* bar = b.bar;
        __builtin_amdgcn_s_waitcnt(0);
        unsigned nloc = b.st[0], nx = b.st[1];
        if (nloc == 0u) { xcd_barrier_complete(bar, b.x, nloc, nx, b.total); b.st[0] = nloc; b.st[1] = nx; }
        const unsigned old = xb_add(&bar[XB_XSUB(b.x)], 1u);
        const unsigned gen = old / nloc;
        if (old + 1u == (gen + 1u) * nloc) {
            __builtin_amdgcn_fence(__ATOMIC_RELEASE, "agent");
            asm volatile("s_waitcnt vmcnt(0)" ::: "memory");
            const unsigned og = xb_add(&bar[XB_TOP], 1u);
            const unsigned tg = og / nx;
            if (og + 1u == (tg + 1u) * nx) xb_add(&bar[XB_TOPGEN], 1u);
            else XB_SPIN(xb_ld(&bar[XB_TOPGEN]) == tg, bar);
            __builtin_amdgcn_fence(__ATOMIC_ACQUIRE, "agent");
            xb_add(&bar[XB_XGEN(b.x)], 1u);
            asm volatile("s_waitcnt vmcnt(0)" ::: "memory");
        } else {
            XB_SPIN(xb_ld(&bar[XB_XGEN(b.x)]) == gen, bar);
            __builtin_amdgcn_fence(__ATOMIC_ACQUIRE, "agent");
            asm volatile("s_waitcnt vmcnt(0)" ::: "memory");
        }
    }
    __syncthreads();
}
namespace pg8 {
#define PG8_LAS __attribute__((address_space(3)))
typedef unsigned short bf16_t;
typedef short bf16x8 __attribute__((ext_vector_type(8)));
typedef float f32x4 __attribute__((ext_vector_type(4)));
typedef unsigned u32x4 __attribute__((ext_vector_type(4)));
constexpr int BM = 256, BK = 64, HALF = 128, HTB = HALF * BK * 2  , STAGE_BYTES = 8 * HTB, NXCD = 8, WGM = 8;

__host__ __device__ __forceinline__ int lds_byte(int r, int c) { const int st = (r >> 4) * 2 + (c >> 5), rr = r & 15, cc = c & 31, ob = rr * 64 + cc * 2; return st * 1024 + (ob ^ (((ob >> 9) & 1) << 5)); }
__host__ __device__ __forceinline__ void stage_rc(int b, int& R, int& C) { const int st = b / 1024, sb = b % 1024, swz = sb ^ (((sb >> 9) & 1) << 5); R = (st >> 1) * 16 + swz / 64; C = (st & 1) * 32 + (swz % 64) / 2; }
__host__ __device__ __forceinline__ int perm32(int rho) { const int n = rho >> 4, i = rho & 15; return 8 * (i >> 2) + 4 * n + (i & 3); }

struct Unit { int pm, pn; };
struct Gemm { const bf16_t* A; const bf16_t* Bt; int M, N, K; };

struct StaticOrder {
    int nM, nN, nwg, G, c;
    __host__ __device__ void init(int M, int N, int G_, int c_) { nM = M / BM; nN = N / BM; nwg = nM * nN; G = G_; c = c_; }
    __host__ __device__ bool next(int i, Unit& u) const {
        const long L = (long)i * G + c; if (L >= nwg) return false;
        int wgid = (int)L; { const int q = nwg / NXCD, r = nwg % NXCD, xcd = wgid % NXCD, off = wgid / NXCD; wgid = (xcd < r ? xcd * (q + 1) : r * (q + 1) + (xcd - r) * q) + off; }
        const int nig = WGM * nN, gid = wgid / nig, fm = gid * WGM, gsz = (nM - fm) < WGM ? (nM - fm) : WGM;
        u.pm = fm + ((wgid % nig) % gsz); u.pn = (wgid % nig) / gsz; return true;
    }
    __device__ __forceinline__ void a_ready(const Unit&) const {}
    __device__ __forceinline__ void done(const Unit&) const {}
};

__device__ __forceinline__ unsigned cvt_pk_bf16(float lo, float hi) { unsigned r; asm volatile("v_cvt_pk_bf16_f32 %0, %1, %2" : "=v"(r) : "v"(lo), "v"(hi)); return r; }
typedef float f32x2 __attribute__((ext_vector_type(2)));
__device__ __forceinline__ f32x2 gelu_pk(f32x2 v) {
    const f32x2 av = __builtin_elementwise_abs(v), d = av * 0.2316418882f + 1.0f;
    f32x2 t; t.x = __builtin_amdgcn_rcpf(d.x); t.y = __builtin_amdgcn_rcpf(d.y);
    f32x2 q = t * 0.5307027145f + (-0.7265760135f); q = q * t + 0.7107068705f; q = q * t + (-0.142248368f); q = q * t + 0.127414796f; q = q * t;
    const f32x2 s = (v * v) * (-0.72134752044f);
    f32x2 e; e.x = __builtin_amdgcn_exp2f(s.x); e.y = __builtin_amdgcn_exp2f(s.y);
    const f32x2 m = v * (q * e), r = v - m;
    f32x2 o; o.x = v.x < 0.f ? m.x : r.x; o.y = v.y < 0.f ? m.y : r.y; return o;
}

template <int ACT  > struct EpiBf16 {
    static constexpr bool PERM = true, AFTER_DRAIN = false; static_assert(ACT == 0 || ACT == 1, "EpiBf16: ACT is 0 (none) or 1 (gelu_pk)");
    bf16_t* O; int ldc; const float* bias; int split_cols; size_t split_stride; float scale0;
    __device__ __forceinline__ void operator()(const f32x4 (&acc)[2][2][4][2], const Unit& u, int wr, int wc, int fr, int fq) const {
        const int row0 = u.pm * BM + wr * 64 + fr; int colt = u.pn * BM; bf16_t* base = O;
        float sc = 1.f; if (split_cols) { const int t = colt / split_cols; base += (size_t)t * split_stride; colt -= t * split_cols; if (t == 0) sc = scale0; }
        const int col0 = colt + wc * 32 + 8 * fq, bcol0 = u.pn * BM + wc * 32 + 8 * fq;
        f32x4 bv[2][2];
#pragma unroll
        for (int bj = 0; bj < 2; ++bj)
#pragma unroll
            for (int n = 0; n < 2; ++n) bv[bj][n] = bias ? *(const f32x4*)(bias + bcol0 + bj * HALF + 4 * n) : (f32x4){0.f, 0.f, 0.f, 0.f};
#pragma unroll
        for (int ai = 0; ai < 2; ++ai)
#pragma unroll
            for (int m = 0; m < 4; ++m) { bf16_t* rowp = base + (size_t)(row0 + ai * HALF + m * 16) * ldc + col0;
#pragma unroll
                for (int bj = 0; bj < 2; ++bj) { f32x4 v0 = acc[ai][bj][m][0] + bv[bj][0], v1 = acc[ai][bj][m][1] + bv[bj][1];
                    if (ACT == 1) { f32x2 a = gelu_pk((f32x2){v0[0], v0[1]}), b = gelu_pk((f32x2){v0[2], v0[3]}), c = gelu_pk((f32x2){v1[0], v1[1]}), d = gelu_pk((f32x2){v1[2], v1[3]});
                        v0 = (f32x4){a.x, a.y, b.x, b.y}; v1 = (f32x4){c.x, c.y, d.x, d.y}; }
                    v0 = v0 * sc; v1 = v1 * sc; u32x4 w; w.x = cvt_pk_bf16(v0[0], v0[1]); w.y = cvt_pk_bf16(v0[2], v0[3]); w.z = cvt_pk_bf16(v1[0], v1[1]); w.w = cvt_pk_bf16(v1[2], v1[3]);
                    *(u32x4*)(rowp + bj * HALF) = w; } }
    }
};
template <class Epi, class Sched, bool ALIGN_EPI = false, bool SP2 = false>
__device__ __forceinline__ void gemm_phase(PG8_LAS unsigned char* lds, const Gemm g, const Sched& S, const Epi& E) {
    int tid_l = threadIdx.x; asm volatile("" : "+v"(tid_l));
    const int tid = tid_l, wid = __builtin_amdgcn_readfirstlane(tid >> 6), lane = tid & 63, wr = wid >> 2, wc = wid & 3, fr = lane & 15, fq = lane >> 4;
    const int K = g.K, nt = K / BK;
    unsigned voffA[2], voffB[2];
#pragma unroll
    for (int i = 0; i < 2; ++i) { int R, C; stage_rc(tid * 16 + i * 8192, R, C); const int Rb = Epi::PERM ? ((R & ~31) + perm32(R & 31)) : R;
        voffA[i] = (unsigned)(R * K + C) * 2u; voffB[i] = (unsigned)(Rb * K + C) * 2u; }
    const size_t kstep = (size_t)(BK * 2);
    const size_t hstep = (size_t)HALF * K * 2;
    const size_t tstep = 2 * hstep;
    const unsigned ldsw = (unsigned)wid * 1024u;
    const int aoff = lds_byte(wr * 64 + fr, fq * 8), boff = lds_byte(wc * 32 + fr, fq * 8);
#define PG8_SA(b, h) (((b) * 2 + (h)) * HTB)
#define PG8_SB(b, h) ((4 + (b) * 2 + (h)) * HTB)
#define PG8_STAGE(bufoff, gbase, voff) do { _Pragma("unroll") for (int _i = 0; _i < 2; ++_i) \
        __builtin_amdgcn_global_load_lds((const unsigned*)((const char*)(gbase) + (voff)[_i]), (PG8_LAS unsigned*)(lds + (bufoff) + ldsw + _i * 8192), 16, 0, 0); } while (0)
#define PG8_LDA(dst, b, h) do { _Pragma("unroll") for (int m = 0; m < 4; ++m) _Pragma("unroll") for (int k = 0; k < 2; ++k) dst[m][k] = *(const PG8_LAS bf16x8*)(lds + PG8_SA(b, h) + aoff + m * 2048 + k * 1024); } while (0)
#define PG8_LDB(dst, b, h) do { _Pragma("unroll") for (int n = 0; n < 2; ++n) _Pragma("unroll") for (int k = 0; k < 2; ++k) dst[n][k] = *(const PG8_LAS bf16x8*)(lds + PG8_SB(b, h) + boff + n * 2048 + k * 1024); } while (0)
#define PG8_MMA(ai, bj, At, Bt) do { __builtin_amdgcn_s_setprio(1); _Pragma("unroll") for (int m = 0; m < 4; ++m) _Pragma("unroll") for (int n = 0; n < 2; ++n) _Pragma("unroll") for (int k = 0; k < 2; ++k) \
        acc[ai][bj][m][n] = __builtin_amdgcn_mfma_f32_16x16x32_bf16(Bt[n][k], At[m][k], acc[ai][bj][m][n], 0, 0, 0); __builtin_amdgcn_s_setprio(0); } while (0)
#define PG8_WAIT_V(n) asm volatile("s_waitcnt vmcnt(" #n ")" ::: "memory")
#define PG8_WAIT_L(n) asm volatile("s_waitcnt lgkmcnt(" #n ")" ::: "memory")
#define PG8_BAR __builtin_amdgcn_s_barrier()
#define PG8_SCHED __builtin_amdgcn_sched_barrier(0)
    Unit cur, nxt; int ui = 0;
    if (!S.next(0, cur)) return;
    f32x4 acc[2][2][4][2];
#pragma unroll
    for (int a = 0; a < 2; ++a)
#pragma unroll
        for (int b = 0; b < 2; ++b)
#pragma unroll
            for (int m = 0; m < 4; ++m)
#pragma unroll
                for (int n = 0; n < 2; ++n) acc[a][b][m][n] = (f32x4){0.f, 0.f, 0.f, 0.f};
    bf16x8 At[4][2], B0[2][2], B1[2][2];
    const char* cA = (const char*)g.A + (size_t)cur.pm * tstep; const char* cB = (const char*)g.Bt + (size_t)cur.pn * tstep;
    S.a_ready(cur);
    if constexpr (SP2) {
        PG8_STAGE(PG8_SB(0, 0), cB, voffB); PG8_STAGE(PG8_SB(0, 1), cB + hstep, voffB); PG8_STAGE(PG8_SA(0, 0), cA, voffA); PG8_STAGE(PG8_SA(0, 1), cA + hstep, voffA);
        if (wr == 1) PG8_BAR;
        PG8_WAIT_V(2); PG8_BAR;
        PG8_STAGE(PG8_SB(1, 0), cB + kstep, voffB); PG8_STAGE(PG8_SA(1, 0), cA + kstep, voffA); PG8_STAGE(PG8_SB(1, 1), cB + hstep + kstep, voffB);
        PG8_WAIT_V(6); PG8_BAR;
    } else {
        PG8_STAGE(PG8_SB(0, 0), cB, voffB); PG8_STAGE(PG8_SA(0, 0), cA, voffA); PG8_STAGE(PG8_SB(0, 1), cB + hstep, voffB); PG8_STAGE(PG8_SA(0, 1), cA + hstep, voffA);
        if (wr == 1) PG8_BAR;
        PG8_WAIT_V(4); PG8_BAR;
        PG8_STAGE(PG8_SB(1, 0), cB + kstep, voffB); PG8_STAGE(PG8_SA(1, 0), cA + kstep, voffA); PG8_STAGE(PG8_SB(1, 1), cB + hstep + kstep, voffB);
        PG8_WAIT_V(6); PG8_BAR;
    }
    for (;;) {
        const bool has_next = S.next(ui + 1, nxt);
        const char* nA = has_next ? (const char*)g.A + (size_t)nxt.pm * tstep : cA; const char* nB = has_next ? (const char*)g.Bt + (size_t)nxt.pn * tstep : cB;
        for (int t = 0; t < nt; t += 2) {
            const bool last = (t == nt - 2);
            const char* a1 = cA + (size_t)(t + 1) * kstep;
            const char* a2 = last ? nA : cA + (size_t)(t + 2) * kstep; const char* b2 = last ? nB : cB + (size_t)(t + 2) * kstep;
            const char* a3 = a2 + kstep; const char* b3 = b2 + kstep;
            if (last && has_next) S.a_ready(nxt);
            if constexpr (SP2) {
            PG8_LDB(B0, 0, 0); PG8_LDB(B1, 0, 1); PG8_SCHED; PG8_LDA(At, 0, 0); PG8_STAGE(PG8_SA(1, 1), a1 + hstep, voffA);
            PG8_WAIT_V(8); PG8_WAIT_L(0); PG8_BAR; PG8_MMA(0, 0, At, B0); PG8_MMA(0, 1, At, B1); PG8_BAR; PG8_SCHED;
            PG8_LDA(At, 0, 1); PG8_STAGE(PG8_SB(0, 0), b2, voffB); PG8_STAGE(PG8_SB(0, 1), b2 + hstep, voffB); PG8_STAGE(PG8_SA(0, 0), a2, voffA);
            PG8_WAIT_V(8); PG8_WAIT_L(0); PG8_BAR; PG8_MMA(1, 0, At, B0); PG8_MMA(1, 1, At, B1); PG8_BAR; PG8_SCHED;
            PG8_LDB(B0, 1, 0); PG8_LDB(B1, 1, 1); PG8_SCHED; PG8_LDA(At, 1, 0); PG8_STAGE(PG8_SA(0, 1), a2 + hstep, voffA);
            PG8_WAIT_V(8); PG8_WAIT_L(0); PG8_BAR; PG8_MMA(0, 0, At, B0); PG8_MMA(0, 1, At, B1); PG8_BAR; PG8_SCHED;
            PG8_LDA(At, 1, 1); PG8_STAGE(PG8_SB(1, 0), b3, voffB); PG8_STAGE(PG8_SB(1, 1), b3 + hstep, voffB); PG8_STAGE(PG8_SA(1, 0), a3, voffA);
            PG8_WAIT_V(8); PG8_WAIT_L(0); PG8_BAR; PG8_MMA(1, 0, At, B0); PG8_MMA(1, 1, At, B1); PG8_BAR; PG8_SCHED;
            } else {
            PG8_LDB(B0, 0, 0); PG8_SCHED; PG8_LDA(At, 0, 0); PG8_STAGE(PG8_SA(1, 1), a1 + hstep, voffA);
            PG8_WAIT_L(8); PG8_BAR; PG8_WAIT_L(0); PG8_MMA(0, 0, At, B0); PG8_BAR; PG8_SCHED;
            PG8_LDB(B1, 0, 1); PG8_STAGE(PG8_SB(0, 0), b2, voffB);
            PG8_BAR; PG8_WAIT_L(0); PG8_MMA(0, 1, At, B1); PG8_BAR;
            PG8_LDA(At, 0, 1); PG8_STAGE(PG8_SA(0, 0), a2, voffA);
            PG8_BAR; PG8_WAIT_L(0); PG8_MMA(1, 0, At, B0); PG8_BAR; PG8_SCHED;
            PG8_STAGE(PG8_SB(0, 1), b2 + hstep, voffB);
            PG8_WAIT_V(6); PG8_BAR; PG8_MMA(1, 1, At, B1); PG8_BAR;
            PG8_LDB(B0, 1, 0); PG8_SCHED; PG8_LDA(At, 1, 0); PG8_STAGE(PG8_SA(0, 1), a2 + hstep, voffA);
            PG8_WAIT_L(8); PG8_BAR; PG8_WAIT_L(0); PG8_MMA(0, 0, At, B0); PG8_BAR; PG8_SCHED;
            PG8_LDB(B1, 1, 1); PG8_STAGE(PG8_SB(1, 0), b3, voffB);
            PG8_BAR; PG8_WAIT_L(0); PG8_MMA(0, 1, At, B1); PG8_BAR;
            PG8_LDA(At, 1, 1); PG8_STAGE(PG8_SA(1, 0), a3, voffA);
            PG8_BAR; PG8_WAIT_L(0); PG8_MMA(1, 0, At, B0); PG8_BAR; PG8_SCHED;
            PG8_STAGE(PG8_SB(1, 1), b3 + hstep, voffB);
            PG8_WAIT_V(6); PG8_BAR; PG8_MMA(1, 1, At, B1); PG8_BAR;
            }
        }
        if constexpr (ALIGN_EPI) { if (wr == 0) PG8_BAR; }
        if constexpr (!Epi::AFTER_DRAIN) { E(acc, cur, wr, wc, fr, fq); S.done(cur); }
        if (!has_next) break;
#pragma unroll
        for (int a = 0; a < 2; ++a)
#pragma unroll
            for (int b = 0; b < 2; ++b)
#pragma unroll
                for (int m = 0; m < 4; ++m)
#pragma unroll
                    for (int n = 0; n < 2; ++n) acc[a][b][m][n] = (f32x4){0.f, 0.f, 0.f, 0.f};
        cur = nxt; cA = nA; cB = nB; ++ui;
        if constexpr (ALIGN_EPI) { if (wr == 1) PG8_BAR; }
    }
    PG8_WAIT_V(0);
    if constexpr (!ALIGN_EPI) { if (wr == 0) PG8_BAR; }
    PG8_BAR;
    if constexpr (Epi::AFTER_DRAIN) { E.fused(acc, cur, wr, wc, fr, fq, lds, wid, lane); S.done(cur); }
#undef PG8_SA
#undef PG8_SB
#undef PG8_STAGE
#undef PG8_LDA
#undef PG8_LDB
#undef PG8_MMA
#undef PG8_WAIT_V
#undef PG8_WAIT_L
#undef PG8_BAR
#undef PG8_SCHED
}
}

namespace pg8 {
struct EpiSwiglu {
    static constexpr bool PERM = false, AFTER_DRAIN = false;
    bf16_t* O; int ldo;
    __device__ __forceinline__ void operator()(const f32x4 (&acc)[2][2][4][2], const Unit& u, int wr, int wc, int fr, int fq) const {
        const int row0 = u.pm * BM + wr * 64 + fr;
#pragma unroll
        for (int ai = 0; ai < 2; ++ai)
#pragma unroll
            for (int m = 0; m < 4; ++m) {
                bf16_t* rowp = O + (size_t)(row0 + ai * HALF + m * 16) * ldo;
#pragma unroll
                for (int bj = 0; bj < 2; ++bj) {
                    const int grp = u.pn * 8 + bj * 4 + wc;
                    const f32x4 g = acc[ai][bj][m][0], up = acc[ai][bj][m][1];
                    const float h0 = fast_silu(g[0]) * up[0], h1 = fast_silu(g[1]) * up[1], h2 = fast_silu(g[2]) * up[2], h3 = fast_silu(g[3]) * up[3];
                    u32x2 w; w.x = cvt_pk_bf16(h0, h1); w.y = cvt_pk_bf16(h2, h3);
                    *(u32x2*)(rowp + grp * 16 + 4 * fq) = w;
                }
            }
    }
};
}

DEV void phase_prep_ffn(const FP& p, LAS unsigned char* lds, int gw, int ngw, int wave, int lane) {
    LAS float* scr = (LAS float*)(lds + wave * 16384);
    const float *wg = p.in[33], *wu = p.in[34], *wd = p.in[35];
    bf16_t* GU = (bf16_t*)(p.ws + WS_W_GU); bf16_t* DN = (bf16_t*)(p.ws + WS_W_DOWN);
    constexpr int I_G = 16 * 88, I_D = 44 * 32;
    for (int it = gw; it < 2 * I_G + I_D; it += ngw) {
        int r = it;
        if (r < I_G) { transpose_item(wg, 1024, 2816, GU, r, scr, lane, RmGU{0}); continue; } r -= I_G;
        if (r < I_G) { transpose_item(wu, 1024, 2816, GU, r, scr, lane, RmGU{1}); continue; } r -= I_G;
        transpose_item(wd, 2816, 1024, DN, r, scr, lane, RmPlain{0});
    }
}
DEV void phase_ffn_gu(const FP& p, LAS unsigned char* lds, int G, int bid) {
    pg8::Gemm g{(const bf16_t*)(p.ws + WS_XN), (const bf16_t*)(p.ws + WS_W_GU), MP, 5632, 1024};
    pg8::StaticOrder S; S.init(MP, 5632, G, bid);
    pg8::EpiSwiglu E{(bf16_t*)(p.ws + WS_HID), 2816};
    pg8::gemm_phase<pg8::EpiSwiglu, pg8::StaticOrder, true, true>(lds, g, S, E);
}
DEV void phase_ffn_down(const FP& p, LAS unsigned char* lds, int G, int bid) {
    pg8::Gemm g{(const bf16_t*)(p.ws + WS_HID), (const bf16_t*)(p.ws + WS_W_DOWN), MP, 1024, 2816};
    pg8::StaticOrder S; S.init(MP, 1024, G, bid);
    pg8::EpiBf16<0> E{(bf16_t*)(p.ws + WS_RAW), 1024, nullptr, 0, 0, 1.f};
    pg8::gemm_phase<pg8::EpiBf16<0>, pg8::StaticOrder, true, true>(lds, g, S, E);
}

typedef short v4i16_t __attribute__((ext_vector_type(4)));
typedef float f32x2_t __attribute__((ext_vector_type(2)));
typedef __bf16 bf16x2_t __attribute__((ext_vector_type(2)));
DEV unsigned cvtpk(float lo, float hi) { f32x2_t v = {lo, hi}; bf16x2_t b = __builtin_convertvector(v, bf16x2_t); return __builtin_bit_cast(unsigned, b); }
DEV f32x16 mfma32(bf16x8 a, bf16x8 b, f32x16 c) { return __builtin_amdgcn_mfma_f32_32x32x16_bf16(a, b, c, 0, 0, 0); }
DEV s16x4 tr_read(LAS const unsigned char* p) { return __builtin_bit_cast(s16x4, __builtin_amdgcn_ds_read_tr16_b64_v4i16((LAS v4i16_t*)p)); }
DEV bf16x8 cat8(s16x4 lo, s16x4 hi) { return (bf16x8){lo[0], lo[1], lo[2], lo[3], hi[0], hi[1], hi[2], hi[3]}; }
DEV float half_max(float v) { auto rr = __builtin_amdgcn_permlane32_swap(__float_as_uint(v), __float_as_uint(v), false, false); return fmaxf(__uint_as_float(rr[0]), __uint_as_float(rr[1])); }
DEV float half_sum(float v) { auto rr = __builtin_amdgcn_permlane32_swap(__float_as_uint(v), __float_as_uint(v), false, false); return __uint_as_float(rr[0]) + __uint_as_float(rr[1]); }
DEV bf16x8 pfrag(const f32x16& S, int s) {
    u32x4 w;
    if (s == 0) { w.x = cvtpk(S[0], S[1]); w.y = cvtpk(S[2], S[3]); w.z = cvtpk(S[4], S[5]); w.w = cvtpk(S[6], S[7]); }
    else { w.x = cvtpk(S[8], S[9]); w.y = cvtpk(S[10], S[11]); w.z = cvtpk(S[12], S[13]); w.w = cvtpk(S[14], S[15]); }
    return __builtin_bit_cast(bf16x8, w);
}
DEV float max16(const f32x16& S) {
    float a = fmaxf(fmaxf(S[0], S[1]), fmaxf(S[2], S[3])), b = fmaxf(fmaxf(S[4], S[5]), fmaxf(S[6], S[7]));
    float c = fmaxf(fmaxf(S[8], S[9]), fmaxf(S[10], S[11])), d = fmaxf(fmaxf(S[12], S[13]), fmaxf(S[14], S[15]));
    return fmaxf(fmaxf(a, b), fmaxf(c, d));
}

namespace pg8 {
struct EpiMemKV {
    static constexpr bool PERM = false, AFTER_DRAIN = false;
    float* ok; float* ov; bf16_t* bk; bf16_t* bv;
    __device__ __forceinline__ void operator()(const f32x4 (&acc)[2][2][4][2], const Unit& u, int wr, int wc, int fr, int fq) const {
        const int row0 = u.pm * BM + wr * 64 + fr; const bool isv = u.pn >= 4; const int colt = (u.pn & 3) * BM + wc * 32 + 4 * fq;
        float* of = isv ? ov : ok; bf16_t* ob = isv ? bv : bk;
#pragma unroll
        for (int ai = 0; ai < 2; ++ai)
#pragma unroll
            for (int m = 0; m < 4; ++m) {
                const size_t ro = (size_t)(row0 + ai * HALF + m * 16) * 1024;
#pragma unroll
                for (int bj = 0; bj < 2; ++bj)
#pragma unroll
                    for (int n = 0; n < 2; ++n) {
                        const f32x4 v = acc[ai][bj][m][n]; const int col = colt + bj * HALF + n * 16;
                        *(f32x4*)(of + ro + col) = v;
                        u32x2 w; w.x = cvt_pk_bf16(v[0], v[1]); w.y = cvt_pk_bf16(v[2], v[3]);
                        *(u32x2*)(ob + ro + col) = w;
                    }
            }
    }
};
}

DEV void phase_prep_x(const FP& p, LAS unsigned char* lds, int gw, int ngw, int wave, int lane) {
    LAS float* scr = (LAS float*)(lds + wave * 16384);
    constexpr int I_S = 16 * 32;
    for (int it = gw; it < 4 * I_S; it += ngw) {
        int r = it;
        if (r < I_S) { transpose_item(p.in[23], 1024, 1024, (bf16_t*)(p.ws + WS_W_Q), r, scr, lane, RmPlain{0}); continue; } r -= I_S;
        if (r < I_S) { transpose_item(p.in[24], 1024, 1024, (bf16_t*)(p.ws + WS_W_KV), r, scr, lane, RmPlain{0}); continue; } r -= I_S;
        if (r < I_S) { transpose_item(p.in[25], 1024, 1024, (bf16_t*)(p.ws + WS_W_KV), r, scr, lane, RmPlain{1024}); continue; } r -= I_S;
        transpose_item(p.in[26], 1024, 1024, (bf16_t*)(p.ws + WS_W_O), r, scr, lane, RmPlain{0});
    }
    row_phase(nullptr, p.in[8], nullptr, nullptr, p.in[22], (bf16_t*)(p.ws + WS_MN), 512, gw, ngw, lane);
}
DEV void phase_memkv(const FP& p, LAS unsigned char* lds, int G, int bid) {
    pg8::Gemm g{(const bf16_t*)(p.ws + WS_MN), (const bf16_t*)(p.ws + WS_W_KV), 512, 2048, 1024};
    pg8::StaticOrder S; S.init(512, 2048, G, bid);
    pg8::EpiMemKV E{p.out + 33822720, p.out + 34347008, (bf16_t*)(p.ws + WS_KM), (bf16_t*)(p.ws + WS_VM)};
    pg8::gemm_phase<pg8::EpiMemKV, pg8::StaticOrder, true, true>(lds, g, S, E);
}
DEV void phase_wq(const FP& p, LAS unsigned char* lds, int G, int bid) {
    pg8::Gemm g{(const bf16_t*)(p.ws + WS_XN), (const bf16_t*)(p.ws + WS_W_Q), MP, 1024, 1024};
    pg8::StaticOrder S; S.init(MP, 1024, G, bid);
    pg8::EpiBf16<0> E{(bf16_t*)(p.ws + WS_QX), 1024, nullptr, 1024, 0, 0.0625f * 1.4426950408889634f};
    pg8::gemm_phase<pg8::EpiBf16<0>, pg8::StaticOrder, true, true>(lds, g, S, E);
}
DEV void phase_wo(const FP& p, LAS unsigned char* lds, int G, int bid) {
    pg8::Gemm g{(const bf16_t*)(p.ws + WS_OX), (const bf16_t*)(p.ws + WS_W_O), MP, 1024, 1024};
    pg8::StaticOrder S; S.init(MP, 1024, G, bid);
    pg8::EpiBf16<0> E{(bf16_t*)(p.ws + WS_RAW), 1024, nullptr, 0, 0, 1.f};
    pg8::gemm_phase<pg8::EpiBf16<0>, pg8::StaticOrder, true, true>(lds, g, S, E);
}

DEV void phase_xattn(const FP& p, LAS unsigned char* lds, int G, int bid) {
    const int tid = threadIdx.x, lane = tid & 63, wave = __builtin_amdgcn_readfirstlane(tid >> 6), r = lane & 31, hh = lane >> 5, qb = wave & 3, eh = wave >> 2;
    const bf16_t* QX = (const bf16_t*)(p.ws + WS_QX); const bf16_t* KM = (const bf16_t*)(p.ws + WS_KM); const bf16_t* VM = (const bf16_t*)(p.ws + WS_VM);
    bf16_t* OX = (bf16_t*)(p.ws + WS_OX);
    constexpr int QOFF = 0, KOFF = 65536, VOFF = 98304;
    const int vlane = (4 * hh + ((lane & 15) >> 2)) * 64 + 32 * ((lane >> 4) & 1) + 8 * (lane & 3);
    for (int u = bid; u < 512; u += G) {
        const int bh = u & 7, b = bh >> 2, h = bh & 3, qblk = u >> 3;
        const size_t qrow0 = (size_t)b * 8192 + (size_t)qblk * 128;
#pragma unroll
        for (int j = 0; j < 8; ++j) {
            const int id = tid + 512 * j, row = id >> 5, ch = id & 31;
            const u32x4 v = *(const u32x4*)(QX + (qrow0 + row) * 1024 + h * 256 + ch * 8);
            *(LAS u32x4*)(lds + QOFF + row * 512 + ((ch ^ (row & 15)) << 4)) = v;
        }
        u32x4 kr[2], vr[2];
#pragma unroll
        for (int j = 0; j < 2; ++j) {
            const int id = tid + 512 * j, key = id >> 5, ch = id & 31;
            kr[j] = *(const u32x4*)(KM + ((size_t)b * 256 + key) * 1024 + h * 256 + ch * 8);
            vr[j] = *(const u32x4*)(VM + ((size_t)b * 256 + key) * 1024 + h * 256 + ch * 8);
        }
#pragma unroll
        for (int j = 0; j < 2; ++j) {
            const int id = tid + 512 * j, key = id >> 5, ch = id & 31;
            *(LAS u32x4*)(lds + KOFF + key * 512 + ((ch ^ (key & 15)) << 4)) = kr[j];
            *(LAS u32x4*)(lds + VOFF + (ch >> 2) * 2048 + key * 64 + (ch & 3) * 16) = vr[j];
        }
        __syncthreads();
        f32x16 O[4];
#pragma unroll
        for (int e = 0; e < 4; ++e)
#pragma unroll
            for (int i = 0; i < 16; ++i) O[e][i] = 0.f;
        float mrun = -1e30f, lsum = 0.f;
        const LAS unsigned char* qp = lds + QOFF + (32 * qb + r) * 512;
        for (int t = 0; t < 8; ++t) {
            const int buf = t & 1;
            if (t + 1 < 8) {
#pragma unroll
                for (int j = 0; j < 2; ++j) {
                    const int id = tid + 512 * j, key = id >> 5, ch = id & 31;
                    kr[j] = *(const u32x4*)(KM + ((size_t)b * 256 + 32 * (t + 1) + key) * 1024 + h * 256 + ch * 8);
                    vr[j] = *(const u32x4*)(VM + ((size_t)b * 256 + 32 * (t + 1) + key) * 1024 + h * 256 + ch * 8);
                }
            }
            const LAS unsigned char* kp = lds + KOFF + buf * 16384 + r * 512;
            const LAS unsigned char* vp = lds + VOFF + buf * 16384 + (4 * eh) * 2048 + vlane;
            f32x16 S;
#pragma unroll
            for (int i = 0; i < 16; ++i) S[i] = 0.f;
#pragma unroll 4
            for (int ks = 0; ks < 16; ++ks) {
                const int sl = ((2 * ks + hh) ^ (r & 15)) << 4;
                const bf16x8 a = *(const LAS bf16x8*)(kp + sl);
                const bf16x8 q = *(const LAS bf16x8*)(qp + sl);
                S = mfma32(a, q, S);
            }
            const float mx = half_max(max16(S));
            const float mnew = fmaxf(mrun, mx), alpha = __builtin_amdgcn_exp2f(mrun - mnew);
            mrun = mnew;
            float ps = 0.f;
#pragma unroll
            for (int i = 0; i < 16; ++i) { S[i] = __builtin_amdgcn_exp2f(S[i] - mnew); ps += S[i]; }
            lsum = lsum * alpha + ps;
#pragma unroll
            for (int e = 0; e < 4; ++e)
#pragma unroll
                for (int i = 0; i < 16; ++i) O[e][i] *= alpha;
            const bf16x8 P0 = pfrag(S, 0), P1 = pfrag(S, 1);
#pragma unroll
            for (int e = 0; e < 4; ++e) {
                const bf16x8 v0 = cat8(tr_read(vp + e * 2048), tr_read(vp + e * 2048 + 512));
                const bf16x8 v1 = cat8(tr_read(vp + e * 2048 + 1024), tr_read(vp + e * 2048 + 1536));
                O[e] = mfma32(v0, P0, O[e]);
                O[e] = mfma32(v1, P1, O[e]);
            }
            if (t + 1 < 8) {
#pragma unroll
                for (int j = 0; j < 2; ++j) {
                    const int id = tid + 512 * j, key = id >> 5, ch = id & 31;
                    *(LAS u32x4*)(lds + KOFF + (buf ^ 1) * 16384 + key * 512 + ((ch ^ (key & 15)) << 4)) = kr[j];
                    *(LAS u32x4*)(lds + VOFF + (buf ^ 1) * 16384 + (ch >> 2) * 2048 + key * 64 + (ch & 3) * 16) = vr[j];
                }
            }
            __syncthreads();
        }
        const float inv = 1.f / half_sum(lsum);
        LAS unsigned char* stg = lds + wave * 16384;
#pragma unroll
        for (int e = 0; e < 4; ++e)
#pragma unroll
            for (int g4 = 0; g4 < 4; ++g4) {
                u32x2 w; w.x = cvtpk(O[e][4 * g4 + 0] * inv, O[e][4 * g4 + 1] * inv); w.y = cvtpk(O[e][4 * g4 + 2] * inv, O[e][4 * g4 + 3] * inv);
                *(LAS u32x2*)(stg + r * 272 + (32 * e + 8 * g4 + 4 * hh) * 2) = w;
            }
        WAVE_SYNC();
#pragma unroll
        for (int i = 0; i < 8; ++i) {
            const int row = i * 4 + (lane >> 4), ch = lane & 15;
            const u32x4 v = *(const LAS u32x4*)(stg + row * 272 + ch * 16);
            *(u32x4*)(OX + (qrow0 + 32 * qb + row) * 1024 + h * 256 + 128 * eh + ch * 8) = v;
        }
        __syncthreads();
    }
}

constexpr float QSCALE = 0.125f * 1.4426950408889634f;
namespace pg8 {
struct EpiIn {
    static constexpr bool PERM = false, AFTER_DRAIN = false;
    bf16_t* ZX; bf16_t* Qb; bf16_t* Kb; bf16_t* Vb; float* okf; float* ovf; float* oconv;
    __device__ __forceinline__ void operator()(const f32x4 (&acc)[2][2][4][2], const Unit& u, int wr, int wc, int fr, int fq) const {
        const int row0 = u.pm * BM + wr * 64 + fr, pn = u.pn;
        if (pn < 6) {
#pragma unroll
            for (int ai = 0; ai < 2; ++ai)
#pragma unroll
                for (int m = 0; m < 4; ++m) {
                    const int row = row0 + ai * HALF + m * 16; const int t = row & 8191;
#pragma unroll
                    for (int bj = 0; bj < 2; ++bj)
#pragma unroll
                        for (int n = 0; n < 2; ++n) {
                            const f32x4 v = acc[ai][bj][m][n]; const int col = pn * BM + bj * HALF + wc * 32 + n * 16 + 4 * fq;
                            u32x2 w; w.x = cvt_pk_bf16(v[0], v[1]); w.y = cvt_pk_bf16(v[2], v[3]);
                            *(u32x2*)(ZX + (size_t)row * 1536 + col) = w;
                            if (pn >= 2 && t >= 8189) *(f32x4*)(oconv + (size_t)((row >> 13) * 3 + (t - 8189)) * 1024 + (col - 512)) = v;
                        }
                }
        } else if (pn < 10) {
            const bool isk = pn >= 8;
            const int g = wc & 1;
            float inv[4];
#pragma unroll
            for (int i = 0; i < 4; ++i) inv[i] = __builtin_amdgcn_exp2f(-(float)(16 * g + 4 * fq + i) * (13.287712379549449f / 32.f)) * 0.15915494309189535f;
#pragma unroll
            for (int ai = 0; ai < 2; ++ai)
#pragma unroll
                for (int m = 0; m < 4; ++m) {
                    const int row = row0 + ai * HALF + m * 16; const float pos = (float)(row & 8191);
                    float cs[4], sn[4];
#pragma unroll
                    for (int i = 0; i < 4; ++i) { float rev = pos * inv[i]; rev -= floorf(rev); sn[i] = __builtin_amdgcn_sinf(rev); cs[i] = __builtin_amdgcn_cosf(rev); }
#pragma unroll
                    for (int bj = 0; bj < 2; ++bj) {
                        const int cl = (pn & 1) * BM + bj * HALF + wc * 32;
                        const f32x4 x1 = acc[ai][bj][m][0], x2 = acc[ai][bj][m][1];
                        f32x4 o1, o2;
#pragma unroll
                        for (int i = 0; i < 4; ++i) { o1[i] = x1[i] * cs[i] - x2[i] * sn[i]; o2[i] = x2[i] * cs[i] + x1[i] * sn[i]; }
                        if (isk) {
                            float* kf = okf + (size_t)row * 512 + (cl >> 6) * 64 + 16 * g + 4 * fq;
                            *(f32x4*)kf = o1; *(f32x4*)(kf + 32) = o2;
                            u32x2 w; w.x = cvt_pk_bf16(o1[0], o1[1]); w.y = cvt_pk_bf16(o1[2], o1[3]);
                            *(u32x2*)(Kb + (size_t)row * 512 + cl + 4 * fq) = w;
                            w.x = cvt_pk_bf16(o2[0], o2[1]); w.y = cvt_pk_bf16(o2[2], o2[3]);
                            *(u32x2*)(Kb + (size_t)row * 512 + cl + 16 + 4 * fq) = w;
                        } else {
                            o1 = o1 * QSCALE; o2 = o2 * QSCALE;
                            u32x2 w; w.x = cvt_pk_bf16(o1[0], o1[1]); w.y = cvt_pk_bf16(o1[2], o1[3]);
                            *(u32x2*)(Qb + (size_t)row * 512 + cl + 4 * fq) = w;
                            w.x = cvt_pk_bf16(o2[0], o2[1]); w.y = cvt_pk_bf16(o2[2], o2[3]);
                            *(u32x2*)(Qb + (size_t)row * 512 + cl + 16 + 4 * fq) = w;
                        }
                    }
                }
        } else {
#pragma unroll
            for (int ai = 0; ai < 2; ++ai)
#pragma unroll
                for (int m = 0; m < 4; ++m) {
                    const int row = row0 + ai * HALF + m * 16;
#pragma unroll
                    for (int bj = 0; bj < 2; ++bj)
#pragma unroll
                        for (int n = 0; n < 2; ++n) {
                            const f32x4 v = acc[ai][bj][m][n]; const int col = (pn - 10) * BM + bj * HALF + wc * 32 + n * 16 + 4 * fq;
                            *(f32x4*)(ovf + (size_t)row * 512 + col) = v;
                            u32x2 w; w.x = cvt_pk_bf16(v[0], v[1]); w.y = cvt_pk_bf16(v[2], v[3]);
                            *(u32x2*)(Vb + (size_t)row * 512 + col) = w;
                        }
                }
        }
    }
};
}

DEV void phase_prep_mix(const FP& p, LAS unsigned char* lds, int gw, int ngw, int wave, int lane) {
    LAS float* scr = (LAS float*)(lds + wave * 16384);
    constexpr int I_IN = 16 * 97, I_OUT = 16 * 32;
    for (int it = gw; it < I_IN + I_OUT; it += ngw) {
        if (it < I_IN) transpose_item(p.in[9], 1024, 3080, (bf16_t*)(p.ws + WS_W_IN), it, scr, lane, RmIn{});
        else transpose_item(p.in[21], 1024, 1024, (bf16_t*)(p.ws + WS_W_OUT), it - I_IN, scr, lane, RmPlain{0});
    }
    __syncthreads();
    LAS float* wdt = (LAS float*)lds;
    for (int i = threadIdx.x; i < 8192; i += 512) wdt[i] = p.in[9][(size_t)(i >> 3) * 3080 + 1536 + (i & 7)];
    __syncthreads();
    const float* x = p.in[0]; const float* g = p.in[27]; bf16_t* xn = (bf16_t*)(p.ws + WS_XN); float* dtv = (float*)(p.ws + WS_DTV);
    const float bias = p.in[12][lane & 7];
    for (int r = gw; r < MP; r += ngw) {
        f32x4 h[4]; float ss = 0.f;
#pragma unroll
        for (int j = 0; j < 4; ++j) { h[j] = ((const f32x4*)(x + (size_t)r * 1024))[lane + 64 * j]; ss += h[j].x * h[j].x + h[j].y * h[j].y + h[j].z * h[j].z + h[j].w * h[j].w; }
        const float rs = rsqrtf(wave_sum(ss) * (1.f / 1024.f) + 1e-6f);
        float d[8];
#pragma unroll
        for (int k = 0; k < 8; ++k) d[k] = 0.f;
#pragma unroll
        for (int j = 0; j < 4; ++j) {
            const f32x4 gg = ((const f32x4*)g)[lane + 64 * j]; h[j] = h[j] * rs * gg;
            u32x2 w; w.x = pk2(h[j].x, h[j].y); w.y = pk2(h[j].z, h[j].w);
            ((u32x2*)(xn + (size_t)r * 1024))[lane + 64 * j] = w;
#pragma unroll
            for (int i = 0; i < 4; ++i) {
                const LAS f32x4* wp = (const LAS f32x4*)(wdt + (4 * (lane + 64 * j) + i) * 8);
                const f32x4 w0 = wp[0], w1 = wp[1]; const float hv = h[j][i];
                d[0] += hv * w0.x; d[1] += hv * w0.y; d[2] += hv * w0.z; d[3] += hv * w0.w; d[4] += hv * w1.x; d[5] += hv * w1.y; d[6] += hv * w1.z; d[7] += hv * w1.w;
            }
        }
#pragma unroll
        for (int k = 0; k < 8; ++k) d[k] = wave_sum(d[k]);
        float mine = d[0];
#pragma unroll
        for (int k = 1; k < 8; ++k) mine = ((lane & 7) == k) ? d[k] : mine;
        const float xx = mine + bias;
        if (lane < 8) dtv[(size_t)r * 8 + lane] = (xx > 20.f) ? xx : log1pf(expf(xx));
    }
    __syncthreads();
}
DEV void phase_inproj(const FP& p, LAS unsigned char* lds, int G, int bid) {
    pg8::Gemm g{(const bf16_t*)(p.ws + WS_XN), (const bf16_t*)(p.ws + WS_W_IN), MP, 3072, 1024};
    pg8::StaticOrder S; S.init(MP, 3072, G, bid);
    pg8::EpiIn E{(bf16_t*)(p.ws + WS_ZX), (bf16_t*)(p.ws + WS_Q), (bf16_t*)(p.ws + WS_K), (bf16_t*)(p.ws + WS_V), p.out + 16908288, p.out + 25296896, p.out + 33816576};
    pg8::gemm_phase<pg8::EpiIn, pg8::StaticOrder, true, true>(lds, g, S, E);
}
DEV void phase_outproj(const FP& p, LAS unsigned char* lds, int G, int bid) {
    pg8::Gemm g{(const bf16_t*)(p.ws + WS_CAT), (const bf16_t*)(p.ws + WS_W_OUT), MP, 1024, 1024};
    pg8::StaticOrder S; S.init(MP, 1024, G, bid);
    pg8::EpiBf16<0> E{(bf16_t*)(p.ws + WS_RAW), 1024, nullptr, 0, 0, 1.f};
    pg8::gemm_phase<pg8::EpiBf16<0>, pg8::StaticOrder, true, true>(lds, g, S, E);
}

DEV float ssd_tables(const FP& p, LAS float* tdt, LAS float* tac, size_t row0, int h, int lane) {
    const float dt = ((const float*)(p.ws + WS_DTV))[(row0 + lane) * 8 + h];
    const float a = -expf(p.in[13][h]);
    float v = dt * a;
#pragma unroll
    for (int o = 1; o < 64; o <<= 1) { const float t = __shfl_up(v, o); if (lane >= o) v += t; }
    tdt[lane * 8 + h] = dt; tac[lane * 8 + h] = v;
    return __shfl(v, 63);
}
template <class F> DEV void ssd_conv8(const FP& p, size_t row0, int col0, int l0, F emit) {
    const bf16_t* ZX = (const bf16_t*)(p.ws + WS_ZX);
    const float* cw = p.in[10]; const float* cb = p.in[11];
    f32x4 w[4][2], bias[2];
#pragma unroll
    for (int j = 0; j < 4; ++j) { w[j][0] = *(const f32x4*)(cw + j * 1024 + col0); w[j][1] = *(const f32x4*)(cw + j * 1024 + col0 + 4); }
    bias[0] = *(const f32x4*)(cb + col0); bias[1] = *(const f32x4*)(cb + col0 + 4);
    const int t0 = (int)(row0 & 8191);
    f32x4 u[4][2];
#pragma unroll
    for (int j = 0; j < 3; ++j) {
        const int l = l0 - 3 + j;
        if (t0 + l >= 0) {
            const u32x4 r = *(const u32x4*)(ZX + (row0 + l) * 1536 + 512 + col0);
            u[j][0] = (f32x4){bflo(r.x), bfhi(r.x), bflo(r.y), bfhi(r.y)}; u[j][1] = (f32x4){bflo(r.z), bfhi(r.z), bflo(r.w), bfhi(r.w)};
        } else { u[j][0] = (f32x4){0.f, 0.f, 0.f, 0.f}; u[j][1] = u[j][0]; }
    }
#pragma unroll
    for (int i = 0; i < 16; ++i) {
        const int l = l0 + i;
        const u32x4 r = *(const u32x4*)(ZX + (row0 + l) * 1536 + 512 + col0);
        u[3][0] = (f32x4){bflo(r.x), bfhi(r.x), bflo(r.y), bfhi(r.y)}; u[3][1] = (f32x4){bflo(r.z), bfhi(r.z), bflo(r.w), bfhi(r.w)};
        f32x4 a0 = bias[0] + w[0][0] * u[0][0] + w[1][0] * u[1][0] + w[2][0] * u[2][0] + w[3][0] * u[3][0];
        f32x4 a1 = bias[1] + w[0][1] * u[0][1] + w[1][1] * u[1][1] + w[2][1] * u[2][1] + w[3][1] * u[3][1];
#pragma unroll
        for (int k = 0; k < 4; ++k) { a0[k] = fast_silu(a0[k]); a1[k] = fast_silu(a1[k]); }
        emit(l, a0, a1);
        u[0][0] = u[1][0]; u[0][1] = u[1][1]; u[1][0] = u[2][0]; u[1][1] = u[2][1]; u[2][0] = u[3][0]; u[2][1] = u[3][1];
    }
}
constexpr int S_XS = 0, S_B = 65536, S_C = 98304, S_TDT = 131072, S_TAC = 133120, S_SSQ = 135168;
DEV int trlane(int lane) { return ((lane & 15) >> 2) * 64 + 32 * ((lane >> 4) & 1) + 8 * (lane & 3); }

DEV void phase_ssd1(const FP& p, LAS unsigned char* lds, int G, int bid) {
    const int tid = threadIdx.x, lane = tid & 63, wave = __builtin_amdgcn_readfirstlane(tid >> 6), hh = lane >> 5;
    LAS float* tdt = (LAS float*)(lds + S_TDT); LAS float* tac = (LAS float*)(lds + S_TAC);
    bf16_t* ST = (bf16_t*)(p.ws + WS_ST); float* cdec = (float*)(p.ws + WS_CDEC);
    for (int u = bid; u < 256; u += G) {
        const int b = u >> 7, c = u & 127; const size_t row0 = (size_t)b * 8192 + (size_t)c * 64;
        const float tot = ssd_tables(p, tdt, tac, row0, wave, lane);
        if (lane == 0) cdec[u * 8 + wave] = expf(tot);
        __syncthreads();
        { const int i = tid; const float t63 = tac[63 * 8 + (i & 7)]; const float s = tdt[i] * expf(t63 - tac[i]); __syncthreads(); tdt[i] = s; }
        __syncthreads();
        if (tid < 384) {
            const int cg = tid >> 2, tq = tid & 3, col0 = cg * 8;
            ssd_conv8(p, row0, col0, tq * 16, [&](int l, f32x4 a0, f32x4 a1) {
                u32x4 w;
                if (cg < 64) {
                    const int h = cg >> 3, pp = col0 & 63; const float s = tdt[l * 8 + h];
                    a0 = a0 * s; a1 = a1 * s;
                    w.x = pk2(a0[0], a0[1]); w.y = pk2(a0[2], a0[3]); w.z = pk2(a1[0], a1[1]); w.w = pk2(a1[2], a1[3]);
                    *(LAS u32x4*)(lds + S_XS + h * 8192 + (pp >> 5) * 4096 + l * 64 + (pp & 31) * 2) = w;
                } else {
                    const int n = col0 - 512, g = n >> 7, nn = n & 127;
                    w.x = pk2(a0[0], a0[1]); w.y = pk2(a0[2], a0[3]); w.z = pk2(a1[0], a1[1]); w.w = pk2(a1[2], a1[3]);
                    *(LAS u32x4*)(lds + S_B + g * 16384 + (nn >> 5) * 4096 + l * 64 + (nn & 31) * 2) = w;
                }
            });
        }
        __syncthreads();
        const int h = wave, g = h >> 2;
        const LAS unsigned char* xa = lds + S_XS + h * 8192 + hh * 512 + trlane(lane);
        const LAS unsigned char* ba = lds + S_B + g * 16384 + hh * 512 + trlane(lane);
        bf16_t* sp = ST + ((size_t)u * 8 + h) * 8192;
#pragma unroll 1
        for (int nh = 0; nh < 2; ++nh) {
            f32x16 acc[2][2];
#pragma unroll
            for (int a = 0; a < 2; ++a)
#pragma unroll
                for (int n = 0; n < 2; ++n)
#pragma unroll
                    for (int i = 0; i < 16; ++i) acc[a][n][i] = 0.f;
#pragma unroll 2
            for (int s = 0; s < 4; ++s) {
                bf16x8 af[2], bfr[2];
#pragma unroll
                for (int a = 0; a < 2; ++a) af[a] = cat8(tr_read(xa + a * 4096 + s * 1024), tr_read(xa + a * 4096 + s * 1024 + 256));
#pragma unroll
                for (int n = 0; n < 2; ++n) bfr[n] = cat8(tr_read(ba + (2 * nh + n) * 4096 + s * 1024), tr_read(ba + (2 * nh + n) * 4096 + s * 1024 + 256));
#pragma unroll
                for (int a = 0; a < 2; ++a)
#pragma unroll
                    for (int n = 0; n < 2; ++n) acc[a][n] = mfma32(af[a], bfr[n], acc[a][n]);
            }
#pragma unroll
            for (int a = 0; a < 2; ++a)
#pragma unroll
                for (int n = 0; n < 2; ++n)
#pragma unroll
                    for (int i = 0; i < 16; ++i) {
                        const int pr = 32 * a + (i & 3) + 8 * (i >> 2) + 4 * hh;
                        sp[pr * 128 + 32 * (2 * nh + n) + (lane & 31)] = (bf16_t)f2bf(acc[a][n][i]);
                    }
        }
        __syncthreads();
    }
}

DEV void ssd2_item(const FP& p, int blk) {
    const int tid = threadIdx.x;
    unsigned* ST = (unsigned*)(p.ws + WS_ST); const float* cdec = (const float*)(p.ws + WS_CDEC); float* pssm = p.out + 33685504;
    const int idx = blk * 512 + tid;
    const int n2 = idx & 63, pr = (idx >> 6) & 63, h = (idx >> 12) & 7, b = idx >> 15;
    float s0 = 0.f, s1 = 0.f;
    for (int c0 = 0; c0 < 128; c0 += 32) {
        unsigned v[32];
#pragma unroll
        for (int j = 0; j < 32; ++j) v[j] = ST[(((size_t)(b * 128 + c0 + j) * 8 + h) * 64 + pr) * 64 + n2];
#pragma unroll
        for (int j = 0; j < 32; ++j) {
            const float dc = cdec[(b * 128 + c0 + j) * 8 + h];
            ST[(((size_t)(b * 128 + c0 + j) * 8 + h) * 64 + pr) * 64 + n2] = pk2(s0, s1);
            s0 = s0 * dc + bflo(v[j]); s1 = s1 * dc + bfhi(v[j]);
        }
    }
    float2 o; o.x = s0; o.y = s1;
    ((float2*)pssm)[(((size_t)b * 8 + h) * 64 + pr) * 64 + n2] = o;
}
DEV void phase_ssd2(const FP& p, int G, int bid) { for (int blk = bid; blk < 128; blk += G) ssd2_item(p, blk); }

DEV void phase_ssd3(const FP& p, LAS unsigned char* lds, int G, int bid) {
    LAS float* tdt = (LAS float*)(lds + S_TDT); LAS float* tac = (LAS float*)(lds + S_TAC); LAS float* ssq = (LAS float*)(lds + S_SSQ);
    const bf16_t* ST = (const bf16_t*)(p.ws + WS_ST); const bf16_t* ZX = (const bf16_t*)(p.ws + WS_ZX); bf16_t* CAT = (bf16_t*)(p.ws + WS_CAT);
    for (int u = bid; u < 256; u += G) {
        int tid = threadIdx.x; asm volatile("" : "+v"(tid));
        const int lane = tid & 63, wave = __builtin_amdgcn_readfirstlane(tid >> 6), r = lane & 31, hh = lane >> 5;
        const int b = u >> 7, c = u & 127; const size_t row0 = (size_t)b * 8192 + (size_t)c * 64;
        (void)ssd_tables(p, tdt, tac, row0, wave, lane);
        {
            const int cg = tid >> 2, tq = tid & 3, col0 = cg * 8;
            ssd_conv8(p, row0, col0, tq * 16, [&](int l, f32x4 a0, f32x4 a1) {
                u32x4 w; w.x = pk2(a0[0], a0[1]); w.y = pk2(a0[2], a0[3]); w.z = pk2(a1[0], a1[1]); w.w = pk2(a1[2], a1[3]);
                if (cg < 64) {
                    const int h = cg >> 3, pp = col0 & 63;
                    *(LAS u32x4*)(lds + S_XS + h * 8192 + (pp >> 5) * 4096 + l * 64 + (pp & 31) * 2) = w;
                } else {
                    const int n = (col0 - 512) & 255, g = n >> 7, ch = (n & 127) >> 3;
                    *(LAS u32x4*)(lds + (col0 < 768 ? S_B : S_C) + g * 16384 + l * 256 + ((ch ^ (l & 15)) << 4)) = w;
                }
            });
        }
        __syncthreads();
        const int h = wave, g = h >> 2;
        f32x16 Y[2][2];
#pragma unroll
        for (int a = 0; a < 2; ++a)
#pragma unroll
            for (int l2 = 0; l2 < 2; ++l2)
#pragma unroll
                for (int i = 0; i < 16; ++i) Y[a][l2][i] = 0.f;
        const LAS unsigned char* cp = lds + S_C + g * 16384 + r * 256;
        const LAS unsigned char* bp = lds + S_B + g * 16384 + r * 256;
        const bf16_t* pv = ST + ((size_t)u * 8 + h) * 8192 + (size_t)r * 128 + 8 * hh;
#pragma unroll 2
        for (int ks = 0; ks < 8; ++ks) {
            const int sl = ((2 * ks + hh) ^ (r & 15)) << 4;
            const bf16x8 c0 = *(const LAS bf16x8*)(cp + sl), c1 = *(const LAS bf16x8*)(cp + 32 * 256 + sl);
            const bf16x8 p0 = *(const bf16x8*)(pv + 16 * ks), p1 = *(const bf16x8*)(pv + 32 * 128 + 16 * ks);
            Y[0][0] = mfma32(p0, c0, Y[0][0]); Y[0][1] = mfma32(p0, c1, Y[0][1]);
            Y[1][0] = mfma32(p1, c0, Y[1][0]); Y[1][1] = mfma32(p1, c1, Y[1][1]);
        }
        float acl[2];
#pragma unroll
        for (int l2 = 0; l2 < 2; ++l2) {
            acl[l2] = tac[(32 * l2 + r) * 8 + h]; const float e = expf(acl[l2]);
#pragma unroll
            for (int a = 0; a < 2; ++a)
#pragma unroll
                for (int i = 0; i < 16; ++i) Y[a][l2][i] *= e;
        }
        __builtin_amdgcn_sched_barrier(0);
        const LAS unsigned char* xa = lds + S_XS + h * 8192 + hh * 256 + trlane(lane);
#pragma unroll
        for (int lb = 0; lb < 2; ++lb)
#pragma unroll
            for (int sb = 0; sb <= lb; ++sb) {
                f32x16 T;
#pragma unroll
                for (int i = 0; i < 16; ++i) T[i] = 0.f;
#pragma unroll 2
                for (int ks = 0; ks < 8; ++ks) {
                    const int sl = ((2 * ks + hh) ^ (r & 15)) << 4;
                    const bf16x8 bb = *(const LAS bf16x8*)(bp + sb * 32 * 256 + sl), cc = *(const LAS bf16x8*)(cp + lb * 32 * 256 + sl);
                    T = mfma32(bb, cc, T);
                }
#pragma unroll
                for (int i = 0; i < 16; ++i) {
                    const int s = 32 * sb + (i & 3) + 8 * (i >> 2) + 4 * hh;
                    const float f = tdt[s * 8 + h] * __builtin_amdgcn_exp2f(1.4426950408889634f * fminf(acl[lb] - tac[s * 8 + h], 0.f));
                    T[i] = (s <= 32 * lb + r) ? T[i] * f : 0.f;
                }
                const bf16x8 P0 = pfrag(T, 0), P1 = pfrag(T, 1);
#pragma unroll
                for (int a = 0; a < 2; ++a) {
                    const bf16x8 x0 = cat8(tr_read(xa + a * 4096 + (2 * sb) * 1024), tr_read(xa + a * 4096 + (2 * sb) * 1024 + 512));
                    const bf16x8 x1 = cat8(tr_read(xa + a * 4096 + (2 * sb + 1) * 1024), tr_read(xa + a * 4096 + (2 * sb + 1) * 1024 + 512));
                    Y[a][lb] = mfma32(x0, P0, Y[a][lb]);
                    Y[a][lb] = mfma32(x1, P1, Y[a][lb]);
                }
            }
        __builtin_amdgcn_sched_barrier(0);
        const float Dh = p.in[14][h];
        float sq[2] = {0.f, 0.f};
#pragma unroll
        for (int a = 0; a < 2; ++a)
#pragma unroll
            for (int l2 = 0; l2 < 2; ++l2) {
                const int l = 32 * l2 + r;
#pragma unroll
                for (int g4 = 0; g4 < 4; ++g4) {
                    const int pp = 8 * g4 + 4 * hh;
                    const u32x2 xw = *(const LAS u32x2*)(lds + S_XS + h * 8192 + a * 4096 + l * 64 + pp * 2);
                    const u32x2 zw = *(const u32x2*)(ZX + (row0 + l) * 1536 + h * 64 + 32 * a + pp);
                    const float xv[4] = {bflo(xw.x), bfhi(xw.x), bflo(xw.y), bfhi(xw.y)}, zv[4] = {bflo(zw.x), bfhi(zw.x), bflo(zw.y), bfhi(zw.y)};
#pragma unroll
                    for (int i = 0; i < 4; ++i) { const float v = (Y[a][l2][4 * g4 + i] + Dh * xv[i]) * fast_silu(zv[i]); Y[a][l2][4 * g4 + i] = v; sq[l2] += v * v; }
                }
            }
#pragma unroll
        for (int l2 = 0; l2 < 2; ++l2) { sq[l2] = half_sum(sq[l2]); if (hh == 0) ssq[(h * 2 + l2) * 32 + r] = sq[l2]; }
        __syncthreads();
        float rs[2];
#pragma unroll
        for (int l2 = 0; l2 < 2; ++l2) {
            float t = 0.f;
#pragma unroll
            for (int k = 0; k < 4; ++k) t += ssq[((4 * g + k) * 2 + l2) * 32 + r];
            rs[l2] = rsqrtf(t * (1.f / 256.f) + 1e-5f);
        }
#pragma unroll
        for (int a = 0; a < 2; ++a)
#pragma unroll
            for (int g4 = 0; g4 < 4; ++g4) {
                const int pcol = h * 64 + 32 * a + 8 * g4 + 4 * hh;
                const f32x4 w = *(const f32x4*)(p.in[15] + pcol);
#pragma unroll
                for (int l2 = 0; l2 < 2; ++l2) {
                    u32x2 o; o.x = cvtpk(Y[a][l2][4 * g4 + 0] * rs[l2] * w[0], Y[a][l2][4 * g4 + 1] * rs[l2] * w[1]);
                    o.y = cvtpk(Y[a][l2][4 * g4 + 2] * rs[l2] * w[2], Y[a][l2][4 * g4 + 3] * rs[l2] * w[3]);
                    *(u32x2*)(CAT + (row0 + 32 * l2 + r) * 1024 + pcol) = o;
                }
            }
        __syncthreads();
    }
}

struct AttnCtx { float lam; };
DEV AttnCtx attn_setup(const FP& p, LAS unsigned char* lds) {
    const int tid0 = threadIdx.x, lane0 = tid0 & 63;
    AttnCtx c; c.lam = expf(wave_sum(p.in[16][lane0] * p.in[17][lane0])) - expf(wave_sum(p.in[18][lane0] * p.in[19][lane0])) + 0.2f;
    LAS float* subw = (LAS float*)(lds + 131072);
    if (tid0 < 128) subw[tid0] = p.in[20][tid0];
    return c;
}
DEV void attn_unit(const FP& p, LAS unsigned char* lds, const AttnCtx& ctx, int bh, int jq) {
    const bf16_t* Qg = (const bf16_t*)(p.ws + WS_Q); const bf16_t* Kg = (const bf16_t*)(p.ws + WS_K); const bf16_t* Vg = (const bf16_t*)(p.ws + WS_V);
    bf16_t* CAT = (bf16_t*)(p.ws + WS_CAT);
    const float lam_init = 0.2f, lam = ctx.lam;
    LAS float* subw = (LAS float*)(lds + 131072);
    const int b = bh >> 2, h = bh & 3;
    int tid = threadIdx.x; asm volatile("" : "+v"(tid));
    const int lane = tid & 63, wave = __builtin_amdgcn_readfirstlane(tid >> 6), r = lane & 31, hh = lane >> 5, qb = wave & 3, c = wave >> 2;
    const int vlane = (4 * hh) * 64 + trlane(lane);
    const size_t rowb = (size_t)b * 8192; const int q0 = jq * 128;
    const int ntb = 2 * jq + 2, myn = 2 * jq + (qb >> 1) + 1;
    constexpr int KOFF = 0, VOFF = 49152;
    bf16x8 qf[4];
#pragma unroll
    for (int ks = 0; ks < 4; ++ks) qf[ks] = *(const bf16x8*)(Qg + (rowb + q0 + 32 * qb + r) * 512 + h * 128 + c * 64 + 16 * ks + 8 * hh);
#pragma unroll
    for (int ks = 0; ks < 4; ++ks) asm volatile("" : "+v"(qf[ks]));
    const bf16_t* ksrc[2]; const bf16_t* vsrc[2]; int kdst[2], vdst[2];
#pragma unroll
    for (int j = 0; j < 2; ++j) {
        const int pc = wave + 8 * j;
        { const int comp = pc >> 3, kb8 = pc & 7, key = 8 * kb8 + (lane >> 3), ch = (lane & 7) ^ ((key >> 1) & 7);
          ksrc[j] = Kg + (rowb + key) * 512 + h * 128 + comp * 64 + ch * 8; kdst[j] = KOFF + comp * 8192 + kb8 * 1024; }
        { const int eb = pc >> 2, kb16 = pc & 3, key = 16 * kb16 + (lane >> 2);
          vsrc[j] = Vg + (rowb + key) * 512 + h * 128 + eb * 32 + (lane & 3) * 8; vdst[j] = VOFF + eb * 4096 + kb16 * 1024; }
    }
#define ATT_DMA(t, bufo) do { _Pragma("unroll") for (int j_ = 0; j_ < 2; ++j_) { \
        __builtin_amdgcn_global_load_lds((const unsigned*)(ksrc[j_] + (size_t)(64 * (t)) * 512), (LAS unsigned*)(lds + kdst[j_] + (bufo)), 16, 0, 0); \
        __builtin_amdgcn_global_load_lds((const unsigned*)(vsrc[j_] + (size_t)(64 * (t)) * 512), (LAS unsigned*)(lds + vdst[j_] + (bufo)), 16, 0, 0); } } while (0)
#define ATT_BAR_L() do { asm volatile("s_waitcnt lgkmcnt(0)" ::: "memory"); __builtin_amdgcn_s_barrier(); asm volatile("" ::: "memory"); } while (0)
#define ATT_BAR_VL() do { asm volatile("s_waitcnt vmcnt(0) lgkmcnt(0)" ::: "memory"); __builtin_amdgcn_s_barrier(); asm volatile("" ::: "memory"); } while (0)
    asm volatile("s_waitcnt vmcnt(0) lgkmcnt(0)" ::: "memory");
    ATT_DMA(0, 0);
    ATT_BAR_VL();
    f32x16 O[4];
#pragma unroll
    for (int e = 0; e < 4; ++e)
#pragma unroll
        for (int i = 0; i < 16; ++i) O[e][i] = 0.f;
    float mrun = -1e30f, lsum = 0.f;
    for (int t = 0; t < ntb; ++t) {
        if (t + 1 < ntb) ATT_DMA(t + 1, ((t + 1) % 3) * 16384);
        if (t < myn) {
            const LAS unsigned char* kp = lds + KOFF + (t % 3) * 16384 + c * 8192 + r * 128;
            const LAS unsigned char* vp = lds + VOFF + (t % 3) * 16384 + vlane;
            f32x16 S0, S1;
#pragma unroll
            for (int i = 0; i < 16; ++i) { S0[i] = 0.f; S1[i] = 0.f; }
#pragma unroll
            for (int ks = 0; ks < 4; ++ks) {
                const int sl = ((2 * ks + hh) ^ ((r >> 1) & 7)) << 4;
                const bf16x8 a0 = *(const LAS bf16x8*)(kp + sl), a1 = *(const LAS bf16x8*)(kp + 32 * 128 + sl);
                S0 = mfma32(a0, qf[ks], S0); S1 = mfma32(a1, qf[ks], S1);
            }
            const float mx = half_max(fmaxf(max16(S0), max16(S1)));
            const float mnew = fmaxf(mrun, mx);
            if (__any(mnew > mrun)) {
                const float alpha = __builtin_amdgcn_exp2f(mrun - mnew);
                lsum *= alpha;
#pragma unroll
                for (int e = 0; e < 4; ++e)
#pragma unroll
                    for (int i = 0; i < 16; ++i) O[e][i] *= alpha;
                mrun = mnew;
            }
            float ps = 0.f;
#pragma unroll
            for (int i = 0; i < 16; ++i) { S0[i] = __builtin_amdgcn_exp2f(S0[i] - mrun); S1[i] = __builtin_amdgcn_exp2f(S1[i] - mrun); ps += S0[i] + S1[i]; }
            lsum += ps;
            const bf16x8 P0 = pfrag(S0, 0), P1 = pfrag(S0, 1), P2 = pfrag(S1, 0), P3 = pfrag(S1, 1);
#pragma unroll
            for (int e = 0; e < 4; ++e) {
                const bf16x8 v0 = cat8(tr_read(vp + e * 4096), tr_read(vp + e * 4096 + 512));
                const bf16x8 v1 = cat8(tr_read(vp + e * 4096 + 1024), tr_read(vp + e * 4096 + 1536));
                const bf16x8 v2 = cat8(tr_read(vp + e * 4096 + 2048), tr_read(vp + e * 4096 + 2560));
                const bf16x8 v3 = cat8(tr_read(vp + e * 4096 + 3072), tr_read(vp + e * 4096 + 3584));
                O[e] = mfma32(v0, P0, O[e]); O[e] = mfma32(v1, P1, O[e]); O[e] = mfma32(v2, P2, O[e]); O[e] = mfma32(v3, P3, O[e]);
            }
        }
        ATT_BAR_VL();
    }
#undef ATT_DMA
    const float inv = 1.f / half_sum(lsum);
    LAS float* xch = (LAS float*)(lds + qb * 16384);
    if (c == 1) {
        const float f = -lam * inv;
#pragma unroll
        for (int e = 0; e < 4; ++e)
#pragma unroll
            for (int i = 0; i < 16; ++i) xch[(e * 16 + i) * 64 + lane] = O[e][i] * f;
    }
    __syncthreads();
    if (c == 0) {
        float ss = 0.f;
#pragma unroll
        for (int e = 0; e < 4; ++e)
#pragma unroll
            for (int i = 0; i < 16; ++i) { const float v = O[e][i] * inv + xch[(e * 16 + i) * 64 + lane]; O[e][i] = v; ss += v * v; }
        ss = half_sum(ss);
        const float rs = rsqrtf(ss * (1.f / 128.f) + 1e-5f) * (1.f - lam_init);
        WAVE_SYNC();
        LAS unsigned char* stg = lds + qb * 16384;
#pragma unroll
        for (int e = 0; e < 4; ++e)
#pragma unroll
            for (int g4 = 0; g4 < 4; ++g4) {
                const int e0 = 32 * e + 8 * g4 + 4 * hh;
                const f32x4 w = *(const LAS f32x4*)(subw + e0);
                u32x2 o; o.x = cvtpk(O[e][4 * g4 + 0] * rs * w[0], O[e][4 * g4 + 1] * rs * w[1]); o.y = cvtpk(O[e][4 * g4 + 2] * rs * w[2], O[e][4 * g4 + 3] * rs * w[3]);
                *(LAS u32x2*)(stg + r * 272 + e0 * 2) = o;
            }
        WAVE_SYNC();
#pragma unroll
        for (int i = 0; i < 8; ++i) {
            const int row = i * 4 + (lane >> 4), ch = lane & 15;
            const u32x4 v = *(const LAS u32x4*)(stg + row * 272 + ch * 16);
            *(u32x4*)(CAT + (rowb + q0 + 32 * qb + row) * 1024 + 512 + h * 128 + ch * 8) = v;
        }
    }
    __syncthreads();
#undef ATT_BAR_L
#undef ATT_BAR_VL
}
DEV void phase_attn(const FP& p, LAS unsigned char* lds, int G, int bid) {
    const AttnCtx ctx = attn_setup(p, lds);
    for (int pu = bid; pu < 256; pu += G) {
        const int bh = pu & 7, pr = pu >> 3;
        attn_unit(p, lds, ctx, bh, pr);
        attn_unit(p, lds, ctx, bh, 63 - pr);
    }
}

constexpr int NS = 128;
constexpr size_t SB_XN = 0, SB_Z = 256 * 1024, SB_XBC = 512 * 1024, SB_Q = 1024 * 1024, SB_DTV = 1280 * 1024, SB_YPRE = 1536 * 1024, SB_CAT = 1792 * 1024, SB_MIX = 2048 * 1024,
                 SB_QX = 2560 * 1024, SB_OX = 3072 * 1024, SB_HID = 3328 * 1024, SB_AML = 4096 * 1024, SB_XML = 4608 * 1024, SB_XO = 5 * MiB, SB_AO = 8 * MiB;
constexpr int N_ATILE = 33;

template <class Epi>
DEV void s_gemm(const bf16_t* A, const bf16_t* Bt, int N, int K, LAS unsigned char* lds, int bid, int G, int rot, const Epi& E) {
    int tid = threadIdx.x; asm volatile("" : "+v"(tid));
    const int lane = tid & 63, wave = __builtin_amdgcn_readfirstlane(tid >> 6), r = lane & 31, hh = lane >> 5;
    const int nun = 4 * (N >> 5), kw = K >> 3, nit = kw >> 5;
    for (int u = (bid + G - rot) % G; u < nun; u += G) {
        const int mb = u & 3, n0 = (u >> 2) * 32;
        const bf16_t* ap = A + (size_t)(32 * mb + r) * K + wave * kw + 16 * hh;
        const bf16_t* bp = Bt + (size_t)(n0 + r) * K + wave * kw + 16 * hh;
        f32x16 acc;
#pragma unroll
        for (int i = 0; i < 16; ++i) acc[i] = 0.f;
#pragma unroll 4
        for (int j = 0; j < nit; ++j) {
            const bf16x8 a0 = *(const bf16x8*)(ap + 32 * j), a1 = *(const bf16x8*)(ap + 32 * j + 8);
            const bf16x8 b0 = *(const bf16x8*)(bp + 32 * j), b1 = *(const bf16x8*)(bp + 32 * j + 8);
            acc = mfma32(b0, a0, acc); acc = mfma32(b1, a1, acc);
        }
        LAS float* red = (LAS float*)lds;
        if (wave != 0) {
#pragma unroll
            for (int i = 0; i < 16; ++i) red[wave * 1024 + i * 64 + lane] = acc[i];
        }
        __syncthreads();
        if (wave == 0) {
#pragma unroll
            for (int w = 1; w < 8; ++w)
#pragma unroll
                for (int i = 0; i < 16; ++i) acc[i] += red[w * 1024 + i * 64 + lane];
            E(acc, 32 * mb + r, n0, hh);
        }
        __syncthreads();
    }
}
struct EpiSF32 {
    float* C; int ldc; float scale;
    __device__ __forceinline__ void operator()(const f32x16& acc, int m, int n0, int hh) const {
#pragma unroll
        for (int g4 = 0; g4 < 4; ++g4) { f32x4 v = {acc[4 * g4] * scale, acc[4 * g4 + 1] * scale, acc[4 * g4 + 2] * scale, acc[4 * g4 + 3] * scale}; *(f32x4*)(C + (size_t)m * ldc + n0 + 8 * g4 + 4 * hh) = v; }
    }
};
struct EpiSSwiglu {
    bf16_t* H;
    __device__ __forceinline__ void operator()(const f32x16& acc, int m, int n0, int hh) const {
#pragma unroll
        for (int g4 = 0; g4 < 2; ++g4) {
            u32x2 w; w.x = cvtpk(fast_silu(acc[4 * g4]) * acc[4 * g4 + 8], fast_silu(acc[4 * g4 + 1]) * acc[4 * g4 + 9]);
            w.y = cvtpk(fast_silu(acc[4 * g4 + 2]) * acc[4 * g4 + 10], fast_silu(acc[4 * g4 + 3]) * acc[4 * g4 + 11]);
            *(u32x2*)(H + (size_t)m * 2816 + 16 * (n0 >> 5) + 8 * g4 + 4 * hh) = w;
        }
    }
};
struct EpiSIn {
    float *z, *xbc, *q, *ok, *ov, *oconv;
    __device__ __forceinline__ void operator()(const f32x16& acc, int m, int n0, int hh) const {
        const int t = m & 15, b = m >> 4;
        if (n0 < 1536) {
#pragma unroll
            for (int g4 = 0; g4 < 4; ++g4) {
                const f32x4 v = {acc[4 * g4], acc[4 * g4 + 1], acc[4 * g4 + 2], acc[4 * g4 + 3]}; const int col = n0 + 8 * g4 + 4 * hh;
                if (n0 < 512) *(f32x4*)(z + (size_t)m * 512 + col) = v;
                else { *(f32x4*)(xbc + (size_t)m * 1024 + col - 512) = v; if (t >= 13) *(f32x4*)(oconv + (size_t)(b * 3 + t - 13) * 1024 + col - 512) = v; }
            }
        } else if (n0 < 2560) {
            const bool isk = n0 >= 2048; const int cl = (n0 - (isk ? 2048 : 1536)), u64 = cl >> 6, g = (cl >> 5) & 1;
            const float pos = (float)(2048 + t);
            float* dst = (isk ? ok : q) + (size_t)m * 512 + u64 * 64;
#pragma unroll
            for (int g4 = 0; g4 < 2; ++g4) {
                f32x4 o1, o2;
#pragma unroll
                for (int i = 0; i < 4; ++i) {
                    const int d0 = 16 * g + 8 * g4 + 4 * hh + i;
                    float rev = pos * (__builtin_amdgcn_exp2f(-(float)d0 * (13.287712379549449f / 32.f)) * 0.15915494309189535f); rev -= floorf(rev);
                    const float sn = __builtin_amdgcn_sinf(rev), cs = __builtin_amdgcn_cosf(rev);
                    const float x1 = acc[4 * g4 + i], x2 = acc[4 * g4 + 8 + i];
                    o1[i] = x1 * cs - x2 * sn; o2[i] = x2 * cs + x1 * sn;
                }
                const int d0 = 16 * g + 8 * g4 + 4 * hh;
                *(f32x4*)(dst + d0) = o1; *(f32x4*)(dst + d0 + 32) = o2;
            }
        } else {
#pragma unroll
            for (int g4 = 0; g4 < 4; ++g4) { const f32x4 v = {acc[4 * g4], acc[4 * g4 + 1], acc[4 * g4 + 2], acc[4 * g4 + 3]}; *(f32x4*)(ov + (size_t)m * 512 + n0 - 2560 + 8 * g4 + 4 * hh) = v; }
        }
    }
};

DEV void s_row(const FP& p, const float* raw, const float* hin, const float* gpost, float* hout, const float* gpre, bf16_t* xn, float* dtv, int bid, int G, int rot) {
    const int lane = threadIdx.x & 63, wave = __builtin_amdgcn_readfirstlane(threadIdx.x >> 6);
    const int blk = (bid + G - rot) % G;
    for (int r = blk + G * wave; r < NS; r += 8 * G) {
        f32x4 h[4];
#pragma unroll
        for (int j = 0; j < 4; ++j) h[j] = ((const f32x4*)(hin + (size_t)r * 1024))[lane + 64 * j];
        if (raw) {
            f32x4 v[4]; float ss = 0.f;
#pragma unroll
            for (int j = 0; j < 4; ++j) { v[j] = ((const f32x4*)(raw + (size_t)r * 1024))[lane + 64 * j]; ss += v[j].x * v[j].x + v[j].y * v[j].y + v[j].z * v[j].z + v[j].w * v[j].w; }
            const float rs = rsqrtf(wave_sum(ss) * (1.f / 1024.f) + 1e-6f);
#pragma unroll
            for (int j = 0; j < 4; ++j) { const f32x4 g = ((const f32x4*)gpost)[lane + 64 * j]; h[j] += v[j] * rs * g; }
        }
        if (hout) {
#pragma unroll
            for (int j = 0; j < 4; ++j) ((f32x4*)(hout + (size_t)r * 1024))[lane + 64 * j] = h[j];
        }
        if (gpre) {
            float ss = 0.f;
#pragma unroll
            for (int j = 0; j < 4; ++j) ss += h[j].x * h[j].x + h[j].y * h[j].y + h[j].z * h[j].z + h[j].w * h[j].w;
            const float rs = rsqrtf(wave_sum(ss) * (1.f / 1024.f) + 1e-6f);
            float d[8];
#pragma unroll
            for (int k = 0; k < 8; ++k) d[k] = 0.f;
#pragma unroll
            for (int j = 0; j < 4; ++j) {
                const f32x4 g = ((const f32x4*)gpre)[lane + 64 * j]; const f32x4 o = h[j] * rs * g;
                u32x2 w; w.x = pk2(o.x, o.y); w.y = pk2(o.z, o.w);
                ((u32x2*)(xn + (size_t)r * 1024))[lane + 64 * j] = w;
                if (dtv) {
#pragma unroll
                    for (int i = 0; i < 4; ++i) {
                        const float* wp = p.in[9] + (size_t)(4 * (lane + 64 * j) + i) * 3080 + 1536;
                        const f32x4 w0 = *(const f32x4*)wp, w1 = *(const f32x4*)(wp + 4); const float hv = o[i];
                        d[0] += hv * w0.x; d[1] += hv * w0.y; d[2] += hv * w0.z; d[3] += hv * w0.w; d[4] += hv * w1.x; d[5] += hv * w1.y; d[6] += hv * w1.z; d[7] += hv * w1.w;
                    }
                }
            }
            if (dtv) {
#pragma unroll
                for (int k = 0; k < 8; ++k) d[k] = wave_sum(d[k]);
                float mine = d[0];
#pragma unroll
                for (int k = 1; k < 8; ++k) mine = ((lane & 7) == k) ? d[k] : mine;
                const float xx = mine + p.in[12][lane & 7];
                if (lane < 8) dtv[(size_t)r * 8 + lane] = (xx > 20.f) ? xx : log1pf(expf(xx));
            }
        }
    }
}

DEV void s_ssd(const FP& p, LAS unsigned char* lds, int bid, int G, int rot) {
    const int tid = threadIdx.x;
    const float* xbc = (const float*)(p.ws + WS_SMP + SB_XBC); const float* zb = (const float*)(p.ws + WS_SMP + SB_Z); const float* dtv = (const float*)(p.ws + WS_SMP + SB_DTV);
    float* ypre = (float*)(p.ws + WS_SMP + SB_YPRE); float* s_ssm = p.out + 35002368;
    const float* cbuf = p.in[5]; const float* cw = p.in[10]; const float* cb = p.in[11];
    LAS float* act = (LAS float*)lds;
    for (int item = (bid + G - rot) % G; item < 64; item += G) {
        const int b = item >> 3, h = item & 7, g = h >> 2;
        for (int e = tid; e < 16 * 320; e += 512) {
            const int t = e / 320, cc = e % 320;
            const int col = (cc < 64) ? h * 64 + cc : (cc < 192 ? 512 + g * 128 + (cc - 64) : 768 + g * 128 + (cc - 192));
            float a = cb[col];
#pragma unroll
            for (int j = 0; j < 4; ++j) {
                const int tt = t - 3 + j;
                const float u = (tt >= 0) ? xbc[(size_t)(b * 16 + tt) * 1024 + col] : cbuf[(size_t)(b * 3 + tt + 3) * 1024 + col];
                a += cw[j * 1024 + col] * u;
            }
            act[e] = a / (1.f + expf(-a));
        }
        __syncthreads();
        const int pp = tid >> 3, seg = tid & 7;
        float hs[16];
        const size_t sbase = ((size_t)(b * 8 + h) * 64 + pp) * 128 + seg * 16;
#pragma unroll
        for (int i = 0; i < 16; ++i) hs[i] = p.in[4][sbase + i];
        const float a = -expf(p.in[13][h]), D = p.in[14][h];
#pragma unroll 1
        for (int t = 0; t < 16; ++t) {
            const float dt = dtv[(b * 16 + t) * 8 + h];
            const float zz = zb[(size_t)(b * 16 + t) * 512 + h * 64 + pp];
            const float x = act[t * 320 + pp];
            const float dA = expf(dt * a), coef = dt * x;
            float y = 0.f;
#pragma unroll
            for (int i = 0; i < 16; ++i) { hs[i] = dA * hs[i] + coef * act[t * 320 + 64 + seg * 16 + i]; y += act[t * 320 + 192 + seg * 16 + i] * hs[i]; }
            y += __shfl_xor(y, 1); y += __shfl_xor(y, 2); y += __shfl_xor(y, 4);
            if (seg == 0) ypre[(size_t)(b * 16 + t) * 512 + h * 64 + pp] = (y + D * x) * (zz / (1.f + expf(-zz)));
        }
#pragma unroll
        for (int i = 0; i < 16; ++i) s_ssm[sbase + i] = hs[i];
        __syncthreads();
    }
}

DEV bf16x8 cvt8(const float* p, float sc) {
    const f32x4 a = *(const f32x4*)p, b = *(const f32x4*)(p + 4);
    u32x4 w; w.x = cvtpk(a.x * sc, a.y * sc); w.y = cvtpk(a.z * sc, a.w * sc); w.z = cvtpk(b.x * sc, b.y * sc); w.w = cvtpk(b.z * sc, b.w * sc);
    return __builtin_bit_cast(bf16x8, w);
}
DEV void s_attn_part(const FP& p, LAS unsigned char* lds, int bid, int G) {
    const int lane = threadIdx.x & 63, wave = __builtin_amdgcn_readfirstlane(threadIdx.x >> 6), r = lane & 31, hh = lane >> 5;
    const float* q = (const float*)(p.ws + WS_SMP + SB_Q); const float* kn = p.out + 34871296; const float* vn = p.out + 34936832; const float* kp = p.in[2]; const float* vp = p.in[3];
    float* aml = (float*)(p.ws + WS_SMP + SB_AML); float* ao = (float*)(p.ws + WS_SMP + SB_AO);
    for (int it = bid + G * wave; it < 32 * N_ATILE; it += 8 * G) {
        const int bh = it / N_ATILE, tile = it % N_ATILE, b = bh >> 2, h = bh & 3;
        f32x16 S[2][2];
#pragma unroll
        for (int c = 0; c < 2; ++c)
#pragma unroll
            for (int sub = 0; sub < 2; ++sub)
#pragma unroll
                for (int i = 0; i < 16; ++i) S[c][sub][i] = 0.f;
        const float* qrow = q + (size_t)(b * 16 + (r & 15)) * 512 + h * 128 + 8 * hh;
#pragma unroll
        for (int sub = 0; sub < 2; ++sub) {
            int kk = tile * 64 + sub * 32 + r; if (kk > 2063) kk = 2063;
            const float* krow = ((kk < 2048) ? kp + (((size_t)b * 2048 + kk) * 4 + h) * 128 : kn + (((size_t)b * 16 + (kk - 2048)) * 4 + h) * 128) + 8 * hh;
#pragma unroll
            for (int c = 0; c < 2; ++c)
#pragma unroll
                for (int ks = 0; ks < 4; ++ks) S[c][sub] = mfma32(cvt8(krow + c * 64 + 16 * ks, 1.f), cvt8(qrow + c * 64 + 16 * ks, QSCALE), S[c][sub]);
        }
        bf16x8 P[2][4];
#pragma unroll
        for (int c = 0; c < 2; ++c) {
            float mx = -1e30f;
#pragma unroll
            for (int sub = 0; sub < 2; ++sub)
#pragma unroll
                for (int i = 0; i < 16; ++i) {
                    const int key = tile * 64 + sub * 32 + (i & 3) + 8 * (i >> 2) + 4 * hh;
                    if (key > 2063) S[c][sub][i] = -1e30f;
                    mx = fmaxf(mx, S[c][sub][i]);
                }
            mx = half_max(mx);
            float l = 0.f;
#pragma unroll
            for (int sub = 0; sub < 2; ++sub)
#pragma unroll
                for (int i = 0; i < 16; ++i) { S[c][sub][i] = __builtin_amdgcn_exp2f(S[c][sub][i] - mx); l += S[c][sub][i]; }
            l = half_sum(l);
            if (lane < 16) { aml[((size_t)it * 32 + lane * 2 + c) * 2] = mx * 0.6931471805599453f; aml[((size_t)it * 32 + lane * 2 + c) * 2 + 1] = l; }
            P[c][0] = pfrag(S[c][0], 0); P[c][1] = pfrag(S[c][0], 1); P[c][2] = pfrag(S[c][1], 0); P[c][3] = pfrag(S[c][1], 1);
        }
#pragma unroll 1
        for (int eb = 0; eb < 4; ++eb) {
            f32x16 O0, O1;
#pragma unroll
            for (int i = 0; i < 16; ++i) { O0[i] = 0.f; O1[i] = 0.f; }
#pragma unroll
            for (int st = 0; st < 4; ++st) {
                float vv[8];
#pragma unroll
                for (int jj = 0; jj < 8; ++jj) {
                    int kj = tile * 64 + 16 * st + 8 * (jj >> 2) + 4 * hh + (jj & 3); if (kj > 2063) kj = 2063;
                    const float* vrow = (kj < 2048) ? vp + (((size_t)b * 2048 + kj) * 4 + h) * 128 : vn + (((size_t)b * 16 + (kj - 2048)) * 4 + h) * 128;
                    vv[jj] = vrow[eb * 32 + r];
                }
                u32x4 w; w.x = cvtpk(vv[0], vv[1]); w.y = cvtpk(vv[2], vv[3]); w.z = cvtpk(vv[4], vv[5]); w.w = cvtpk(vv[6], vv[7]);
                const bf16x8 vf = __builtin_bit_cast(bf16x8, w);
                O0 = mfma32(vf, P[0][st], O0); O1 = mfma32(vf, P[1][st], O1);
            }
            if (r < 16) {
#pragma unroll
                for (int g4 = 0; g4 < 4; ++g4) {
                    const int e0 = eb * 32 + 8 * g4 + 4 * hh;
                    *(f32x4*)(ao + ((size_t)it * 32 + r * 2 + 0) * 128 + e0) = (f32x4){O0[4 * g4], O0[4 * g4 + 1], O0[4 * g4 + 2], O0[4 * g4 + 3]};
                    *(f32x4*)(ao + ((size_t)it * 32 + r * 2 + 1) * 128 + e0) = (f32x4){O1[4 * g4], O1[4 * g4 + 1], O1[4 * g4 + 2], O1[4 * g4 + 3]};
                }
            }
        }
    }
}
DEV void s_attn_comb(const FP& p, int bid, int G, int rot) {
    const int lane = threadIdx.x & 63, wave = __builtin_amdgcn_readfirstlane(threadIdx.x >> 6);
    const float* aml = (const float*)(p.ws + WS_SMP + SB_AML); const float* ao = (const float*)(p.ws + WS_SMP + SB_AO); const float* ypre = (const float*)(p.ws + WS_SMP + SB_YPRE);
    bf16_t* cat = (bf16_t*)(p.ws + WS_SMP + SB_CAT);
    const float lam_init = 0.2f;
    const float lam = expf(wave_sum(p.in[16][lane] * p.in[17][lane])) - expf(wave_sum(p.in[18][lane] * p.in[19][lane])) + lam_init;
    const int blk = (bid + G - rot) % G;
    for (int it = blk + G * wave; it < 512 + 256; it += 8 * G) {
        if (it < 512) {
            const int bh = it >> 4, qi = it & 15, b = bh >> 2, h = bh & 3;
            float o[2][2];
#pragma unroll
            for (int c = 0; c < 2; ++c) {
                const float mj = (lane < N_ATILE) ? aml[((size_t)(bh * N_ATILE + lane) * 32 + qi * 2 + c) * 2] : -1e30f;
                const float lj = (lane < N_ATILE) ? aml[((size_t)(bh * N_ATILE + lane) * 32 + qi * 2 + c) * 2 + 1] : 0.f;
                const float M = wave_max(mj), wj = expf(mj - M), L = wave_sum(lj * wj);
                float ax = 0.f, ay = 0.f;
#pragma unroll 11
                for (int j = 0; j < N_ATILE; ++j) {
                    const float w = __shfl(wj, j);
                    const float2 v = ((const float2*)(ao + ((size_t)(bh * N_ATILE + j) * 32 + qi * 2 + c) * 128))[lane];
                    ax += w * v.x; ay += w * v.y;
                }
                o[c][0] = ax / L; o[c][1] = ay / L;
            }
            const float ox = o[0][0] - lam * o[1][0], oy = o[0][1] - lam * o[1][1];
            const float ms = wave_sum(ox * ox + oy * oy) * (1.f / 128.f);
            const float rs = rsqrtf(ms + 1e-5f) * (1.f - lam_init);
            const float2 w = ((const float2*)p.in[20])[lane];
            ((unsigned*)(cat + (size_t)(b * 16 + qi) * 1024 + 512 + h * 128))[lane] = pk2(ox * rs * w.x, oy * rs * w.y);
        } else {
            const int i2 = it - 512, row = i2 >> 1, g = i2 & 1;
            const f32x4 v = ((const f32x4*)(ypre + (size_t)row * 512 + g * 256))[lane];
            const float rs = rsqrtf(wave_sum(v.x * v.x + v.y * v.y + v.z * v.z + v.w * v.w) * (1.f / 256.f) + 1e-5f);
            const f32x4 ww = ((const f32x4*)(p.in[15] + g * 256))[lane];
            u32x2 o; o.x = pk2(v.x * rs * ww.x, v.y * rs * ww.y); o.y = pk2(v.z * rs * ww.z, v.w * rs * ww.w);
            ((u32x2*)(cat + (size_t)row * 1024 + g * 256))[lane] = o;
        }
    }
}
DEV void s_xattn_part(const FP& p, LAS unsigned char* lds, int bid, int G, int rot) {
    const int lane = threadIdx.x & 63, wave = __builtin_amdgcn_readfirstlane(threadIdx.x >> 6), r = lane & 31, hh = lane >> 5;
    const float* qx = (const float*)(p.ws + WS_SMP + SB_QX); const float* mk = p.in[6]; const float* mv = p.in[7];
    float* xml = (float*)(p.ws + WS_SMP + SB_XML); float* xo = (float*)(p.ws + WS_SMP + SB_XO);
    const int blk = (bid + G - rot) % G;
    for (int it = blk + G * wave; it < 128; it += 8 * G) {
        const int bh = it >> 2, tile = it & 3, b = bh >> 2, h = bh & 3;
        f32x16 S[2];
#pragma unroll
        for (int sub = 0; sub < 2; ++sub)
#pragma unroll
            for (int i = 0; i < 16; ++i) S[sub][i] = 0.f;
        const float* qrow = qx + (size_t)(b * 16 + (r & 15)) * 1024 + h * 256 + 8 * hh;
#pragma unroll 4
        for (int ks = 0; ks < 16; ++ks) {
            const bf16x8 qf = cvt8(qrow + 16 * ks, 0.0625f * 1.4426950408889634f);
#pragma unroll
            for (int sub = 0; sub < 2; ++sub) {
                const float* krow = mk + (((size_t)b * 256 + tile * 64 + sub * 32 + r) * 4 + h) * 256 + 8 * hh;
                S[sub] = mfma32(cvt8(krow + 16 * ks, 1.f), qf, S[sub]);
            }
        }
        float mx = half_max(fmaxf(max16(S[0]), max16(S[1])));
        float l = 0.f;
#pragma unroll
        for (int sub = 0; sub < 2; ++sub)
#pragma unroll
            for (int i = 0; i < 16; ++i) { S[sub][i] = __builtin_amdgcn_exp2f(S[sub][i] - mx); l += S[sub][i]; }
        l = half_sum(l);
        if (lane < 16) { xml[((size_t)it * 16 + lane) * 2] = mx * 0.6931471805599453f; xml[((size_t)it * 16 + lane) * 2 + 1] = l; }
        bf16x8 P[4];
        P[0] = pfrag(S[0], 0); P[1] = pfrag(S[0], 1); P[2] = pfrag(S[1], 0); P[3] = pfrag(S[1], 1);
#pragma unroll 1
        for (int eb = 0; eb < 8; ++eb) {
            f32x16 O;
#pragma unroll
            for (int i = 0; i < 16; ++i) O[i] = 0.f;
#pragma unroll
            for (int st = 0; st < 4; ++st) {
                float vv[8];
#pragma unroll
                for (int jj = 0; jj < 8; ++jj) {
                    const int kj = tile * 64 + 16 * st + 8 * (jj >> 2) + 4 * hh + (jj & 3);
                    vv[jj] = mv[(((size_t)b * 256 + kj) * 4 + h) * 256 + eb * 32 + r];
                }
                u32x4 w; w.x = cvtpk(vv[0], vv[1]); w.y = cvtpk(vv[2], vv[3]); w.z = cvtpk(vv[4], vv[5]); w.w = cvtpk(vv[6], vv[7]);
                O = mfma32(__builtin_bit_cast(bf16x8, w), P[st], O);
            }
            if (r < 16) {
#pragma unroll
                for (int g4 = 0; g4 < 4; ++g4) *(f32x4*)(xo + ((size_t)it * 16 + r) * 256 + eb * 32 + 8 * g4 + 4 * hh) = (f32x4){O[4 * g4], O[4 * g4 + 1], O[4 * g4 + 2], O[4 * g4 + 3]};
            }
        }
    }
}
DEV void s_xattn_comb(const FP& p, int bid, int G, int rot) {
    const int lane = threadIdx.x & 63, wave = __builtin_amdgcn_readfirstlane(threadIdx.x >> 6);
    const float* xml = (const float*)(p.ws + WS_SMP + SB_XML); const float* xo = (const float*)(p.ws + WS_SMP + SB_XO);
    bf16_t* ox = (bf16_t*)(p.ws + WS_SMP + SB_OX);
    const int blk = (bid + G - rot) % G;
    for (int it = blk + G * wave; it < 512; it += 8 * G) {
        const int bh = it >> 4, qi = it & 15, b = bh >> 2, h = bh & 3;
        float m[4], l[4];
#pragma unroll
        for (int j = 0; j < 4; ++j) { m[j] = xml[((size_t)(bh * 4 + j) * 16 + qi) * 2]; l[j] = xml[((size_t)(bh * 4 + j) * 16 + qi) * 2 + 1]; }
        const float M = fmaxf(fmaxf(m[0], m[1]), fmaxf(m[2], m[3]));
        float L = 0.f; f32x4 acc = {0.f, 0.f, 0.f, 0.f};
#pragma unroll
        for (int j = 0; j < 4; ++j) { const float w = expf(m[j] - M); L += l[j] * w; acc += ((const f32x4*)(xo + ((size_t)(bh * 4 + j) * 16 + qi) * 256))[lane] * w; }
        const float il = 1.f / L;
        u32x2 o; o.x = pk2(acc.x * il, acc.y * il); o.y = pk2(acc.z * il, acc.w * il);
        ((u32x2*)(ox + (size_t)(b * 16 + qi) * 1024 + h * 256))[lane] = o;
    }
}

namespace cg = cooperative_groups;


DEV unsigned long long rf64(unsigned long long v) {
    const unsigned lo = __builtin_amdgcn_readfirstlane((unsigned)v), hi = __builtin_amdgcn_readfirstlane((unsigned)(v >> 32));
    return ((unsigned long long)hi << 32) | lo;
}
DEV FP fp_from_lds(const LAS unsigned long long* tab) {
    asm volatile("" ::: "memory");
    FP q;
#pragma unroll
    for (int i = 0; i < 36; ++i) q.in[i] = (const float*)rf64(tab[i]);
    q.out = (float*)rf64(tab[36]); q.ws = (unsigned char*)rf64(tab[37]);
    return q;
}

constexpr int CW_TEAM = 8192, CW_QUEUE = 4160;
constexpr int TEAM = 64;
DEV void sample_chain(const FP& p, LAS unsigned char* lds, int tb, int T, const XcdBarrier& tbar) {
    unsigned char* sb = p.ws + WS_SMP;
    float* ys = p.out + 16777216; const float* xs = p.in[1];
    s_gemm((const bf16_t*)(sb + SB_XN), (const bf16_t*)(p.ws + WS_W_IN), 3072, 1024, lds, tb, T, 0,
           EpiSIn{(float*)(sb + SB_Z), (float*)(sb + SB_XBC), (float*)(sb + SB_Q), p.out + 34871296, p.out + 34936832, p.out + 35526656});
    xcd_barrier(tbar);
    s_ssd(p, lds, tb, T, 0);
    s_attn_part(p, lds, tb, T);
    xcd_barrier(tbar);
    s_attn_comb(p, tb, T, 0);
    xcd_barrier(tbar);
    s_gemm((const bf16_t*)(sb + SB_CAT), (const bf16_t*)(p.ws + WS_W_OUT), 1024, 1024, lds, tb, T, 0, EpiSF32{(float*)(sb + SB_MIX), 1024, 1.f});
    xcd_barrier(tbar);
    s_row(p, (const float*)(sb + SB_MIX), xs, p.in[28], ys, p.in[29], (bf16_t*)(sb + SB_XN), nullptr, tb, T, 0);
    xcd_barrier(tbar);
    s_gemm((const bf16_t*)(sb + SB_XN), (const bf16_t*)(p.ws + WS_W_Q), 1024, 1024, lds, tb, T, 0, EpiSF32{(float*)(sb + SB_QX), 1024, 1.f});
    xcd_barrier(tbar);
    s_xattn_part(p, lds, tb, T, 0);
    xcd_barrier(tbar);
    s_xattn_comb(p, tb, T, 0);
    xcd_barrier(tbar);
    s_gemm((const bf16_t*)(sb + SB_OX), (const bf16_t*)(p.ws + WS_W_O), 1024, 1024, lds, tb, T, 0, EpiSF32{(float*)(sb + SB_MIX), 1024, 1.f});
    xcd_barrier(tbar);
    s_row(p, (const float*)(sb + SB_MIX), ys, p.in[30], ys, p.in[31], (bf16_t*)(sb + SB_XN), nullptr, tb, T, 0);
    xcd_barrier(tbar);
    s_gemm((const bf16_t*)(sb + SB_XN), (const bf16_t*)(p.ws + WS_W_GU), 5632, 1024, lds, tb, T, 0, EpiSSwiglu{(bf16_t*)(sb + SB_HID)});
    xcd_barrier(tbar);
    s_gemm((const bf16_t*)(sb + SB_HID), (const bf16_t*)(p.ws + WS_W_DOWN), 1024, 2816, lds, tb, T, 0, EpiSF32{(float*)(sb + SB_MIX), 1024, 1.f});
    xcd_barrier(tbar);
    s_row(p, (const float*)(sb + SB_MIX), ys, p.in[32], ys, nullptr, nullptr, nullptr, tb, T, 0);
    __syncthreads();
}
DEV void p3_queue(const FP& p, LAS unsigned char* lds, int bid) {
    unsigned* qh = (unsigned*)(p.ws + WS_CTL) + CW_QUEUE;
    volatile LAS int* slot = (volatile LAS int*)(lds + LDS_BYTES - 32);
    const AttnCtx ctx = attn_setup(p, lds);
    for (;;) {
        __syncthreads();
        if (threadIdx.x == 0) {
            int u = -1;
            for (int k = 0; k < 8 && u < 0; ++k) {
                const int q = (bid + k) & 7;
                const unsigned v = __hip_atomic_fetch_add(qh + 64 * q, 1u, __ATOMIC_RELAXED, __HIP_MEMORY_SCOPE_AGENT);
                if (v < 80u) u = q * 80 + (int)v;
            }
            slot[0] = u;
        }
        __syncthreads();
        const int u = slot[0];
        if (u < 0) break;
        const int q = u / 80, v = u % 80;
        if (v < 16) ssd2_item(p, q * 16 + v);
        else attn_unit(p, lds, ctx, q, 63 - (v - 16));
    }
}
__global__ void __launch_bounds__(512, 2) k_mega(FP p0) {
    extern __shared__ __attribute__((aligned(16))) unsigned char lds_raw[];
    LAS unsigned char* lds = (LAS unsigned char*)lds_raw;
    cg::grid_group grid = cg::this_grid();
    const int G = gridDim.x, bid = blockIdx.x, ngw = G * 8;
#define IDS() int tid_ = threadIdx.x; asm volatile("" : "+v"(tid_)); const int lane = tid_ & 63, wave = __builtin_amdgcn_readfirstlane(tid_ >> 6), gw = bid * 8 + wave; (void)lane; (void)gw
    LAS unsigned long long* tab = (LAS unsigned long long*)(lds + LDS_BYTES - 512);
    if (threadIdx.x < 36) tab[threadIdx.x] = (unsigned long long)p0.in[threadIdx.x];
    if (threadIdx.x == 36) tab[36] = (unsigned long long)p0.out;
    if (threadIdx.x == 37) tab[37] = (unsigned long long)p0.ws;
#define PH(...) do { const FP p = fp_from_lds(tab); float* y = p.out; unsigned char* sb = p.ws + WS_SMP; (void)y; (void)sb; __VA_ARGS__ } while (0)
    volatile LAS unsigned* MISC = (volatile LAS unsigned*)(lds + LDS_BYTES - 64);
    if (threadIdx.x < 16) MISC[threadIdx.x] = 0u;
    __syncthreads();
    XcdBarrier bar = xcd_barrier_post((unsigned*)(p0.ws + WS_CTL), MISC);
    PH( { IDS(); phase_prep_x(p, lds, gw, ngw, wave, lane); phase_prep_ffn(p, lds, gw, ngw, wave, lane); phase_prep_mix(p, lds, gw, ngw, wave, lane); } );
    PH( s_row(p, nullptr, p.in[1], nullptr, nullptr, p.in[27], (bf16_t*)(sb + SB_XN), (float*)(sb + SB_DTV), bid, G, 0); );
    grid.sync();
    PH( phase_inproj(p, lds, G, bid); );
    xcd_barrier(bar);
    PH( phase_ssd1(p, lds, G, bid); );
    PH( phase_memkv(p, lds, G, bid); );
    xcd_barrier(bar);
    PH( { const int T = (G >= 2 * TEAM) ? TEAM : 1; if (bid >= G - T) { XcdBarrier tbar = xcd_barrier_post((unsigned*)(p.ws + WS_CTL) + CW_TEAM, (volatile LAS unsigned*)(lds + LDS_BYTES - 48), (unsigned)T); sample_chain(p, lds, bid - (G - T), T, tbar); } } );
    PH( p3_queue(p, lds, bid); );
    xcd_barrier(bar);
    PH( phase_ssd3(p, lds, G, bid); );
    xcd_barrier(bar);
    PH( phase_outproj(p, lds, G, bid); );
    xcd_barrier(bar);
    PH( { IDS(); row_phase((const bf16_t*)(p.ws + WS_RAW), p.in[0], p.in[28], y, p.in[29], (bf16_t*)(p.ws + WS_XN), MP, gw, ngw, lane); } );
    xcd_barrier(bar);
    PH( phase_wq(p, lds, G, bid); );
    xcd_barrier(bar);
    PH( phase_xattn(p, lds, G, bid); );
    xcd_barrier(bar);
    PH( phase_wo(p, lds, G, bid); );
    xcd_barrier(bar);
    PH( { IDS(); row_phase((const bf16_t*)(p.ws + WS_RAW), y, p.in[30], y, p.in[31], (bf16_t*)(p.ws + WS_XN), MP, gw, ngw, lane); } );
    xcd_barrier(bar);
    PH( phase_ffn_gu(p, lds, G, bid); );
    xcd_barrier(bar);
    PH( phase_ffn_down(p, lds, G, bid); );
    xcd_barrier(bar);
    PH( { IDS(); row_phase((const bf16_t*)(p.ws + WS_RAW), y, p.in[32], y, nullptr, nullptr, MP, gw, ngw, lane); } );
}

extern "C" void kernel_launch(void* const* d_in, const int* in_sizes, int n_in, void* d_out, int out_size, void* d_ws, size_t ws_size, hipStream_t stream) {
    static int grid = 0;
    if (!grid) {
        int dev = 0, cus = 0, per_cu = 0;
        (void)hipGetDevice(&dev);
        (void)hipDeviceGetAttribute(&cus, hipDeviceAttributeMultiprocessorCount, dev);
        (void)hipFuncSetAttribute((const void*)k_mega, hipFuncAttributeMaxDynamicSharedMemorySize, LDS_BYTES);
        (void)hipOccupancyMaxActiveBlocksPerMultiprocessor(&per_cu, (const void*)k_mega, 512, LDS_BYTES);
        if (per_cu < 1) per_cu = 1;
        grid = cus * per_cu;
        if (grid > 256) grid = 256;
        if (n_in != 36 || ws_size < 256 * MiB) fprintf(stderr, "kernel_launch: unexpected n_in %d / ws_size %zu\n", n_in, ws_size);
    }
    (void)hipMemsetAsync((unsigned char*)d_ws + WS_CTL, 0, 65536, stream);
    FP p{};
    for (int i = 0; i < 36; ++i) p.in[i] = (const float*)d_in[i];
    p.out = (float*)d_out; p.ws = (unsigned char*)d_ws;
    void* args[] = {&p};
    hipError_t e = hipLaunchCooperativeKernel((const void*)k_mega, dim3(grid), dim3(512), args, LDS_BYTES, stream);
    if (e != hipSuccess) fprintf(stderr, "cooperative launch failed: %s (grid %d)\n", hipGetErrorString(e), grid);
}
```

```cpp
#include <hip/hip_runtime.h>
#include <cstdint>
#include <cstdio>
#include <hip/hip_cooperative_groups.h>

#define DEV static __device__ __forceinline__
#define LAS __attribute__((address_space(3)))
#define WAVE_SYNC() asm volatile("s_waitcnt lgkmcnt(0)" ::: "memory")

DEV float wave_sum(float v) {
#pragma unroll
    for (int o = 32; o > 0; o >>= 1) v += __shfl_xor(v, o);
    return v;
}
DEV float wave_max(float v) {
#pragma unroll
    for (int o = 32; o > 0; o >>= 1) v = fmaxf(v, __shfl_xor(v, o));
    return v;
}
typedef float nf4 __attribute__((ext_vector_type(4)));
DEV float4 lds_ld4(const LAS float* p) { const nf4 v = *(const LAS nf4*)p; float4 r; r.x = v[0]; r.y = v[1]; r.z = v[2]; r.w = v[3]; return r; }
DEV float silu_f(float x) { return x / (1.f + expf(-x)); }


typedef unsigned short bf16_t;
typedef float f32x4 __attribute__((ext_vector_type(4)));
typedef float f32x16 __attribute__((ext_vector_type(16)));
typedef short bf16x8 __attribute__((ext_vector_type(8)));
typedef short s16x4 __attribute__((ext_vector_type(4)));
typedef unsigned u32x4 __attribute__((ext_vector_type(4)));
typedef unsigned u32x2 __attribute__((ext_vector_type(2)));

constexpr size_t MiB = 1u << 20;
constexpr size_t WS_W_IN = 0, WS_W_OUT = 6 * MiB, WS_W_Q = 8 * MiB, WS_W_KV = 10 * MiB, WS_W_O = 14 * MiB, WS_W_GU = 16 * MiB, WS_W_DOWN = 27 * MiB;
constexpr size_t WS_CTL = 33 * MiB, WS_DTV = 34 * MiB, WS_CDEC = 34 * MiB + 512 * 1024, WS_MN = 35 * MiB;
constexpr size_t WS_XN = 36 * MiB, WS_CAT = 68 * MiB, WS_QX = 68 * MiB, WS_Q = 100 * MiB, WS_K = 116 * MiB, WS_RAW = 100 * MiB;
constexpr size_t WS_ZX = 132 * MiB, WS_OX = 132 * MiB, WS_V = 180 * MiB, WS_ST = 196 * MiB, WS_HID = 132 * MiB, WS_KM = 228 * MiB, WS_VM = 229 * MiB, WS_SMP = 230 * MiB;
constexpr int MP = 16384;
constexpr int LDS_BYTES = 147456;

DEV unsigned f2bf(float f) { unsigned u = __builtin_bit_cast(unsigned, f); return (u + 0x7fffu + ((u >> 16) & 1u)) >> 16; }
DEV unsigned pk2(float lo, float hi) { return f2bf(lo) | (f2bf(hi) << 16); }
DEV float bflo(unsigned w) { return __builtin_bit_cast(float, w << 16); }
DEV float bfhi(unsigned w) { return __builtin_bit_cast(float, w & 0xffff0000u); }
DEV float fast_silu(float x) { return x * __builtin_amdgcn_rcpf(1.f + __builtin_amdgcn_exp2f(-1.4426950408889634f * x)); }

struct FP {
    const float* in[36];
    float* out;
    unsigned char* ws;
};

template <class RowMap>
DEV void transpose_item(const float* W, int K, int N, bf16_t* WT, int item, LAS float* scr, int lane, RowMap rm) {
    const int nblk = (N + 31) / 32, kb = item / nblk, nb = item % nblk, k0 = 64 * kb, n0 = 32 * nb;
    const int ncol = n0 + (lane & 31);
#pragma unroll 8
    for (int i = 0; i < 32; ++i) { const int kk = 2 * i + (lane >> 5); scr[kk * 33 + (lane & 31)] = (ncol < N) ? W[(size_t)(k0 + kk) * N + ncol] : 0.f; }
    WAVE_SYNC();
    const int c = lane & 7;
#pragma unroll
    for (int j = 0; j < 4; ++j) {
        const int n = (lane >> 3) + 8 * j; const LAS float* s = scr + (8 * c) * 33 + n;
        const int src = n0 + n; const int dst = (src < N) ? rm(src) : -1;
        u32x4 o; o.x = pk2(s[0 * 33], s[1 * 33]); o.y = pk2(s[2 * 33], s[3 * 33]); o.z = pk2(s[4 * 33], s[5 * 33]); o.w = pk2(s[6 * 33], s[7 * 33]);
        if (dst >= 0) *(u32x4*)(WT + (size_t)dst * K + k0 + 8 * c) = o;
    }
    WAVE_SYNC();
}
struct RmPlain { int off; __device__ __forceinline__ int operator()(int n) const { return off + n; } };
struct RmGU { int up; __device__ __forceinline__ int operator()(int n) const { return 32 * (n >> 4) + 16 * up + (n & 15); } };
struct RmIn {
    __device__ __forceinline__ int operator()(int n) const {
        if (n < 1536) return n;
        if (n < 1544) return -1;
        const int m = n - 1544;
        if (m < 1024) { const int u = m >> 6, d = m & 63; return 1536 + 64 * u + 32 * ((d & 31) >> 4) + 16 * (d >> 5) + (d & 15); }
        return 1536 + m;
    }
};

DEV void row_phase(const bf16_t* raw, const float* hin, const float* gpost, float* hout, const float* gpre, bf16_t* xn, int M, int gw, int ngw, int lane) {
    for (int r = gw; r < M; r += ngw) {
        f32x4 h[4];
#pragma unroll
        for (int j = 0; j < 4; ++j) h[j] = ((const f32x4*)(hin + (size_t)r * 1024))[lane + 64 * j];
        if (raw) {
            f32x4 v[4]; float ss = 0.f;
#pragma unroll
            for (int j = 0; j < 4; ++j) {
                const u32x2 w = ((const u32x2*)(raw + (size_t)r * 1024))[lane + 64 * j];
                v[j] = (f32x4){bflo(w.x), bfhi(w.x), bflo(w.y), bfhi(w.y)};
                ss += v[j].x * v[j].x + v[j].y * v[j].y + v[j].z * v[j].z + v[j].w * v[j].w;
            }
            const float rs = rsqrtf(wave_sum(ss) * (1.f / 1024.f) + 1e-6f);
#pragma unroll
            for (int j = 0; j < 4; ++j) { const f32x4 g = ((const f32x4*)gpost)[lane + 64 * j]; h[j] += v[j] * rs * g; }
        }
        if (hout) {
#pragma unroll
            for (int j = 0; j < 4; ++j) ((f32x4*)(hout + (size_t)r * 1024))[lane + 64 * j] = h[j];
        }
        if (gpre) {
            float ss = 0.f;
#pragma unroll
            for (int j = 0; j < 4; ++j) ss += h[j].x * h[j].x + h[j].y * h[j].y + h[j].z * h[j].z + h[j].w * h[j].w;
            const float rs = rsqrtf(wave_sum(ss) * (1.f / 1024.f) + 1e-6f);
#pragma unroll
            for (int j = 0; j < 4; ++j) {
                const f32x4 g = ((const f32x4*)gpre)[lane + 64 * j]; const f32x4 o = h[j] * rs * g;
                u32x2 w; w.x = pk2(o.x, o.y); w.y = pk2(o.z, o.w);
                ((u32x2*)(xn + (size_t)r * 1024))[lane + 64 * j] = w;
            }
        }
    }
}


#define RLX_AGENT __ATOMIC_RELAXED, __HIP_MEMORY_SCOPE_AGENT
#define LDS_WAIT() asm volatile("s_waitcnt lgkmcnt(0)" ::: "memory")
#define VM_WAIT() asm volatile("s_waitcnt vmcnt(0)" ::: "memory")
__device__ __forceinline__ unsigned long long rt() { return __builtin_amdgcn_s_memrealtime(); }
#define XB_TMO      128
#define XB_XCNT(j)  (256  + 64 * (j))
#define XB_XSUB(j)  (1280 + 64 * (j))
#define XB_XGEN(j)  (2304 + 64 * (j))
#define XB_TOP      3328
#define XB_TOPGEN   3392
#define XCD_BAR_WORDS 3456
#define XB_SPIN_CAP (1u << 18)

__device__ __forceinline__ unsigned xb_ld(unsigned* p)              { return __hip_atomic_load(p, __ATOMIC_RELAXED, __HIP_MEMORY_SCOPE_AGENT); }
__device__ __forceinline__ unsigned xb_add(unsigned* p, unsigned v) { return __hip_atomic_fetch_add(p, v, __ATOMIC_RELAXED, __HIP_MEMORY_SCOPE_AGENT); }
__device__ __forceinline__ unsigned xb_xcc_id() { return (unsigned)__builtin_amdgcn_s_getreg((3 << 11) | 20) & 0xFu; }
#define XB_SPIN(cond, bar) do { unsigned _sp = 0; while (cond) { __builtin_amdgcn_s_sleep(1); \
    if ((++_sp & 255u) == 0u) { if (xb_ld(&(bar)[XB_TMO])) break; if (_sp > XB_SPIN_CAP) { atomicAdd(&(bar)[XB_TMO], 1u); break; } } } } while (0)

struct XcdBarrier {
    unsigned* bar; unsigned x; unsigned total;
    volatile LAS unsigned* st;
};

__device__ __forceinline__ XcdBarrier xcd_barrier_post(unsigned* bar, volatile LAS unsigned* st, unsigned total = 0u) {
    XcdBarrier b; b.bar = bar; b.x = xb_xcc_id(); b.st = st; b.total = total;
    if (threadIdx.x == 0) (void)xb_add(&bar[XB_XCNT(b.x)], 1u);
    return b;
}
__device__ __forceinline__ void xcd_barrier_complete(unsigned* bar, unsigned x, unsigned& nloc, unsigned& nx, unsigned total) {
    const unsigned G = total ? total : gridDim.x * gridDim.y * gridDim.z;
    unsigned sum, cnt, mine, sp = 0u;
    for (;;) {
        sum = 0u; cnt = 0u; mine = 0u;
#pragma unroll
        for (unsigned j = 0; j < 16; ++j) { const unsigned c = xb_ld(&bar[XB_XCNT(j)]); sum += c; cnt += (c > 0u) ? 1u : 0u; mine = (j == x) ? c : mine; }
        if (sum == G) break;
        __builtin_amdgcn_s_sleep(1);
        if ((++sp & 255u) == 0u) { if (xb_ld(&bar[XB_TMO])) break; if (sp > XB_SPIN_CAP) { atomicAdd(&bar[XB_TMO], 1u); break; } }
    }
    nloc = mine > 0u ? mine : 1u; nx = cnt > 0u ? cnt : 1u;
}

__device__ __forceinline__ void xcd_barrier(const XcdBarrier& b) {
    asm volatile("s_waitcnt vmcnt(0)" ::: "memory");
    __syncthreads();
    if (threadIdx.x == 0) {
        unsigned* bar = b.bar;
        __builtin_amdgcn_s_waitcnt(0);
        unsigned nloc = b.st[0], nx = b.st[1];
        if (nloc == 0u) { xcd_barrier_complete(bar, b.x, nloc, nx, b.total); b.st[0] = nloc; b.st[1] = nx; }
        const unsigned old = xb_add(&bar[XB_XSUB(b.x)], 1u);
        const unsigned gen = old / nloc;
        if (old + 1u == (gen + 1u) * nloc) {
            __builtin_amdgcn_fence(__ATOMIC_RELEASE, "agent");
            asm volatile("s_waitcnt vmcnt(0)" ::: "memory");
            const unsigned og = xb_add(&bar[XB_TOP], 1u);
            const unsigned tg = og / nx;
            if (og + 1u == (tg + 1u) * nx) xb_add(&bar[XB_TOPGEN], 1u);
            else XB_SPIN(xb_ld(&bar[XB_TOPGEN]) == tg, bar);
            __builtin_amdgcn_fence(__ATOMIC_ACQUIRE, "agent");
            xb_add(&bar[XB_XGEN(b.x)], 1u);
            asm volatile("s_waitcnt vmcnt(0)" ::: "memory");
        } else {
            XB_SPIN(xb_ld(&bar[XB_XGEN(b.x)]) == gen, bar);
            __builtin_amdgcn_fence(__ATOMIC_ACQUIRE, "agent");
            asm volatile("s_waitcnt vmcnt(0)" ::: "memory");
        }
    }
    __syncthreads();
}
namespace pg8 {
#define PG8_LAS __attribute__((address_space(3)))
typedef unsigned short bf16_t;
typedef short bf16x8 __attribute__((ext_vector_type(8)));
typedef float f32x4 __attribute__((ext_vector_type(4)));
typedef unsigned u32x4 __attribute__((ext_vector_type(4)));
constexpr int BM = 256, BK = 64, HALF = 128, HTB = HALF * BK * 2  , STAGE_BYTES = 8 * HTB, NXCD = 8, WGM = 8;

__host__ __device__ __forceinline__ int lds_byte(int r, int c) { const int st = (r >> 4) * 2 + (c >> 5), rr = r & 15, cc = c & 31, ob = rr * 64 + cc * 2; return st * 1024 + (ob ^ (((ob >> 9) & 1) << 5)); }
__host__ __device__ __forceinline__ void stage_rc(int b, int& R, int& C) { const int st = b / 1024, sb = b % 1024, swz = sb ^ (((sb >> 9) & 1) << 5); R = (st >> 1) * 16 + swz / 64; C = (st & 1) * 32 + (swz % 64) / 2; }
__host__ __device__ __forceinline__ int perm32(int rho) { const int n = rho >> 4, i = rho & 15; return 8 * (i >> 2) + 4 * n + (i & 3); }

struct Unit { int pm, pn; };
struct Gemm { const bf16_t* A; const bf16_t* Bt; int M, N, K; };

struct StaticOrder {
    int nM, nN, nwg, G, c;
    __host__ __device__ void init(int M, int N, int G_, int c_) { nM = M / BM; nN = N / BM; nwg = nM * nN; G = G_; c = c_; }
    __host__ __device__ bool next(int i, Unit& u) const {
        const long L = (long)i * G + c; if (L >= nwg) return false;
        int wgid = (int)L; { const int q = nwg / NXCD, r = nwg % NXCD, xcd = wgid % NXCD, off = wgid / NXCD; wgid = (xcd < r ? xcd * (q + 1) : r * (q + 1) + (xcd - r) * q) + off; }
        const int nig = WGM * nN, gid = wgid / nig, fm = gid * WGM, gsz = (nM - fm) < WGM ? (nM - fm) : WGM;
        u.pm = fm + ((wgid % nig) % gsz); u.pn = (wgid % nig) / gsz; return true;
    }
    __device__ __forceinline__ void a_ready(const Unit&) const {}
    __device__ __forceinline__ void done(const Unit&) const {}
};

__device__ __forceinline__ unsigned cvt_pk_bf16(float lo, float hi) { unsigned r; asm volatile("v_cvt_pk_bf16_f32 %0, %1, %2" : "=v"(r) : "v"(lo), "v"(hi)); return r; }
typedef float f32x2 __attribute__((ext_vector_type(2)));
__device__ __forceinline__ f32x2 gelu_pk(f32x2 v) {
    const f32x2 av = __builtin_elementwise_abs(v), d = av * 0.2316418882f + 1.0f;
    f32x2 t; t.x = __builtin_amdgcn_rcpf(d.x); t.y = __builtin_amdgcn_rcpf(d.y);
    f32x2 q = t * 0.5307027145f + (-0.7265760135f); q = q * t + 0.7107068705f; q = q * t + (-0.142248368f); q = q * t + 0.127414796f; q = q * t;
    const f32x2 s = (v * v) * (-0.72134752044f);
    f32x2 e; e.x = __builtin_amdgcn_exp2f(s.x); e.y = __builtin_amdgcn_exp2f(s.y);
    const f32x2 m = v * (q * e), r = v - m;
    f32x2 o; o.x = v.x < 0.f ? m.x : r.x; o.y = v.y < 0.f ? m.y : r.y; return o;
}

template <int ACT  > struct EpiBf16 {
    static constexpr bool PERM = true, AFTER_DRAIN = false; static_assert(ACT == 0 || ACT == 1, "EpiBf16: ACT is 0 (none) or 1 (gelu_pk)");
    bf16_t* O; int ldc; const float* bias; int split_cols; size_t split_stride; float scale0;
    __device__ __forceinline__ void operator()(const f32x4 (&acc)[2][2][4][2], const Unit& u, int wr, int wc, int fr, int fq) const {
        const int row0 = u.pm * BM + wr * 64 + fr; int colt = u.pn * BM; bf16_t* base = O;
        float sc = 1.f; if (split_cols) { const int t = colt / split_cols; base += (size_t)t * split_stride; colt -= t * split_cols; if (t == 0) sc = scale0; }
        const int col0 = colt + wc * 32 + 8 * fq, bcol0 = u.pn * BM + wc * 32 + 8 * fq;
        f32x4 bv[2][2];
#pragma unroll
        for (int bj = 0; bj < 2; ++bj)
#pragma unroll
            for (int n = 0; n < 2; ++n) bv[bj][n] = bias ? *(const f32x4*)(bias + bcol0 + bj * HALF + 4 * n) : (f32x4){0.f, 0.f, 0.f, 0.f};
#pragma unroll
        for (int ai = 0; ai < 2; ++ai)
#pragma unroll
            for (int m = 0; m < 4; ++m) { bf16_t* rowp = base + (size_t)(row0 + ai * HALF + m * 16) * ldc + col0;
#pragma unroll
                for (int bj = 0; bj < 2; ++bj) { f32x4 v0 = acc[ai][bj][m][0] + bv[bj][0], v1 = acc[ai][bj][m][1] + bv[bj][1];
                    if (ACT == 1) { f32x2 a = gelu_pk((f32x2){v0[0], v0[1]}), b = gelu_pk((f32x2){v0[2], v0[3]}), c = gelu_pk((f32x2){v1[0], v1[1]}), d = gelu_pk((f32x2){v1[2], v1[3]});
                        v0 = (f32x4){a.x, a.y, b.x, b.y}; v1 = (f32x4){c.x, c.y, d.x, d.y}; }
                    v0 = v0 * sc; v1 = v1 * sc; u32x4 w; w.x = cvt_pk_bf16(v0[0], v0[1]); w.y = cvt_pk_bf16(v0[2], v0[3]); w.z = cvt_pk_bf16(v1[0], v1[1]); w.w = cvt_pk_bf16(v1[2], v1[3]);
                    *(u32x4*)(rowp + bj * HALF) = w; } }
    }
};
template <class Epi, class Sched, bool ALIGN_EPI = false, bool SP2 = false>
__device__ __forceinline__ void gemm_phase(PG8_LAS unsigned char* lds, const Gemm g, const Sched& S, const Epi& E) {
    int tid_l = threadIdx.x; asm volatile("" : "+v"(tid_l));
    const int tid = tid_l, wid = __builtin_amdgcn_readfirstlane(tid >> 6), lane = tid & 63, wr = wid >> 2, wc = wid & 3, fr = lane & 15, fq = lane >> 4;
    const int K = g.K, nt = K / BK;
    unsigned voffA[2], voffB[2];
#pragma unroll
    for (int i = 0; i < 2; ++i) { int R, C; stage_rc(tid * 16 + i * 8192, R, C); const int Rb = Epi::PERM ? ((R & ~31) + perm32(R & 31)) : R;
        voffA[i] = (unsigned)(R * K + C) * 2u; voffB[i] = (unsigned)(Rb * K + C) * 2u; }
    const size_t kstep = (size_t)(BK * 2);
    const size_t hstep = (size_t)HALF * K * 2;
    const size_t tstep = 2 * hstep;
    const unsigned ldsw = (unsigned)wid * 1024u;
    const int aoff = lds_byte(wr * 64 + fr, fq * 8), boff = lds_byte(wc * 32 + fr, fq * 8);
#define PG8_SA(b, h) (((b) * 2 + (h)) * HTB)
#define PG8_SB(b, h) ((4 + (b) * 2 + (h)) * HTB)
#define PG8_STAGE(bufoff, gbase, voff) do { _Pragma("unroll") for (int _i = 0; _i < 2; ++_i) \
        __builtin_amdgcn_global_load_lds((const unsigned*)((const char*)(gbase) + (voff)[_i]), (PG8_LAS unsigned*)(lds + (bufoff) + ldsw + _i * 8192), 16, 0, 0); } while (0)
#define PG8_LDA(dst, b, h) do { _Pragma("unroll") for (int m = 0; m < 4; ++m) _Pragma("unroll") for (int k = 0; k < 2; ++k) dst[m][k] = *(const PG8_LAS bf16x8*)(lds + PG8_SA(b, h) + aoff + m * 2048 + k * 1024); } while (0)
#define PG8_LDB(dst, b, h) do { _Pragma("unroll") for (int n = 0; n < 2; ++n) _Pragma("unroll") for (int k = 0; k < 2; ++k) dst[n][k] = *(const PG8_LAS bf16x8*)(lds + PG8_SB(b, h) + boff + n * 2048 + k * 1024); } while (0)
#define PG8_MMA(ai, bj, At, Bt) do { __builtin_amdgcn_s_setprio(1); _Pragma("unroll") for (int m = 0; m < 4; ++m) _Pragma("unroll") for (int n = 0; n < 2; ++n) _Pragma("unroll") for (int k = 0; k < 2; ++k) \
        acc[ai][bj][m][n] = __builtin_amdgcn_mfma_f32_16x16x32_bf16(Bt[n][k], At[m][k], acc[ai][bj][m][n], 0, 0, 0); __builtin_amdgcn_s_setprio(0); } while (0)
#define PG8_WAIT_V(n) asm volatile("s_waitcnt vmcnt(" #n ")" ::: "memory")
#define PG8_WAIT_L(n) asm volatile("s_waitcnt lgkmcnt(" #n ")" ::: "memory")
#define PG8_BAR __builtin_amdgcn_s_barrier()
#define PG8_SCHED __builtin_amdgcn_sched_barrier(0)
    Unit cur, nxt; int ui = 0;
    if (!S.next(0, cur)) return;
    f32x4 acc[2][2][4][2];
#pragma unroll
    for (int a = 0; a < 2; ++a)
#pragma unroll
        for (int b = 0; b < 2; ++b)
#pragma unroll
            for (int m = 0; m < 4; ++m)
#pragma unroll
                for (int n = 0; n < 2; ++n) acc[a][b][m][n] = (f32x4){0.f, 0.f, 0.f, 0.f};
    bf16x8 At[4][2], B0[2][2], B1[2][2];
    const char* cA = (const char*)g.A + (size_t)cur.pm * tstep; const char* cB = (const char*)g.Bt + (size_t)cur.pn * tstep;
    S.a_ready(cur);
    if constexpr (SP2) {
        PG8_STAGE(PG8_SB(0, 0), cB, voffB); PG8_STAGE(PG8_SB(0, 1), cB + hstep, voffB); PG8_STAGE(PG8_SA(0, 0), cA, voffA); PG8_STAGE(PG8_SA(0, 1), cA + hstep, voffA);
        if (wr == 1) PG8_BAR;
        PG8_WAIT_V(2); PG8_BAR;
        PG8_STAGE(PG8_SB(1, 0), cB + kstep, voffB); PG8_STAGE(PG8_SA(1, 0), cA + kstep, voffA); PG8_STAGE(PG8_SB(1, 1), cB + hstep + kstep, voffB);
        PG8_WAIT_V(6); PG8_BAR;
    } else {
        PG8_STAGE(PG8_SB(0, 0), cB, voffB); PG8_STAGE(PG8_SA(0, 0), cA, voffA); PG8_STAGE(PG8_SB(0, 1), cB + hstep, voffB); PG8_STAGE(PG8_SA(0, 1), cA + hstep, voffA);
        if (wr == 1) PG8_BAR;
        PG8_WAIT_V(4); PG8_BAR;
        PG8_STAGE(PG8_SB(1, 0), cB + kstep, voffB); PG8_STAGE(PG8_SA(1, 0), cA + kstep, voffA); PG8_STAGE(PG8_SB(1, 1), cB + hstep + kstep, voffB);
        PG8_WAIT_V(6); PG8_BAR;
    }
    for (;;) {
        const bool has_next = S.next(ui + 1, nxt);
        const char* nA = has_next ? (const char*)g.A + (size_t)nxt.pm * tstep : cA; const char* nB = has_next ? (const char*)g.Bt + (size_t)nxt.pn * tstep : cB;
        for (int t = 0; t < nt; t += 2) {
            const bool last = (t == nt - 2);
            const char* a1 = cA + (size_t)(t + 1) * kstep;
            const char* a2 = last ? nA : cA + (size_t)(t + 2) * kstep; const char* b2 = last ? nB : cB + (size_t)(t + 2) * kstep;
            const char* a3 = a2 + kstep; const char* b3 = b2 + kstep;
            if (last && has_next) S.a_ready(nxt);
            if constexpr (SP2) {
            PG8_LDB(B0, 0, 0); PG8_LDB(B1, 0, 1); PG8_SCHED; PG8_LDA(At, 0, 0); PG8_STAGE(PG8_SA(1, 1), a1 + hstep, voffA);
            PG8_WAIT_V(8); PG8_WAIT_L(0); PG8_BAR; PG8_MMA(0, 0, At, B0); PG8_MMA(0, 1, At, B1); PG8_BAR; PG8_SCHED;
            PG8_LDA(At, 0, 1); PG8_STAGE(PG8_SB(0, 0), b2, voffB); PG8_STAGE(PG8_SB(0, 1), b2 + hstep, voffB); PG8_STAGE(PG8_SA(0, 0), a2, voffA);
            PG8_WAIT_V(8); PG8_WAIT_L(0); PG8_BAR; PG8_MMA(1, 0, At, B0); PG8_MMA(1, 1, At, B1); PG8_BAR; PG8_SCHED;
            PG8_LDB(B0, 1, 0); PG8_LDB(B1, 1, 1); PG8_SCHED; PG8_LDA(At, 1, 0); PG8_STAGE(PG8_SA(0, 1), a2 + hstep, voffA);
            PG8_WAIT_V(8); PG8_WAIT_L(0); PG8_BAR; PG8_MMA(0, 0, At, B0); PG8_MMA(0, 1, At, B1); PG8_BAR; PG8_SCHED;
            PG8_LDA(At, 1, 1); PG8_STAGE(PG8_SB(1, 0), b3, voffB); PG8_STAGE(PG8_SB(1, 1), b3 + hstep, voffB); PG8_STAGE(PG8_SA(1, 0), a3, voffA);
            PG8_WAIT_V(8); PG8_WAIT_L(0); PG8_BAR; PG8_MMA(1, 0, At, B0); PG8_MMA(1, 1, At, B1); PG8_BAR; PG8_SCHED;
            } else {
            PG8_LDB(B0, 0, 0); PG8_SCHED; PG8_LDA(At, 0, 0); PG8_STAGE(PG8_SA(1, 1), a1 + hstep, voffA);
            PG8_WAIT_L(8); PG8_BAR; PG8_WAIT_L(0); PG8_MMA(0, 0, At, B0); PG8_BAR; PG8_SCHED;
            PG8_LDB(B1, 0, 1); PG8_STAGE(PG8_SB(0, 0), b2, voffB);
            PG8_BAR; PG8_WAIT_L(0); PG8_MMA(0, 1, At, B1); PG8_BAR;
            PG8_LDA(At, 0, 1); PG8_STAGE(PG8_SA(0, 0), a2, voffA);
            PG8_BAR; PG8_WAIT_L(0); PG8_MMA(1, 0, At, B0); PG8_BAR; PG8_SCHED;
            PG8_STAGE(PG8_SB(0, 1), b2 + hstep, voffB);
            PG8_WAIT_V(6); PG8_BAR; PG8_MMA(1, 1, At, B1); PG8_BAR;
            PG8_LDB(B0, 1, 0); PG8_SCHED; PG8_LDA(At, 1, 0); PG8_STAGE(PG8_SA(0, 1), a2 + hstep, voffA);
            PG8_WAIT_L(8); PG8_BAR; PG8_WAIT_L(0); PG8_MMA(0, 0, At, B0); PG8_BAR; PG8_SCHED;
            PG8_LDB(B1, 1, 1); PG8_STAGE(PG8_SB(1, 0), b3, voffB);
            PG8_BAR; PG8_WAIT_L(0); PG8_MMA(0, 1, At, B1); PG8_BAR;
            PG8_LDA(At, 1, 1); PG8_STAGE(PG8_SA(1, 0), a3, voffA);
            PG8_BAR; PG8_WAIT_L(0); PG8_MMA(1, 0, At, B0); PG8_BAR; PG8_SCHED;
            PG8_STAGE(PG8_SB(1, 1), b3 + hstep, voffB);
            PG8_WAIT_V(6); PG8_BAR; PG8_MMA(1, 1, At, B1); PG8_BAR;
            }
        }
        if constexpr (ALIGN_EPI) { if (wr == 0) PG8_BAR; }
        if constexpr (!Epi::AFTER_DRAIN) { E(acc, cur, wr, wc, fr, fq); S.done(cur); }
        if (!has_next) break;
#pragma unroll
        for (int a = 0; a < 2; ++a)
#pragma unroll
            for (int b = 0; b < 2; ++b)
#pragma unroll
                for (int m = 0; m < 4; ++m)
#pragma unroll
                    for (int n = 0; n < 2; ++n) acc[a][b][m][n] = (f32x4){0.f, 0.f, 0.f, 0.f};
        cur = nxt; cA = nA; cB = nB; ++ui;
        if constexpr (ALIGN_EPI) { if (wr == 1) PG8_BAR; }
    }
    PG8_WAIT_V(0);
    if constexpr (!ALIGN_EPI) { if (wr == 0) PG8_BAR; }
    PG8_BAR;
    if constexpr (Epi::AFTER_DRAIN) { E.fused(acc, cur, wr, wc, fr, fq, lds, wid, lane); S.done(cur); }
#undef PG8_SA
#undef PG8_SB
#undef PG8_STAGE
#undef PG8_LDA
#undef PG8_LDB
#undef PG8_MMA
#undef PG8_WAIT_V
#undef PG8_WAIT_L
#undef PG8_BAR
#undef PG8_SCHED
}
}

namespace pg8 {
struct EpiSwiglu {
    static constexpr bool PERM = false, AFTER_DRAIN = false;
    bf16_t* O; int ldo;
    __device__ __forceinline__ void operator()(const f32x4 (&acc)[2][2][4][2], const Unit& u, int wr, int wc, int fr, int fq) const {
        const int row0 = u.pm * BM + wr * 64 + fr;
#pragma unroll
        for (int ai = 0; ai < 2; ++ai)
#pragma unroll
            for (int m = 0; m < 4; ++m) {
                bf16_t* rowp = O + (size_t)(row0 + ai * HALF + m * 16) * ldo;
#pragma unroll
                for (int bj = 0; bj < 2; ++bj) {
                    const int grp = u.pn * 8 + bj * 4 + wc;
                    const f32x4 g = acc[ai][bj][m][0], up = acc[ai][bj][m][1];
                    const float h0 = fast_silu(g[0]) * up[0], h1 = fast_silu(g[1]) * up[1], h2 = fast_silu(g[2]) * up[2], h3 = fast_silu(g[3]) * up[3];
                    u32x2 w; w.x = cvt_pk_bf16(h0, h1); w.y = cvt_pk_bf16(h2, h3);
                    *(u32x2*)(rowp + grp * 16 + 4 * fq) = w;
                }
            }
    }
};
}

DEV void phase_prep_ffn(const FP& p, LAS unsigned char* lds, int gw, int ngw, int wave, int lane) {
    LAS float* scr = (LAS float*)(lds + wave * 16384);
    const float *wg = p.in[33], *wu = p.in[34], *wd = p.in[35];
    bf16_t* GU = (bf16_t*)(p.ws + WS_W_GU); bf16_t* DN = (bf16_t*)(p.ws + WS_W_DOWN);
    constexpr int I_G = 16 * 88, I_D = 44 * 32;
    for (int it = gw; it < 2 * I_G + I_D; it += ngw) {
        int r = it;
        if (r < I_G) { transpose_item(wg, 1024, 2816, GU, r, scr, lane, RmGU{0}); continue; } r -= I_G;
        if (r < I_G) { transpose_item(wu, 1024, 2816, GU, r, scr, lane, RmGU{1}); continue; } r -= I_G;
        transpose_item(wd, 2816, 1024, DN, r, scr, lane, RmPlain{0});
    }
}
DEV void phase_ffn_gu(const FP& p, LAS unsigned char* lds, int G, int bid) {
    pg8::Gemm g{(const bf16_t*)(p.ws + WS_XN), (const bf16_t*)(p.ws + WS_W_GU), MP, 5632, 1024};
    pg8::StaticOrder S; S.init(MP, 5632, G, bid);
    pg8::EpiSwiglu E{(bf16_t*)(p.ws + WS_HID), 2816};
    pg8::gemm_phase<pg8::EpiSwiglu, pg8::StaticOrder, true, true>(lds, g, S, E);
}
DEV void phase_ffn_down(const FP& p, LAS unsigned char* lds, int G, int bid) {
    pg8::Gemm g{(const bf16_t*)(p.ws + WS_HID), (const bf16_t*)(p.ws + WS_W_DOWN), MP, 1024, 2816};
    pg8::StaticOrder S; S.init(MP, 1024, G, bid);
    pg8::EpiBf16<0> E{(bf16_t*)(p.ws + WS_RAW), 1024, nullptr, 0, 0, 1.f};
    pg8::gemm_phase<pg8::EpiBf16<0>, pg8::StaticOrder, true, true>(lds, g, S, E);
}

typedef short v4i16_t __attribute__((ext_vector_type(4)));
typedef float f32x2_t __attribute__((ext_vector_type(2)));
typedef __bf16 bf16x2_t __attribute__((ext_vector_type(2)));
DEV unsigned cvtpk(float lo, float hi) { f32x2_t v = {lo, hi}; bf16x2_t b = __builtin_convertvector(v, bf16x2_t); return __builtin_bit_cast(unsigned, b); }
DEV f32x16 mfma32(bf16x8 a, bf16x8 b, f32x16 c) { return __builtin_amdgcn_mfma_f32_32x32x16_bf16(a, b, c, 0, 0, 0); }
DEV s16x4 tr_read(LAS const unsigned char* p) { return __builtin_bit_cast(s16x4, __builtin_amdgcn_ds_read_tr16_b64_v4i16((LAS v4i16_t*)p)); }
DEV bf16x8 cat8(s16x4 lo, s16x4 hi) { return (bf16x8){lo[0], lo[1], lo[2], lo[3], hi[0], hi[1], hi[2], hi[3]}; }
DEV float half_max(float v) { auto rr = __builtin_amdgcn_permlane32_swap(__float_as_uint(v), __float_as_uint(v), false, false); return fmaxf(__uint_as_float(rr[0]), __uint_as_float(rr[1])); }
DEV float half_sum(float v) { auto rr = __builtin_amdgcn_permlane32_swap(__float_as_uint(v), __float_as_uint(v), false, false); return __uint_as_float(rr[0]) + __uint_as_float(rr[1]); }
DEV bf16x8 pfrag(const f32x16& S, int s) {
    u32x4 w;
    if (s == 0) { w.x = cvtpk(S[0], S[1]); w.y = cvtpk(S[2], S[3]); w.z = cvtpk(S[4], S[5]); w.w = cvtpk(S[6], S[7]); }
    else { w.x = cvtpk(S[8], S[9]); w.y = cvtpk(S[10], S[11]); w.z = cvtpk(S[12], S[13]); w.w = cvtpk(S[14], S[15]); }
    return __builtin_bit_cast(bf16x8, w);
}
DEV float max16(const f32x16& S) {
    float a = fmaxf(fmaxf(S[0], S[1]), fmaxf(S[2], S[3])), b = fmaxf(fmaxf(S[4], S[5]), fmaxf(S[6], S[7]));
    float c = fmaxf(fmaxf(S[8], S[9]), fmaxf(S[10], S[11])), d = fmaxf(fmaxf(S[12], S[13]), fmaxf(S[14], S[15]));
    return fmaxf(fmaxf(a, b), fmaxf(c, d));
}

namespace pg8 {
struct EpiMemKV {
    static constexpr bool PERM = false, AFTER_DRAIN = false;
    float* ok; float* ov; bf16_t* bk; bf16_t* bv;
    __device__ __forceinline__ void operator()(const f32x4 (&acc)[2][2][4][2], const Unit& u, int wr, int wc, int fr, int fq) const {
        const int row0 = u.pm * BM + wr * 64 + fr; const bool isv = u.pn >= 4; const int colt = (u.pn & 3) * BM + wc * 32 + 4 * fq;
        float* of = isv ? ov : ok; bf16_t* ob = isv ? bv : bk;
#pragma unroll
        for (int ai = 0; ai < 2; ++ai)
#pragma unroll
            for (int m = 0; m < 4; ++m) {
                const size_t ro = (size_t)(row0 + ai * HALF + m * 16) * 1024;
#pragma unroll
                for (int bj = 0; bj < 2; ++bj)
#pragma unroll
                    for (int n = 0; n < 2; ++n) {
                        const f32x4 v = acc[ai][bj][m][n]; const int col = colt + bj * HALF + n * 16;
                        *(f32x4*)(of + ro + col) = v;
                        u32x2 w; w.x = cvt_pk_bf16(v[0], v[1]); w.y = cvt_pk_bf16(v[2], v[3]);
                        *(u32x2*)(ob + ro + col) = w;
                    }
            }
    }
};
}

DEV void phase_prep_x(const FP& p, LAS unsigned char* lds, int gw, int ngw, int wave, int lane) {
    LAS float* scr = (LAS float*)(lds + wave * 16384);
    constexpr int I_S = 16 * 32;
    for (int it = gw; it < 4 * I_S; it += ngw) {
        int r = it;
        if (r < I_S) { transpose_item(p.in[23], 1024, 1024, (bf16_t*)(p.ws + WS_W_Q), r, scr, lane, RmPlain{0}); continue; } r -= I_S;
        if (r < I_S) { transpose_item(p.in[24], 1024, 1024, (bf16_t*)(p.ws + WS_W_KV), r, scr, lane, RmPlain{0}); continue; } r -= I_S;
        if (r < I_S) { transpose_item(p.in[25], 1024, 1024, (bf16_t*)(p.ws + WS_W_KV), r, scr, lane, RmPlain{1024}); continue; } r -= I_S;
        transpose_item(p.in[26], 1024, 1024, (bf16_t*)(p.ws + WS_W_O), r, scr, lane, RmPlain{0});
    }
    row_phase(nullptr, p.in[8], nullptr, nullptr, p.in[22], (bf16_t*)(p.ws + WS_MN), 512, gw, ngw, lane);
}
DEV void phase_memkv(const FP& p, LAS unsigned char* lds, int G, int bid) {
    pg8::Gemm g{(const bf16_t*)(p.ws + WS_MN), (const bf16_t*)(p.ws + WS_W_KV), 512, 2048, 1024};
    pg8::StaticOrder S; S.init(512, 2048, G, bid);
    pg8::EpiMemKV E{p.out + 33822720, p.out + 34347008, (bf16_t*)(p.ws + WS_KM), (bf16_t*)(p.ws + WS_VM)};
    pg8::gemm_phase<pg8::EpiMemKV, pg8::StaticOrder, true, true>(lds, g, S, E);
}
namespace pg8 { struct OneUnit { int pm, pn;
    __device__ __forceinline__ bool next(int i, Unit& u) const { if (i) return false; u.pm = pm; u.pn = pn; return true; }
    __device__ __forceinline__ void a_ready(const Unit&) const {}
    __device__ __forceinline__ void done(const Unit&) const {} }; }
DEV void memkv_unit(const FP& p, LAS unsigned char* lds, int idx) {
    pg8::Gemm g{(const bf16_t*)(p.ws + WS_MN), (const bf16_t*)(p.ws + WS_W_KV), 512, 2048, 1024};
    pg8::OneUnit S{idx >> 3, idx & 7};
    pg8::EpiMemKV E{p.out + 33822720, p.out + 34347008, (bf16_t*)(p.ws + WS_KM), (bf16_t*)(p.ws + WS_VM)};
    pg8::gemm_phase<pg8::EpiMemKV, pg8::OneUnit, true, true>(lds, g, S, E);
}
DEV void phase_wq(const FP& p, LAS unsigned char* lds, int G, int bid) {
    pg8::Gemm g{(const bf16_t*)(p.ws + WS_XN), (const bf16_t*)(p.ws + WS_W_Q), MP, 1024, 1024};
    pg8::StaticOrder S; S.init(MP, 1024, G, bid);
    pg8::EpiBf16<0> E{(bf16_t*)(p.ws + WS_QX), 1024, nullptr, 1024, 0, 0.0625f * 1.4426950408889634f};
    pg8::gemm_phase<pg8::EpiBf16<0>, pg8::StaticOrder, true, true>(lds, g, S, E);
}
DEV void phase_wo(const FP& p, LAS unsigned char* lds, int G, int bid) {
    pg8::Gemm g{(const bf16_t*)(p.ws + WS_OX), (const bf16_t*)(p.ws + WS_W_O), MP, 1024, 1024};
    pg8::StaticOrder S; S.init(MP, 1024, G, bid);
    pg8::EpiBf16<0> E{(bf16_t*)(p.ws + WS_RAW), 1024, nullptr, 0, 0, 1.f};
    pg8::gemm_phase<pg8::EpiBf16<0>, pg8::StaticOrder, true, true>(lds, g, S, E);
}

DEV void phase_xattn(const FP& p, LAS unsigned char* lds, int G, int bid) {
    const int tid = threadIdx.x, lane = tid & 63, wave = __builtin_amdgcn_readfirstlane(tid >> 6), r = lane & 31, hh = lane >> 5, qb = wave & 3, eh = wave >> 2;
    const bf16_t* QX = (const bf16_t*)(p.ws + WS_QX); const bf16_t* KM = (const bf16_t*)(p.ws + WS_KM); const bf16_t* VM = (const bf16_t*)(p.ws + WS_VM);
    bf16_t* OX = (bf16_t*)(p.ws + WS_OX);
    constexpr int QOFF = 0, KOFF = 65536, VOFF = 98304;
    const int vlane = (4 * hh + ((lane & 15) >> 2)) * 64 + 32 * ((lane >> 4) & 1) + 8 * (lane & 3);
    for (int u = bid; u < 512; u += G) {
        const int bh = u & 7, b = bh >> 2, h = bh & 3, qblk = u >> 3;
        const size_t qrow0 = (size_t)b * 8192 + (size_t)qblk * 128;
#pragma unroll
        for (int j = 0; j < 8; ++j) {
            const int id = tid + 512 * j, row = id >> 5, ch = id & 31;
            const u32x4 v = *(const u32x4*)(QX + (qrow0 + row) * 1024 + h * 256 + ch * 8);
            *(LAS u32x4*)(lds + QOFF + row * 512 + ((ch ^ (row & 15)) << 4)) = v;
        }
        u32x4 kr[2], vr[2];
#pragma unroll
        for (int j = 0; j < 2; ++j) {
            const int id = tid + 512 * j, key = id >> 5, ch = id & 31;
            kr[j] = *(const u32x4*)(KM + ((size_t)b * 256 + key) * 1024 + h * 256 + ch * 8);
            vr[j] = *(const u32x4*)(VM + ((size_t)b * 256 + key) * 1024 + h * 256 + ch * 8);
        }
#pragma unroll
        for (int j = 0; j < 2; ++j) {
            const int id = tid + 512 * j, key = id >> 5, ch = id & 31;
            *(LAS u32x4*)(lds + KOFF + key * 512 + ((ch ^ (key & 15)) << 4)) = kr[j];
            *(LAS u32x4*)(lds + VOFF + (ch >> 2) * 2048 + key * 64 + (ch & 3) * 16) = vr[j];
        }
        __syncthreads();
        f32x16 O[4];
#pragma unroll
        for (int e = 0; e < 4; ++e)
#pragma unroll
            for (int i = 0; i < 16; ++i) O[e][i] = 0.f;
        float mrun = -1e30f, lsum = 0.f;
        const LAS unsigned char* qp = lds + QOFF + (32 * qb + r) * 512;
        for (int t = 0; t < 8; ++t) {
            const int buf = t & 1;
            if (t + 1 < 8) {
#pragma unroll
                for (int j = 0; j < 2; ++j) {
                    const int id = tid + 512 * j, key = id >> 5, ch = id & 31;
                    kr[j] = *(const u32x4*)(KM + ((size_t)b * 256 + 32 * (t + 1) + key) * 1024 + h * 256 + ch * 8);
                    vr[j] = *(const u32x4*)(VM + ((size_t)b * 256 + 32 * (t + 1) + key) * 1024 + h * 256 + ch * 8);
                }
            }
            const LAS unsigned char* kp = lds + KOFF + buf * 16384 + r * 512;
            const LAS unsigned char* vp = lds + VOFF + buf * 16384 + (4 * eh) * 2048 + vlane;
            f32x16 S;
#pragma unroll
            for (int i = 0; i < 16; ++i) S[i] = 0.f;
#pragma unroll 4
            for (int ks = 0; ks < 16; ++ks) {
                const int sl = ((2 * ks + hh) ^ (r & 15)) << 4;
                const bf16x8 a = *(const LAS bf16x8*)(kp + sl);
                const bf16x8 q = *(const LAS bf16x8*)(qp + sl);
                S = mfma32(a, q, S);
            }
            const float mx = half_max(max16(S));
            const float mnew = fmaxf(mrun, mx), alpha = __builtin_amdgcn_exp2f(mrun - mnew);
            mrun = mnew;
            float ps = 0.f;
#pragma unroll
            for (int i = 0; i < 16; ++i) { S[i] = __builtin_amdgcn_exp2f(S[i] - mnew); ps += S[i]; }
            lsum = lsum * alpha + ps;
#pragma unroll
            for (int e = 0; e < 4; ++e)
#pragma unroll
                for (int i = 0; i < 16; ++i) O[e][i] *= alpha;
            const bf16x8 P0 = pfrag(S, 0), P1 = pfrag(S, 1);
#pragma unroll
            for (int e = 0; e < 4; ++e) {
                const bf16x8 v0 = cat8(tr_read(vp + e * 2048), tr_read(vp + e * 2048 + 512));
                const bf16x8 v1 = cat8(tr_read(vp + e * 2048 + 1024), tr_read(vp + e * 2048 + 1536));
                O[e] = mfma32(v0, P0, O[e]);
                O[e] = mfma32(v1, P1, O[e]);
            }
            if (t + 1 < 8) {
#pragma unroll
                for (int j = 0; j < 2; ++j) {
                    const int id = tid + 512 * j, key = id >> 5, ch = id & 31;
                    *(LAS u32x4*)(lds + KOFF + (buf ^ 1) * 16384 + key * 512 + ((ch ^ (key & 15)) << 4)) = kr[j];
                    *(LAS u32x4*)(lds + VOFF + (buf ^ 1) * 16384 + (ch >> 2) * 2048 + key * 64 + (ch & 3) * 16) = vr[j];
                }
            }
            __syncthreads();
        }
        const float inv = 1.f / half_sum(lsum);
        LAS unsigned char* stg = lds + wave * 16384;
#pragma unroll
        for (int e = 0; e < 4; ++e)
#pragma unroll
            for (int g4 = 0; g4 < 4; ++g4) {
                u32x2 w; w.x = cvtpk(O[e][4 * g4 + 0] * inv, O[e][4 * g4 + 1] * inv); w.y = cvtpk(O[e][4 * g4 + 2] * inv, O[e][4 * g4 + 3] * inv);
                *(LAS u32x2*)(stg + r * 272 + (32 * e + 8 * g4 + 4 * hh) * 2) = w;
            }
        WAVE_SYNC();
#pragma unroll
        for (int i = 0; i < 8; ++i) {
            const int row = i * 4 + (lane >> 4), ch = lane & 15;
            const u32x4 v = *(const LAS u32x4*)(stg + row * 272 + ch * 16);
            *(u32x4*)(OX + (qrow0 + 32 * qb + row) * 1024 + h * 256 + 128 * eh + ch * 8) = v;
        }
        __syncthreads();
    }
}

constexpr float QSCALE = 0.125f * 1.4426950408889634f;
namespace pg8 {
struct EpiIn {
    static constexpr bool PERM = false, AFTER_DRAIN = false;
    bf16_t* ZX; bf16_t* Qb; bf16_t* Kb; bf16_t* Vb; float* okf; float* ovf; float* oconv;
    __device__ __forceinline__ void operator()(const f32x4 (&acc)[2][2][4][2], const Unit& u, int wr, int wc, int fr, int fq) const {
        const int row0 = u.pm * BM + wr * 64 + fr, pn = u.pn;
        if (pn < 6) {
#pragma unroll
            for (int ai = 0; ai < 2; ++ai)
#pragma unroll
                for (int m = 0; m < 4; ++m) {
                    const int row = row0 + ai * HALF + m * 16; const int t = row & 8191;
#pragma unroll
                    for (int bj = 0; bj < 2; ++bj)
#pragma unroll
                        for (int n = 0; n < 2; ++n) {
                            const f32x4 v = acc[ai][bj][m][n]; const int col = pn * BM + bj * HALF + wc * 32 + n * 16 + 4 * fq;
                            u32x2 w; w.x = cvt_pk_bf16(v[0], v[1]); w.y = cvt_pk_bf16(v[2], v[3]);
                            *(u32x2*)(ZX + (size_t)row * 1536 + col) = w;
                            if (pn >= 2 && t >= 8189) *(f32x4*)(oconv + (size_t)((row >> 13) * 3 + (t - 8189)) * 1024 + (col - 512)) = v;
                        }
                }
        } else if (pn < 10) {
            const bool isk = pn >= 8;
            const int g = wc & 1;
            float inv[4];
#pragma unroll
            for (int i = 0; i < 4; ++i) inv[i] = __builtin_amdgcn_exp2f(-(float)(16 * g + 4 * fq + i) * (13.287712379549449f / 32.f)) * 0.15915494309189535f;
#pragma unroll
            for (int ai = 0; ai < 2; ++ai)
#pragma unroll
                for (int m = 0; m < 4; ++m) {
                    const int row = row0 + ai * HALF + m * 16; const float pos = (float)(row & 8191);
                    float cs[4], sn[4];
#pragma unroll
                    for (int i = 0; i < 4; ++i) { float rev = pos * inv[i]; rev -= floorf(rev); sn[i] = __builtin_amdgcn_sinf(rev); cs[i] = __builtin_amdgcn_cosf(rev); }
#pragma unroll
                    for (int bj = 0; bj < 2; ++bj) {
                        const int cl = (pn & 1) * BM + bj * HALF + wc * 32;
                        const f32x4 x1 = acc[ai][bj][m][0], x2 = acc[ai][bj][m][1];
                        f32x4 o1, o2;
#pragma unroll
                        for (int i = 0; i < 4; ++i) { o1[i] = x1[i] * cs[i] - x2[i] * sn[i]; o2[i] = x2[i] * cs[i] + x1[i] * sn[i]; }
                        if (isk) {
                            float* kf = okf + (size_t)row * 512 + (cl >> 6) * 64 + 16 * g + 4 * fq;
                            *(f32x4*)kf = o1; *(f32x4*)(kf + 32) = o2;
                            u32x2 w; w.x = cvt_pk_bf16(o1[0], o1[1]); w.y = cvt_pk_bf16(o1[2], o1[3]);
                            *(u32x2*)(Kb + (size_t)row * 512 + cl + 4 * fq) = w;
                            w.x = cvt_pk_bf16(o2[0], o2[1]); w.y = cvt_pk_bf16(o2[2], o2[3]);
                            *(u32x2*)(Kb + (size_t)row * 512 + cl + 16 + 4 * fq) = w;
                        } else {
                            o1 = o1 * QSCALE; o2 = o2 * QSCALE;
                            u32x2 w; w.x = cvt_pk_bf16(o1[0], o1[1]); w.y = cvt_pk_bf16(o1[2], o1[3]);
                            *(u32x2*)(Qb + (size_t)row * 512 + cl + 4 * fq) = w;
                            w.x = cvt_pk_bf16(o2[0], o2[1]); w.y = cvt_pk_bf16(o2[2], o2[3]);
                            *(u32x2*)(Qb + (size_t)row * 512 + cl + 16 + 4 * fq) = w;
                        }
                    }
                }
        } else {
#pragma unroll
            for (int ai = 0; ai < 2; ++ai)
#pragma unroll
                for (int m = 0; m < 4; ++m) {
                    const int row = row0 + ai * HALF + m * 16;
#pragma unroll
                    for (int bj = 0; bj < 2; ++bj)
#pragma unroll
                        for (int n = 0; n < 2; ++n) {
                            const f32x4 v = acc[ai][bj][m][n]; const int col = (pn - 10) * BM + bj * HALF + wc * 32 + n * 16 + 4 * fq;
                            *(f32x4*)(ovf + (size_t)row * 512 + col) = v;
                            u32x2 w; w.x = cvt_pk_bf16(v[0], v[1]); w.y = cvt_pk_bf16(v[2], v[3]);
                            *(u32x2*)(Vb + (size_t)row * 512 + col) = w;
                        }
                }
        }
    }
};
}

DEV void phase_prep_mix(const FP& p, LAS unsigned char* lds, int gw, int ngw, int wave, int lane) {
    LAS float* scr = (LAS float*)(lds + wave * 16384);
    constexpr int I_IN = 16 * 97, I_OUT = 16 * 32;
    for (int it = gw; it < I_IN + I_OUT; it += ngw) {
        if (it < I_IN) transpose_item(p.in[9], 1024, 3080, (bf16_t*)(p.ws + WS_W_IN), it, scr, lane, RmIn{});
        else transpose_item(p.in[21], 1024, 1024, (bf16_t*)(p.ws + WS_W_OUT), it - I_IN, scr, lane, RmPlain{0});
    }
    __syncthreads();
    LAS float* wdt = (LAS float*)lds;
    for (int i = threadIdx.x; i < 8192; i += 512) wdt[i] = p.in[9][(size_t)(i >> 3) * 3080 + 1536 + (i & 7)];
    __syncthreads();
    const float* x = p.in[0]; const float* g = p.in[27]; bf16_t* xn = (bf16_t*)(p.ws + WS_XN); float* dtv = (float*)(p.ws + WS_DTV);
    const float bias = p.in[12][lane & 7];
    for (int r = gw; r < MP; r += ngw) {
        f32x4 h[4]; float ss = 0.f;
#pragma unroll
        for (int j = 0; j < 4; ++j) { h[j] = ((const f32x4*)(x + (size_t)r * 1024))[lane + 64 * j]; ss += h[j].x * h[j].x + h[j].y * h[j].y + h[j].z * h[j].z + h[j].w * h[j].w; }
        const float rs = rsqrtf(wave_sum(ss) * (1.f / 1024.f) + 1e-6f);
        float d[8];
#pragma unroll
        for (int k = 0; k < 8; ++k) d[k] = 0.f;
#pragma unroll
        for (int j = 0; j < 4; ++j) {
            const f32x4 gg = ((const f32x4*)g)[lane + 64 * j]; h[j] = h[j] * rs * gg;
            u32x2 w; w.x = pk2(h[j].x, h[j].y); w.y = pk2(h[j].z, h[j].w);
            ((u32x2*)(xn + (size_t)r * 1024))[lane + 64 * j] = w;
#pragma unroll
            for (int i = 0; i < 4; ++i) {
                const LAS f32x4* wp = (const LAS f32x4*)(wdt + (4 * (lane + 64 * j) + i) * 8);
                const f32x4 w0 = wp[0], w1 = wp[1]; const float hv = h[j][i];
                d[0] += hv * w0.x; d[1] += hv * w0.y; d[2] += hv * w0.z; d[3] += hv * w0.w; d[4] += hv * w1.x; d[5] += hv * w1.y; d[6] += hv * w1.z; d[7] += hv * w1.w;
            }
        }
#pragma unroll
        for (int k = 0; k < 8; ++k) d[k] = wave_sum(d[k]);
        float mine = d[0];
#pragma unroll
        for (int k = 1; k < 8; ++k) mine = ((lane & 7) == k) ? d[k] : mine;
        const float xx = mine + bias;
        if (lane < 8) dtv[(size_t)r * 8 + lane] = (xx > 20.f) ? xx : log1pf(expf(xx));
    }
    __syncthreads();
}
DEV void phase_inproj(const FP& p, LAS unsigned char* lds, int G, int bid) {
    pg8::Gemm g{(const bf16_t*)(p.ws + WS_XN), (const bf16_t*)(p.ws + WS_W_IN), MP, 3072, 1024};
    pg8::StaticOrder S; S.init(MP, 3072, G, bid);
    pg8::EpiIn E{(bf16_t*)(p.ws + WS_ZX), (bf16_t*)(p.ws + WS_Q), (bf16_t*)(p.ws + WS_K), (bf16_t*)(p.ws + WS_V), p.out + 16908288, p.out + 25296896, p.out + 33816576};
    pg8::gemm_phase<pg8::EpiIn, pg8::StaticOrder, true, true>(lds, g, S, E);
}
DEV void phase_outproj(const FP& p, LAS unsigned char* lds, int G, int bid) {
    pg8::Gemm g{(const bf16_t*)(p.ws + WS_CAT), (const bf16_t*)(p.ws + WS_W_OUT), MP, 1024, 1024};
    pg8::StaticOrder S; S.init(MP, 1024, G, bid);
    pg8::EpiBf16<0> E{(bf16_t*)(p.ws + WS_RAW), 1024, nullptr, 0, 0, 1.f};
    pg8::gemm_phase<pg8::EpiBf16<0>, pg8::StaticOrder, true, true>(lds, g, S, E);
}

DEV float ssd_tables(const FP& p, LAS float* tdt, LAS float* tac, size_t row0, int h, int lane) {
    const float dt = ((const float*)(p.ws + WS_DTV))[(row0 + lane) * 8 + h];
    const float a = -expf(p.in[13][h]);
    float v = dt * a;
#pragma unroll
    for (int o = 1; o < 64; o <<= 1) { const float t = __shfl_up(v, o); if (lane >= o) v += t; }
    tdt[lane * 8 + h] = dt; tac[lane * 8 + h] = v;
    return __shfl(v, 63);
}
template <class F> DEV void ssd_conv8(const FP& p, size_t row0, int col0, int l0, F emit) {
    const bf16_t* ZX = (const bf16_t*)(p.ws + WS_ZX);
    const float* cw = p.in[10]; const float* cb = p.in[11];
    f32x4 w[4][2], bias[2];
#pragma unroll
    for (int j = 0; j < 4; ++j) { w[j][0] = *(const f32x4*)(cw + j * 1024 + col0); w[j][1] = *(const f32x4*)(cw + j * 1024 + col0 + 4); }
    bias[0] = *(const f32x4*)(cb + col0); bias[1] = *(const f32x4*)(cb + col0 + 4);
    const int t0 = (int)(row0 & 8191);
    f32x4 u[4][2];
#pragma unroll
    for (int j = 0; j < 3; ++j) {
        const int l = l0 - 3 + j;
        if (t0 + l >= 0) {
            const u32x4 r = *(const u32x4*)(ZX + (row0 + l) * 1536 + 512 + col0);
            u[j][0] = (f32x4){bflo(r.x), bfhi(r.x), bflo(r.y), bfhi(r.y)}; u[j][1] = (f32x4){bflo(r.z), bfhi(r.z), bflo(r.w), bfhi(r.w)};
        } else { u[j][0] = (f32x4){0.f, 0.f, 0.f, 0.f}; u[j][1] = u[j][0]; }
    }
#pragma unroll
    for (int i = 0; i < 16; ++i) {
        const int l = l0 + i;
        const u32x4 r = *(const u32x4*)(ZX + (row0 + l) * 1536 + 512 + col0);
        u[3][0] = (f32x4){bflo(r.x), bfhi(r.x), bflo(r.y), bfhi(r.y)}; u[3][1] = (f32x4){bflo(r.z), bfhi(r.z), bflo(r.w), bfhi(r.w)};
        f32x4 a0 = bias[0] + w[0][0] * u[0][0] + w[1][0] * u[1][0] + w[2][0] * u[2][0] + w[3][0] * u[3][0];
        f32x4 a1 = bias[1] + w[0][1] * u[0][1] + w[1][1] * u[1][1] + w[2][1] * u[2][1] + w[3][1] * u[3][1];
#pragma unroll
        for (int k = 0; k < 4; ++k) { a0[k] = fast_silu(a0[k]); a1[k] = fast_silu(a1[k]); }
        emit(l, a0, a1);
        u[0][0] = u[1][0]; u[0][1] = u[1][1]; u[1][0] = u[2][0]; u[1][1] = u[2][1]; u[2][0] = u[3][0]; u[2][1] = u[3][1];
    }
}
constexpr int S_XS = 0, S_B = 65536, S_C = 98304, S_TDT = 131072, S_TAC = 133120, S_SSQ = 135168;
DEV int trlane(int lane) { return ((lane & 15) >> 2) * 64 + 32 * ((lane >> 4) & 1) + 8 * (lane & 3); }

DEV void phase_ssd1(const FP& p, LAS unsigned char* lds, int G, int bid) {
    const int tid = threadIdx.x, lane = tid & 63, wave = __builtin_amdgcn_readfirstlane(tid >> 6), hh = lane >> 5;
    LAS float* tdt = (LAS float*)(lds + S_TDT); LAS float* tac = (LAS float*)(lds + S_TAC);
    bf16_t* ST = (bf16_t*)(p.ws + WS_ST); float* cdec = (float*)(p.ws + WS_CDEC);
    for (int u = bid; u < 256; u += G) {
        const int b = u >> 7, c = u & 127; const size_t row0 = (size_t)b * 8192 + (size_t)c * 64;
        const float tot = ssd_tables(p, tdt, tac, row0, wave, lane);
        if (lane == 0) cdec[u * 8 + wave] = expf(tot);
        __syncthreads();
        { const int i = tid; const float t63 = tac[63 * 8 + (i & 7)]; const float s = tdt[i] * expf(t63 - tac[i]); __syncthreads(); tdt[i] = s; }
        __syncthreads();
        if (tid < 384) {
            const int cg = tid >> 2, tq = tid & 3, col0 = cg * 8;
            ssd_conv8(p, row0, col0, tq * 16, [&](int l, f32x4 a0, f32x4 a1) {
                u32x4 w;
                if (cg < 64) {
                    const int h = cg >> 3, pp = col0 & 63; const float s = tdt[l * 8 + h];
                    a0 = a0 * s; a1 = a1 * s;
                    w.x = pk2(a0[0], a0[1]); w.y = pk2(a0[2], a0[3]); w.z = pk2(a1[0], a1[1]); w.w = pk2(a1[2], a1[3]);
                    *(LAS u32x4*)(lds + S_XS + h * 8192 + (pp >> 5) * 4096 + l * 64 + (pp & 31) * 2) = w;
                } else {
                    const int n = col0 - 512, g = n >> 7, nn = n & 127;
                    w.x = pk2(a0[0], a0[1]); w.y = pk2(a0[2], a0[3]); w.z = pk2(a1[0], a1[1]); w.w = pk2(a1[2], a1[3]);
                    *(LAS u32x4*)(lds + S_B + g * 16384 + (nn >> 5) * 4096 + l * 64 + (nn & 31) * 2) = w;
                }
            });
        }
        __syncthreads();
        const int h = wave, g = h >> 2;
        const LAS unsigned char* xa = lds + S_XS + h * 8192 + hh * 512 + trlane(lane);
        const LAS unsigned char* ba = lds + S_B + g * 16384 + hh * 512 + trlane(lane);
        bf16_t* sp = ST + ((size_t)u * 8 + h) * 8192;
#pragma unroll 1
        for (int nh = 0; nh < 2; ++nh) {
            f32x16 acc[2][2];
#pragma unroll
            for (int a = 0; a < 2; ++a)
#pragma unroll
                for (int n = 0; n < 2; ++n)
#pragma unroll
                    for (int i = 0; i < 16; ++i) acc[a][n][i] = 0.f;
#pragma unroll 2
            for (int s = 0; s < 4; ++s) {
                bf16x8 af[2], bfr[2];
#pragma unroll
                for (int a = 0; a < 2; ++a) af[a] = cat8(tr_read(xa + a * 4096 + s * 1024), tr_read(xa + a * 4096 + s * 1024 + 256));
#pragma unroll
                for (int n = 0; n < 2; ++n) bfr[n] = cat8(tr_read(ba + (2 * nh + n) * 4096 + s * 1024), tr_read(ba + (2 * nh + n) * 4096 + s * 1024 + 256));
#pragma unroll
                for (int a = 0; a < 2; ++a)
#pragma unroll
                    for (int n = 0; n < 2; ++n) acc[a][n] = mfma32(af[a], bfr[n], acc[a][n]);
            }
#pragma unroll
            for (int a = 0; a < 2; ++a)
#pragma unroll
                for (int n = 0; n < 2; ++n)
#pragma unroll
                    for (int i = 0; i < 16; ++i) {
                        const int pr = 32 * a + (i & 3) + 8 * (i >> 2) + 4 * hh;
                        sp[pr * 128 + 32 * (2 * nh + n) + (lane & 31)] = (bf16_t)f2bf(acc[a][n][i]);
                    }
        }
        __syncthreads();
    }
}

DEV void ssd2_item(const FP& p, int blk) {
    const int tid = threadIdx.x;
    unsigned* ST = (unsigned*)(p.ws + WS_ST); const float* cdec = (const float*)(p.ws + WS_CDEC); float* pssm = p.out + 33685504;
    const int idx = blk * 512 + tid;
    const int n2 = idx & 63, pr = (idx >> 6) & 63, h = (idx >> 12) & 7, b = idx >> 15;
    float s0 = 0.f, s1 = 0.f;
    for (int c0 = 0; c0 < 128; c0 += 32) {
        unsigned v[32];
#pragma unroll
        for (int j = 0; j < 32; ++j) v[j] = ST[(((size_t)(b * 128 + c0 + j) * 8 + h) * 64 + pr) * 64 + n2];
#pragma unroll
        for (int j = 0; j < 32; ++j) {
            const float dc = cdec[(b * 128 + c0 + j) * 8 + h];
            ST[(((size_t)(b * 128 + c0 + j) * 8 + h) * 64 + pr) * 64 + n2] = pk2(s0, s1);
            s0 = s0 * dc + bflo(v[j]); s1 = s1 * dc + bfhi(v[j]);
        }
    }
    float2 o; o.x = s0; o.y = s1;
    ((float2*)pssm)[(((size_t)b * 8 + h) * 64 + pr) * 64 + n2] = o;
}
DEV void phase_ssd2(const FP& p, int G, int bid) { for (int blk = bid; blk < 128; blk += G) ssd2_item(p, blk); }

DEV void phase_ssd3(const FP& p, LAS unsigned char* lds, int G, int bid) {
    LAS float* tdt = (LAS float*)(lds + S_TDT); LAS float* tac = (LAS float*)(lds + S_TAC); LAS float* ssq = (LAS float*)(lds + S_SSQ);
    const bf16_t* ST = (const bf16_t*)(p.ws + WS_ST); const bf16_t* ZX = (const bf16_t*)(p.ws + WS_ZX); bf16_t* CAT = (bf16_t*)(p.ws + WS_CAT);
    for (int u = bid; u < 256; u += G) {
        int tid = threadIdx.x; asm volatile("" : "+v"(tid));
        const int lane = tid & 63, wave = __builtin_amdgcn_readfirstlane(tid >> 6), r = lane & 31, hh = lane >> 5;
        const int b = u >> 7, c = u & 127; const size_t row0 = (size_t)b * 8192 + (size_t)c * 64;
        (void)ssd_tables(p, tdt, tac, row0, wave, lane);
        {
            const int cg = tid >> 2, tq = tid & 3, col0 = cg * 8;
            ssd_conv8(p, row0, col0, tq * 16, [&](int l, f32x4 a0, f32x4 a1) {
                u32x4 w; w.x = pk2(a0[0], a0[1]); w.y = pk2(a0[2], a0[3]); w.z = pk2(a1[0], a1[1]); w.w = pk2(a1[2], a1[3]);
                if (cg < 64) {
                    const int h = cg >> 3, pp = col0 & 63;
                    *(LAS u32x4*)(lds + S_XS + h * 8192 + (pp >> 5) * 4096 + l * 64 + (pp & 31) * 2) = w;
                } else {
                    const int n = (col0 - 512) & 255, g = n >> 7, ch = (n & 127) >> 3;
                    *(LAS u32x4*)(lds + (col0 < 768 ? S_B : S_C) + g * 16384 + l * 256 + ((ch ^ (l & 15)) << 4)) = w;
                }
            });
        }
        __syncthreads();
        const int h = wave, g = h >> 2;
        f32x16 Y[2][2];
#pragma unroll
        for (int a = 0; a < 2; ++a)
#pragma unroll
            for (int l2 = 0; l2 < 2; ++l2)
#pragma unroll
                for (int i = 0; i < 16; ++i) Y[a][l2][i] = 0.f;
        const LAS unsigned char* cp = lds + S_C + g * 16384 + r * 256;
        const LAS unsigned char* bp = lds + S_B + g * 16384 + r * 256;
        const bf16_t* pv = ST + ((size_t)u * 8 + h) * 8192 + (size_t)r * 128 + 8 * hh;
#pragma unroll 2
        for (int ks = 0; ks < 8; ++ks) {
            const int sl = ((2 * ks + hh) ^ (r & 15)) << 4;
            const bf16x8 c0 = *(const LAS bf16x8*)(cp + sl), c1 = *(const LAS bf16x8*)(cp + 32 * 256 + sl);
            const bf16x8 p0 = *(const bf16x8*)(pv + 16 * ks), p1 = *(const bf16x8*)(pv + 32 * 128 + 16 * ks);
            Y[0][0] = mfma32(p0, c0, Y[0][0]); Y[0][1] = mfma32(p0, c1, Y[0][1]);
            Y[1][0] = mfma32(p1, c0, Y[1][0]); Y[1][1] = mfma32(p1, c1, Y[1][1]);
        }
        float acl[2];
#pragma unroll
        for (int l2 = 0; l2 < 2; ++l2) {
            acl[l2] = tac[(32 * l2 + r) * 8 + h]; const float e = expf(acl[l2]);
#pragma unroll
            for (int a = 0; a < 2; ++a)
#pragma unroll
                for (int i = 0; i < 16; ++i) Y[a][l2][i] *= e;
        }
        __builtin_amdgcn_sched_barrier(0);
        const LAS unsigned char* xa = lds + S_XS + h * 8192 + hh * 256 + trlane(lane);
#pragma unroll
        for (int lb = 0; lb < 2; ++lb)
#pragma unroll
            for (int sb = 0; sb <= lb; ++sb) {
                f32x16 T;
#pragma unroll
                for (int i = 0; i < 16; ++i) T[i] = 0.f;
#pragma unroll 2
                for (int ks = 0; ks < 8; ++ks) {
                    const int sl = ((2 * ks + hh) ^ (r & 15)) << 4;
                    const bf16x8 bb = *(const LAS bf16x8*)(bp + sb * 32 * 256 + sl), cc = *(const LAS bf16x8*)(cp + lb * 32 * 256 + sl);
                    T = mfma32(bb, cc, T);
                }
#pragma unroll
                for (int i = 0; i < 16; ++i) {
                    const int s = 32 * sb + (i & 3) + 8 * (i >> 2) + 4 * hh;
                    const float f = tdt[s * 8 + h] * __builtin_amdgcn_exp2f(1.4426950408889634f * fminf(acl[lb] - tac[s * 8 + h], 0.f));
                    T[i] = (s <= 32 * lb + r) ? T[i] * f : 0.f;
                }
                const bf16x8 P0 = pfrag(T, 0), P1 = pfrag(T, 1);
#pragma unroll
                for (int a = 0; a < 2; ++a) {
                    const bf16x8 x0 = cat8(tr_read(xa + a * 4096 + (2 * sb) * 1024), tr_read(xa + a * 4096 + (2 * sb) * 1024 + 512));
                    const bf16x8 x1 = cat8(tr_read(xa + a * 4096 + (2 * sb + 1) * 1024), tr_read(xa + a * 4096 + (2 * sb + 1) * 1024 + 512));
                    Y[a][lb] = mfma32(x0, P0, Y[a][lb]);
                    Y[a][lb] = mfma32(x1, P1, Y[a][lb]);
                }
            }
        __builtin_amdgcn_sched_barrier(0);
        const float Dh = p.in[14][h];
        float sq[2] = {0.f, 0.f};
#pragma unroll
        for (int a = 0; a < 2; ++a)
#pragma unroll
            for (int l2 = 0; l2 < 2; ++l2) {
                const int l = 32 * l2 + r;
#pragma unroll
                for (int g4 = 0; g4 < 4; ++g4) {
                    const int pp = 8 * g4 + 4 * hh;
                    const u32x2 xw = *(const LAS u32x2*)(lds + S_XS + h * 8192 + a * 4096 + l * 64 + pp * 2);
                    const u32x2 zw = *(const u32x2*)(ZX + (row0 + l) * 1536 + h * 64 + 32 * a + pp);
                    const float xv[4] = {bflo(xw.x), bfhi(xw.x), bflo(xw.y), bfhi(xw.y)}, zv[4] = {bflo(zw.x), bfhi(zw.x), bflo(zw.y), bfhi(zw.y)};
#pragma unroll
                    for (int i = 0; i < 4; ++i) { const float v = (Y[a][l2][4 * g4 + i] + Dh * xv[i]) * fast_silu(zv[i]); Y[a][l2][4 * g4 + i] = v; sq[l2] += v * v; }
                }
            }
#pragma unroll
        for (int l2 = 0; l2 < 2; ++l2) { sq[l2] = half_sum(sq[l2]); if (hh == 0) ssq[(h * 2 + l2) * 32 + r] = sq[l2]; }
        __syncthreads();
        float rs[2];
#pragma unroll
        for (int l2 = 0; l2 < 2; ++l2) {
            float t = 0.f;
#pragma unroll
            for (int k = 0; k < 4; ++k) t += ssq[((4 * g + k) * 2 + l2) * 32 + r];
            rs[l2] = rsqrtf(t * (1.f / 256.f) + 1e-5f);
        }
#pragma unroll
        for (int a = 0; a < 2; ++a)
#pragma unroll
            for (int g4 = 0; g4 < 4; ++g4) {
                const int pcol = h * 64 + 32 * a + 8 * g4 + 4 * hh;
                const f32x4 w = *(const f32x4*)(p.in[15] + pcol);
#pragma unroll
                for (int l2 = 0; l2 < 2; ++l2) {
                    u32x2 o; o.x = cvtpk(Y[a][l2][4 * g4 + 0] * rs[l2] * w[0], Y[a][l2][4 * g4 + 1] * rs[l2] * w[1]);
                    o.y = cvtpk(Y[a][l2][4 * g4 + 2] * rs[l2] * w[2], Y[a][l2][4 * g4 + 3] * rs[l2] * w[3]);
                    *(u32x2*)(CAT + (row0 + 32 * l2 + r) * 1024 + pcol) = o;
                }
            }
        __syncthreads();
    }
}

struct AttnCtx { unsigned lam_bits; };
DEV AttnCtx attn_setup(const FP& p, LAS unsigned char* lds) {
    const int tid0 = threadIdx.x, lane0 = tid0 & 63;
    AttnCtx c; float lamv = expf(wave_sum(p.in[16][lane0] * p.in[17][lane0])) - expf(wave_sum(p.in[18][lane0] * p.in[19][lane0])) + 0.2f;
    asm volatile("" : "+v"(lamv));
    c.lam_bits = __builtin_amdgcn_readfirstlane(__float_as_uint(lamv));
    LAS float* subw = (LAS float*)(lds + 131072);
    if (tid0 < 128) subw[tid0] = p.in[20][tid0];
    return c;
}
DEV void attn_unit(const FP& p, LAS unsigned char* lds, const AttnCtx& ctx, int bh, int jq) {
    const bf16_t* Qg = (const bf16_t*)(p.ws + WS_Q); const bf16_t* Kg = (const bf16_t*)(p.ws + WS_K); const bf16_t* Vg = (const bf16_t*)(p.ws + WS_V);
    bf16_t* CAT = (bf16_t*)(p.ws + WS_CAT);
    const float lam_init = 0.2f, lam = __uint_as_float(ctx.lam_bits);
    LAS float* subw = (LAS float*)(lds + 131072);
    const int b = bh >> 2, h = bh & 3;
    int tid = threadIdx.x; asm volatile("" : "+v"(tid));
    const int lane = tid & 63, wave = __builtin_amdgcn_readfirstlane(tid >> 6), r = lane & 31, hh = lane >> 5, qb = wave & 3, c = wave >> 2;
    const int vlane = (4 * hh) * 64 + trlane(lane);
    const size_t rowb = (size_t)b * 8192; const int q0 = jq * 128;
    const int ntb = 2 * jq + 2, myn = 2 * jq + (qb >> 1) + 1;
    constexpr int KOFF = 0, VOFF = 32768;
    bf16x8 qf[4];
#pragma unroll
    for (int ks = 0; ks < 4; ++ks) qf[ks] = *(const bf16x8*)(Qg + (rowb + q0 + 32 * qb + r) * 512 + h * 128 + c * 64 + 16 * ks + 8 * hh);
#pragma unroll
    for (int ks = 0; ks < 4; ++ks) asm volatile("" : "+v"(qf[ks]));
    const bf16_t* ksrc[2]; const bf16_t* vsrc[2]; int kdst[2], vdst[2];
#pragma unroll
    for (int j = 0; j < 2; ++j) {
        const int pc = wave + 8 * j;
        { const int comp = pc >> 3, kb8 = pc & 7, key = 8 * kb8 + (lane >> 3), ch = (lane & 7) ^ ((key >> 1) & 7);
          ksrc[j] = Kg + (rowb + key) * 512 + h * 128 + comp * 64 + ch * 8; kdst[j] = KOFF + comp * 8192 + kb8 * 1024; }
        { const int eb = pc >> 2, kb16 = pc & 3, key = 16 * kb16 + (lane >> 2);
          vsrc[j] = Vg + (rowb + key) * 512 + h * 128 + eb * 32 + (lane & 3) * 8; vdst[j] = VOFF + eb * 4096 + kb16 * 1024; }
    }
#define ATT_DMA(tt, bufo) do { _Pragma("unroll") for (int s_ = 0; s_ < 2; ++s_) _Pragma("unroll") for (int j_ = 0; j_ < 2; ++j_) { \
        __builtin_amdgcn_global_load_lds((const unsigned*)(ksrc[j_] + (size_t)(128 * (tt) + 64 * s_) * 512), (LAS unsigned*)(lds + kdst[j_] + (bufo) + 16384 * s_), 16, 0, 0); \
        __builtin_amdgcn_global_load_lds((const unsigned*)(vsrc[j_] + (size_t)(128 * (tt) + 64 * s_) * 512), (LAS unsigned*)(lds + vdst[j_] + (bufo) + 16384 * s_), 16, 0, 0); } } while (0)
#define ATT_BAR_L() do { asm volatile("s_waitcnt lgkmcnt(0)" ::: "memory"); __builtin_amdgcn_s_barrier(); asm volatile("" ::: "memory"); } while (0)
#define ATT_BAR_VL() do { asm volatile("s_waitcnt vmcnt(0) lgkmcnt(0)" ::: "memory"); __builtin_amdgcn_s_barrier(); asm volatile("" ::: "memory"); } while (0)
    asm volatile("s_waitcnt vmcnt(0) lgkmcnt(0)" ::: "memory");
    ATT_DMA(0, 0);
    ATT_BAR_VL();
    f32x16 O[4];
#pragma unroll
    for (int e = 0; e < 4; ++e)
#pragma unroll
        for (int i = 0; i < 16; ++i) O[e][i] = 0.f;
    float mrun = -1e30f, lsum = 0.f;
    const int nst = jq + 1;
    for (int tt = 0; tt < nst; ++tt) {
        const int bufo = (tt & 1) * 65536;
        if (tt + 1 < nst) ATT_DMA(tt + 1, 65536 - bufo);
#pragma unroll
        for (int sub = 0; sub < 2; ++sub) {
            if (2 * tt + sub < myn) {
                const LAS unsigned char* kp = lds + bufo + sub * 16384 + KOFF + c * 8192 + r * 128;
                const LAS unsigned char* vp = lds + bufo + sub * 16384 + VOFF + vlane;
                f32x16 S0, S1;
#pragma unroll
                for (int i = 0; i < 16; ++i) { S0[i] = 0.f; S1[i] = 0.f; }
#pragma unroll
                for (int ks = 0; ks < 4; ++ks) {
                    const int sl = ((2 * ks + hh) ^ ((r >> 1) & 7)) << 4;
                    const bf16x8 a0 = *(const LAS bf16x8*)(kp + sl), a1 = *(const LAS bf16x8*)(kp + 32 * 128 + sl);
                    S0 = mfma32(a0, qf[ks], S0); S1 = mfma32(a1, qf[ks], S1);
                }
                const float mx = half_max(fmaxf(max16(S0), max16(S1)));
                const float mnew = fmaxf(mrun, mx);
                if (__any(mnew > mrun)) {
                    const float alpha = __builtin_amdgcn_exp2f(mrun - mnew);
                    lsum *= alpha;
#pragma unroll
                    for (int e = 0; e < 4; ++e)
#pragma unroll
                        for (int i = 0; i < 16; ++i) O[e][i] *= alpha;
                    mrun = mnew;
                }
                float ps = 0.f;
#pragma unroll
                for (int i = 0; i < 16; ++i) { S0[i] = __builtin_amdgcn_exp2f(S0[i] - mrun); S1[i] = __builtin_amdgcn_exp2f(S1[i] - mrun); ps += S0[i] + S1[i]; }
                lsum += ps;
                const bf16x8 P0 = pfrag(S0, 0), P1 = pfrag(S0, 1), P2 = pfrag(S1, 0), P3 = pfrag(S1, 1);
#pragma unroll
                for (int e = 0; e < 4; ++e) {
                    const bf16x8 v0 = cat8(tr_read(vp + e * 4096), tr_read(vp + e * 4096 + 512));
                    const bf16x8 v1 = cat8(tr_read(vp + e * 4096 + 1024), tr_read(vp + e * 4096 + 1536));
                    const bf16x8 v2 = cat8(tr_read(vp + e * 4096 + 2048), tr_read(vp + e * 4096 + 2560));
                    const bf16x8 v3 = cat8(tr_read(vp + e * 4096 + 3072), tr_read(vp + e * 4096 + 3584));
                    O[e] = mfma32(v0, P0, O[e]); O[e] = mfma32(v1, P1, O[e]); O[e] = mfma32(v2, P2, O[e]); O[e] = mfma32(v3, P3, O[e]);
                }
            }
        }
        ATT_BAR_VL();
    }
#undef ATT_DMA
    const float inv = 1.f / half_sum(lsum);
    LAS float* xch = (LAS float*)(lds + qb * 16384);
    if (c == 1) {
        const float f = -lam * inv;
#pragma unroll
        for (int e = 0; e < 4; ++e)
#pragma unroll
            for (int i = 0; i < 16; ++i) xch[(e * 16 + i) * 64 + lane] = O[e][i] * f;
    }
    __syncthreads();
    if (c == 0) {
        float ss = 0.f;
#pragma unroll
        for (int e = 0; e < 4; ++e)
#pragma unroll
            for (int i = 0; i < 16; ++i) { const float v = O[e][i] * inv + xch[(e * 16 + i) * 64 + lane]; O[e][i] = v; ss += v * v; }
        ss = half_sum(ss);
        const float rs = rsqrtf(ss * (1.f / 128.f) + 1e-5f) * (1.f - lam_init);
        WAVE_SYNC();
        LAS unsigned char* stg = lds + qb * 16384;
#pragma unroll
        for (int e = 0; e < 4; ++e)
#pragma unroll
            for (int g4 = 0; g4 < 4; ++g4) {
                const int e0 = 32 * e + 8 * g4 + 4 * hh;
                const f32x4 w = *(const LAS f32x4*)(subw + e0);
                u32x2 o; o.x = cvtpk(O[e][4 * g4 + 0] * rs * w[0], O[e][4 * g4 + 1] * rs * w[1]); o.y = cvtpk(O[e][4 * g4 + 2] * rs * w[2], O[e][4 * g4 + 3] * rs * w[3]);
                *(LAS u32x2*)(stg + r * 272 + e0 * 2) = o;
            }
        WAVE_SYNC();
#pragma unroll
        for (int i = 0; i < 8; ++i) {
            const int row = i * 4 + (lane >> 4), ch = lane & 15;
            const u32x4 v = *(const LAS u32x4*)(stg + row * 272 + ch * 16);
            *(u32x4*)(CAT + (rowb + q0 + 32 * qb + row) * 1024 + 512 + h * 128 + ch * 8) = v;
        }
    }
    __syncthreads();
#undef ATT_BAR_L
#undef ATT_BAR_VL
}
DEV void phase_attn(const FP& p, LAS unsigned char* lds, int G, int bid) {
    const AttnCtx ctx = attn_setup(p, lds);
    for (int pu = bid; pu < 256; pu += G) {
        const int bh = pu & 7, pr = pu >> 3;
        attn_unit(p, lds, ctx, bh, pr);
        attn_unit(p, lds, ctx, bh, 63 - pr);
    }
}

constexpr int NS = 128;
constexpr size_t SB_XN = 0, SB_Z = 256 * 1024, SB_XBC = 512 * 1024, SB_Q = 1024 * 1024, SB_DTV = 1280 * 1024, SB_YPRE = 1536 * 1024, SB_CAT = 1792 * 1024, SB_MIX = 2048 * 1024,
                 SB_QX = 2560 * 1024, SB_OX = 3072 * 1024, SB_HID = 3328 * 1024, SB_AML = 4096 * 1024, SB_XML = 4608 * 1024, SB_XO = 5 * MiB, SB_AO = 8 * MiB;
constexpr int N_ATILE = 33;

template <class Epi>
DEV void s_gemm(const bf16_t* A, const bf16_t* Bt, int N, int K, LAS unsigned char* lds, int bid, int G, int rot, const Epi& E) {
    int tid = threadIdx.x; asm volatile("" : "+v"(tid));
    const int lane = tid & 63, wave = __builtin_amdgcn_readfirstlane(tid >> 6), r = lane & 31, hh = lane >> 5;
    const int nun = 4 * (N >> 5), kw = K >> 3, nit = kw >> 5;
    for (int u = (bid + G - rot) % G; u < nun; u += G) {
        const int mb = u & 3, n0 = (u >> 2) * 32;
        const bf16_t* ap = A + (size_t)(32 * mb + r) * K + wave * kw + 16 * hh;
        const bf16_t* bp = Bt + (size_t)(n0 + r) * K + wave * kw + 16 * hh;
        f32x16 acc;
#pragma unroll
        for (int i = 0; i < 16; ++i) acc[i] = 0.f;
#pragma unroll 4
        for (int j = 0; j < nit; ++j) {
            const bf16x8 a0 = *(const bf16x8*)(ap + 32 * j), a1 = *(const bf16x8*)(ap + 32 * j + 8);
            const bf16x8 b0 = *(const bf16x8*)(bp + 32 * j), b1 = *(const bf16x8*)(bp + 32 * j + 8);
            acc = mfma32(b0, a0, acc); acc = mfma32(b1, a1, acc);
        }
        LAS float* red = (LAS float*)lds;
        if (wave != 0) {
#pragma unroll
            for (int i = 0; i < 16; ++i) red[wave * 1024 + i * 64 + lane] = acc[i];
        }
        __syncthreads();
        if (wave == 0) {
#pragma unroll
            for (int w = 1; w < 8; ++w)
#pragma unroll
                for (int i = 0; i < 16; ++i) acc[i] += red[w * 1024 + i * 64 + lane];
            E(acc, 32 * mb + r, n0, hh);
        }
        __syncthreads();
    }
}
struct EpiSF32 {
    float* C; int ldc; float scale;
    __device__ __forceinline__ void operator()(const f32x16& acc, int m, int n0, int hh) const {
#pragma unroll
        for (int g4 = 0; g4 < 4; ++g4) { f32x4 v = {acc[4 * g4] * scale, acc[4 * g4 + 1] * scale, acc[4 * g4 + 2] * scale, acc[4 * g4 + 3] * scale}; *(f32x4*)(C + (size_t)m * ldc + n0 + 8 * g4 + 4 * hh) = v; }
    }
};
struct EpiSSwiglu {
    bf16_t* H;
    __device__ __forceinline__ void operator()(const f32x16& acc, int m, int n0, int hh) const {
#pragma unroll
        for (int g4 = 0; g4 < 2; ++g4) {
            u32x2 w; w.x = cvtpk(fast_silu(acc[4 * g4]) * acc[4 * g4 + 8], fast_silu(acc[4 * g4 + 1]) * acc[4 * g4 + 9]);
            w.y = cvtpk(fast_silu(acc[4 * g4 + 2]) * acc[4 * g4 + 10], fast_silu(acc[4 * g4 + 3]) * acc[4 * g4 + 11]);
            *(u32x2*)(H + (size_t)m * 2816 + 16 * (n0 >> 5) + 8 * g4 + 4 * hh) = w;
        }
    }
};
struct EpiSIn {
    float *z, *xbc, *q, *ok, *ov, *oconv;
    __device__ __forceinline__ void operator()(const f32x16& acc, int m, int n0, int hh) const {
        const int t = m & 15, b = m >> 4;
        if (n0 < 1536) {
#pragma unroll
            for (int g4 = 0; g4 < 4; ++g4) {
                const f32x4 v = {acc[4 * g4], acc[4 * g4 + 1], acc[4 * g4 + 2], acc[4 * g4 + 3]}; const int col = n0 + 8 * g4 + 4 * hh;
                if (n0 < 512) *(f32x4*)(z + (size_t)m * 512 + col) = v;
                else { *(f32x4*)(xbc + (size_t)m * 1024 + col - 512) = v; if (t >= 13) *(f32x4*)(oconv + (size_t)(b * 3 + t - 13) * 1024 + col - 512) = v; }
            }
        } else if (n0 < 2560) {
            const bool isk = n0 >= 2048; const int cl = (n0 - (isk ? 2048 : 1536)), u64 = cl >> 6, g = (cl >> 5) & 1;
            const float pos = (float)(2048 + t);
            float* dst = (isk ? ok : q) + (size_t)m * 512 + u64 * 64;
#pragma unroll
            for (int g4 = 0; g4 < 2; ++g4) {
                f32x4 o1, o2;
#pragma unroll
                for (int i = 0; i < 4; ++i) {
                    const int d0 = 16 * g + 8 * g4 + 4 * hh + i;
                    float rev = pos * (__builtin_amdgcn_exp2f(-(float)d0 * (13.287712379549449f / 32.f)) * 0.15915494309189535f); rev -= floorf(rev);
                    const float sn = __builtin_amdgcn_sinf(rev), cs = __builtin_amdgcn_cosf(rev);
                    const float x1 = acc[4 * g4 + i], x2 = acc[4 * g4 + 8 + i];
                    o1[i] = x1 * cs - x2 * sn; o2[i] = x2 * cs + x1 * sn;
                }
                const int d0 = 16 * g + 8 * g4 + 4 * hh;
                *(f32x4*)(dst + d0) = o1; *(f32x4*)(dst + d0 + 32) = o2;
            }
        } else {
#pragma unroll
            for (int g4 = 0; g4 < 4; ++g4) { const f32x4 v = {acc[4 * g4], acc[4 * g4 + 1], acc[4 * g4 + 2], acc[4 * g4 + 3]}; *(f32x4*)(ov + (size_t)m * 512 + n0 - 2560 + 8 * g4 + 4 * hh) = v; }
        }
    }
};

DEV void s_row(const FP& p, const float* raw, const float* hin, const float* gpost, float* hout, const float* gpre, bf16_t* xn, float* dtv, int bid, int G, int rot) {
    const int lane = threadIdx.x & 63, wave = __builtin_amdgcn_readfirstlane(threadIdx.x >> 6);
    const int blk = (bid + G - rot) % G;
    for (int r = blk + G * wave; r < NS; r += 8 * G) {
        f32x4 h[4];
#pragma unroll
        for (int j = 0; j < 4; ++j) h[j] = ((const f32x4*)(hin + (size_t)r * 1024))[lane + 64 * j];
        if (raw) {
            f32x4 v[4]; float ss = 0.f;
#pragma unroll
            for (int j = 0; j < 4; ++j) { v[j] = ((const f32x4*)(raw + (size_t)r * 1024))[lane + 64 * j]; ss += v[j].x * v[j].x + v[j].y * v[j].y + v[j].z * v[j].z + v[j].w * v[j].w; }
            const float rs = rsqrtf(wave_sum(ss) * (1.f / 1024.f) + 1e-6f);
#pragma unroll
            for (int j = 0; j < 4; ++j) { const f32x4 g = ((const f32x4*)gpost)[lane + 64 * j]; h[j] += v[j] * rs * g; }
        }
        if (hout) {
#pragma unroll
            for (int j = 0; j < 4; ++j) ((f32x4*)(hout + (size_t)r * 1024))[lane + 64 * j] = h[j];
        }
        if (gpre) {
            float ss = 0.f;
#pragma unroll
            for (int j = 0; j < 4; ++j) ss += h[j].x * h[j].x + h[j].y * h[j].y + h[j].z * h[j].z + h[j].w * h[j].w;
            const float rs = rsqrtf(wave_sum(ss) * (1.f / 1024.f) + 1e-6f);
            float d[8];
#pragma unroll
            for (int k = 0; k < 8; ++k) d[k] = 0.f;
#pragma unroll
            for (int j = 0; j < 4; ++j) {
                const f32x4 g = ((const f32x4*)gpre)[lane + 64 * j]; const f32x4 o = h[j] * rs * g;
                u32x2 w; w.x = pk2(o.x, o.y); w.y = pk2(o.z, o.w);
                ((u32x2*)(xn + (size_t)r * 1024))[lane + 64 * j] = w;
                if (dtv) {
#pragma unroll
                    for (int i = 0; i < 4; ++i) {
                        const float* wp = p.in[9] + (size_t)(4 * (lane + 64 * j) + i) * 3080 + 1536;
                        const f32x4 w0 = *(const f32x4*)wp, w1 = *(const f32x4*)(wp + 4); const float hv = o[i];
                        d[0] += hv * w0.x; d[1] += hv * w0.y; d[2] += hv * w0.z; d[3] += hv * w0.w; d[4] += hv * w1.x; d[5] += hv * w1.y; d[6] += hv * w1.z; d[7] += hv * w1.w;
                    }
                }
            }
            if (dtv) {
#pragma unroll
                for (int k = 0; k < 8; ++k) d[k] = wave_sum(d[k]);
                float mine = d[0];
#pragma unroll
                for (int k = 1; k < 8; ++k) mine = ((lane & 7) == k) ? d[k] : mine;
                const float xx = mine + p.in[12][lane & 7];
                if (lane < 8) dtv[(size_t)r * 8 + lane] = (xx > 20.f) ? xx : log1pf(expf(xx));
            }
        }
    }
}

DEV void s_ssd(const FP& p, LAS unsigned char* lds, int bid, int G, int rot) {
    const int tid = threadIdx.x;
    const float* xbc = (const float*)(p.ws + WS_SMP + SB_XBC); const float* zb = (const float*)(p.ws + WS_SMP + SB_Z); const float* dtv = (const float*)(p.ws + WS_SMP + SB_DTV);
    float* ypre = (float*)(p.ws + WS_SMP + SB_YPRE); float* s_ssm = p.out + 35002368;
    const float* cbuf = p.in[5]; const float* cw = p.in[10]; const float* cb = p.in[11];
    LAS float* act = (LAS float*)lds;
    for (int item = (bid + G - rot) % G; item < 64; item += G) {
        const int b = item >> 3, h = item & 7, g = h >> 2;
        for (int e = tid; e < 16 * 320; e += 512) {
            const int t = e / 320, cc = e % 320;
            const int col = (cc < 64) ? h * 64 + cc : (cc < 192 ? 512 + g * 128 + (cc - 64) : 768 + g * 128 + (cc - 192));
            float a = cb[col];
#pragma unroll
            for (int j = 0; j < 4; ++j) {
                const int tt = t - 3 + j;
                const float u = (tt >= 0) ? xbc[(size_t)(b * 16 + tt) * 1024 + col] : cbuf[(size_t)(b * 3 + tt + 3) * 1024 + col];
                a += cw[j * 1024 + col] * u;
            }
            act[e] = a / (1.f + expf(-a));
        }
        __syncthreads();
        const int pp = tid >> 3, seg = tid & 7;
        float hs[16];
        const size_t sbase = ((size_t)(b * 8 + h) * 64 + pp) * 128 + seg * 16;
#pragma unroll
        for (int i = 0; i < 16; ++i) hs[i] = p.in[4][sbase + i];
        const float a = -expf(p.in[13][h]), D = p.in[14][h];
#pragma unroll 1
        for (int t = 0; t < 16; ++t) {
            const float dt = dtv[(b * 16 + t) * 8 + h];
            const float zz = zb[(size_t)(b * 16 + t) * 512 + h * 64 + pp];
            const float x = act[t * 320 + pp];
            const float dA = expf(dt * a), coef = dt * x;
            float y = 0.f;
#pragma unroll
            for (int i = 0; i < 16; ++i) { hs[i] = dA * hs[i] + coef * act[t * 320 + 64 + seg * 16 + i]; y += act[t * 320 + 192 + seg * 16 + i] * hs[i]; }
            y += __shfl_xor(y, 1); y += __shfl_xor(y, 2); y += __shfl_xor(y, 4);
            if (seg == 0) ypre[(size_t)(b * 16 + t) * 512 + h * 64 + pp] = (y + D * x) * (zz / (1.f + expf(-zz)));
        }
#pragma unroll
        for (int i = 0; i < 16; ++i) s_ssm[sbase + i] = hs[i];
        __syncthreads();
    }
}

DEV bf16x8 cvt8(const float* p, float sc) {
    const f32x4 a = *(const f32x4*)p, b = *(const f32x4*)(p + 4);
    u32x4 w; w.x = cvtpk(a.x * sc, a.y * sc); w.y = cvtpk(a.z * sc, a.w * sc); w.z = cvtpk(b.x * sc, b.y * sc); w.w = cvtpk(b.z * sc, b.w * sc);
    return __builtin_bit_cast(bf16x8, w);
}
DEV void s_attn_part(const FP& p, LAS unsigned char* lds, int bid, int G) {
    const int lane = threadIdx.x & 63, wave = __builtin_amdgcn_readfirstlane(threadIdx.x >> 6), r = lane & 31, hh = lane >> 5;
    const float* q = (const float*)(p.ws + WS_SMP + SB_Q); const float* kn = p.out + 34871296; const float* vn = p.out + 34936832; const float* kp = p.in[2]; const float* vp = p.in[3];
    float* aml = (float*)(p.ws + WS_SMP + SB_AML); float* ao = (float*)(p.ws + WS_SMP + SB_AO);
    for (int it = bid + G * wave; it < 32 * N_ATILE; it += 8 * G) {
        const int bh = it / N_ATILE, tile = it % N_ATILE, b = bh >> 2, h = bh & 3;
        f32x16 S[2][2];
#pragma unroll
        for (int c = 0; c < 2; ++c)
#pragma unroll
            for (int sub = 0; sub < 2; ++sub)
#pragma unroll
                for (int i = 0; i < 16; ++i) S[c][sub][i] = 0.f;
        const float* qrow = q + (size_t)(b * 16 + (r & 15)) * 512 + h * 128 + 8 * hh;
#pragma unroll
        for (int sub = 0; sub < 2; ++sub) {
            int kk = tile * 64 + sub * 32 + r; if (kk > 2063) kk = 2063;
            const float* krow = ((kk < 2048) ? kp + (((size_t)b * 2048 + kk) * 4 + h) * 128 : kn + (((size_t)b * 16 + (kk - 2048)) * 4 + h) * 128) + 8 * hh;
#pragma unroll
            for (int c = 0; c < 2; ++c)
#pragma unroll
                for (int ks = 0; ks < 4; ++ks) S[c][sub] = mfma32(cvt8(krow + c * 64 + 16 * ks, 1.f), cvt8(qrow + c * 64 + 16 * ks, QSCALE), S[c][sub]);
        }
        bf16x8 P[2][4];
#pragma unroll
        for (int c = 0; c < 2; ++c) {
            float mx = -1e30f;
#pragma unroll
            for (int sub = 0; sub < 2; ++sub)
#pragma unroll
                for (int i = 0; i < 16; ++i) {
                    const int key = tile * 64 + sub * 32 + (i & 3) + 8 * (i >> 2) + 4 * hh;
                    if (key > 2063) S[c][sub][i] = -1e30f;
                    mx = fmaxf(mx, S[c][sub][i]);
                }
            mx = half_max(mx);
            float l = 0.f;
#pragma unroll
            for (int sub = 0; sub < 2; ++sub)
#pragma unroll
                for (int i = 0; i < 16; ++i) { S[c][sub][i] = __builtin_amdgcn_exp2f(S[c][sub][i] - mx); l += S[c][sub][i]; }
            l = half_sum(l);
            if (lane < 16) { aml[((size_t)it * 32 + lane * 2 + c) * 2] = mx * 0.6931471805599453f; aml[((size_t)it * 32 + lane * 2 + c) * 2 + 1] = l; }
            P[c][0] = pfrag(S[c][0], 0); P[c][1] = pfrag(S[c][0], 1); P[c][2] = pfrag(S[c][1], 0); P[c][3] = pfrag(S[c][1], 1);
        }
#pragma unroll 1
        for (int eb = 0; eb < 4; ++eb) {
            f32x16 O0, O1;
#pragma unroll
            for (int i = 0; i < 16; ++i) { O0[i] = 0.f; O1[i] = 0.f; }
#pragma unroll
            for (int st = 0; st < 4; ++st) {
                float vv[8];
#pragma unroll
                for (int jj = 0; jj < 8; ++jj) {
                    int kj = tile * 64 + 16 * st + 8 * (jj >> 2) + 4 * hh + (jj & 3); if (kj > 2063) kj = 2063;
                    const float* vrow = (kj < 2048) ? vp + (((size_t)b * 2048 + kj) * 4 + h) * 128 : vn + (((size_t)b * 16 + (kj - 2048)) * 4 + h) * 128;
                    vv[jj] = vrow[eb * 32 + r];
                }
                u32x4 w; w.x = cvtpk(vv[0], vv[1]); w.y = cvtpk(vv[2], vv[3]); w.z = cvtpk(vv[4], vv[5]); w.w = cvtpk(vv[6], vv[7]);
                const bf16x8 vf = __builtin_bit_cast(bf16x8, w);
                O0 = mfma32(vf, P[0][st], O0); O1 = mfma32(vf, P[1][st], O1);
            }
            if (r < 16) {
#pragma unroll
                for (int g4 = 0; g4 < 4; ++g4) {
                    const int e0 = eb * 32 + 8 * g4 + 4 * hh;
                    *(f32x4*)(ao + ((size_t)it * 32 + r * 2 + 0) * 128 + e0) = (f32x4){O0[4 * g4], O0[4 * g4 + 1], O0[4 * g4 + 2], O0[4 * g4 + 3]};
                    *(f32x4*)(ao + ((size_t)it * 32 + r * 2 + 1) * 128 + e0) = (f32x4){O1[4 * g4], O1[4 * g4 + 1], O1[4 * g4 + 2], O1[4 * g4 + 3]};
                }
            }
        }
    }
}
DEV void s_attn_comb(const FP& p, int bid, int G, int rot) {
    const int lane = threadIdx.x & 63, wave = __builtin_amdgcn_readfirstlane(threadIdx.x >> 6);
    const float* aml = (const float*)(p.ws + WS_SMP + SB_AML); const float* ao = (const float*)(p.ws + WS_SMP + SB_AO); const float* ypre = (const float*)(p.ws + WS_SMP + SB_YPRE);
    bf16_t* cat = (bf16_t*)(p.ws + WS_SMP + SB_CAT);
    const float lam_init = 0.2f;
    const float lam = expf(wave_sum(p.in[16][lane] * p.in[17][lane])) - expf(wave_sum(p.in[18][lane] * p.in[19][lane])) + lam_init;
    const int blk = (bid + G - rot) % G;
    for (int it = blk + G * wave; it < 512 + 256; it += 8 * G) {
        if (it < 512) {
            const int bh = it >> 4, qi = it & 15, b = bh >> 2, h = bh & 3;
            float o[2][2];
#pragma unroll
            for (int c = 0; c < 2; ++c) {
                const float mj = (lane < N_ATILE) ? aml[((size_t)(bh * N_ATILE + lane) * 32 + qi * 2 + c) * 2] : -1e30f;
                const float lj = (lane < N_ATILE) ? aml[((size_t)(bh * N_ATILE + lane) * 32 + qi * 2 + c) * 2 + 1] : 0.f;
                const float M = wave_max(mj), wj = expf(mj - M), L = wave_sum(lj * wj);
                float ax = 0.f, ay = 0.f;
#pragma unroll 11
                for (int j = 0; j < N_ATILE; ++j) {
                    const float w = __shfl(wj, j);
                    const float2 v = ((const float2*)(ao + ((size_t)(bh * N_ATILE + j) * 32 + qi * 2 + c) * 128))[lane];
                    ax += w * v.x; ay += w * v.y;
                }
                o[c][0] = ax / L; o[c][1] = ay / L;
            }
            const float ox = o[0][0] - lam * o[1][0], oy = o[0][1] - lam * o[1][1];
            const float ms = wave_sum(ox * ox + oy * oy) * (1.f / 128.f);
            const float rs = rsqrtf(ms + 1e-5f) * (1.f - lam_init);
            const float2 w = ((const float2*)p.in[20])[lane];
            ((unsigned*)(cat + (size_t)(b * 16 + qi) * 1024 + 512 + h * 128))[lane] = pk2(ox * rs * w.x, oy * rs * w.y);
        } else {
            const int i2 = it - 512, row = i2 >> 1, g = i2 & 1;
            const f32x4 v = ((const f32x4*)(ypre + (size_t)row * 512 + g * 256))[lane];
            const float rs = rsqrtf(wave_sum(v.x * v.x + v.y * v.y + v.z * v.z + v.w * v.w) * (1.f / 256.f) + 1e-5f);
            const f32x4 ww = ((const f32x4*)(p.in[15] + g * 256))[lane];
            u32x2 o; o.x = pk2(v.x * rs * ww.x, v.y * rs * ww.y); o.y = pk2(v.z * rs * ww.z, v.w * rs * ww.w);
            ((u32x2*)(cat + (size_t)row * 1024 + g * 256))[lane] = o;
        }
    }
}
DEV void s_xattn_part(const FP& p, LAS unsigned char* lds, int bid, int G, int rot) {
    const int lane = threadIdx.x & 63, wave = __builtin_amdgcn_readfirstlane(threadIdx.x >> 6), r = lane & 31, hh = lane >> 5;
    const float* qx = (const float*)(p.ws + WS_SMP + SB_QX); const float* mk = p.in[6]; const float* mv = p.in[7];
    float* xml = (float*)(p.ws + WS_SMP + SB_XML); float* xo = (float*)(p.ws + WS_SMP + SB_XO);
    const int blk = (bid + G - rot) % G;
    for (int it = blk + G * wave; it < 128; it += 8 * G) {
        const int bh = it >> 2, tile = it & 3, b = bh >> 2, h = bh & 3;
        f32x16 S[2];
#pragma unroll
        for (int sub = 0; sub < 2; ++sub)
#pragma unroll
            for (int i = 0; i < 16; ++i) S[sub][i] = 0.f;
        const float* qrow = qx + (size_t)(b * 16 + (r & 15)) * 1024 + h * 256 + 8 * hh;
#pragma unroll 4
        for (int ks = 0; ks < 16; ++ks) {
            const bf16x8 qf = cvt8(qrow + 16 * ks, 0.0625f * 1.4426950408889634f);
#pragma unroll
            for (int sub = 0; sub < 2; ++sub) {
                const float* krow = mk + (((size_t)b * 256 + tile * 64 + sub * 32 + r) * 4 + h) * 256 + 8 * hh;
                S[sub] = mfma32(cvt8(krow + 16 * ks, 1.f), qf, S[sub]);
            }
        }
        float mx = half_max(fmaxf(max16(S[0]), max16(S[1])));
        float l = 0.f;
#pragma unroll
        for (int sub = 0; sub < 2; ++sub)
#pragma unroll
            for (int i = 0; i < 16; ++i) { S[sub][i] = __builtin_amdgcn_exp2f(S[sub][i] - mx); l += S[sub][i]; }
        l = half_sum(l);
        if (lane < 16) { xml[((size_t)it * 16 + lane) * 2] = mx * 0.6931471805599453f; xml[((size_t)it * 16 + lane) * 2 + 1] = l; }
        bf16x8 P[4];
        P[0] = pfrag(S[0], 0); P[1] = pfrag(S[0], 1); P[2] = pfrag(S[1], 0); P[3] = pfrag(S[1], 1);
#pragma unroll 1
        for (int eb = 0; eb < 8; ++eb) {
            f32x16 O;
#pragma unroll
            for (int i = 0; i < 16; ++i) O[i] = 0.f;
#pragma unroll
            for (int st = 0; st < 4; ++st) {
                float vv[8];
#pragma unroll
                for (int jj = 0; jj < 8; ++jj) {
                    const int kj = tile * 64 + 16 * st + 8 * (jj >> 2) + 4 * hh + (jj & 3);
                    vv[jj] = mv[(((size_t)b * 256 + kj) * 4 + h) * 256 + eb * 32 + r];
                }
                u32x4 w; w.x = cvtpk(vv[0], vv[1]); w.y = cvtpk(vv[2], vv[3]); w.z = cvtpk(vv[4], vv[5]); w.w = cvtpk(vv[6], vv[7]);
                O = mfma32(__builtin_bit_cast(bf16x8, w), P[st], O);
            }
            if (r < 16) {
#pragma unroll
                for (int g4 = 0; g4 < 4; ++g4) *(f32x4*)(xo + ((size_t)it * 16 + r) * 256 + eb * 32 + 8 * g4 + 4 * hh) = (f32x4){O[4 * g4], O[4 * g4 + 1], O[4 * g4 + 2], O[4 * g4 + 3]};
            }
        }
    }
}
DEV void s_xattn_comb(const FP& p, int bid, int G, int rot) {
    const int lane = threadIdx.x & 63, wave = __builtin_amdgcn_readfirstlane(threadIdx.x >> 6);
    const float* xml = (const float*)(p.ws + WS_SMP + SB_XML); const float* xo = (const float*)(p.ws + WS_SMP + SB_XO);
    bf16_t* ox = (bf16_t*)(p.ws + WS_SMP + SB_OX);
    const int blk = (bid + G - rot) % G;
    for (int it = blk + G * wave; it < 512; it += 8 * G) {
        const int bh = it >> 4, qi = it & 15, b = bh >> 2, h = bh & 3;
        float m[4], l[4];
#pragma unroll
        for (int j = 0; j < 4; ++j) { m[j] = xml[((size_t)(bh * 4 + j) * 16 + qi) * 2]; l[j] = xml[((size_t)(bh * 4 + j) * 16 + qi) * 2 + 1]; }
        const float M = fmaxf(fmaxf(m[0], m[1]), fmaxf(m[2], m[3]));
        float L = 0.f; f32x4 acc = {0.f, 0.f, 0.f, 0.f};
#pragma unroll
        for (int j = 0; j < 4; ++j) { const float w = expf(m[j] - M); L += l[j] * w; acc += ((const f32x4*)(xo + ((size_t)(bh * 4 + j) * 16 + qi) * 256))[lane] * w; }
        const float il = 1.f / L;
        u32x2 o; o.x = pk2(acc.x * il, acc.y * il); o.y = pk2(acc.z * il, acc.w * il);
        ((u32x2*)(ox + (size_t)(b * 16 + qi) * 1024 + h * 256))[lane] = o;
    }
}

namespace cg = cooperative_groups;


DEV unsigned long long rf64(unsigned long long v) {
    const unsigned lo = __builtin_amdgcn_readfirstlane((unsigned)v), hi = __builtin_amdgcn_readfirstlane((unsigned)(v >> 32));
    return ((unsigned long long)hi << 32) | lo;
}
DEV FP fp_from_lds(const LAS unsigned long long* tab) {
    asm volatile("" ::: "memory");
    FP q;
#pragma unroll
    for (int i = 0; i < 36; ++i) q.in[i] = (const float*)rf64(tab[i]);
    q.out = (float*)rf64(tab[36]); q.ws = (unsigned char*)rf64(tab[37]);
    return q;
}

constexpr int CW_TEAM = 8192, CW_QUEUE = 4160;
constexpr int TEAM = 64;
DEV void sample_chain(const FP& p, LAS unsigned char* lds, int tb, int T, const XcdBarrier& tbar) {
    unsigned char* sb = p.ws + WS_SMP;
    float* ys = p.out + 16777216; const float* xs = p.in[1];
    s_gemm((const bf16_t*)(sb + SB_XN), (const bf16_t*)(p.ws + WS_W_IN), 3072, 1024, lds, tb, T, 0,
           EpiSIn{(float*)(sb + SB_Z), (float*)(sb + SB_XBC), (float*)(sb + SB_Q), p.out + 34871296, p.out + 34936832, p.out + 35526656});
    xcd_barrier(tbar);
    s_ssd(p, lds, tb, T, 0);
    s_attn_part(p, lds, tb, T);
    xcd_barrier(tbar);
    s_attn_comb(p, tb, T, 0);
    xcd_barrier(tbar);
    s_gemm((const bf16_t*)(sb + SB_CAT), (const bf16_t*)(p.ws + WS_W_OUT), 1024, 1024, lds, tb, T, 0, EpiSF32{(float*)(sb + SB_MIX), 1024, 1.f});
    xcd_barrier(tbar);
    s_row(p, (const float*)(sb + SB_MIX), xs, p.in[28], ys, p.in[29], (bf16_t*)(sb + SB_XN), nullptr, tb, T, 0);
    xcd_barrier(tbar);
    s_gemm((const bf16_t*)(sb + SB_XN), (const bf16_t*)(p.ws + WS_W_Q), 1024, 1024, lds, tb, T, 0, EpiSF32{(float*)(sb + SB_QX), 1024, 1.f});
    xcd_barrier(tbar);
    s_xattn_part(p, lds, tb, T, 0);
    xcd_barrier(tbar);
    s_xattn_comb(p, tb, T, 0);
    xcd_barrier(tbar);
    s_gemm((const bf16_t*)(sb + SB_OX), (const bf16_t*)(p.ws + WS_W_O), 1024, 1024, lds, tb, T, 0, EpiSF32{(float*)(sb + SB_MIX), 1024, 1.f});
    xcd_barrier(tbar);
    s_row(p, (const float*)(sb + SB_MIX), ys, p.in[30], ys, p.in[31], (bf16_t*)(sb + SB_XN), nullptr, tb, T, 0);
    xcd_barrier(tbar);
    s_gemm((const bf16_t*)(sb + SB_XN), (const bf16_t*)(p.ws + WS_W_GU), 5632, 1024, lds, tb, T, 0, EpiSSwiglu{(bf16_t*)(sb + SB_HID)});
    xcd_barrier(tbar);
    s_gemm((const bf16_t*)(sb + SB_HID), (const bf16_t*)(p.ws + WS_W_DOWN), 1024, 2816, lds, tb, T, 0, EpiSF32{(float*)(sb + SB_MIX), 1024, 1.f});
    xcd_barrier(tbar);
    s_row(p, (const float*)(sb + SB_MIX), ys, p.in[32], ys, nullptr, nullptr, nullptr, tb, T, 0);
    __syncthreads();
}
DEV void p3_queue(const FP& p, LAS unsigned char* lds, int bid) {
    unsigned* qh = (unsigned*)(p.ws + WS_CTL) + CW_QUEUE;
    volatile LAS int* slot = (volatile LAS int*)(lds + LDS_BYTES - 32);
    const AttnCtx ctx = attn_setup(p, lds);
    for (;;) {
        __syncthreads();
        if (threadIdx.x == 0) {
            int u = -1;
            for (int k = 0; k < 8 && u < 0; ++k) {
                const int q = (bid + k) & 7;
                const unsigned v = __hip_atomic_fetch_add(qh + 64 * q, 1u, __ATOMIC_RELAXED, __HIP_MEMORY_SCOPE_AGENT);
                if (v < 82u) u = q * 82 + (int)v;
            }
            slot[0] = u;
        }
        __syncthreads();
        const int u = slot[0];
        if (u < 0) break;
        const int q = u / 82, v = u % 82;
        if (v < 16) ssd2_item(p, q * 16 + v);
        else if (v < 18) memkv_unit(p, lds, q * 2 + (v - 16));
        else attn_unit(p, lds, ctx, q, 63 - (v - 18));
    }
}
__global__ void __launch_bounds__(512, 2) k_mega(FP p0) {
    extern __shared__ __attribute__((aligned(16))) unsigned char lds_raw[];
    LAS unsigned char* lds = (LAS unsigned char*)lds_raw;
    cg::grid_group grid = cg::this_grid();
    const int G = gridDim.x, bid = blockIdx.x, ngw = G * 8;
#define IDS() int tid_ = threadIdx.x; asm volatile("" : "+v"(tid_)); const int lane = tid_ & 63, wave = __builtin_amdgcn_readfirstlane(tid_ >> 6), gw = bid * 8 + wave; (void)lane; (void)gw
    LAS unsigned long long* tab = (LAS unsigned long long*)(lds + LDS_BYTES - 512);
    if (threadIdx.x < 36) tab[threadIdx.x] = (unsigned long long)p0.in[threadIdx.x];
    if (threadIdx.x == 36) tab[36] = (unsigned long long)p0.out;
    if (threadIdx.x == 37) tab[37] = (unsigned long long)p0.ws;
#define PH(...) do { const FP p = fp_from_lds(tab); float* y = p.out; unsigned char* sb = p.ws + WS_SMP; (void)y; (void)sb; __VA_ARGS__ } while (0)
    volatile LAS unsigned* MISC = (volatile LAS unsigned*)(lds + LDS_BYTES - 64);
    if (threadIdx.x < 16) MISC[threadIdx.x] = 0u;
    __syncthreads();
    XcdBarrier bar = xcd_barrier_post((unsigned*)(p0.ws + WS_CTL), MISC);
    PH( { IDS(); phase_prep_x(p, lds, gw, ngw, wave, lane); phase_prep_ffn(p, lds, gw, ngw, wave, lane); phase_prep_mix(p, lds, gw, ngw, wave, lane); } );
    PH( s_row(p, nullptr, p.in[1], nullptr, nullptr, p.in[27], (bf16_t*)(sb + SB_XN), (float*)(sb + SB_DTV), bid, G, 0); );
    grid.sync();
    PH( phase_inproj(p, lds, G, bid); );
    xcd_barrier(bar);
    PH( phase_ssd1(p, lds, G, bid); );
    xcd_barrier(bar);
    PH( { const int T = (G >= 2 * TEAM) ? TEAM : 1; if (bid >= G - T) { XcdBarrier tbar = xcd_barrier_post((unsigned*)(p.ws + WS_CTL) + CW_TEAM, (volatile LAS unsigned*)(lds + LDS_BYTES - 48), (unsigned)T); sample_chain(p, lds, bid - (G - T), T, tbar); } } );
    PH( p3_queue(p, lds, bid); );
    xcd_barrier(bar);
    PH( phase_ssd3(p, lds, G, bid); );
    xcd_barrier(bar);
    PH( phase_outproj(p, lds, G, bid); );
    xcd_barrier(bar);
    PH( { IDS(); row_phase((const bf16_t*)(p.ws + WS_RAW), p.in[0], p.in[28], y, p.in[29], (bf16_t*)(p.ws + WS_XN), MP, gw, ngw, lane); } );
    xcd_barrier(bar);
    PH( phase_wq(p, lds, G, bid); );
    xcd_barrier(bar);
    PH( phase_xattn(p, lds, G, bid); );
    xcd_barrier(bar);
    PH( phase_wo(p, lds, G, bid); );
    xcd_barrier(bar);
    PH( { IDS(); row_phase((const bf16_t*)(p.ws + WS_RAW), y, p.in[30], y, p.in[31], (bf16_t*)(p.ws + WS_XN), MP, gw, ngw, lane); } );
    xcd_barrier(bar);
    PH( phase_ffn_gu(p, lds, G, bid); );
    xcd_barrier(bar);
    PH( phase_ffn_down(p, lds, G, bid); );
    xcd_barrier(bar);
    PH( { IDS(); row_phase((const bf16_t*)(p.ws + WS_RAW), y, p.in[32], y, nullptr, nullptr, MP, gw, ngw, lane); } );
}

extern "C" void kernel_launch(void* const* d_in, const int* in_sizes, int n_in, void* d_out, int out_size, void* d_ws, size_t ws_size, hipStream_t stream) {
    static int grid = 0;
    if (!grid) {
        int dev = 0, cus = 0, per_cu = 0;
        (void)hipGetDevice(&dev);
        (void)hipDeviceGetAttribute(&cus, hipDeviceAttributeMultiprocessorCount, dev);
        (void)hipFuncSetAttribute((const void*)k_mega, hipFuncAttributeMaxDynamicSharedMemorySize, LDS_BYTES);
        (void)hipOccupancyMaxActiveBlocksPerMultiprocessor(&per_cu, (const void*)k_mega, 512, LDS_BYTES);
        if (per_cu < 1) per_cu = 1;
        grid = cus * per_cu;
        if (grid > 256) grid = 256;
        if (n_in != 36 || ws_size < 256 * MiB) fprintf(stderr, "kernel_launch: unexpected n_in %d / ws_size %zu\n", n_in, ws_size);
    }
    (void)hipMemsetAsync((unsigned char*)d_ws + WS_CTL, 0, 65536, stream);
    FP p{};
    for (int i = 0; i < 36; ++i) p.in[i] = (const float*)d_in[i];
    p.out = (float*)d_out; p.ws = (unsigned char*)d_ws;
    void* args[] = {&p};
    hipError_t e = hipLaunchCooperativeKernel((const void*)k_mega, dim3(grid), dim3(512), args, LDS_BYTES, stream);
    if (e != hipSuccess) fprintf(stderr, "cooperative launch failed: %s (grid %d)\n", hipGetErrorString(e), grid);
}
```

```cpp
#include <hip/hip_runtime.h>
#include <cstdint>
#include <cstdio>
#include <hip/hip_cooperative_groups.h>

#define DEV static __device__ __forceinline__
#define LAS __attribute__((address_space(3)))
#define WAVE_SYNC() asm volatile("s_waitcnt lgkmcnt(0)" ::: "memory")

DEV float wave_sum(float v) {
#pragma unroll
    for (int o = 32; o > 0; o >>= 1) v += __shfl_xor(v, o);
    return v;
}
DEV float wave_max(float v) {
#pragma unroll
    for (int o = 32; o > 0; o >>= 1) v = fmaxf(v, __shfl_xor(v, o));
    return v;
}
typedef float nf4 __attribute__((ext_vector_type(4)));
DEV float4 lds_ld4(const LAS float* p) { const nf4 v = *(const LAS nf4*)p; float4 r; r.x = v[0]; r.y = v[1]; r.z = v[2]; r.w = v[3]; return r; }
DEV float silu_f(float x) { return x / (1.f + expf(-x)); }


typedef unsigned short bf16_t;
typedef float f32x4 __attribute__((ext_vector_type(4)));
typedef float f32x16 __attribute__((ext_vector_type(16)));
typedef short bf16x8 __attribute__((ext_vector_type(8)));
typedef short s16x4 __attribute__((ext_vector_type(4)));
typedef unsigned u32x4 __attribute__((ext_vector_type(4)));
typedef unsigned u32x2 __attribute__((ext_vector_type(2)));

constexpr size_t MiB = 1u << 20;
constexpr size_t WS_W_IN = 0, WS_W_OUT = 6 * MiB, WS_W_Q = 8 * MiB, WS_W_KV = 10 * MiB, WS_W_O = 14 * MiB, WS_W_GU = 16 * MiB, WS_W_DOWN = 27 * MiB;
constexpr size_t WS_CTL = 33 * MiB, WS_DTV = 34 * MiB, WS_CDEC = 34 * MiB + 512 * 1024, WS_MN = 35 * MiB;
constexpr size_t WS_XN = 36 * MiB, WS_CAT = 68 * MiB, WS_QX = 68 * MiB, WS_Q = 100 * MiB, WS_K = 116 * MiB, WS_RAW = 100 * MiB;
constexpr size_t WS_ZX = 132 * MiB, WS_OX = 132 * MiB, WS_V = 180 * MiB, WS_ST = 196 * MiB, WS_HID = 132 * MiB, WS_KM = 228 * MiB, WS_VM = 229 * MiB, WS_SMP = 230 * MiB;
constexpr int MP = 16384;
constexpr int LDS_BYTES = 147456;

DEV unsigned f2bf(float f) { unsigned u = __builtin_bit_cast(unsigned, f); return (u + 0x7fffu + ((u >> 16) & 1u)) >> 16; }
DEV unsigned pk2(float lo, float hi) { return f2bf(lo) | (f2bf(hi) << 16); }
DEV float bflo(unsigned w) { return __builtin_bit_cast(float, w << 16); }
DEV float bfhi(unsigned w) { return __builtin_bit_cast(float, w & 0xffff0000u); }
DEV float fast_silu(float x) { return x * __builtin_amdgcn_rcpf(1.f + __builtin_amdgcn_exp2f(-1.4426950408889634f * x)); }

struct FP {
    const float* in[36];
    float* out;
    unsigned char* ws;
};

template <class RowMap>
DEV void transpose_item(const float* W, int K, int N, bf16_t* WT, int item, LAS float* scr, int lane, RowMap rm) {
    const int nblk = (N + 31) / 32, kb = item / nblk, nb = item % nblk, k0 = 64 * kb, n0 = 32 * nb;
    const int ncol = n0 + (lane & 31);
#pragma unroll 8
    for (int i = 0; i < 32; ++i) { const int kk = 2 * i + (lane >> 5); scr[kk * 33 + (lane & 31)] = (ncol < N) ? W[(size_t)(k0 + kk) * N + ncol] : 0.f; }
    WAVE_SYNC();
    const int c = lane & 7;
#pragma unroll
    for (int j = 0; j < 4; ++j) {
        const int n = (lane >> 3) + 8 * j; const LAS float* s = scr + (8 * c) * 33 + n;
        const int src = n0 + n; const int dst = (src < N) ? rm(src) : -1;
        u32x4 o; o.x = pk2(s[0 * 33], s[1 * 33]); o.y = pk2(s[2 * 33], s[3 * 33]); o.z = pk2(s[4 * 33], s[5 * 33]); o.w = pk2(s[6 * 33], s[7 * 33]);
        if (dst >= 0) *(u32x4*)(WT + (size_t)dst * K + k0 + 8 * c) = o;
    }
    WAVE_SYNC();
}
struct RmPlain { int off; __device__ __forceinline__ int operator()(int n) const { return off + n; } };
struct RmGU { int up; __device__ __forceinline__ int operator()(int n) const { return 32 * (n >> 4) + 16 * up + (n & 15); } };
struct RmIn {
    __device__ __forceinline__ int operator()(int n) const {
        if (n < 1536) return n;
        if (n < 1544) return -1;
        const int m = n - 1544;
        if (m < 1024) { const int u = m >> 6, d = m & 63; return 1536 + 64 * u + 32 * ((d & 31) >> 4) + 16 * (d >> 5) + (d & 15); }
        return 1536 + m;
    }
};

DEV void row_phase(const bf16_t* raw, const float* hin, const float* gpost, float* hout, const float* gpre, bf16_t* xn, int M, int gw, int ngw, int lane) {
    for (int r = gw; r < M; r += ngw) {
        f32x4 h[4];
#pragma unroll
        for (int j = 0; j < 4; ++j) h[j] = ((const f32x4*)(hin + (size_t)r * 1024))[lane + 64 * j];
        if (raw) {
            f32x4 v[4]; float ss = 0.f;
#pragma unroll
            for (int j = 0; j < 4; ++j) {
                const u32x2 w = ((const u32x2*)(raw + (size_t)r * 1024))[lane + 64 * j];
                v[j] = (f32x4){bflo(w.x), bfhi(w.x), bflo(w.y), bfhi(w.y)};
                ss += v[j].x * v[j].x + v[j].y * v[j].y + v[j].z * v[j].z + v[j].w * v[j].w;
            }
            const float rs = rsqrtf(wave_sum(ss) * (1.f / 1024.f) + 1e-6f);
#pragma unroll
            for (int j = 0; j < 4; ++j) { const f32x4 g = ((const f32x4*)gpost)[lane + 64 * j]; h[j] += v[j] * rs * g; }
        }
        if (hout) {
#pragma unroll
            for (int j = 0; j < 4; ++j) ((f32x4*)(hout + (size_t)r * 1024))[lane + 64 * j] = h[j];
        }
        if (gpre) {
            float ss = 0.f;
#pragma unroll
            for (int j = 0; j < 4; ++j) ss += h[j].x * h[j].x + h[j].y * h[j].y + h[j].z * h[j].z + h[j].w * h[j].w;
            const float rs = rsqrtf(wave_sum(ss) * (1.f / 1024.f) + 1e-6f);
#pragma unroll
            for (int j = 0; j < 4; ++j) {
                const f32x4 g = ((const f32x4*)gpre)[lane + 64 * j]; const f32x4 o = h[j] * rs * g;
                u32x2 w; w.x = pk2(o.x, o.y); w.y = pk2(o.z, o.w);
                ((u32x2*)(xn + (size_t)r * 1024))[lane + 64 * j] = w;
            }
        }
    }
}


#define RLX_AGENT __ATOMIC_RELAXED, __HIP_MEMORY_SCOPE_AGENT
#define LDS_WAIT() asm volatile("s_waitcnt lgkmcnt(0)" ::: "memory")
#define VM_WAIT() asm volatile("s_waitcnt vmcnt(0)" ::: "memory")
__device__ __forceinline__ unsigned long long rt() { return __builtin_amdgcn_s_memrealtime(); }
#define XB_TMO      128
#define XB_XCNT(j)  (256  + 64 * (j))
#define XB_XSUB(j)  (1280 + 64 * (j))
#define XB_XGEN(j)  (2304 + 64 * (j))
#define XB_TOP      3328
#define XB_TOPGEN   3392
#define XCD_BAR_WORDS 3456
#define XB_SPIN_CAP (1u << 18)

__device__ __forceinline__ unsigned xb_ld(unsigned* p)              { return __hip_atomic_load(p, __ATOMIC_RELAXED, __HIP_MEMORY_SCOPE_AGENT); }
__device__ __forceinline__ unsigned xb_add(unsigned* p, unsigned v) { return __hip_atomic_fetch_add(p, v, __ATOMIC_RELAXED, __HIP_MEMORY_SCOPE_AGENT); }
__device__ __forceinline__ unsigned xb_xcc_id() { return (unsigned)__builtin_amdgcn_s_getreg((3 << 11) | 20) & 0xFu; }
#define XB_SPIN(cond, bar) do { unsigned _sp = 0; while (cond) { __builtin_amdgcn_s_sleep(1); \
    if ((++_sp & 255u) == 0u) { if (xb_ld(&(bar)[XB_TMO])) break; if (_sp > XB_SPIN_CAP) { atomicAdd(&(bar)[XB_TMO], 1u); break; } } } } while (0)

struct XcdBarrier {
    unsigned* bar; unsigned x; unsigned total;
    volatile LAS unsigned* st;
};

__device__ __forceinline__ XcdBarrier xcd_barrier_post(unsigned* bar, volatile LAS unsigned* st, unsigned total = 0u) {
    XcdBarrier b; b.bar = bar; b.x = xb_xcc_id(); b.st = st; b.total = total;
    if (threadIdx.x == 0) (void)xb_add(&bar[XB_XCNT(b.x)], 1u);
    return b;
}
__device__ __forceinline__ void xcd_barrier_complete(unsigned* bar, unsigned x, unsigned& nloc, unsigned& nx, unsigned total) {
    const unsigned G = total ? total : gridDim.x * gridDim.y * gridDim.z;
    unsigned sum, cnt, mine, sp = 0u;
    for (;;) {
        sum = 0u; cnt = 0u; mine = 0u;
#pragma unroll
        for (unsigned j = 0; j < 16; ++j) { const unsigned c = xb_ld(&bar[XB_XCNT(j)]); sum += c; cnt += (c > 0u) ? 1u : 0u; mine = (j == x) ? c : mine; }
        if (sum == G) break;
        __builtin_amdgcn_s_sleep(1);
        if ((++sp & 255u) == 0u) { if (xb_ld(&bar[XB_TMO])) break; if (sp > XB_SPIN_CAP) { atomicAdd(&bar[XB_TMO], 1u); break; } }
    }
    nloc = mine > 0u ? mine : 1u; nx = cnt > 0u ? cnt : 1u;
}

__device__ __forceinline__ void xcd_barrier(const XcdBarrier& b) {
    asm volatile("s_waitcnt vmcnt(0)" ::: "memory");
    __syncthreads();
    if (threadIdx.x == 0) {
        unsigned* bar = b.bar;
        __builtin_amdgcn_s_waitcnt(0);
        unsigned nloc = b.st[0], nx = b.st[1];
        if (nloc == 0u) { xcd_barrier_complete(bar, b.x, nloc, nx, b.total); b.st[0] = nloc; b.st[1] = nx; }
        const unsigned old = xb_add(&bar[XB_XSUB(b.x)], 1u);
        const unsigned gen = old / nloc;
        if (old + 1u == (gen + 1u) * nloc) {
            __builtin_amdgcn_fence(__ATOMIC_RELEASE, "agent");
            asm volatile("s_waitcnt vmcnt(0)" ::: "memory");
            const unsigned og = xb_add(&bar[XB_TOP], 1u);
            const unsigned tg = og / nx;
            if (og + 1u == (tg + 1u) * nx) xb_add(&bar[XB_TOPGEN], 1u);
            else XB_SPIN(xb_ld(&bar[XB_TOPGEN]) == tg, bar);
            __builtin_amdgcn_fence(__ATOMIC_ACQUIRE, "agent");
            xb_add(&bar[XB_XGEN(b.x)], 1u);
            asm volatile("s_waitcnt vmcnt(0)" ::: "memory");
        } else {
            XB_SPIN(xb_ld(&bar[XB_XGEN(b.x)]) == gen, bar);
            __builtin_amdgcn_fence(__ATOMIC_ACQUIRE, "agent");
            asm volatile("s_waitcnt vmcnt(0)" ::: "memory");
        }
    }
    __syncthreads();
}
namespace pg8 {
#define PG8_LAS __attribute__((address_space(3)))
typedef unsigned short bf16_t;
typedef short bf16x8 __attribute__((ext_vector_type(8)));
typedef float f32x4 __attribute__((ext_vector_type(4)));
typedef unsigned u32x4 __attribute__((ext_vector_type(4)));
constexpr int BM = 256, BK = 64, HALF = 128, HTB = HALF * BK * 2  , STAGE_BYTES = 8 * HTB, NXCD = 8, WGM = 8;

__host__ __device__ __forceinline__ int lds_byte(int r, int c) { const int st = (r >> 4) * 2 + (c >> 5), rr = r & 15, cc = c & 31, ob = rr * 64 + cc * 2; return st * 1024 + (ob ^ (((ob >> 9) & 1) << 5)); }
__host__ __device__ __forceinline__ void stage_rc(int b, int& R, int& C) { const int st = b / 1024, sb = b % 1024, swz = sb ^ (((sb >> 9) & 1) << 5); R = (st >> 1) * 16 + swz / 64; C = (st & 1) * 32 + (swz % 64) / 2; }
__host__ __device__ __forceinline__ int perm32(int rho) { const int n = rho >> 4, i = rho & 15; return 8 * (i >> 2) + 4 * n + (i & 3); }

struct Unit { int pm, pn; };
struct Gemm { const bf16_t* A; const bf16_t* Bt; int M, N, K; };

struct StaticOrder {
    int nM, nN, nwg, G, c;
    __host__ __device__ void init(int M, int N, int G_, int c_) { nM = M / BM; nN = N / BM; nwg = nM * nN; G = G_; c = c_; }
    __host__ __device__ bool next(int i, Unit& u) const {
        const long L = (long)i * G + c; if (L >= nwg) return false;
        int wgid = (int)L; { const int q = nwg / NXCD, r = nwg % NXCD, xcd = wgid % NXCD, off = wgid / NXCD; wgid = (xcd < r ? xcd * (q + 1) : r * (q + 1) + (xcd - r) * q) + off; }
        const int nig = WGM * nN, gid = wgid / nig, fm = gid * WGM, gsz = (nM - fm) < WGM ? (nM - fm) : WGM;
        u.pm = fm + ((wgid % nig) % gsz); u.pn = (wgid % nig) / gsz; return true;
    }
    __device__ __forceinline__ void a_ready(const Unit&) const {}
    __device__ __forceinline__ void done(const Unit&) const {}
};

__device__ __forceinline__ unsigned cvt_pk_bf16(float lo, float hi) { unsigned r; asm volatile("v_cvt_pk_bf16_f32 %0, %1, %2" : "=v"(r) : "v"(lo), "v"(hi)); return r; }
typedef float f32x2 __attribute__((ext_vector_type(2)));
__device__ __forceinline__ f32x2 gelu_pk(f32x2 v) {
    const f32x2 av = __builtin_elementwise_abs(v), d = av * 0.2316418882f + 1.0f;
    f32x2 t; t.x = __builtin_amdgcn_rcpf(d.x); t.y = __builtin_amdgcn_rcpf(d.y);
    f32x2 q = t * 0.5307027145f + (-0.7265760135f); q = q * t + 0.7107068705f; q = q * t + (-0.142248368f); q = q * t + 0.127414796f; q = q * t;
    const f32x2 s = (v * v) * (-0.72134752044f);
    f32x2 e; e.x = __builtin_amdgcn_exp2f(s.x); e.y = __builtin_amdgcn_exp2f(s.y);
    const f32x2 m = v * (q * e), r = v - m;
    f32x2 o; o.x = v.x < 0.f ? m.x : r.x; o.y = v.y < 0.f ? m.y : r.y; return o;
}

template <int ACT  > struct EpiBf16 {
    static constexpr bool PERM = true, AFTER_DRAIN = false; static_assert(ACT == 0 || ACT == 1, "EpiBf16: ACT is 0 (none) or 1 (gelu_pk)");
    bf16_t* O; int ldc; const float* bias; int split_cols; size_t split_stride; float scale0;
    __device__ __forceinline__ void operator()(const f32x4 (&acc)[2][2][4][2], const Unit& u, int wr, int wc, int fr, int fq) const {
        const int row0 = u.pm * BM + wr * 64 + fr; int colt = u.pn * BM; bf16_t* base = O;
        float sc = 1.f; if (split_cols) { const int t = colt / split_cols; base += (size_t)t * split_stride; colt -= t * split_cols; if (t == 0) sc = scale0; }
        const int col0 = colt + wc * 32 + 8 * fq, bcol0 = u.pn * BM + wc * 32 + 8 * fq;
        f32x4 bv[2][2];
#pragma unroll
        for (int bj = 0; bj < 2; ++bj)
#pragma unroll
            for (int n = 0; n < 2; ++n) bv[bj][n] = bias ? *(const f32x4*)(bias + bcol0 + bj * HALF + 4 * n) : (f32x4){0.f, 0.f, 0.f, 0.f};
#pragma unroll
        for (int ai = 0; ai < 2; ++ai)
#pragma unroll
            for (int m = 0; m < 4; ++m) { bf16_t* rowp = base + (size_t)(row0 + ai * HALF + m * 16) * ldc + col0;
#pragma unroll
                for (int bj = 0; bj < 2; ++bj) { f32x4 v0 = acc[ai][bj][m][0] + bv[bj][0], v1 = acc[ai][bj][m][1] + bv[bj][1];
                    if (ACT == 1) { f32x2 a = gelu_pk((f32x2){v0[0], v0[1]}), b = gelu_pk((f32x2){v0[2], v0[3]}), c = gelu_pk((f32x2){v1[0], v1[1]}), d = gelu_pk((f32x2){v1[2], v1[3]});
                        v0 = (f32x4){a.x, a.y, b.x, b.y}; v1 = (f32x4){c.x, c.y, d.x, d.y}; }
                    v0 = v0 * sc; v1 = v1 * sc; u32x4 w; w.x = cvt_pk_bf16(v0[0], v0[1]); w.y = cvt_pk_bf16(v0[2], v0[3]); w.z = cvt_pk_bf16(v1[0], v1[1]); w.w = cvt_pk_bf16(v1[2], v1[3]);
                    *(u32x4*)(rowp + bj * HALF) = w; } }
    }
};
template <class Epi, class Sched, bool ALIGN_EPI = false, bool SP2 = false>
__device__ __forceinline__ void gemm_phase(PG8_LAS unsigned char* lds, const Gemm g, const Sched& S, const Epi& E) {
    int tid_l = threadIdx.x; asm volatile("" : "+v"(tid_l));
    const int tid = tid_l, wid = __builtin_amdgcn_readfirstlane(tid >> 6), lane = tid & 63, wr = wid >> 2, wc = wid & 3, fr = lane & 15, fq = lane >> 4;
    const int K = g.K, nt = K / BK;
    unsigned voffA[2], voffB[2];
#pragma unroll
    for (int i = 0; i < 2; ++i) { int R, C; stage_rc(tid * 16 + i * 8192, R, C); const int Rb = Epi::PERM ? ((R & ~31) + perm32(R & 31)) : R;
        voffA[i] = (unsigned)(R * K + C) * 2u; voffB[i] = (unsigned)(Rb * K + C) * 2u; }
    const size_t kstep = (size_t)(BK * 2);
    const size_t hstep = (size_t)HALF * K * 2;
    const size_t tstep = 2 * hstep;
    const unsigned ldsw = (unsigned)wid * 1024u;
    const int aoff = lds_byte(wr * 64 + fr, fq * 8), boff = lds_byte(wc * 32 + fr, fq * 8);
#define PG8_SA(b, h) (((b) * 2 + (h)) * HTB)
#define PG8_SB(b, h) ((4 + (b) * 2 + (h)) * HTB)
#define PG8_STAGE(bufoff, gbase, voff) do { _Pragma("unroll") for (int _i = 0; _i < 2; ++_i) \
        __builtin_amdgcn_global_load_lds((const unsigned*)((const char*)(gbase) + (voff)[_i]), (PG8_LAS unsigned*)(lds + (bufoff) + ldsw + _i * 8192), 16, 0, 0); } while (0)
#define PG8_LDA(dst, b, h) do { _Pragma("unroll") for (int m = 0; m < 4; ++m) _Pragma("unroll") for (int k = 0; k < 2; ++k) dst[m][k] = *(const PG8_LAS bf16x8*)(lds + PG8_SA(b, h) + aoff + m * 2048 + k * 1024); } while (0)
#define PG8_LDB(dst, b, h) do { _Pragma("unroll") for (int n = 0; n < 2; ++n) _Pragma("unroll") for (int k = 0; k < 2; ++k) dst[n][k] = *(const PG8_LAS bf16x8*)(lds + PG8_SB(b, h) + boff + n * 2048 + k * 1024); } while (0)
#define PG8_MMA(ai, bj, At, Bt) do { __builtin_amdgcn_s_setprio(1); _Pragma("unroll") for (int m = 0; m < 4; ++m) _Pragma("unroll") for (int n = 0; n < 2; ++n) _Pragma("unroll") for (int k = 0; k < 2; ++k) \
        acc[ai][bj][m][n] = __builtin_amdgcn_mfma_f32_16x16x32_bf16(Bt[n][k], At[m][k], acc[ai][bj][m][n], 0, 0, 0); __builtin_amdgcn_s_setprio(0); } while (0)
#define PG8_WAIT_V(n) asm volatile("s_waitcnt vmcnt(" #n ")" ::: "memory")
#define PG8_WAIT_L(n) asm volatile("s_waitcnt lgkmcnt(" #n ")" ::: "memory")
#define PG8_BAR __builtin_amdgcn_s_barrier()
#define PG8_SCHED __builtin_amdgcn_sched_barrier(0)
    Unit cur, nxt; int ui = 0;
    if (!S.next(0, cur)) return;
    f32x4 acc[2][2][4][2];
#pragma unroll
    for (int a = 0; a < 2; ++a)
#pragma unroll
        for (int b = 0; b < 2; ++b)
#pragma unroll
            for (int m = 0; m < 4; ++m)
#pragma unroll
                for (int n = 0; n < 2; ++n) acc[a][b][m][n] = (f32x4){0.f, 0.f, 0.f, 0.f};
    bf16x8 At[4][2], B0[2][2], B1[2][2];
    const char* cA = (const char*)g.A + (size_t)cur.pm * tstep; const char* cB = (const char*)g.Bt + (size_t)cur.pn * tstep;
    S.a_ready(cur);
    if constexpr (SP2) {
        PG8_STAGE(PG8_SB(0, 0), cB, voffB); PG8_STAGE(PG8_SB(0, 1), cB + hstep, voffB); PG8_STAGE(PG8_SA(0, 0), cA, voffA); PG8_STAGE(PG8_SA(0, 1), cA + hstep, voffA);
        if (wr == 1) PG8_BAR;
        PG8_WAIT_V(2); PG8_BAR;
        PG8_STAGE(PG8_SB(1, 0), cB + kstep, voffB); PG8_STAGE(PG8_SA(1, 0), cA + kstep, voffA); PG8_STAGE(PG8_SB(1, 1), cB + hstep + kstep, voffB);
        PG8_WAIT_V(6); PG8_BAR;
    } else {
        PG8_STAGE(PG8_SB(0, 0), cB, voffB); PG8_STAGE(PG8_SA(0, 0), cA, voffA); PG8_STAGE(PG8_SB(0, 1), cB + hstep, voffB); PG8_STAGE(PG8_SA(0, 1), cA + hstep, voffA);
        if (wr == 1) PG8_BAR;
        PG8_WAIT_V(4); PG8_BAR;
        PG8_STAGE(PG8_SB(1, 0), cB + kstep, voffB); PG8_STAGE(PG8_SA(1, 0), cA + kstep, voffA); PG8_STAGE(PG8_SB(1, 1), cB + hstep + kstep, voffB);
        PG8_WAIT_V(6); PG8_BAR;
    }
    for (;;) {
        const bool has_next = S.next(ui + 1, nxt);
        const char* nA = has_next ? (const char*)g.A + (size_t)nxt.pm * tstep : cA; const char* nB = has_next ? (const char*)g.Bt + (size_t)nxt.pn * tstep : cB;
        for (int t = 0; t < nt; t += 2) {
            const bool last = (t == nt - 2);
            const char* a1 = cA + (size_t)(t + 1) * kstep;
            const char* a2 = last ? nA : cA + (size_t)(t + 2) * kstep; const char* b2 = last ? nB : cB + (size_t)(t + 2) * kstep;
            const char* a3 = a2 + kstep; const char* b3 = b2 + kstep;
            if (last && has_next) S.a_ready(nxt);
            if constexpr (SP2) {
            PG8_LDB(B0, 0, 0); PG8_LDB(B1, 0, 1); PG8_SCHED; PG8_LDA(At, 0, 0); PG8_STAGE(PG8_SA(1, 1), a1 + hstep, voffA);
            PG8_WAIT_V(8); PG8_WAIT_L(0); PG8_BAR; PG8_MMA(0, 0, At, B0); PG8_MMA(0, 1, At, B1); PG8_BAR; PG8_SCHED;
            PG8_LDA(At, 0, 1); PG8_STAGE(PG8_SB(0, 0), b2, voffB); PG8_STAGE(PG8_SB(0, 1), b2 + hstep, voffB); PG8_STAGE(PG8_SA(0, 0), a2, voffA);
            PG8_WAIT_V(8); PG8_WAIT_L(0); PG8_BAR; PG8_MMA(1, 0, At, B0); PG8_MMA(1, 1, At, B1); PG8_BAR; PG8_SCHED;
            PG8_LDB(B0, 1, 0); PG8_LDB(B1, 1, 1); PG8_SCHED; PG8_LDA(At, 1, 0); PG8_STAGE(PG8_SA(0, 1), a2 + hstep, voffA);
            PG8_WAIT_V(8); PG8_WAIT_L(0); PG8_BAR; PG8_MMA(0, 0, At, B0); PG8_MMA(0, 1, At, B1); PG8_BAR; PG8_SCHED;
            PG8_LDA(At, 1, 1); PG8_STAGE(PG8_SB(1, 0), b3, voffB); PG8_STAGE(PG8_SB(1, 1), b3 + hstep, voffB); PG8_STAGE(PG8_SA(1, 0), a3, voffA);
            PG8_WAIT_V(8); PG8_WAIT_L(0); PG8_BAR; PG8_MMA(1, 0, At, B0); PG8_MMA(1, 1, At, B1); PG8_BAR; PG8_SCHED;
            } else {
            PG8_LDB(B0, 0, 0); PG8_SCHED; PG8_LDA(At, 0, 0); PG8_STAGE(PG8_SA(1, 1), a1 + hstep, voffA);
            PG8_WAIT_L(8); PG8_BAR; PG8_WAIT_L(0); PG8_MMA(0, 0, At, B0); PG8_BAR; PG8_SCHED;
            PG8_LDB(B1, 0, 1); PG8_STAGE(PG8_SB(0, 0), b2, voffB);
            PG8_BAR; PG8_WAIT_L(0); PG8_MMA(0, 1, At, B1); PG8_BAR;
            PG8_LDA(At, 0, 1); PG8_STAGE(PG8_SA(0, 0), a2, voffA);
            PG8_BAR; PG8_WAIT_L(0); PG8_MMA(1, 0, At, B0); PG8_BAR; PG8_SCHED;
            PG8_STAGE(PG8_SB(0, 1), b2 + hstep, voffB);
            PG8_WAIT_V(6); PG8_BAR; PG8_MMA(1, 1, At, B1); PG8_BAR;
            PG8_LDB(B0, 1, 0); PG8_SCHED; PG8_LDA(At, 1, 0); PG8_STAGE(PG8_SA(0, 1), a2 + hstep, voffA);
            PG8_WAIT_L(8); PG8_BAR; PG8_WAIT_L(0); PG8_MMA(0, 0, At, B0); PG8_BAR; PG8_SCHED;
            PG8_LDB(B1, 1, 1); PG8_STAGE(PG8_SB(1, 0), b3, voffB);
            PG8_BAR; PG8_WAIT_L(0); PG8_MMA(0, 1, At, B1); PG8_BAR;
            PG8_LDA(At, 1, 1); PG8_STAGE(PG8_SA(1, 0), a3, voffA);
            PG8_BAR; PG8_WAIT_L(0); PG8_MMA(1, 0, At, B0); PG8_BAR; PG8_SCHED;
            PG8_STAGE(PG8_SB(1, 1), b3 + hstep, voffB);
            PG8_WAIT_V(6); PG8_BAR; PG8_MMA(1, 1, At, B1); PG8_BAR;
            }
        }
        if constexpr (ALIGN_EPI) { if (wr == 0) PG8_BAR; }
        if constexpr (!Epi::AFTER_DRAIN) { E(acc, cur, wr, wc, fr, fq); S.done(cur); }
        if (!has_next) break;
#pragma unroll
        for (int a = 0; a < 2; ++a)
#pragma unroll
            for (int b = 0; b < 2; ++b)
#pragma unroll
                for (int m = 0; m < 4; ++m)
#pragma unroll
                    for (int n = 0; n < 2; ++n) acc[a][b][m][n] = (f32x4){0.f, 0.f, 0.f, 0.f};
        cur = nxt; cA = nA; cB = nB; ++ui;
        if constexpr (ALIGN_EPI) { if (wr == 1) PG8_BAR; }
    }
    PG8_WAIT_V(0);
    if constexpr (!ALIGN_EPI) { if (wr == 0) PG8_BAR; }
    PG8_BAR;
    if constexpr (Epi::AFTER_DRAIN) { E.fused(acc, cur, wr, wc, fr, fq, lds, wid, lane); S.done(cur); }
#undef PG8_SA
#undef PG8_SB
#undef PG8_STAGE
#undef PG8_LDA
#undef PG8_LDB
#undef PG8_MMA
#undef PG8_WAIT_V
#undef PG8_WAIT_L
#undef PG8_BAR
#undef PG8_SCHED
}
}

namespace pg8 {
struct EpiSwiglu {
    static constexpr bool PERM = false, AFTER_DRAIN = false;
    bf16_t* O; int ldo;
    __device__ __forceinline__ void operator()(const f32x4 (&acc)[2][2][4][2], const Unit& u, int wr, int wc, int fr, int fq) const {
        const int row0 = u.pm * BM + wr * 64 + fr;
#pragma unroll
        for (int ai = 0; ai < 2; ++ai)
#pragma unroll
            for (int m = 0; m < 4; ++m) {
                bf16_t* rowp = O + (size_t)(row0 + ai * HALF + m * 16) * ldo;
#pragma unroll
                for (int bj = 0; bj < 2; ++bj) {
                    const int grp = u.pn * 8 + bj * 4 + wc;
                    const f32x4 g = acc[ai][bj][m][0], up = acc[ai][bj][m][1];
                    const float h0 = fast_silu(g[0]) * up[0], h1 = fast_silu(g[1]) * up[1], h2 = fast_silu(g[2]) * up[2], h3 = fast_silu(g[3]) * up[3];
                    u32x2 w; w.x = cvt_pk_bf16(h0, h1); w.y = cvt_pk_bf16(h2, h3);
                    *(u32x2*)(rowp + grp * 16 + 4 * fq) = w;
                }
            }
    }
};
}

DEV void phase_prep_ffn(const FP& p, LAS unsigned char* lds, int gw, int ngw, int wave, int lane) {
    LAS float* scr = (LAS float*)(lds + wave * 16384);
    const float *wg = p.in[33], *wu = p.in[34], *wd = p.in[35];
    bf16_t* GU = (bf16_t*)(p.ws + WS_W_GU); bf16_t* DN = (bf16_t*)(p.ws + WS_W_DOWN);
    constexpr int I_G = 16 * 88, I_D = 44 * 32;
    for (int it = gw; it < 2 * I_G + I_D; it += ngw) {
        int r = it;
        if (r < I_G) { transpose_item(wg, 1024, 2816, GU, r, scr, lane, RmGU{0}); continue; } r -= I_G;
        if (r < I_G) { transpose_item(wu, 1024, 2816, GU, r, scr, lane, RmGU{1}); continue; } r -= I_G;
        transpose_item(wd, 2816, 1024, DN, r, scr, lane, RmPlain{0});
    }
}
DEV void phase_ffn_gu(const FP& p, LAS unsigned char* lds, int G, int bid) {
    pg8::Gemm g{(const bf16_t*)(p.ws + WS_XN), (const bf16_t*)(p.ws + WS_W_GU), MP, 5632, 1024};
    pg8::StaticOrder S; S.init(MP, 5632, G, bid);
    pg8::EpiSwiglu E{(bf16_t*)(p.ws + WS_HID), 2816};
    pg8::gemm_phase<pg8::EpiSwiglu, pg8::StaticOrder, true, true>(lds, g, S, E);
}
DEV void phase_ffn_down(const FP& p, LAS unsigned char* lds, int G, int bid) {
    pg8::Gemm g{(const bf16_t*)(p.ws + WS_HID), (const bf16_t*)(p.ws + WS_W_DOWN), MP, 1024, 2816};
    pg8::StaticOrder S; S.init(MP, 1024, G, bid);
    pg8::EpiBf16<0> E{(bf16_t*)(p.ws + WS_RAW), 1024, nullptr, 0, 0, 1.f};
    pg8::gemm_phase<pg8::EpiBf16<0>, pg8::StaticOrder, true, true>(lds, g, S, E);
}

typedef short v4i16_t __attribute__((ext_vector_type(4)));
typedef float f32x2_t __attribute__((ext_vector_type(2)));
typedef __bf16 bf16x2_t __attribute__((ext_vector_type(2)));
DEV unsigned cvtpk(float lo, float hi) { f32x2_t v = {lo, hi}; bf16x2_t b = __builtin_convertvector(v, bf16x2_t); return __builtin_bit_cast(unsigned, b); }
DEV f32x16 mfma32(bf16x8 a, bf16x8 b, f32x16 c) { return __builtin_amdgcn_mfma_f32_32x32x16_bf16(a, b, c, 0, 0, 0); }
DEV s16x4 tr_read(LAS const unsigned char* p) { return __builtin_bit_cast(s16x4, __builtin_amdgcn_ds_read_tr16_b64_v4i16((LAS v4i16_t*)p)); }
DEV bf16x8 cat8(s16x4 lo, s16x4 hi) { return (bf16x8){lo[0], lo[1], lo[2], lo[3], hi[0], hi[1], hi[2], hi[3]}; }
DEV float half_max(float v) { auto rr = __builtin_amdgcn_permlane32_swap(__float_as_uint(v), __float_as_uint(v), false, false); return fmaxf(__uint_as_float(rr[0]), __uint_as_float(rr[1])); }
DEV float half_sum(float v) { auto rr = __builtin_amdgcn_permlane32_swap(__float_as_uint(v), __float_as_uint(v), false, false); return __uint_as_float(rr[0]) + __uint_as_float(rr[1]); }
DEV bf16x8 pfrag(const f32x16& S, int s) {
    u32x4 w;
    if (s == 0) { w.x = cvtpk(S[0], S[1]); w.y = cvtpk(S[2], S[3]); w.z = cvtpk(S[4], S[5]); w.w = cvtpk(S[6], S[7]); }
    else { w.x = cvtpk(S[8], S[9]); w.y = cvtpk(S[10], S[11]); w.z = cvtpk(S[12], S[13]); w.w = cvtpk(S[14], S[15]); }
    return __builtin_bit_cast(bf16x8, w);
}
DEV float max16(const f32x16& S) {
    float a = fmaxf(fmaxf(S[0], S[1]), fmaxf(S[2], S[3])), b = fmaxf(fmaxf(S[4], S[5]), fmaxf(S[6], S[7]));
    float c = fmaxf(fmaxf(S[8], S[9]), fmaxf(S[10], S[11])), d = fmaxf(fmaxf(S[12], S[13]), fmaxf(S[14], S[15]));
    return fmaxf(fmaxf(a, b), fmaxf(c, d));
}

namespace pg8 {
struct EpiMemKV {
    static constexpr bool PERM = false, AFTER_DRAIN = false;
    float* ok; float* ov; bf16_t* bk; bf16_t* bv;
    __device__ __forceinline__ void operator()(const f32x4 (&acc)[2][2][4][2], const Unit& u, int wr, int wc, int fr, int fq) const {
        const int row0 = u.pm * BM + wr * 64 + fr; const bool isv = u.pn >= 4; const int colt = (u.pn & 3) * BM + wc * 32 + 4 * fq;
        float* of = isv ? ov : ok; bf16_t* ob = isv ? bv : bk;
#pragma unroll
        for (int ai = 0; ai < 2; ++ai)
#pragma unroll
            for (int m = 0; m < 4; ++m) {
                const size_t ro = (size_t)(row0 + ai * HALF + m * 16) * 1024;
#pragma unroll
                for (int bj = 0; bj < 2; ++bj)
#pragma unroll
                    for (int n = 0; n < 2; ++n) {
                        const f32x4 v = acc[ai][bj][m][n]; const int col = colt + bj * HALF + n * 16;
                        *(f32x4*)(of + ro + col) = v;
                        u32x2 w; w.x = cvt_pk_bf16(v[0], v[1]); w.y = cvt_pk_bf16(v[2], v[3]);
                        *(u32x2*)(ob + ro + col) = w;
                    }
            }
    }
};
}

DEV void phase_prep_x(const FP& p, LAS unsigned char* lds, int gw, int ngw, int wave, int lane) {
    LAS float* scr = (LAS float*)(lds + wave * 16384);
    constexpr int I_S = 16 * 32;
    for (int it = gw; it < 4 * I_S; it += ngw) {
        int r = it;
        if (r < I_S) { transpose_item(p.in[23], 1024, 1024, (bf16_t*)(p.ws + WS_W_Q), r, scr, lane, RmPlain{0}); continue; } r -= I_S;
        if (r < I_S) { transpose_item(p.in[24], 1024, 1024, (bf16_t*)(p.ws + WS_W_KV), r, scr, lane, RmPlain{0}); continue; } r -= I_S;
        if (r < I_S) { transpose_item(p.in[25], 1024, 1024, (bf16_t*)(p.ws + WS_W_KV), r, scr, lane, RmPlain{1024}); continue; } r -= I_S;
        transpose_item(p.in[26], 1024, 1024, (bf16_t*)(p.ws + WS_W_O), r, scr, lane, RmPlain{0});
    }
    row_phase(nullptr, p.in[8], nullptr, nullptr, p.in[22], (bf16_t*)(p.ws + WS_MN), 512, gw, ngw, lane);
}
DEV void phase_memkv(const FP& p, LAS unsigned char* lds, int G, int bid) {
    pg8::Gemm g{(const bf16_t*)(p.ws + WS_MN), (const bf16_t*)(p.ws + WS_W_KV), 512, 2048, 1024};
    pg8::StaticOrder S; S.init(512, 2048, G, bid);
    pg8::EpiMemKV E{p.out + 33822720, p.out + 34347008, (bf16_t*)(p.ws + WS_KM), (bf16_t*)(p.ws + WS_VM)};
    pg8::gemm_phase<pg8::EpiMemKV, pg8::StaticOrder, true, true>(lds, g, S, E);
}
namespace pg8 { struct OneUnit { int pm, pn;
    __device__ __forceinline__ bool next(int i, Unit& u) const { if (i) return false; u.pm = pm; u.pn = pn; return true; }
    __device__ __forceinline__ void a_ready(const Unit&) const {}
    __device__ __forceinline__ void done(const Unit&) const {} }; }
DEV void memkv_unit(const FP& p, LAS unsigned char* lds, int idx) {
    pg8::Gemm g{(const bf16_t*)(p.ws + WS_MN), (const bf16_t*)(p.ws + WS_W_KV), 512, 2048, 1024};
    pg8::OneUnit S{idx >> 3, idx & 7};
    pg8::EpiMemKV E{p.out + 33822720, p.out + 34347008, (bf16_t*)(p.ws + WS_KM), (bf16_t*)(p.ws + WS_VM)};
    pg8::gemm_phase<pg8::EpiMemKV, pg8::OneUnit, true, true>(lds, g, S, E);
}
DEV void phase_wq(const FP& p, LAS unsigned char* lds, int G, int bid) {
    pg8::Gemm g{(const bf16_t*)(p.ws + WS_XN), (const bf16_t*)(p.ws + WS_W_Q), MP, 1024, 1024};
    pg8::StaticOrder S; S.init(MP, 1024, G, bid);
    pg8::EpiBf16<0> E{(bf16_t*)(p.ws + WS_QX), 1024, nullptr, 1024, 0, 0.0625f * 1.4426950408889634f};
    pg8::gemm_phase<pg8::EpiBf16<0>, pg8::StaticOrder, true, true>(lds, g, S, E);
}
DEV void phase_wo(const FP& p, LAS unsigned char* lds, int G, int bid) {
    pg8::Gemm g{(const bf16_t*)(p.ws + WS_OX), (const bf16_t*)(p.ws + WS_W_O), MP, 1024, 1024};
    pg8::StaticOrder S; S.init(MP, 1024, G, bid);
    pg8::EpiBf16<0> E{(bf16_t*)(p.ws + WS_RAW), 1024, nullptr, 0, 0, 1.f};
    pg8::gemm_phase<pg8::EpiBf16<0>, pg8::StaticOrder, true, true>(lds, g, S, E);
}

DEV void phase_xattn(const FP& p, LAS unsigned char* lds, int G, int bid) {
    const int tid = threadIdx.x, lane = tid & 63, wave = __builtin_amdgcn_readfirstlane(tid >> 6), r = lane & 31, hh = lane >> 5, qb = wave & 3, eh = wave >> 2;
    const bf16_t* QX = (const bf16_t*)(p.ws + WS_QX); const bf16_t* KM = (const bf16_t*)(p.ws + WS_KM); const bf16_t* VM = (const bf16_t*)(p.ws + WS_VM);
    bf16_t* OX = (bf16_t*)(p.ws + WS_OX);
    constexpr int QOFF = 0, KOFF = 65536, VOFF = 98304;
    const int vlane = (4 * hh + ((lane & 15) >> 2)) * 64 + 32 * ((lane >> 4) & 1) + 8 * (lane & 3);
    for (int u = bid; u < 512; u += G) {
        const int bh = u & 7, b = bh >> 2, h = bh & 3, qblk = u >> 3;
        const size_t qrow0 = (size_t)b * 8192 + (size_t)qblk * 128;
#pragma unroll
        for (int j = 0; j < 8; ++j) {
            const int id = tid + 512 * j, row = id >> 5, ch = id & 31;
            const u32x4 v = *(const u32x4*)(QX + (qrow0 + row) * 1024 + h * 256 + ch * 8);
            *(LAS u32x4*)(lds + QOFF + row * 512 + ((ch ^ (row & 15)) << 4)) = v;
        }
        u32x4 kr[2], vr[2];
#pragma unroll
        for (int j = 0; j < 2; ++j) {
            const int id = tid + 512 * j, key = id >> 5, ch = id & 31;
            kr[j] = *(const u32x4*)(KM + ((size_t)b * 256 + key) * 1024 + h * 256 + ch * 8);
            vr[j] = *(const u32x4*)(VM + ((size_t)b * 256 + key) * 1024 + h * 256 + ch * 8);
        }
#pragma unroll
        for (int j = 0; j < 2; ++j) {
            const int id = tid + 512 * j, key = id >> 5, ch = id & 31;
            *(LAS u32x4*)(lds + KOFF + key * 512 + ((ch ^ (key & 15)) << 4)) = kr[j];
            *(LAS u32x4*)(lds + VOFF + (ch >> 2) * 2048 + key * 64 + (ch & 3) * 16) = vr[j];
        }
        __syncthreads();
        f32x16 O[4];
#pragma unroll
        for (int e = 0; e < 4; ++e)
#pragma unroll
            for (int i = 0; i < 16; ++i) O[e][i] = 0.f;
        float mrun = -1e30f, lsum = 0.f;
        const LAS unsigned char* qp = lds + QOFF + (32 * qb + r) * 512;
        for (int t = 0; t < 8; ++t) {
            const int buf = t & 1;
            if (t + 1 < 8) {
#pragma unroll
                for (int j = 0; j < 2; ++j) {
                    const int id = tid + 512 * j, key = id >> 5, ch = id & 31;
                    kr[j] = *(const u32x4*)(KM + ((size_t)b * 256 + 32 * (t + 1) + key) * 1024 + h * 256 + ch * 8);
                    vr[j] = *(const u32x4*)(VM + ((size_t)b * 256 + 32 * (t + 1) + key) * 1024 + h * 256 + ch * 8);
                }
            }
            const LAS unsigned char* kp = lds + KOFF + buf * 16384 + r * 512;
            const LAS unsigned char* vp = lds + VOFF + buf * 16384 + (4 * eh) * 2048 + vlane;
            f32x16 S;
#pragma unroll
            for (int i = 0; i < 16; ++i) S[i] = 0.f;
#pragma unroll 4
            for (int ks = 0; ks < 16; ++ks) {
                const int sl = ((2 * ks + hh) ^ (r & 15)) << 4;
                const bf16x8 a = *(const LAS bf16x8*)(kp + sl);
                const bf16x8 q = *(const LAS bf16x8*)(qp + sl);
                S = mfma32(a, q, S);
            }
            const float mx = half_max(max16(S));
            const float mnew = fmaxf(mrun, mx), alpha = __builtin_amdgcn_exp2f(mrun - mnew);
            mrun = mnew;
            float ps = 0.f;
#pragma unroll
            for (int i = 0; i < 16; ++i) { S[i] = __builtin_amdgcn_exp2f(S[i] - mnew); ps += S[i]; }
            lsum = lsum * alpha + ps;
#pragma unroll
            for (int e = 0; e < 4; ++e)
#pragma unroll
                for (int i = 0; i < 16; ++i) O[e][i] *= alpha;
            const bf16x8 P0 = pfrag(S, 0), P1 = pfrag(S, 1);
#pragma unroll
            for (int e = 0; e < 4; ++e) {
                const bf16x8 v0 = cat8(tr_read(vp + e * 2048), tr_read(vp + e * 2048 + 512));
                const bf16x8 v1 = cat8(tr_read(vp + e * 2048 + 1024), tr_read(vp + e * 2048 + 1536));
                O[e] = mfma32(v0, P0, O[e]);
                O[e] = mfma32(v1, P1, O[e]);
            }
            if (t + 1 < 8) {
#pragma unroll
                for (int j = 0; j < 2; ++j) {
                    const int id = tid + 512 * j, key = id >> 5, ch = id & 31;
                    *(LAS u32x4*)(lds + KOFF + (buf ^ 1) * 16384 + key * 512 + ((ch ^ (key & 15)) << 4)) = kr[j];
                    *(LAS u32x4*)(lds + VOFF + (buf ^ 1) * 16384 + (ch >> 2) * 2048 + key * 64 + (ch & 3) * 16) = vr[j];
                }
            }
            __syncthreads();
        }
        const float inv = 1.f / half_sum(lsum);
        LAS unsigned char* stg = lds + wave * 16384;
#pragma unroll
        for (int e = 0; e < 4; ++e)
#pragma unroll
            for (int g4 = 0; g4 < 4; ++g4) {
                u32x2 w; w.x = cvtpk(O[e][4 * g4 + 0] * inv, O[e][4 * g4 + 1] * inv); w.y = cvtpk(O[e][4 * g4 + 2] * inv, O[e][4 * g4 + 3] * inv);
                *(LAS u32x2*)(stg + r * 272 + (32 * e + 8 * g4 + 4 * hh) * 2) = w;
            }
        WAVE_SYNC();
#pragma unroll
        for (int i = 0; i < 8; ++i) {
            const int row = i * 4 + (lane >> 4), ch = lane & 15;
            const u32x4 v = *(const LAS u32x4*)(stg + row * 272 + ch * 16);
            *(u32x4*)(OX + (qrow0 + 32 * qb + row) * 1024 + h * 256 + 128 * eh + ch * 8) = v;
        }
        __syncthreads();
    }
}

constexpr float QSCALE = 0.125f * 1.4426950408889634f;
namespace pg8 {
struct EpiIn {
    static constexpr bool PERM = false, AFTER_DRAIN = false;
    bf16_t* ZX; bf16_t* Qb; bf16_t* Kb; bf16_t* Vb; float* okf; float* ovf; float* oconv;
    __device__ __forceinline__ void operator()(const f32x4 (&acc)[2][2][4][2], const Unit& u, int wr, int wc, int fr, int fq) const {
        const int row0 = u.pm * BM + wr * 64 + fr, pn = u.pn;
        if (pn < 6) {
#pragma unroll
            for (int ai = 0; ai < 2; ++ai)
#pragma unroll
                for (int m = 0; m < 4; ++m) {
                    const int row = row0 + ai * HALF + m * 16; const int t = row & 8191;
#pragma unroll
                    for (int bj = 0; bj < 2; ++bj)
#pragma unroll
                        for (int n = 0; n < 2; ++n) {
                            const f32x4 v = acc[ai][bj][m][n]; const int col = pn * BM + bj * HALF + wc * 32 + n * 16 + 4 * fq;
                            u32x2 w; w.x = cvt_pk_bf16(v[0], v[1]); w.y = cvt_pk_bf16(v[2], v[3]);
                            *(u32x2*)(ZX + (size_t)row * 1536 + col) = w;
                            if (pn >= 2 && t >= 8189) *(f32x4*)(oconv + (size_t)((row >> 13) * 3 + (t - 8189)) * 1024 + (col - 512)) = v;
                        }
                }
        } else if (pn < 10) {
            const bool isk = pn >= 8;
            const int g = wc & 1;
            float inv[4];
#pragma unroll
            for (int i = 0; i < 4; ++i) inv[i] = __builtin_amdgcn_exp2f(-(float)(16 * g + 4 * fq + i) * (13.287712379549449f / 32.f)) * 0.15915494309189535f;
#pragma unroll
            for (int ai = 0; ai < 2; ++ai)
#pragma unroll
                for (int m = 0; m < 4; ++m) {
                    const int row = row0 + ai * HALF + m * 16; const float pos = (float)(row & 8191);
                    float cs[4], sn[4];
#pragma unroll
                    for (int i = 0; i < 4; ++i) { float rev = pos * inv[i]; rev -= floorf(rev); sn[i] = __builtin_amdgcn_sinf(rev); cs[i] = __builtin_amdgcn_cosf(rev); }
#pragma unroll
                    for (int bj = 0; bj < 2; ++bj) {
                        const int cl = (pn & 1) * BM + bj * HALF + wc * 32;
                        const f32x4 x1 = acc[ai][bj][m][0], x2 = acc[ai][bj][m][1];
                        f32x4 o1, o2;
#pragma unroll
                        for (int i = 0; i < 4; ++i) { o1[i] = x1[i] * cs[i] - x2[i] * sn[i]; o2[i] = x2[i] * cs[i] + x1[i] * sn[i]; }
                        if (isk) {
                            float* kf = okf + (size_t)row * 512 + (cl >> 6) * 64 + 16 * g + 4 * fq;
                            *(f32x4*)kf = o1; *(f32x4*)(kf + 32) = o2;
                            u32x2 w; w.x = cvt_pk_bf16(o1[0], o1[1]); w.y = cvt_pk_bf16(o1[2], o1[3]);
                            *(u32x2*)(Kb + (size_t)row * 512 + cl + 4 * fq) = w;
                            w.x = cvt_pk_bf16(o2[0], o2[1]); w.y = cvt_pk_bf16(o2[2], o2[3]);
                            *(u32x2*)(Kb + (size_t)row * 512 + cl + 16 + 4 * fq) = w;
                        } else {
                            o1 = o1 * QSCALE; o2 = o2 * QSCALE;
                            u32x2 w; w.x = cvt_pk_bf16(o1[0], o1[1]); w.y = cvt_pk_bf16(o1[2], o1[3]);
                            *(u32x2*)(Qb + (size_t)row * 512 + cl + 4 * fq) = w;
                            w.x = cvt_pk_bf16(o2[0], o2[1]); w.y = cvt_pk_bf16(o2[2], o2[3]);
                            *(u32x2*)(Qb + (size_t)row * 512 + cl + 16 + 4 * fq) = w;
                        }
                    }
                }
        } else {
#pragma unroll
            for (int ai = 0; ai < 2; ++ai)
#pragma unroll
                for (int m = 0; m < 4; ++m) {
                    const int row = row0 + ai * HALF + m * 16;
#pragma unroll
                    for (int bj = 0; bj < 2; ++bj)
#pragma unroll
                        for (int n = 0; n < 2; ++n) {
                            const f32x4 v = acc[ai][bj][m][n]; const int col = (pn - 10) * BM + bj * HALF + wc * 32 + n * 16 + 4 * fq;
                            *(f32x4*)(ovf + (size_t)row * 512 + col) = v;
                            u32x2 w; w.x = cvt_pk_bf16(v[0], v[1]); w.y = cvt_pk_bf16(v[2], v[3]);
                            *(u32x2*)(Vb + (size_t)row * 512 + col) = w;
                        }
                }
        }
    }
};
}

DEV void phase_prep_mix(const FP& p, LAS unsigned char* lds, int gw, int ngw, int wave, int lane) {
    LAS float* scr = (LAS float*)(lds + wave * 16384);
    constexpr int I_IN = 16 * 97, I_OUT = 16 * 32;
    for (int it = gw; it < I_IN + I_OUT; it += ngw) {
        if (it < I_IN) transpose_item(p.in[9], 1024, 3080, (bf16_t*)(p.ws + WS_W_IN), it, scr, lane, RmIn{});
        else transpose_item(p.in[21], 1024, 1024, (bf16_t*)(p.ws + WS_W_OUT), it - I_IN, scr, lane, RmPlain{0});
    }
    __syncthreads();
    LAS float* wdt = (LAS float*)lds;
    for (int i = threadIdx.x; i < 8192; i += 512) wdt[i] = p.in[9][(size_t)(i >> 3) * 3080 + 1536 + (i & 7)];
    __syncthreads();
    const float* x = p.in[0]; const float* g = p.in[27]; bf16_t* xn = (bf16_t*)(p.ws + WS_XN); float* dtv = (float*)(p.ws + WS_DTV);
    const float bias = p.in[12][lane & 7];
    for (int r = gw; r < MP; r += ngw) {
        f32x4 h[4]; float ss = 0.f;
#pragma unroll
        for (int j = 0; j < 4; ++j) { h[j] = ((const f32x4*)(x + (size_t)r * 1024))[lane + 64 * j]; ss += h[j].x * h[j].x + h[j].y * h[j].y + h[j].z * h[j].z + h[j].w * h[j].w; }
        const float rs = rsqrtf(wave_sum(ss) * (1.f / 1024.f) + 1e-6f);
        float d[8];
#pragma unroll
        for (int k = 0; k < 8; ++k) d[k] = 0.f;
#pragma unroll
        for (int j = 0; j < 4; ++j) {
            const f32x4 gg = ((const f32x4*)g)[lane + 64 * j]; h[j] = h[j] * rs * gg;
            u32x2 w; w.x = pk2(h[j].x, h[j].y); w.y = pk2(h[j].z, h[j].w);
            ((u32x2*)(xn + (size_t)r * 1024))[lane + 64 * j] = w;
#pragma unroll
            for (int i = 0; i < 4; ++i) {
                const LAS f32x4* wp = (const LAS f32x4*)(wdt + (4 * (lane + 64 * j) + i) * 8);
                const f32x4 w0 = wp[0], w1 = wp[1]; const float hv = h[j][i];
                d[0] += hv * w0.x; d[1] += hv * w0.y; d[2] += hv * w0.z; d[3] += hv * w0.w; d[4] += hv * w1.x; d[5] += hv * w1.y; d[6] += hv * w1.z; d[7] += hv * w1.w;
            }
        }
#pragma unroll
        for (int k = 0; k < 8; ++k) d[k] = wave_sum(d[k]);
        float mine = d[0];
#pragma unroll
        for (int k = 1; k < 8; ++k) mine = ((lane & 7) == k) ? d[k] : mine;
        const float xx = mine + bias;
        if (lane < 8) dtv[(size_t)r * 8 + lane] = (xx > 20.f) ? xx : log1pf(expf(xx));
    }
    __syncthreads();
}
DEV void phase_inproj(const FP& p, LAS unsigned char* lds, int G, int bid) {
    pg8::Gemm g{(const bf16_t*)(p.ws + WS_XN), (const bf16_t*)(p.ws + WS_W_IN), MP, 3072, 1024};
    pg8::StaticOrder S; S.init(MP, 3072, G, bid);
    pg8::EpiIn E{(bf16_t*)(p.ws + WS_ZX), (bf16_t*)(p.ws + WS_Q), (bf16_t*)(p.ws + WS_K), (bf16_t*)(p.ws + WS_V), p.out + 16908288, p.out + 25296896, p.out + 33816576};
    pg8::gemm_phase<pg8::EpiIn, pg8::StaticOrder, true, true>(lds, g, S, E);
}
DEV void phase_outproj(const FP& p, LAS unsigned char* lds, int G, int bid) {
    pg8::Gemm g{(const bf16_t*)(p.ws + WS_CAT), (const bf16_t*)(p.ws + WS_W_OUT), MP, 1024, 1024};
    pg8::StaticOrder S; S.init(MP, 1024, G, bid);
    pg8::EpiBf16<0> E{(bf16_t*)(p.ws + WS_RAW), 1024, nullptr, 0, 0, 1.f};
    pg8::gemm_phase<pg8::EpiBf16<0>, pg8::StaticOrder, true, true>(lds, g, S, E);
}

DEV float ssd_tables(const FP& p, LAS float* tdt, LAS float* tac, size_t row0, int h, int lane) {
    const float dt = ((const float*)(p.ws + WS_DTV))[(row0 + lane) * 8 + h];
    const float a = -expf(p.in[13][h]);
    float v = dt * a;
#pragma unroll
    for (int o = 1; o < 64; o <<= 1) { const float t = __shfl_up(v, o); if (lane >= o) v += t; }
    tdt[lane * 8 + h] = dt; tac[lane * 8 + h] = v;
    return __shfl(v, 63);
}
template <class F> DEV void ssd_conv8(const FP& p, size_t row0, int col0, int l0, F emit) {
    const bf16_t* ZX = (const bf16_t*)(p.ws + WS_ZX);
    const float* cw = p.in[10]; const float* cb = p.in[11];
    f32x4 w[4][2], bias[2];
#pragma unroll
    for (int j = 0; j < 4; ++j) { w[j][0] = *(const f32x4*)(cw + j * 1024 + col0); w[j][1] = *(const f32x4*)(cw + j * 1024 + col0 + 4); }
    bias[0] = *(const f32x4*)(cb + col0); bias[1] = *(const f32x4*)(cb + col0 + 4);
    const int t0 = (int)(row0 & 8191);
    f32x4 u[4][2];
#pragma unroll
    for (int j = 0; j < 3; ++j) {
        const int l = l0 - 3 + j;
        if (t0 + l >= 0) {
            const u32x4 r = *(const u32x4*)(ZX + (row0 + l) * 1536 + 512 + col0);
            u[j][0] = (f32x4){bflo(r.x), bfhi(r.x), bflo(r.y), bfhi(r.y)}; u[j][1] = (f32x4){bflo(r.z), bfhi(r.z), bflo(r.w), bfhi(r.w)};
        } else { u[j][0] = (f32x4){0.f, 0.f, 0.f, 0.f}; u[j][1] = u[j][0]; }
    }
#pragma unroll
    for (int i = 0; i < 16; ++i) {
        const int l = l0 + i;
        const u32x4 r = *(const u32x4*)(ZX + (row0 + l) * 1536 + 512 + col0);
        u[3][0] = (f32x4){bflo(r.x), bfhi(r.x), bflo(r.y), bfhi(r.y)}; u[3][1] = (f32x4){bflo(r.z), bfhi(r.z), bflo(r.w), bfhi(r.w)};
        f32x4 a0 = bias[0] + w[0][0] * u[0][0] + w[1][0] * u[1][0] + w[2][0] * u[2][0] + w[3][0] * u[3][0];
        f32x4 a1 = bias[1] + w[0][1] * u[0][1] + w[1][1] * u[1][1] + w[2][1] * u[2][1] + w[3][1] * u[3][1];
#pragma unroll
        for (int k = 0; k < 4; ++k) { a0[k] = fast_silu(a0[k]); a1[k] = fast_silu(a1[k]); }
        emit(l, a0, a1);
        u[0][0] = u[1][0]; u[0][1] = u[1][1]; u[1][0] = u[2][0]; u[1][1] = u[2][1]; u[2][0] = u[3][0]; u[2][1] = u[3][1];
    }
}
constexpr int S_XS = 0, S_B = 65536, S_C = 98304, S_TDT = 131072, S_TAC = 133120, S_SSQ = 135168;
DEV int trlane(int lane) { return ((lane & 15) >> 2) * 64 + 32 * ((lane >> 4) & 1) + 8 * (lane & 3); }

DEV void phase_ssd1(const FP& p, LAS unsigned char* lds, int G, int bid) {
    const int tid = threadIdx.x, lane = tid & 63, wave = __builtin_amdgcn_readfirstlane(tid >> 6), hh = lane >> 5;
    LAS float* tdt = (LAS float*)(lds + S_TDT); LAS float* tac = (LAS float*)(lds + S_TAC);
    bf16_t* ST = (bf16_t*)(p.ws + WS_ST); float* cdec = (float*)(p.ws + WS_CDEC);
    for (int u = bid; u < 256; u += G) {
        const int b = u >> 7, c = u & 127; const size_t row0 = (size_t)b * 8192 + (size_t)c * 64;
        const float tot = ssd_tables(p, tdt, tac, row0, wave, lane);
        if (lane == 0) cdec[u * 8 + wave] = expf(tot);
        __syncthreads();
        { const int i = tid; const float t63 = tac[63 * 8 + (i & 7)]; const float s = tdt[i] * expf(t63 - tac[i]); __syncthreads(); tdt[i] = s; }
        __syncthreads();
        if (tid < 384) {
            const int cg = tid >> 2, tq = tid & 3, col0 = cg * 8;
            ssd_conv8(p, row0, col0, tq * 16, [&](int l, f32x4 a0, f32x4 a1) {
                u32x4 w;
                if (cg < 64) {
                    const int h = cg >> 3, pp = col0 & 63; const float s = tdt[l * 8 + h];
                    a0 = a0 * s; a1 = a1 * s;
                    w.x = pk2(a0[0], a0[1]); w.y = pk2(a0[2], a0[3]); w.z = pk2(a1[0], a1[1]); w.w = pk2(a1[2], a1[3]);
                    *(LAS u32x4*)(lds + S_XS + h * 8192 + (pp >> 5) * 4096 + l * 64 + (pp & 31) * 2) = w;
                } else {
                    const int n = col0 - 512, g = n >> 7, nn = n & 127;
                    w.x = pk2(a0[0], a0[1]); w.y = pk2(a0[2], a0[3]); w.z = pk2(a1[0], a1[1]); w.w = pk2(a1[2], a1[3]);
                    *(LAS u32x4*)(lds + S_B + g * 16384 + (nn >> 5) * 4096 + l * 64 + (nn & 31) * 2) = w;
                }
            });
        }
        __syncthreads();
        const int h = wave, g = h >> 2;
        const LAS unsigned char* xa = lds + S_XS + h * 8192 + hh * 512 + trlane(lane);
        const LAS unsigned char* ba = lds + S_B + g * 16384 + hh * 512 + trlane(lane);
        bf16_t* sp = ST + ((size_t)u * 8 + h) * 8192;
#pragma unroll 1
        for (int nh = 0; nh < 2; ++nh) {
            f32x16 acc[2][2];
#pragma unroll
            for (int a = 0; a < 2; ++a)
#pragma unroll
                for (int n = 0; n < 2; ++n)
#pragma unroll
                    for (int i = 0; i < 16; ++i) acc[a][n][i] = 0.f;
#pragma unroll 2
            for (int s = 0; s < 4; ++s) {
                bf16x8 af[2], bfr[2];
#pragma unroll
                for (int a = 0; a < 2; ++a) af[a] = cat8(tr_read(xa + a * 4096 + s * 1024), tr_read(xa + a * 4096 + s * 1024 + 256));
#pragma unroll
                for (int n = 0; n < 2; ++n) bfr[n] = cat8(tr_read(ba + (2 * nh + n) * 4096 + s * 1024), tr_read(ba + (2 * nh + n) * 4096 + s * 1024 + 256));
#pragma unroll
                for (int a = 0; a < 2; ++a)
#pragma unroll
                    for (int n = 0; n < 2; ++n) acc[a][n] = mfma32(af[a], bfr[n], acc[a][n]);
            }
#pragma unroll
            for (int a = 0; a < 2; ++a)
#pragma unroll
                for (int n = 0; n < 2; ++n)
#pragma unroll
                    for (int i = 0; i < 16; ++i) {
                        const int pr = 32 * a + (i & 3) + 8 * (i >> 2) + 4 * hh;
                        sp[pr * 128 + 32 * (2 * nh + n) + (lane & 31)] = (bf16_t)f2bf(acc[a][n][i]);
                    }
        }
        __syncthreads();
    }
}

DEV void ssd2_item(const FP& p, int blk) {
    const int tid = threadIdx.x;
    unsigned* ST = (unsigned*)(p.ws + WS_ST); const float* cdec = (const float*)(p.ws + WS_CDEC); float* pssm = p.out + 33685504;
    const int idx = blk * 512 + tid;
    const int n2 = idx & 63, pr = (idx >> 6) & 63, h = (idx >> 12) & 7, b = idx >> 15;
    float s0 = 0.f, s1 = 0.f;
    for (int c0 = 0; c0 < 128; c0 += 32) {
        unsigned v[32];
#pragma unroll
        for (int j = 0; j < 32; ++j) v[j] = ST[(((size_t)(b * 128 + c0 + j) * 8 + h) * 64 + pr) * 64 + n2];
#pragma unroll
        for (int j = 0; j < 32; ++j) {
            const float dc = cdec[(b * 128 + c0 + j) * 8 + h];
            ST[(((size_t)(b * 128 + c0 + j) * 8 + h) * 64 + pr) * 64 + n2] = pk2(s0, s1);
            s0 = s0 * dc + bflo(v[j]); s1 = s1 * dc + bfhi(v[j]);
        }
    }
    float2 o; o.x = s0; o.y = s1;
    ((float2*)pssm)[(((size_t)b * 8 + h) * 64 + pr) * 64 + n2] = o;
}
DEV void phase_ssd2(const FP& p, int G, int bid) { for (int blk = bid; blk < 128; blk += G) ssd2_item(p, blk); }

DEV void phase_ssd3(const FP& p, LAS unsigned char* lds, int G, int bid) {
    LAS float* tdt = (LAS float*)(lds + S_TDT); LAS float* tac = (LAS float*)(lds + S_TAC); LAS float* ssq = (LAS float*)(lds + S_SSQ);
    const bf16_t* ST = (const bf16_t*)(p.ws + WS_ST); const bf16_t* ZX = (const bf16_t*)(p.ws + WS_ZX); bf16_t* CAT = (bf16_t*)(p.ws + WS_CAT);
    for (int u = bid; u < 256; u += G) {
        int tid = threadIdx.x; asm volatile("" : "+v"(tid));
        const int lane = tid & 63, wave = __builtin_amdgcn_readfirstlane(tid >> 6), r = lane & 31, hh = lane >> 5;
        const int b = u >> 7, c = u & 127; const size_t row0 = (size_t)b * 8192 + (size_t)c * 64;
        (void)ssd_tables(p, tdt, tac, row0, wave, lane);
        {
            const int cg = tid >> 2, tq = tid & 3, col0 = cg * 8;
            ssd_conv8(p, row0, col0, tq * 16, [&](int l, f32x4 a0, f32x4 a1) {
                u32x4 w; w.x = pk2(a0[0], a0[1]); w.y = pk2(a0[2], a0[3]); w.z = pk2(a1[0], a1[1]); w.w = pk2(a1[2], a1[3]);
                if (cg < 64) {
                    const int h = cg >> 3, pp = col0 & 63;
                    *(LAS u32x4*)(lds + S_XS + h * 8192 + (pp >> 5) * 4096 + l * 64 + (pp & 31) * 2) = w;
                } else {
                    const int n = (col0 - 512) & 255, g = n >> 7, ch = (n & 127) >> 3;
                    *(LAS u32x4*)(lds + (col0 < 768 ? S_B : S_C) + g * 16384 + l * 256 + ((ch ^ (l & 15)) << 4)) = w;
                }
            });
        }
        __syncthreads();
        const int h = wave, g = h >> 2;
        f32x16 Y[2][2];
#pragma unroll
        for (int a = 0; a < 2; ++a)
#pragma unroll
            for (int l2 = 0; l2 < 2; ++l2)
#pragma unroll
                for (int i = 0; i < 16; ++i) Y[a][l2][i] = 0.f;
        const LAS unsigned char* cp = lds + S_C + g * 16384 + r * 256;
        const LAS unsigned char* bp = lds + S_B + g * 16384 + r * 256;
        const bf16_t* pv = ST + ((size_t)u * 8 + h) * 8192 + (size_t)r * 128 + 8 * hh;
#pragma unroll 2
        for (int ks = 0; ks < 8; ++ks) {
            const int sl = ((2 * ks + hh) ^ (r & 15)) << 4;
            const bf16x8 c0 = *(const LAS bf16x8*)(cp + sl), c1 = *(const LAS bf16x8*)(cp + 32 * 256 + sl);
            const bf16x8 p0 = *(const bf16x8*)(pv + 16 * ks), p1 = *(const bf16x8*)(pv + 32 * 128 + 16 * ks);
            Y[0][0] = mfma32(p0, c0, Y[0][0]); Y[0][1] = mfma32(p0, c1, Y[0][1]);
            Y[1][0] = mfma32(p1, c0, Y[1][0]); Y[1][1] = mfma32(p1, c1, Y[1][1]);
        }
        float acl[2];
#pragma unroll
        for (int l2 = 0; l2 < 2; ++l2) {
            acl[l2] = tac[(32 * l2 + r) * 8 + h]; const float e = expf(acl[l2]);
#pragma unroll
            for (int a = 0; a < 2; ++a)
#pragma unroll
                for (int i = 0; i < 16; ++i) Y[a][l2][i] *= e;
        }
        __builtin_amdgcn_sched_barrier(0);
        const LAS unsigned char* xa = lds + S_XS + h * 8192 + hh * 256 + trlane(lane);
#pragma unroll
        for (int lb = 0; lb < 2; ++lb)
#pragma unroll
            for (int sb = 0; sb <= lb; ++sb) {
                f32x16 T;
#pragma unroll
                for (int i = 0; i < 16; ++i) T[i] = 0.f;
#pragma unroll 2
                for (int ks = 0; ks < 8; ++ks) {
                    const int sl = ((2 * ks + hh) ^ (r & 15)) << 4;
                    const bf16x8 bb = *(const LAS bf16x8*)(bp + sb * 32 * 256 + sl), cc = *(const LAS bf16x8*)(cp + lb * 32 * 256 + sl);
                    T = mfma32(bb, cc, T);
                }
#pragma unroll
                for (int i = 0; i < 16; ++i) {
                    const int s = 32 * sb + (i & 3) + 8 * (i >> 2) + 4 * hh;
                    const float f = tdt[s * 8 + h] * __builtin_amdgcn_exp2f(1.4426950408889634f * fminf(acl[lb] - tac[s * 8 + h], 0.f));
                    T[i] = (s <= 32 * lb + r) ? T[i] * f : 0.f;
                }
                const bf16x8 P0 = pfrag(T, 0), P1 = pfrag(T, 1);
#pragma unroll
                for (int a = 0; a < 2; ++a) {
                    const bf16x8 x0 = cat8(tr_read(xa + a * 4096 + (2 * sb) * 1024), tr_read(xa + a * 4096 + (2 * sb) * 1024 + 512));
                    const bf16x8 x1 = cat8(tr_read(xa + a * 4096 + (2 * sb + 1) * 1024), tr_read(xa + a * 4096 + (2 * sb + 1) * 1024 + 512));
                    Y[a][lb] = mfma32(x0, P0, Y[a][lb]);
                    Y[a][lb] = mfma32(x1, P1, Y[a][lb]);
                }
            }
        __builtin_amdgcn_sched_barrier(0);
        const float Dh = p.in[14][h];
        float sq[2] = {0.f, 0.f};
#pragma unroll
        for (int a = 0; a < 2; ++a)
#pragma unroll
            for (int l2 = 0; l2 < 2; ++l2) {
                const int l = 32 * l2 + r;
#pragma unroll
                for (int g4 = 0; g4 < 4; ++g4) {
                    const int pp = 8 * g4 + 4 * hh;
                    const u32x2 xw = *(const LAS u32x2*)(lds + S_XS + h * 8192 + a * 4096 + l * 64 + pp * 2);
                    const u32x2 zw = *(const u32x2*)(ZX + (row0 + l) * 1536 + h * 64 + 32 * a + pp);
                    const float xv[4] = {bflo(xw.x), bfhi(xw.x), bflo(xw.y), bfhi(xw.y)}, zv[4] = {bflo(zw.x), bfhi(zw.x), bflo(zw.y), bfhi(zw.y)};
#pragma unroll
                    for (int i = 0; i < 4; ++i) { const float v = (Y[a][l2][4 * g4 + i] + Dh * xv[i]) * fast_silu(zv[i]); Y[a][l2][4 * g4 + i] = v; sq[l2] += v * v; }
                }
            }
#pragma unroll
        for (int l2 = 0; l2 < 2; ++l2) { sq[l2] = half_sum(sq[l2]); if (hh == 0) ssq[(h * 2 + l2) * 32 + r] = sq[l2]; }
        __syncthreads();
        float rs[2];
#pragma unroll
        for (int l2 = 0; l2 < 2; ++l2) {
            float t = 0.f;
#pragma unroll
            for (int k = 0; k < 4; ++k) t += ssq[((4 * g + k) * 2 + l2) * 32 + r];
            rs[l2] = rsqrtf(t * (1.f / 256.f) + 1e-5f);
        }
#pragma unroll
        for (int a = 0; a < 2; ++a)
#pragma unroll
            for (int g4 = 0; g4 < 4; ++g4) {
                const int pcol = h * 64 + 32 * a + 8 * g4 + 4 * hh;
                const f32x4 w = *(const f32x4*)(p.in[15] + pcol);
#pragma unroll
                for (int l2 = 0; l2 < 2; ++l2) {
                    u32x2 o; o.x = cvtpk(Y[a][l2][4 * g4 + 0] * rs[l2] * w[0], Y[a][l2][4 * g4 + 1] * rs[l2] * w[1]);
                    o.y = cvtpk(Y[a][l2][4 * g4 + 2] * rs[l2] * w[2], Y[a][l2][4 * g4 + 3] * rs[l2] * w[3]);
                    *(u32x2*)(CAT + (row0 + 32 * l2 + r) * 1024 + pcol) = o;
                }
            }
        __syncthreads();
    }
}

struct AttnCtx { unsigned lam_bits; };
DEV AttnCtx attn_setup(const FP& p, LAS unsigned char* lds) {
    const int tid0 = threadIdx.x, lane0 = tid0 & 63;
    AttnCtx c; float lamv = expf(wave_sum(p.in[16][lane0] * p.in[17][lane0])) - expf(wave_sum(p.in[18][lane0] * p.in[19][lane0])) + 0.2f;
    asm volatile("" : "+v"(lamv));
    c.lam_bits = __builtin_amdgcn_readfirstlane(__float_as_uint(lamv));
    LAS float* subw = (LAS float*)(lds + 131072);
    if (tid0 < 128) subw[tid0] = p.in[20][tid0];
    return c;
}
DEV void attn_unit(const FP& p, LAS unsigned char* lds, const AttnCtx& ctx, int bh, int jq) {
    const bf16_t* Qg = (const bf16_t*)(p.ws + WS_Q); const bf16_t* Kg = (const bf16_t*)(p.ws + WS_K); const bf16_t* Vg = (const bf16_t*)(p.ws + WS_V);
    bf16_t* CAT = (bf16_t*)(p.ws + WS_CAT);
    const float lam_init = 0.2f, lam = __uint_as_float(ctx.lam_bits);
    LAS float* subw = (LAS float*)(lds + 131072);
    const int b = bh >> 2, h = bh & 3;
    int tid = threadIdx.x; asm volatile("" : "+v"(tid));
    const int lane = tid & 63, wave = __builtin_amdgcn_readfirstlane(tid >> 6), r = lane & 31, hh = lane >> 5, qb = wave & 3, c = wave >> 2;
    const int vlane = (4 * hh) * 64 + trlane(lane);
    const size_t rowb = (size_t)b * 8192; const int q0 = jq * 128;
    const int ntb = 2 * jq + 2, myn = 2 * jq + (qb >> 1) + 1;
    constexpr int KOFF = 0, VOFF = 32768;
    bf16x8 qf[4];
#pragma unroll
    for (int ks = 0; ks < 4; ++ks) qf[ks] = *(const bf16x8*)(Qg + (rowb + q0 + 32 * qb + r) * 512 + h * 128 + c * 64 + 16 * ks + 8 * hh);
#pragma unroll
    for (int ks = 0; ks < 4; ++ks) asm volatile("" : "+v"(qf[ks]));
    const bf16_t* ksrc[2]; const bf16_t* vsrc[2]; int kdst[2], vdst[2];
#pragma unroll
    for (int j = 0; j < 2; ++j) {
        const int pc = wave + 8 * j;
        { const int comp = pc >> 3, kb8 = pc & 7, key = 8 * kb8 + (lane >> 3), ch = (lane & 7) ^ ((key >> 1) & 7);
          ksrc[j] = Kg + (rowb + key) * 512 + h * 128 + comp * 64 + ch * 8; kdst[j] = KOFF + comp * 8192 + kb8 * 1024; }
        { const int eb = pc >> 2, kb16 = pc & 3, key = 16 * kb16 + (lane >> 2);
          vsrc[j] = Vg + (rowb + key) * 512 + h * 128 + eb * 32 + (lane & 3) * 8; vdst[j] = VOFF + eb * 4096 + kb16 * 1024; }
    }
#define ATT_DMA(tt, bufo) do { _Pragma("unroll") for (int s_ = 0; s_ < 2; ++s_) _Pragma("unroll") for (int j_ = 0; j_ < 2; ++j_) { \
        __builtin_amdgcn_global_load_lds((const unsigned*)(ksrc[j_] + (size_t)(128 * (tt) + 64 * s_) * 512), (LAS unsigned*)(lds + kdst[j_] + (bufo) + 16384 * s_), 16, 0, 0); \
        __builtin_amdgcn_global_load_lds((const unsigned*)(vsrc[j_] + (size_t)(128 * (tt) + 64 * s_) * 512), (LAS unsigned*)(lds + vdst[j_] + (bufo) + 16384 * s_), 16, 0, 0); } } while (0)
#define ATT_BAR_L() do { asm volatile("s_waitcnt lgkmcnt(0)" ::: "memory"); __builtin_amdgcn_s_barrier(); asm volatile("" ::: "memory"); } while (0)
#define ATT_BAR_VL() do { asm volatile("s_waitcnt vmcnt(0) lgkmcnt(0)" ::: "memory"); __builtin_amdgcn_s_barrier(); asm volatile("" ::: "memory"); } while (0)
    asm volatile("s_waitcnt vmcnt(0) lgkmcnt(0)" ::: "memory");
    ATT_DMA(0, 0);
    ATT_BAR_VL();
    f32x16 O[4];
#pragma unroll
    for (int e = 0; e < 4; ++e)
#pragma unroll
        for (int i = 0; i < 16; ++i) O[e][i] = 0.f;
    float mrun = -1e30f, lsum = 0.f;
    const int nst = jq + 1;
    for (int tt = 0; tt < nst; ++tt) {
        const int bufo = (tt & 1) * 65536;
        if (tt + 1 < nst) ATT_DMA(tt + 1, 65536 - bufo);
#pragma unroll
        for (int sub = 0; sub < 2; ++sub) {
            if (2 * tt + sub < myn) {
                const LAS unsigned char* kp = lds + bufo + sub * 16384 + KOFF + c * 8192 + r * 128;
                const LAS unsigned char* vp = lds + bufo + sub * 16384 + VOFF + vlane;
                f32x16 S0, S1;
#pragma unroll
                for (int i = 0; i < 16; ++i) { S0[i] = 0.f; S1[i] = 0.f; }
#pragma unroll
                for (int ks = 0; ks < 4; ++ks) {
                    const int sl = ((2 * ks + hh) ^ ((r >> 1) & 7)) << 4;
                    const bf16x8 a0 = *(const LAS bf16x8*)(kp + sl), a1 = *(const LAS bf16x8*)(kp + 32 * 128 + sl);
                    S0 = mfma32(a0, qf[ks], S0); S1 = mfma32(a1, qf[ks], S1);
                }
                const float mx = half_max(fmaxf(max16(S0), max16(S1)));
                const float mnew = fmaxf(mrun, mx);
                if (__any(mnew > mrun)) {
                    const float alpha = __builtin_amdgcn_exp2f(mrun - mnew);
                    lsum *= alpha;
#pragma unroll
                    for (int e = 0; e < 4; ++e)
#pragma unroll
                        for (int i = 0; i < 16; ++i) O[e][i] *= alpha;
                    mrun = mnew;
                }
                float ps = 0.f;
#pragma unroll
                for (int i = 0; i < 16; ++i) { S0[i] = __builtin_amdgcn_exp2f(S0[i] - mrun); S1[i] = __builtin_amdgcn_exp2f(S1[i] - mrun); ps += S0[i] + S1[i]; }
                lsum += ps;
                const bf16x8 P0 = pfrag(S0, 0), P1 = pfrag(S0, 1), P2 = pfrag(S1, 0), P3 = pfrag(S1, 1);
#pragma unroll
                for (int e = 0; e < 4; ++e) {
                    const bf16x8 v0 = cat8(tr_read(vp + e * 4096), tr_read(vp + e * 4096 + 512));
                    const bf16x8 v1 = cat8(tr_read(vp + e * 4096 + 1024), tr_read(vp + e * 4096 + 1536));
                    const bf16x8 v2 = cat8(tr_read(vp + e * 4096 + 2048), tr_read(vp + e * 4096 + 2560));
                    const bf16x8 v3 = cat8(tr_read(vp + e * 4096 + 3072), tr_read(vp + e * 4096 + 3584));
                    O[e] = mfma32(v0, P0, O[e]); O[e] = mfma32(v1, P1, O[e]); O[e] = mfma32(v2, P2, O[e]); O[e] = mfma32(v3, P3, O[e]);
                }
            }
        }
        ATT_BAR_VL();
    }
#undef ATT_DMA
    const float inv = 1.f / half_sum(lsum);
    LAS float* xch = (LAS float*)(lds + qb * 16384);
    if (c == 1) {
        const float f = -lam * inv;
#pragma unroll
        for (int e = 0; e < 4; ++e)
#pragma unroll
            for (int i = 0; i < 16; ++i) xch[(e * 16 + i) * 64 + lane] = O[e][i] * f;
    }
    __syncthreads();
    if (c == 0) {
        float ss = 0.f;
#pragma unroll
        for (int e = 0; e < 4; ++e)
#pragma unroll
            for (int i = 0; i < 16; ++i) { const float v = O[e][i] * inv + xch[(e * 16 + i) * 64 + lane]; O[e][i] = v; ss += v * v; }
        ss = half_sum(ss);
        const float rs = rsqrtf(ss * (1.f / 128.f) + 1e-5f) * (1.f - lam_init);
        WAVE_SYNC();
        LAS unsigned char* stg = lds + qb * 16384;
#pragma unroll
        for (int e = 0; e < 4; ++e)
#pragma unroll
            for (int g4 = 0; g4 < 4; ++g4) {
                const int e0 = 32 * e + 8 * g4 + 4 * hh;
                const f32x4 w = *(const LAS f32x4*)(subw + e0);
                u32x2 o; o.x = cvtpk(O[e][4 * g4 + 0] * rs * w[0], O[e][4 * g4 + 1] * rs * w[1]); o.y = cvtpk(O[e][4 * g4 + 2] * rs * w[2], O[e][4 * g4 + 3] * rs * w[3]);
                *(LAS u32x2*)(stg + r * 272 + e0 * 2) = o;
            }
        WAVE_SYNC();
#pragma unroll
        for (int i = 0; i < 8; ++i) {
            const int row = i * 4 + (lane >> 4), ch = lane & 15;
            const u32x4 v = *(const LAS u32x4*)(stg + row * 272 + ch * 16);
            *(u32x4*)(CAT + (rowb + q0 + 32 * qb + row) * 1024 + 512 + h * 128 + ch * 8) = v;
        }
    }
    __syncthreads();
#undef ATT_BAR_L
#undef ATT_BAR_VL
}
DEV void phase_attn(const FP& p, LAS unsigned char* lds, int G, int bid) {
    const AttnCtx ctx = attn_setup(p, lds);
    for (int pu = bid; pu < 256; pu += G) {
        const int bh = pu & 7, pr = pu >> 3;
        attn_unit(p, lds, ctx, bh, pr);
        attn_unit(p, lds, ctx, bh, 63 - pr);
    }
}

constexpr int NS = 128;
constexpr size_t SB_XN = 0, SB_Z = 256 * 1024, SB_XBC = 512 * 1024, SB_Q = 1024 * 1024, SB_DTV = 1280 * 1024, SB_YPRE = 1536 * 1024, SB_CAT = 1792 * 1024, SB_MIX = 2048 * 1024,
                 SB_QX = 2560 * 1024, SB_OX = 3072 * 1024, SB_HID = 3328 * 1024, SB_AML = 4096 * 1024, SB_XML = 4608 * 1024, SB_XO = 5 * MiB, SB_AO = 8 * MiB;
constexpr int N_ATILE = 33;

template <class Epi>
DEV void s_gemm(const bf16_t* A, const bf16_t* Bt, int N, int K, LAS unsigned char* lds, int bid, int G, int rot, const Epi& E) {
    int tid = threadIdx.x; asm volatile("" : "+v"(tid));
    const int lane = tid & 63, wave = __builtin_amdgcn_readfirstlane(tid >> 6), r = lane & 31, hh = lane >> 5;
    const int nun = 4 * (N >> 5), kw = K >> 3, nit = kw >> 5;
    for (int u = (bid + G - rot) % G; u < nun; u += G) {
        const int mb = u & 3, n0 = (u >> 2) * 32;
        const bf16_t* ap = A + (size_t)(32 * mb + r) * K + wave * kw + 16 * hh;
        const bf16_t* bp = Bt + (size_t)(n0 + r) * K + wave * kw + 16 * hh;
        f32x16 acc;
#pragma unroll
        for (int i = 0; i < 16; ++i) acc[i] = 0.f;
#pragma unroll 4
        for (int j = 0; j < nit; ++j) {
            const bf16x8 a0 = *(const bf16x8*)(ap + 32 * j), a1 = *(const bf16x8*)(ap + 32 * j + 8);
            const bf16x8 b0 = *(const bf16x8*)(bp + 32 * j), b1 = *(const bf16x8*)(bp + 32 * j + 8);
            acc = mfma32(b0, a0, acc); acc = mfma32(b1, a1, acc);
        }
        LAS float* red = (LAS float*)lds;
        if (wave != 0) {
#pragma unroll
            for (int i = 0; i < 16; ++i) red[wave * 1024 + i * 64 + lane] = acc[i];
        }
        __syncthreads();
        if (wave == 0) {
#pragma unroll
            for (int w = 1; w < 8; ++w)
#pragma unroll
                for (int i = 0; i < 16; ++i) acc[i] += red[w * 1024 + i * 64 + lane];
            E(acc, 32 * mb + r, n0, hh);
        }
        __syncthreads();
    }
}
struct EpiSF32 {
    float* C; int ldc; float scale;
    __device__ __forceinline__ void operator()(const f32x16& acc, int m, int n0, int hh) const {
#pragma unroll
        for (int g4 = 0; g4 < 4; ++g4) { f32x4 v = {acc[4 * g4] * scale, acc[4 * g4 + 1] * scale, acc[4 * g4 + 2] * scale, acc[4 * g4 + 3] * scale}; *(f32x4*)(C + (size_t)m * ldc + n0 + 8 * g4 + 4 * hh) = v; }
    }
};
struct EpiSSwiglu {
    bf16_t* H;
    __device__ __forceinline__ void operator()(const f32x16& acc, int m, int n0, int hh) const {
#pragma unroll
        for (int g4 = 0; g4 < 2; ++g4) {
            u32x2 w; w.x = cvtpk(fast_silu(acc[4 * g4]) * acc[4 * g4 + 8], fast_silu(acc[4 * g4 + 1]) * acc[4 * g4 + 9]);
            w.y = cvtpk(fast_silu(acc[4 * g4 + 2]) * acc[4 * g4 + 10], fast_silu(acc[4 * g4 + 3]) * acc[4 * g4 + 11]);
            *(u32x2*)(H + (size_t)m * 2816 + 16 * (n0 >> 5) + 8 * g4 + 4 * hh) = w;
        }
    }
};
struct EpiSIn {
    float *z, *xbc, *q, *ok, *ov, *oconv;
    __device__ __forceinline__ void operator()(const f32x16& acc, int m, int n0, int hh) const {
        const int t = m & 15, b = m >> 4;
        if (n0 < 1536) {
#pragma unroll
            for (int g4 = 0; g4 < 4; ++g4) {
                const f32x4 v = {acc[4 * g4], acc[4 * g4 + 1], acc[4 * g4 + 2], acc[4 * g4 + 3]}; const int col = n0 + 8 * g4 + 4 * hh;
                if (n0 < 512) *(f32x4*)(z + (size_t)m * 512 + col) = v;
                else { *(f32x4*)(xbc + (size_t)m * 1024 + col - 512) = v; if (t >= 13) *(f32x4*)(oconv + (size_t)(b * 3 + t - 13) * 1024 + col - 512) = v; }
            }
        } else if (n0 < 2560) {
            const bool isk = n0 >= 2048; const int cl = (n0 - (isk ? 2048 : 1536)), u64 = cl >> 6, g = (cl >> 5) & 1;
            const float pos = (float)(2048 + t);
            float* dst = (isk ? ok : q) + (size_t)m * 512 + u64 * 64;
#pragma unroll
            for (int g4 = 0; g4 < 2; ++g4) {
                f32x4 o1, o2;
#pragma unroll
                for (int i = 0; i < 4; ++i) {
                    const int d0 = 16 * g + 8 * g4 + 4 * hh + i;
                    float rev = pos * (__builtin_amdgcn_exp2f(-(float)d0 * (13.287712379549449f / 32.f)) * 0.15915494309189535f); rev -= floorf(rev);
                    const float sn = __builtin_amdgcn_sinf(rev), cs = __builtin_amdgcn_cosf(rev);
                    const float x1 = acc[4 * g4 + i], x2 = acc[4 * g4 + 8 + i];
                    o1[i] = x1 * cs - x2 * sn; o2[i] = x2 * cs + x1 * sn;
                }
                const int d0 = 16 * g + 8 * g4 + 4 * hh;
                *(f32x4*)(dst + d0) = o1; *(f32x4*)(dst + d0 + 32) = o2;
            }
        } else {
#pragma unroll
            for (int g4 = 0; g4 < 4; ++g4) { const f32x4 v = {acc[4 * g4], acc[4 * g4 + 1], acc[4 * g4 + 2], acc[4 * g4 + 3]}; *(f32x4*)(ov + (size_t)m * 512 + n0 - 2560 + 8 * g4 + 4 * hh) = v; }
        }
    }
};

DEV void s_row(const FP& p, const float* raw, const float* hin, const float* gpost, float* hout, const float* gpre, bf16_t* xn, float* dtv, int bid, int G, int rot) {
    const int lane = threadIdx.x & 63, wave = __builtin_amdgcn_readfirstlane(threadIdx.x >> 6);
    const int blk = (bid + G - rot) % G;
    for (int r = blk + G * wave; r < NS; r += 8 * G) {
        f32x4 h[4];
#pragma unroll
        for (int j = 0; j < 4; ++j) h[j] = ((const f32x4*)(hin + (size_t)r * 1024))[lane + 64 * j];
        if (raw) {
            f32x4 v[4]; float ss = 0.f;
#pragma unroll
            for (int j = 0; j < 4; ++j) { v[j] = ((const f32x4*)(raw + (size_t)r * 1024))[lane + 64 * j]; ss += v[j].x * v[j].x + v[j].y * v[j].y + v[j].z * v[j].z + v[j].w * v[j].w; }
            const float rs = rsqrtf(wave_sum(ss) * (1.f / 1024.f) + 1e-6f);
#pragma unroll
            for (int j = 0; j < 4; ++j) { const f32x4 g = ((const f32x4*)gpost)[lane + 64 * j]; h[j] += v[j] * rs * g; }
        }
        if (hout) {
#pragma unroll
            for (int j = 0; j < 4; ++j) ((f32x4*)(hout + (size_t)r * 1024))[lane + 64 * j] = h[j];
        }
        if (gpre) {
            float ss = 0.f;
#pragma unroll
            for (int j = 0; j < 4; ++j) ss += h[j].x * h[j].x + h[j].y * h[j].y + h[j].z * h[j].z + h[j].w * h[j].w;
            const float rs = rsqrtf(wave_sum(ss) * (1.f / 1024.f) + 1e-6f);
            float d[8];
#pragma unroll
            for (int k = 0; k < 8; ++k) d[k] = 0.f;
#pragma unroll
            for (int j = 0; j < 4; ++j) {
                const f32x4 g = ((const f32x4*)gpre)[lane + 64 * j]; const f32x4 o = h[j] * rs * g;
                u32x2 w; w.x = pk2(o.x, o.y); w.y = pk2(o.z, o.w);
                ((u32x2*)(xn + (size_t)r * 1024))[lane + 64 * j] = w;
                if (dtv) {
#pragma unroll
                    for (int i = 0; i < 4; ++i) {
                        const float* wp = p.in[9] + (size_t)(4 * (lane + 64 * j) + i) * 3080 + 1536;
                        const f32x4 w0 = *(const f32x4*)wp, w1 = *(const f32x4*)(wp + 4); const float hv = o[i];
                        d[0] += hv * w0.x; d[1] += hv * w0.y; d[2] += hv * w0.z; d[3] += hv * w0.w; d[4] += hv * w1.x; d[5] += hv * w1.y; d[6] += hv * w1.z; d[7] += hv * w1.w;
                    }
                }
            }
            if (dtv) {
#pragma unroll
                for (int k = 0; k < 8; ++k) d[k] = wave_sum(d[k]);
                float mine = d[0];
#pragma unroll
                for (int k = 1; k < 8; ++k) mine = ((lane & 7) == k) ? d[k] : mine;
                const float xx = mine + p.in[12][lane & 7];
                if (lane < 8) dtv[(size_t)r * 8 + lane] = (xx > 20.f) ? xx : log1pf(expf(xx));
            }
        }
    }
}

DEV void s_ssd(const FP& p, LAS unsigned char* lds, int bid, int G, int rot) {
    const int tid = threadIdx.x;
    const float* xbc = (const float*)(p.ws + WS_SMP + SB_XBC); const float* zb = (const float*)(p.ws + WS_SMP + SB_Z); const float* dtv = (const float*)(p.ws + WS_SMP + SB_DTV);
    float* ypre = (float*)(p.ws + WS_SMP + SB_YPRE); float* s_ssm = p.out + 35002368;
    const float* cbuf = p.in[5]; const float* cw = p.in[10]; const float* cb = p.in[11];
    LAS float* act = (LAS float*)lds;
    for (int item = (bid + G - rot) % G; item < 64; item += G) {
        const int b = item >> 3, h = item & 7, g = h >> 2;
        for (int e = tid; e < 16 * 320; e += 512) {
            const int t = e / 320, cc = e % 320;
            const int col = (cc < 64) ? h * 64 + cc : (cc < 192 ? 512 + g * 128 + (cc - 64) : 768 + g * 128 + (cc - 192));
            float a = cb[col];
#pragma unroll
            for (int j = 0; j < 4; ++j) {
                const int tt = t - 3 + j;
                const float u = (tt >= 0) ? xbc[(size_t)(b * 16 + tt) * 1024 + col] : cbuf[(size_t)(b * 3 + tt + 3) * 1024 + col];
                a += cw[j * 1024 + col] * u;
            }
            act[e] = a / (1.f + expf(-a));
        }
        __syncthreads();
        const int pp = tid >> 3, seg = tid & 7;
        float hs[16];
        const size_t sbase = ((size_t)(b * 8 + h) * 64 + pp) * 128 + seg * 16;
#pragma unroll
        for (int i = 0; i < 16; ++i) hs[i] = p.in[4][sbase + i];
        const float a = -expf(p.in[13][h]), D = p.in[14][h];
#pragma unroll 1
        for (int t = 0; t < 16; ++t) {
            const float dt = dtv[(b * 16 + t) * 8 + h];
            const float zz = zb[(size_t)(b * 16 + t) * 512 + h * 64 + pp];
            const float x = act[t * 320 + pp];
            const float dA = expf(dt * a), coef = dt * x;
            float y = 0.f;
#pragma unroll
            for (int i = 0; i < 16; ++i) { hs[i] = dA * hs[i] + coef * act[t * 320 + 64 + seg * 16 + i]; y += act[t * 320 + 192 + seg * 16 + i] * hs[i]; }
            y += __shfl_xor(y, 1); y += __shfl_xor(y, 2); y += __shfl_xor(y, 4);
            if (seg == 0) ypre[(size_t)(b * 16 + t) * 512 + h * 64 + pp] = (y + D * x) * (zz / (1.f + expf(-zz)));
        }
#pragma unroll
        for (int i = 0; i < 16; ++i) s_ssm[sbase + i] = hs[i];
        __syncthreads();
    }
}

DEV bf16x8 cvt8(const float* p, float sc) {
    const f32x4 a = *(const f32x4*)p, b = *(const f32x4*)(p + 4);
    u32x4 w; w.x = cvtpk(a.x * sc, a.y * sc); w.y = cvtpk(a.z * sc, a.w * sc); w.z = cvtpk(b.x * sc, b.y * sc); w.w = cvtpk(b.z * sc, b.w * sc);
    return __builtin_bit_cast(bf16x8, w);
}
DEV void s_attn_part(const FP& p, LAS unsigned char* lds, int bid, int G) {
    const int lane = threadIdx.x & 63, wave = __builtin_amdgcn_readfirstlane(threadIdx.x >> 6), r = lane & 31, hh = lane >> 5;
    const float* q = (const float*)(p.ws + WS_SMP + SB_Q); const float* kn = p.out + 34871296; const float* vn = p.out + 34936832; const float* kp = p.in[2]; const float* vp = p.in[3];
    float* aml = (float*)(p.ws + WS_SMP + SB_AML); float* ao = (float*)(p.ws + WS_SMP + SB_AO);
    for (int it = bid + G * wave; it < 32 * N_ATILE; it += 8 * G) {
        const int bh = it / N_ATILE, tile = it % N_ATILE, b = bh >> 2, h = bh & 3;
        f32x16 S[2][2];
#pragma unroll
        for (int c = 0; c < 2; ++c)
#pragma unroll
            for (int sub = 0; sub < 2; ++sub)
#pragma unroll
                for (int i = 0; i < 16; ++i) S[c][sub][i] = 0.f;
        const float* qrow = q + (size_t)(b * 16 + (r & 15)) * 512 + h * 128 + 8 * hh;
#pragma unroll
        for (int sub = 0; sub < 2; ++sub) {
            int kk = tile * 64 + sub * 32 + r; if (kk > 2063) kk = 2063;
            const float* krow = ((kk < 2048) ? kp + (((size_t)b * 2048 + kk) * 4 + h) * 128 : kn + (((size_t)b * 16 + (kk - 2048)) * 4 + h) * 128) + 8 * hh;
#pragma unroll
            for (int c = 0; c < 2; ++c)
#pragma unroll
                for (int ks = 0; ks < 4; ++ks) S[c][sub] = mfma32(cvt8(krow + c * 64 + 16 * ks, 1.f), cvt8(qrow + c * 64 + 16 * ks, QSCALE), S[c][sub]);
        }
        bf16x8 P[2][4];
#pragma unroll
        for (int c = 0; c < 2; ++c) {
            float mx = -1e30f;
#pragma unroll
            for (int sub = 0; sub < 2; ++sub)
#pragma unroll
                for (int i = 0; i < 16; ++i) {
                    const int key = tile * 64 + sub * 32 + (i & 3) + 8 * (i >> 2) + 4 * hh;
                    if (key > 2063) S[c][sub][i] = -1e30f;
                    mx = fmaxf(mx, S[c][sub][i]);
                }
            mx = half_max(mx);
            float l = 0.f;
#pragma unroll
            for (int sub = 0; sub < 2; ++sub)
#pragma unroll
                for (int i = 0; i < 16; ++i) { S[c][sub][i] = __builtin_amdgcn_exp2f(S[c][sub][i] - mx); l += S[c][sub][i]; }
            l = half_sum(l);
            if (lane < 16) { aml[((size_t)it * 32 + lane * 2 + c) * 2] = mx * 0.6931471805599453f; aml[((size_t)it * 32 + lane * 2 + c) * 2 + 1] = l; }
            P[c][0] = pfrag(S[c][0], 0); P[c][1] = pfrag(S[c][0], 1); P[c][2] = pfrag(S[c][1], 0); P[c][3] = pfrag(S[c][1], 1);
        }
#pragma unroll 1
        for (int eb = 0; eb < 4; ++eb) {
            f32x16 O0, O1;
#pragma unroll
            for (int i = 0; i < 16; ++i) { O0[i] = 0.f; O1[i] = 0.f; }
#pragma unroll
            for (int st = 0; st < 4; ++st) {
                float vv[8];
#pragma unroll
                for (int jj = 0; jj < 8; ++jj) {
                    int kj = tile * 64 + 16 * st + 8 * (jj >> 2) + 4 * hh + (jj & 3); if (kj > 2063) kj = 2063;
                    const float* vrow = (kj < 2048) ? vp + (((size_t)b * 2048 + kj) * 4 + h) * 128 : vn + (((size_t)b * 16 + (kj - 2048)) * 4 + h) * 128;
                    vv[jj] = vrow[eb * 32 + r];
                }
                u32x4 w; w.x = cvtpk(vv[0], vv[1]); w.y = cvtpk(vv[2], vv[3]); w.z = cvtpk(vv[4], vv[5]); w.w = cvtpk(vv[6], vv[7]);
                const bf16x8 vf = __builtin_bit_cast(bf16x8, w);
                O0 = mfma32(vf, P[0][st], O0); O1 = mfma32(vf, P[1][st], O1);
            }
            if (r < 16) {
#pragma unroll
                for (int g4 = 0; g4 < 4; ++g4) {
                    const int e0 = eb * 32 + 8 * g4 + 4 * hh;
                    *(f32x4*)(ao + ((size_t)it * 32 + r * 2 + 0) * 128 + e0) = (f32x4){O0[4 * g4], O0[4 * g4 + 1], O0[4 * g4 + 2], O0[4 * g4 + 3]};
                    *(f32x4*)(ao + ((size_t)it * 32 + r * 2 + 1) * 128 + e0) = (f32x4){O1[4 * g4], O1[4 * g4 + 1], O1[4 * g4 + 2], O1[4 * g4 + 3]};
                }
            }
        }
    }
}
DEV void s_attn_comb(const FP& p, int bid, int G, int rot) {
    const int lane = threadIdx.x & 63, wave = __builtin_amdgcn_readfirstlane(threadIdx.x >> 6);
    const float* aml = (const float*)(p.ws + WS_SMP + SB_AML); const float* ao = (const float*)(p.ws + WS_SMP + SB_AO); const float* ypre = (const float*)(p.ws + WS_SMP + SB_YPRE);
    bf16_t* cat = (bf16_t*)(p.ws + WS_SMP + SB_CAT);
    const float lam_init = 0.2f;
    const float lam = expf(wave_sum(p.in[16][lane] * p.in[17][lane])) - expf(wave_sum(p.in[18][lane] * p.in[19][lane])) + lam_init;
    const int blk = (bid + G - rot) % G;
    for (int it = blk + G * wave; it < 512 + 256; it += 8 * G) {
        if (it < 512) {
            const int bh = it >> 4, qi = it & 15, b = bh >> 2, h = bh & 3;
            float o[2][2];
#pragma unroll
            for (int c = 0; c < 2; ++c) {
                const float mj = (lane < N_ATILE) ? aml[((size_t)(bh * N_ATILE + lane) * 32 + qi * 2 + c) * 2] : -1e30f;
                const float lj = (lane < N_ATILE) ? aml[((size_t)(bh * N_ATILE + lane) * 32 + qi * 2 + c) * 2 + 1] : 0.f;
                const float M = wave_max(mj), wj = expf(mj - M), L = wave_sum(lj * wj);
                float ax = 0.f, ay = 0.f;
#pragma unroll 11
                for (int j = 0; j < N_ATILE; ++j) {
                    const float w = __shfl(wj, j);
                    const float2 v = ((const float2*)(ao + ((size_t)(bh * N_ATILE + j) * 32 + qi * 2 + c) * 128))[lane];
                    ax += w * v.x; ay += w * v.y;
                }
                o[c][0] = ax / L; o[c][1] = ay / L;
            }
            const float ox = o[0][0] - lam * o[1][0], oy = o[0][1] - lam * o[1][1];
            const float ms = wave_sum(ox * ox + oy * oy) * (1.f / 128.f);
            const float rs = rsqrtf(ms + 1e-5f) * (1.f - lam_init);
            const float2 w = ((const float2*)p.in[20])[lane];
            ((unsigned*)(cat + (size_t)(b * 16 + qi) * 1024 + 512 + h * 128))[lane] = pk2(ox * rs * w.x, oy * rs * w.y);
        } else {
            const int i2 = it - 512, row = i2 >> 1, g = i2 & 1;
            const f32x4 v = ((const f32x4*)(ypre + (size_t)row * 512 + g * 256))[lane];
            const float rs = rsqrtf(wave_sum(v.x * v.x + v.y * v.y + v.z * v.z + v.w * v.w) * (1.f / 256.f) + 1e-5f);
            const f32x4 ww = ((const f32x4*)(p.in[15] + g * 256))[lane];
            u32x2 o; o.x = pk2(v.x * rs * ww.x, v.y * rs * ww.y); o.y = pk2(v.z * rs * ww.z, v.w * rs * ww.w);
            ((u32x2*)(cat + (size_t)row * 1024 + g * 256))[lane] = o;
        }
    }
}
DEV void s_xattn_part(const FP& p, LAS unsigned char* lds, int bid, int G, int rot) {
    const int lane = threadIdx.x & 63, wave = __builtin_amdgcn_readfirstlane(threadIdx.x >> 6), r = lane & 31, hh = lane >> 5;
    const float* qx = (const float*)(p.ws + WS_SMP + SB_QX); const float* mk = p.in[6]; const float* mv = p.in[7];
    float* xml = (float*)(p.ws + WS_SMP + SB_XML); float* xo = (float*)(p.ws + WS_SMP + SB_XO);
    const int blk = (bid + G - rot) % G;
    for (int it = blk + G * wave; it < 128; it += 8 * G) {
        const int bh = it >> 2, tile = it & 3, b = bh >> 2, h = bh & 3;
        f32x16 S[2];
#pragma unroll
        for (int sub = 0; sub < 2; ++sub)
#pragma unroll
            for (int i = 0; i < 16; ++i) S[sub][i] = 0.f;
        const float* qrow = qx + (size_t)(b * 16 + (r & 15)) * 1024 + h * 256 + 8 * hh;
#pragma unroll 4
        for (int ks = 0; ks < 16; ++ks) {
            const bf16x8 qf = cvt8(qrow + 16 * ks, 0.0625f * 1.4426950408889634f);
#pragma unroll
            for (int sub = 0; sub < 2; ++sub) {
                const float* krow = mk + (((size_t)b * 256 + tile * 64 + sub * 32 + r) * 4 + h) * 256 + 8 * hh;
                S[sub] = mfma32(cvt8(krow + 16 * ks, 1.f), qf, S[sub]);
            }
        }
        float mx = half_max(fmaxf(max16(S[0]), max16(S[1])));
        float l = 0.f;
#pragma unroll
        for (int sub = 0; sub < 2; ++sub)
#pragma unroll
            for (int i = 0; i < 16; ++i) { S[sub][i] = __builtin_amdgcn_exp2f(S[sub][i] - mx); l += S[sub][i]; }
        l = half_sum(l);
        if (lane < 16) { xml[((size_t)it * 16 + lane) * 2] = mx * 0.6931471805599453f; xml[((size_t)it * 16 + lane) * 2 + 1] = l; }
        bf16x8 P[4];
        P[0] = pfrag(S[0], 0); P[1] = pfrag(S[0], 1); P[2] = pfrag(S[1], 0); P[3] = pfrag(S[1], 1);
#pragma unroll 1
        for (int eb = 0; eb < 8; ++eb) {
            f32x16 O;
#pragma unroll
            for (int i = 0; i < 16; ++i) O[i] = 0.f;
#pragma unroll
            for (int st = 0; st < 4; ++st) {
                float vv[8];
#pragma unroll
                for (int jj = 0; jj < 8; ++jj) {
                    const int kj = tile * 64 + 16 * st + 8 * (jj >> 2) + 4 * hh + (jj & 3);
                    vv[jj] = mv[(((size_t)b * 256 + kj) * 4 + h) * 256 + eb * 32 + r];
                }
                u32x4 w; w.x = cvtpk(vv[0], vv[1]); w.y = cvtpk(vv[2], vv[3]); w.z = cvtpk(vv[4], vv[5]); w.w = cvtpk(vv[6], vv[7]);
                O = mfma32(__builtin_bit_cast(bf16x8, w), P[st], O);
            }
            if (r < 16) {
#pragma unroll
                for (int g4 = 0; g4 < 4; ++g4) *(f32x4*)(xo + ((size_t)it * 16 + r) * 256 + eb * 32 + 8 * g4 + 4 * hh) = (f32x4){O[4 * g4], O[4 * g4 + 1], O[4 * g4 + 2], O[4 * g4 + 3]};
            }
        }
    }
}
DEV void s_xattn_comb(const FP& p, int bid, int G, int rot) {
    const int lane = threadIdx.x & 63, wave = __builtin_amdgcn_readfirstlane(threadIdx.x >> 6);
    const float* xml = (const float*)(p.ws + WS_SMP + SB_XML); const float* xo = (const float*)(p.ws + WS_SMP + SB_XO);
    bf16_t* ox = (bf16_t*)(p.ws + WS_SMP + SB_OX);
    const int blk = (bid + G - rot) % G;
    for (int it = blk + G * wave; it < 512; it += 8 * G) {
        const int bh = it >> 4, qi = it & 15, b = bh >> 2, h = bh & 3;
        float m[4], l[4];
#pragma unroll
        for (int j = 0; j < 4; ++j) { m[j] = xml[((size_t)(bh * 4 + j) * 16 + qi) * 2]; l[j] = xml[((size_t)(bh * 4 + j) * 16 + qi) * 2 + 1]; }
        const float M = fmaxf(fmaxf(m[0], m[1]), fmaxf(m[2], m[3]));
        float L = 0.f; f32x4 acc = {0.f, 0.f, 0.f, 0.f};
#pragma unroll
        for (int j = 0; j < 4; ++j) { const float w = expf(m[j] - M); L += l[j] * w; acc += ((const f32x4*)(xo + ((size_t)(bh * 4 + j) * 16 + qi) * 256))[lane] * w; }
        const float il = 1.f / L;
        u32x2 o; o.x = pk2(acc.x * il, acc.y * il); o.y = pk2(acc.z * il, acc.w * il);
        ((u32x2*)(ox + (size_t)(b * 16 + qi) * 1024 + h * 256))[lane] = o;
    }
}

namespace cg = cooperative_groups;


DEV unsigned long long rf64(unsigned long long v) {
    const unsigned lo = __builtin_amdgcn_readfirstlane((unsigned)v), hi = __builtin_amdgcn_readfirstlane((unsigned)(v >> 32));
    return ((unsigned long long)hi << 32) | lo;
}
DEV FP fp_from_lds(const LAS unsigned long long* tab) {
    asm volatile("" ::: "memory");
    FP q;
#pragma unroll
    for (int i = 0; i < 36; ++i) q.in[i] = (const float*)rf64(tab[i]);
    q.out = (float*)rf64(tab[36]); q.ws = (unsigned char*)rf64(tab[37]);
    return q;
}

constexpr int CW_TEAM = 8192, CW_QUEUE = 4160;
constexpr int TEAM = 64;
DEV void sample_chain(const FP& p, LAS unsigned char* lds, int tb, int T, const XcdBarrier& tbar) {
    unsigned char* sb = p.ws + WS_SMP;
    float* ys = p.out + 16777216; const float* xs = p.in[1];
    s_gemm((const bf16_t*)(sb + SB_XN), (const bf16_t*)(p.ws + WS_W_IN), 3072, 1024, lds, tb, T, 0,
           EpiSIn{(float*)(sb + SB_Z), (float*)(sb + SB_XBC), (float*)(sb + SB_Q), p.out + 34871296, p.out + 34936832, p.out + 35526656});
    xcd_barrier(tbar);
    s_ssd(p, lds, tb, T, 0);
    s_attn_part(p, lds, tb, T);
    xcd_barrier(tbar);
    s_attn_comb(p, tb, T, 0);
    xcd_barrier(tbar);
    s_gemm((const bf16_t*)(sb + SB_CAT), (const bf16_t*)(p.ws + WS_W_OUT), 1024, 1024, lds, tb, T, 0, EpiSF32{(float*)(sb + SB_MIX), 1024, 1.f});
    xcd_barrier(tbar);
    s_row(p, (const float*)(sb + SB_MIX), xs, p.in[28], ys, p.in[29], (bf16_t*)(sb + SB_XN), nullptr, tb, T, 0);
    xcd_barrier(tbar);
    s_gemm((const bf16_t*)(sb + SB_XN), (const bf16_t*)(p.ws + WS_W_Q), 1024, 1024, lds, tb, T, 0, EpiSF32{(float*)(sb + SB_QX), 1024, 1.f});
    xcd_barrier(tbar);
    s_xattn_part(p, lds, tb, T, 0);
    xcd_barrier(tbar);
    s_xattn_comb(p, tb, T, 0);
    xcd_barrier(tbar);
    s_gemm((const bf16_t*)(sb + SB_OX), (const bf16_t*)(p.ws + WS_W_O), 1024, 1024, lds, tb, T, 0, EpiSF32{(float*)(sb + SB_MIX), 1024, 1.f});
    xcd_barrier(tbar);
    s_row(p, (const float*)(sb + SB_MIX), ys, p.in[30], ys, p.in[31], (bf16_t*)(sb + SB_XN), nullptr, tb, T, 0);
    xcd_barrier(tbar);
    s_gemm((const bf16_t*)(sb + SB_XN), (const bf16_t*)(p.ws + WS_W_GU), 5632, 1024, lds, tb, T, 0, EpiSSwiglu{(bf16_t*)(sb + SB_HID)});
    xcd_barrier(tbar);
    s_gemm((const bf16_t*)(sb + SB_HID), (const bf16_t*)(p.ws + WS_W_DOWN), 1024, 2816, lds, tb, T, 0, EpiSF32{(float*)(sb + SB_MIX), 1024, 1.f});
    xcd_barrier(tbar);
    s_row(p, (const float*)(sb + SB_MIX), ys, p.in[32], ys, nullptr, nullptr, nullptr, tb, T, 0);
    __syncthreads();
}
DEV void p3_queue(const FP& p, LAS unsigned char* lds, int bid) {
    unsigned* qh = (unsigned*)(p.ws + WS_CTL) + CW_QUEUE;
    volatile LAS int* slot = (volatile LAS int*)(lds + LDS_BYTES - 32);
    const AttnCtx ctx = attn_setup(p, lds);
    for (;;) {
        __syncthreads();
        if (threadIdx.x == 0) {
            int u = -1;
            for (int k = 0; k < 8 && u < 0; ++k) {
                const int q = (bid + k) & 7;
                const unsigned v = __hip_atomic_fetch_add(qh + 64 * q, 1u, __ATOMIC_RELAXED, __HIP_MEMORY_SCOPE_AGENT);
                if (v < 82u) u = q * 82 + (int)v;
            }
            slot[0] = u;
        }
        __syncthreads();
        const int u = slot[0];
        if (u < 0) break;
        const int q = u / 82, v = u % 82;
        if (v < 16) ssd2_item(p, q * 16 + v);
        else if (v < 18) memkv_unit(p, lds, q * 2 + (v - 16));
        else attn_unit(p, lds, ctx, q, 63 - (v - 18));
    }
}
__global__ void __launch_bounds__(512, 2) k_mega(FP p0) {
    extern __shared__ __attribute__((aligned(16))) unsigned char lds_raw[];
    LAS unsigned char* lds = (LAS unsigned char*)lds_raw;
    const int G = gridDim.x, bid = blockIdx.x, ngw = G * 8;
#define IDS() int tid_ = threadIdx.x; asm volatile("" : "+v"(tid_)); const int lane = tid_ & 63, wave = __builtin_amdgcn_readfirstlane(tid_ >> 6), gw = bid * 8 + wave; (void)lane; (void)gw
    LAS unsigned long long* tab = (LAS unsigned long long*)(lds + LDS_BYTES - 512);
    if (threadIdx.x < 36) tab[threadIdx.x] = (unsigned long long)p0.in[threadIdx.x];
    if (threadIdx.x == 36) tab[36] = (unsigned long long)p0.out;
    if (threadIdx.x == 37) tab[37] = (unsigned long long)p0.ws;
#define PH(...) do { const FP p = fp_from_lds(tab); float* y = p.out; unsigned char* sb = p.ws + WS_SMP; (void)y; (void)sb; __VA_ARGS__ } while (0)
    volatile LAS unsigned* MISC = (volatile LAS unsigned*)(lds + LDS_BYTES - 64);
    if (threadIdx.x < 16) MISC[threadIdx.x] = 0u;
    __syncthreads();
    XcdBarrier bar = xcd_barrier_post((unsigned*)(p0.ws + WS_CTL), MISC);
    PH( { IDS(); phase_prep_x(p, lds, gw, ngw, wave, lane); phase_prep_ffn(p, lds, gw, ngw, wave, lane); phase_prep_mix(p, lds, gw, ngw, wave, lane); } );
    PH( s_row(p, nullptr, p.in[1], nullptr, nullptr, p.in[27], (bf16_t*)(sb + SB_XN), (float*)(sb + SB_DTV), bid, G, 0); );
    xcd_barrier(bar);
    PH( phase_inproj(p, lds, G, bid); );
    xcd_barrier(bar);
    PH( phase_ssd1(p, lds, G, bid); );
    xcd_barrier(bar);
    PH( { const int T = (G >= 2 * TEAM) ? TEAM : 1; if (bid >= G - T) { XcdBarrier tbar = xcd_barrier_post((unsigned*)(p.ws + WS_CTL) + CW_TEAM, (volatile LAS unsigned*)(lds + LDS_BYTES - 48), (unsigned)T); sample_chain(p, lds, bid - (G - T), T, tbar); } } );
    PH( p3_queue(p, lds, bid); );
    xcd_barrier(bar);
    PH( phase_ssd3(p, lds, G, bid); );
    xcd_barrier(bar);
    PH( phase_outproj(p, lds, G, bid); );
    xcd_barrier(bar);
    PH( { IDS(); row_phase((const bf16_t*)(p.ws + WS_RAW), p.in[0], p.in[28], y, p.in[29], (bf16_t*)(p.ws + WS_XN), MP, gw, ngw, lane); } );
    xcd_barrier(bar);
    PH( phase_wq(p, lds, G, bid); );
    xcd_barrier(bar);
    PH( phase_xattn(p, lds, G, bid); );
    xcd_barrier(bar);
    PH( phase_wo(p, lds, G, bid); );
    xcd_barrier(bar);
    PH( { IDS(); row_phase((const bf16_t*)(p.ws + WS_RAW), y, p.in[30], y, p.in[31], (bf16_t*)(p.ws + WS_XN), MP, gw, ngw, lane); } );
    xcd_barrier(bar);
    PH( phase_ffn_gu(p, lds, G, bid); );
    xcd_barrier(bar);
    PH( phase_ffn_down(p, lds, G, bid); );
    xcd_barrier(bar);
    PH( { IDS(); row_phase((const bf16_t*)(p.ws + WS_RAW), y, p.in[32], y, nullptr, nullptr, MP, gw, ngw, lane); } );
}

extern "C" void kernel_launch(void* const* d_in, const int* in_sizes, int n_in, void* d_out, int out_size, void* d_ws, size_t ws_size, hipStream_t stream) {
    static int grid = 0;
    if (!grid) {
        int dev = 0, cus = 0, per_cu = 0;
        (void)hipGetDevice(&dev);
        (void)hipDeviceGetAttribute(&cus, hipDeviceAttributeMultiprocessorCount, dev);
        (void)hipFuncSetAttribute((const void*)k_mega, hipFuncAttributeMaxDynamicSharedMemorySize, LDS_BYTES);
        (void)hipOccupancyMaxActiveBlocksPerMultiprocessor(&per_cu, (const void*)k_mega, 512, LDS_BYTES);
        if (per_cu < 1) per_cu = 1;
        grid = cus * per_cu;
        if (grid > 256) grid = 256;
        if (n_in != 36 || ws_size < 256 * MiB) fprintf(stderr, "kernel_launch: unexpected n_in %d / ws_size %zu\n", n_in, ws_size);
    }
    (void)hipMemsetAsync((unsigned char*)d_ws + WS_CTL, 0, 65536, stream);
    FP p{};
    for (int i = 0; i < 36; ++i) p.in[i] = (const float*)d_in[i];
    p.out = (float*)d_out; p.ws = (unsigned char*)d_ws;
    void* args[] = {&p};
    hipError_t e = hipLaunchCooperativeKernel((const void*)k_mega, dim3(grid), dim3(512), args, LDS_BYTES, stream);
    if (e != hipSuccess) fprintf(stderr, "cooperative launch failed: %s (grid %d)\n", hipGetErrorString(e), grid);
}
```

```cpp
#include <hip/hip_runtime.h>
#include <cstdint>
#include <cstdio>
#include <hip/hip_cooperative_groups.h>

#define DEV static __device__ __forceinline__
#define LAS __attribute__((address_space(3)))
#define WAVE_SYNC() asm volatile("s_waitcnt lgkmcnt(0)" ::: "memory")

DEV float wave_sum(float v) {
#pragma unroll
    for (int o = 32; o > 0; o >>= 1) v += __shfl_xor(v, o);
    return v;
}
DEV float wave_max(float v) {
#pragma unroll
    for (int o = 32; o > 0; o >>= 1) v = fmaxf(v, __shfl_xor(v, o));
    return v;
}
typedef float nf4 __attribute__((ext_vector_type(4)));
DEV float4 lds_ld4(const LAS float* p) { const nf4 v = *(const LAS nf4*)p; float4 r; r.x = v[0]; r.y = v[1]; r.z = v[2]; r.w = v[3]; return r; }
DEV float silu_f(float x) { return x / (1.f + expf(-x)); }


typedef unsigned short bf16_t;
typedef float f32x4 __attribute__((ext_vector_type(4)));
typedef float f32x16 __attribute__((ext_vector_type(16)));
typedef short bf16x8 __attribute__((ext_vector_type(8)));
typedef short s16x4 __attribute__((ext_vector_type(4)));
typedef unsigned u32x4 __attribute__((ext_vector_type(4)));
typedef unsigned u32x2 __attribute__((ext_vector_type(2)));

constexpr size_t MiB = 1u << 20;
constexpr size_t WS_W_IN = 0, WS_W_OUT = 6 * MiB, WS_W_Q = 8 * MiB, WS_W_KV = 10 * MiB, WS_W_O = 14 * MiB, WS_W_GU = 16 * MiB, WS_W_DOWN = 27 * MiB;
constexpr size_t WS_CTL = 33 * MiB, WS_DTV = 34 * MiB, WS_CDEC = 34 * MiB + 512 * 1024, WS_MN = 35 * MiB;
constexpr size_t WS_XN = 36 * MiB, WS_CAT = 68 * MiB, WS_QX = 68 * MiB, WS_Q = 100 * MiB, WS_K = 116 * MiB, WS_RAW = 100 * MiB;
constexpr size_t WS_ZX = 132 * MiB, WS_OX = 132 * MiB, WS_V = 180 * MiB, WS_ST = 196 * MiB, WS_HID = 132 * MiB, WS_KM = 228 * MiB, WS_VM = 229 * MiB, WS_SMP = 230 * MiB;
constexpr int MP = 16384;
constexpr int LDS_BYTES = 147456;

DEV unsigned f2bf(float f) { unsigned u = __builtin_bit_cast(unsigned, f); return (u + 0x7fffu + ((u >> 16) & 1u)) >> 16; }
DEV unsigned pk2(float lo, float hi) { return f2bf(lo) | (f2bf(hi) << 16); }
DEV float bflo(unsigned w) { return __builtin_bit_cast(float, w << 16); }
DEV float bfhi(unsigned w) { return __builtin_bit_cast(float, w & 0xffff0000u); }
DEV float fast_silu(float x) { return x * __builtin_amdgcn_rcpf(1.f + __builtin_amdgcn_exp2f(-1.4426950408889634f * x)); }

struct FP {
    const float* in[36];
    float* out;
    unsigned char* ws;
};

template <class RowMap>
DEV void transpose_item(const float* W, int K, int N, bf16_t* WT, int item, LAS float* scr, int lane, RowMap rm) {
    const int nblk = (N + 31) / 32, kb = item / nblk, nb = item % nblk, k0 = 64 * kb, n0 = 32 * nb;
    const int ncol = n0 + (lane & 31);
#pragma unroll 8
    for (int i = 0; i < 32; ++i) { const int kk = 2 * i + (lane >> 5); scr[kk * 33 + (lane & 31)] = (ncol < N) ? W[(size_t)(k0 + kk) * N + ncol] : 0.f; }
    WAVE_SYNC();
    const int c = lane & 7;
#pragma unroll
    for (int j = 0; j < 4; ++j) {
        const int n = (lane >> 3) + 8 * j; const LAS float* s = scr + (8 * c) * 33 + n;
        const int src = n0 + n; const int dst = (src < N) ? rm(src) : -1;
        u32x4 o; o.x = pk2(s[0 * 33], s[1 * 33]); o.y = pk2(s[2 * 33], s[3 * 33]); o.z = pk2(s[4 * 33], s[5 * 33]); o.w = pk2(s[6 * 33], s[7 * 33]);
        if (dst >= 0) *(u32x4*)(WT + (size_t)dst * K + k0 + 8 * c) = o;
    }
    WAVE_SYNC();
}
struct RmPlain { int off; __device__ __forceinline__ int operator()(int n) const { return off + n; } };
struct RmGU { int up; __device__ __forceinline__ int operator()(int n) const { return 32 * (n >> 4) + 16 * up + (n & 15); } };
struct RmIn {
    __device__ __forceinline__ int operator()(int n) const {
        if (n < 1536) return n;
        if (n < 1544) return -1;
        const int m = n - 1544;
        if (m < 1024) { const int u = m >> 6, d = m & 63; return 1536 + 64 * u + 32 * ((d & 31) >> 4) + 16 * (d >> 5) + (d & 15); }
        return 1536 + m;
    }
};

DEV void row_phase(const bf16_t* raw, const float* hin, const float* gpost, float* hout, const float* gpre, bf16_t* xn, int M, int gw, int ngw, int lane) {
    for (int r = gw; r < M; r += ngw) {
        f32x4 h[4];
#pragma unroll
        for (int j = 0; j < 4; ++j) h[j] = ((const f32x4*)(hin + (size_t)r * 1024))[lane + 64 * j];
        if (raw) {
            f32x4 v[4]; float ss = 0.f;
#pragma unroll
            for (int j = 0; j < 4; ++j) {
                const u32x2 w = ((const u32x2*)(raw + (size_t)r * 1024))[lane + 64 * j];
                v[j] = (f32x4){bflo(w.x), bfhi(w.x), bflo(w.y), bfhi(w.y)};
                ss += v[j].x * v[j].x + v[j].y * v[j].y + v[j].z * v[j].z + v[j].w * v[j].w;
            }
            const float rs = rsqrtf(wave_sum(ss) * (1.f / 1024.f) + 1e-6f);
#pragma unroll
            for (int j = 0; j < 4; ++j) { const f32x4 g = ((const f32x4*)gpost)[lane + 64 * j]; h[j] += v[j] * rs * g; }
        }
        if (hout) {
#pragma unroll
            for (int j = 0; j < 4; ++j) ((f32x4*)(hout + (size_t)r * 1024))[lane + 64 * j] = h[j];
        }
        if (gpre) {
            float ss = 0.f;
#pragma unroll
            for (int j = 0; j < 4; ++j) ss += h[j].x * h[j].x + h[j].y * h[j].y + h[j].z * h[j].z + h[j].w * h[j].w;
            const float rs = rsqrtf(wave_sum(ss) * (1.f / 1024.f) + 1e-6f);
#pragma unroll
            for (int j = 0; j < 4; ++j) {
                const f32x4 g = ((const f32x4*)gpre)[lane + 64 * j]; const f32x4 o = h[j] * rs * g;
                u32x2 w; w.x = pk2(o.x, o.y); w.y = pk2(o.z, o.w);
                ((u32x2*)(xn + (size_t)r * 1024))[lane + 64 * j] = w;
            }
        }
    }
}


#define RLX_AGENT __ATOMIC_RELAXED, __HIP_MEMORY_SCOPE_AGENT
#define LDS_WAIT() asm volatile("s_waitcnt lgkmcnt(0)" ::: "memory")
#define VM_WAIT() asm volatile("s_waitcnt vmcnt(0)" ::: "memory")
__device__ __forceinline__ unsigned long long rt() { return __builtin_amdgcn_s_memrealtime(); }
#define XB_TMO      128
#define XB_XCNT(j)  (256  + 64 * (j))
#define XB_XSUB(j)  (1280 + 64 * (j))
#define XB_XGEN(j)  (2304 + 64 * (j))
#define XB_TOP      3328
#define XB_TOPGEN   3392
#define XCD_BAR_WORDS 3456
#define XB_SPIN_CAP (1u << 18)

__device__ __forceinline__ unsigned xb_ld(unsigned* p)              { return __hip_atomic_load(p, __ATOMIC_RELAXED, __HIP_MEMORY_SCOPE_AGENT); }
__device__ __forceinline__ unsigned xb_add(unsigned* p, unsigned v) { return __hip_atomic_fetch_add(p, v, __ATOMIC_RELAXED, __HIP_MEMORY_SCOPE_AGENT); }
__device__ __forceinline__ unsigned xb_xcc_id() { return (unsigned)__builtin_amdgcn_s_getreg((3 << 11) | 20) & 0xFu; }
#define XB_SPIN(cond, bar) do { unsigned _sp = 0; while (cond) { __builtin_amdgcn_s_sleep(1); \
    if ((++_sp & 255u) == 0u) { if (xb_ld(&(bar)[XB_TMO])) break; if (_sp > XB_SPIN_CAP) { atomicAdd(&(bar)[XB_TMO], 1u); break; } } } } while (0)

struct XcdBarrier {
    unsigned* bar; unsigned x; unsigned total;
    volatile LAS unsigned* st;
};

__device__ __forceinline__ XcdBarrier xcd_barrier_post(unsigned* bar, volatile LAS unsigned* st, unsigned total = 0u) {
    XcdBarrier b; b.bar = bar; b.x = xb_xcc_id(); b.st = st; b.total = total;
    if (threadIdx.x == 0) (void)xb_add(&bar[XB_XCNT(b.x)], 1u);
    return b;
}
__device__ __forceinline__ void xcd_barrier_complete(unsigned* bar, unsigned x, unsigned& nloc, unsigned& nx, unsigned total) {
    const unsigned G = total ? total : gridDim.x * gridDim.y * gridDim.z;
    unsigned sum, cnt, mine, sp = 0u;
    for (;;) {
        sum = 0u; cnt = 0u; mine = 0u;
#pragma unroll
        for (unsigned j = 0; j < 16; ++j) { const unsigned c = xb_ld(&bar[XB_XCNT(j)]); sum += c; cnt += (c > 0u) ? 1u : 0u; mine = (j == x) ? c : mine; }
        if (sum == G) break;
        __builtin_amdgcn_s_sleep(1);
        if ((++sp & 255u) == 0u) { if (xb_ld(&bar[XB_TMO])) break; if (sp > XB_SPIN_CAP) { atomicAdd(&bar[XB_TMO], 1u); break; } }
    }
    nloc = mine > 0u ? mine : 1u; nx = cnt > 0u ? cnt : 1u;
}

__device__ __forceinline__ void xcd_barrier(const XcdBarrier& b) {
    asm volatile("s_waitcnt vmcnt(0)" ::: "memory");
    __syncthreads();
    if (threadIdx.x == 0) {
        unsigned* bar = b.bar;
        __builtin_amdgcn_s_waitcnt(0);
        unsigned nloc = b.st[0], nx = b.st[1];
        if (nloc == 0u) { xcd_barrier_complete(bar, b.x, nloc, nx, b.total); b.st[0] = nloc; b.st[1] = nx; }
        const unsigned old = xb_add(&bar[XB_XSUB(b.x)], 1u);
        const unsigned gen = old / nloc;
        if (old + 1u == (gen + 1u) * nloc) {
            __builtin_amdgcn_fence(__ATOMIC_RELEASE, "agent");
            asm volatile("s_waitcnt vmcnt(0)" ::: "memory");
            const unsigned og = xb_add(&bar[XB_TOP], 1u);
            const unsigned tg = og / nx;
            if (og + 1u == (tg + 1u) * nx) xb_add(&bar[XB_TOPGEN], 1u);
            else XB_SPIN(xb_ld(&bar[XB_TOPGEN]) == tg, bar);
            __builtin_amdgcn_fence(__ATOMIC_ACQUIRE, "agent");
            xb_add(&bar[XB_XGEN(b.x)], 1u);
            asm volatile("s_waitcnt vmcnt(0)" ::: "memory");
        } else {
            XB_SPIN(xb_ld(&bar[XB_XGEN(b.x)]) == gen, bar);
            __builtin_amdgcn_fence(__ATOMIC_ACQUIRE, "agent");
            asm volatile("s_waitcnt vmcnt(0)" ::: "memory");
        }
    }
    __syncthreads();
}
namespace pg8 {
#define PG8_LAS __attribute__((address_space(3)))
typedef unsigned short bf16_t;
typedef short bf16x8 __attribute__((ext_vector_type(8)));
typedef float f32x4 __attribute__((ext_vector_type(4)));
typedef unsigned u32x4 __attribute__((ext_vector_type(4)));
constexpr int BM = 256, BK = 64, HALF = 128, HTB = HALF * BK * 2  , STAGE_BYTES = 8 * HTB, NXCD = 8, WGM = 8;

__host__ __device__ __forceinline__ int lds_byte(int r, int c) { const int st = (r >> 4) * 2 + (c >> 5), rr = r & 15, cc = c & 31, ob = rr * 64 + cc * 2; return st * 1024 + (ob ^ (((ob >> 9) & 1) << 5)); }
__host__ __device__ __forceinline__ void stage_rc(int b, int& R, int& C) { const int st = b / 1024, sb = b % 1024, swz = sb ^ (((sb >> 9) & 1) << 5); R = (st >> 1) * 16 + swz / 64; C = (st & 1) * 32 + (swz % 64) / 2; }
__host__ __device__ __forceinline__ int perm32(int rho) { const int n = rho >> 4, i = rho & 15; return 8 * (i >> 2) + 4 * n + (i & 3); }

struct Unit { int pm, pn; };
struct Gemm { const bf16_t* A; const bf16_t* Bt; int M, N, K; };

struct StaticOrder {
    int nM, nN, nwg, G, c;
    __host__ __device__ void init(int M, int N, int G_, int c_) { nM = M / BM; nN = N / BM; nwg = nM * nN; G = G_; c = c_; }
    __host__ __device__ bool next(int i, Unit& u) const {
        const long L = (long)i * G + c; if (L >= nwg) return false;
        int wgid = (int)L; { const int q = nwg / NXCD, r = nwg % NXCD, xcd = wgid % NXCD, off = wgid / NXCD; wgid = (xcd < r ? xcd * (q + 1) : r * (q + 1) + (xcd - r) * q) + off; }
        const int nig = WGM * nN, gid = wgid / nig, fm = gid * WGM, gsz = (nM - fm) < WGM ? (nM - fm) : WGM;
        u.pm = fm + ((wgid % nig) % gsz); u.pn = (wgid % nig) / gsz; return true;
    }
    __device__ __forceinline__ void a_ready(const Unit&) const {}
    __device__ __forceinline__ void done(const Unit&) const {}
};

__device__ __forceinline__ unsigned cvt_pk_bf16(float lo, float hi) { unsigned r; asm volatile("v_cvt_pk_bf16_f32 %0, %1, %2" : "=v"(r) : "v"(lo), "v"(hi)); return r; }
typedef float f32x2 __attribute__((ext_vector_type(2)));
__device__ __forceinline__ f32x2 gelu_pk(f32x2 v) {
    const f32x2 av = __builtin_elementwise_abs(v), d = av * 0.2316418882f + 1.0f;
    f32x2 t; t.x = __builtin_amdgcn_rcpf(d.x); t.y = __builtin_amdgcn_rcpf(d.y);
    f32x2 q = t * 0.5307027145f + (-0.7265760135f); q = q * t + 0.7107068705f; q = q * t + (-0.142248368f); q = q * t + 0.127414796f; q = q * t;
    const f32x2 s = (v * v) * (-0.72134752044f);
    f32x2 e; e.x = __builtin_amdgcn_exp2f(s.x); e.y = __builtin_amdgcn_exp2f(s.y);
    const f32x2 m = v * (q * e), r = v - m;
    f32x2 o; o.x = v.x < 0.f ? m.x : r.x; o.y = v.y < 0.f ? m.y : r.y; return o;
}

template <int ACT  > struct EpiBf16 {
    static constexpr bool PERM = true, AFTER_DRAIN = false; static_assert(ACT == 0 || ACT == 1, "EpiBf16: ACT is 0 (none) or 1 (gelu_pk)");
    bf16_t* O; int ldc; const float* bias; int split_cols; size_t split_stride; float scale0;
    __device__ __forceinline__ void operator()(const f32x4 (&acc)[2][2][4][2], const Unit& u, int wr, int wc, int fr, int fq) const {
        const int row0 = u.pm * BM + wr * 64 + fr; int colt = u.pn * BM; bf16_t* base = O;
        float sc = 1.f; if (split_cols) { const int t = colt / split_cols; base += (size_t)t * split_stride; colt -= t * split_cols; if (t == 0) sc = scale0; }
        const int col0 = colt + wc * 32 + 8 * fq, bcol0 = u.pn * BM + wc * 32 + 8 * fq;
        f32x4 bv[2][2];
#pragma unroll
        for (int bj = 0; bj < 2; ++bj)
#pragma unroll
            for (int n = 0; n < 2; ++n) bv[bj][n] = bias ? *(const f32x4*)(bias + bcol0 + bj * HALF + 4 * n) : (f32x4){0.f, 0.f, 0.f, 0.f};
#pragma unroll
        for (int ai = 0; ai < 2; ++ai)
#pragma unroll
            for (int m = 0; m < 4; ++m) { bf16_t* rowp = base + (size_t)(row0 + ai * HALF + m * 16) * ldc + col0;
#pragma unroll
                for (int bj = 0; bj < 2; ++bj) { f32x4 v0 = acc[ai][bj][m][0] + bv[bj][0], v1 = acc[ai][bj][m][1] + bv[bj][1];
                    if (ACT == 1) { f32x2 a = gelu_pk((f32x2){v0[0], v0[1]}), b = gelu_pk((f32x2){v0[2], v0[3]}), c = gelu_pk((f32x2){v1[0], v1[1]}), d = gelu_pk((f32x2){v1[2], v1[3]});
                        v0 = (f32x4){a.x, a.y, b.x, b.y}; v1 = (f32x4){c.x, c.y, d.x, d.y}; }
                    v0 = v0 * sc; v1 = v1 * sc; u32x4 w; w.x = cvt_pk_bf16(v0[0], v0[1]); w.y = cvt_pk_bf16(v0[2], v0[3]); w.z = cvt_pk_bf16(v1[0], v1[1]); w.w = cvt_pk_bf16(v1[2], v1[3]);
                    *(u32x4*)(rowp + bj * HALF) = w; } }
    }
};
template <class Epi, class Sched, bool ALIGN_EPI = false, bool SP2 = false>
__device__ __forceinline__ void gemm_phase(PG8_LAS unsigned char* lds, const Gemm g, const Sched& S, const Epi& E) {
    int tid_l = threadIdx.x; asm volatile("" : "+v"(tid_l));
    const int tid = tid_l, wid = __builtin_amdgcn_readfirstlane(tid >> 6), lane = tid & 63, wr = wid >> 2, wc = wid & 3, fr = lane & 15, fq = lane >> 4;
    const int K = g.K, nt = K / BK;
    unsigned voffA[2], voffB[2];
#pragma unroll
    for (int i = 0; i < 2; ++i) { int R, C; stage_rc(tid * 16 + i * 8192, R, C); const int Rb = Epi::PERM ? ((R & ~31) + perm32(R & 31)) : R;
        voffA[i] = (unsigned)(R * K + C) * 2u; voffB[i] = (unsigned)(Rb * K + C) * 2u; }
    const size_t kstep = (size_t)(BK * 2);
    const size_t hstep = (size_t)HALF * K * 2;
    const size_t tstep = 2 * hstep;
    const unsigned ldsw = (unsigned)wid * 1024u;
    const int aoff = lds_byte(wr * 64 + fr, fq * 8), boff = lds_byte(wc * 32 + fr, fq * 8);
#define PG8_SA(b, h) (((b) * 2 + (h)) * HTB)
#define PG8_SB(b, h) ((4 + (b) * 2 + (h)) * HTB)
#define PG8_STAGE(bufoff, gbase, voff) do { _Pragma("unroll") for (int _i = 0; _i < 2; ++_i) \
        __builtin_amdgcn_global_load_lds((const unsigned*)((const char*)(gbase) + (voff)[_i]), (PG8_LAS unsigned*)(lds + (bufoff) + ldsw + _i * 8192), 16, 0, 0); } while (0)
#define PG8_LDA(dst, b, h) do { _Pragma("unroll") for (int m = 0; m < 4; ++m) _Pragma("unroll") for (int k = 0; k < 2; ++k) dst[m][k] = *(const PG8_LAS bf16x8*)(lds + PG8_SA(b, h) + aoff + m * 2048 + k * 1024); } while (0)
#define PG8_LDB(dst, b, h) do { _Pragma("unroll") for (int n = 0; n < 2; ++n) _Pragma("unroll") for (int k = 0; k < 2; ++k) dst[n][k] = *(const PG8_LAS bf16x8*)(lds + PG8_SB(b, h) + boff + n * 2048 + k * 1024); } while (0)
#define PG8_MMA(ai, bj, At, Bt) do { __builtin_amdgcn_s_setprio(1); _Pragma("unroll") for (int m = 0; m < 4; ++m) _Pragma("unroll") for (int n = 0; n < 2; ++n) _Pragma("unroll") for (int k = 0; k < 2; ++k) \
        acc[ai][bj][m][n] = __builtin_amdgcn_mfma_f32_16x16x32_bf16(Bt[n][k], At[m][k], acc[ai][bj][m][n], 0, 0, 0); __builtin_amdgcn_s_setprio(0); } while (0)
#define PG8_WAIT_V(n) asm volatile("s_waitcnt vmcnt(" #n ")" ::: "memory")
#define PG8_WAIT_L(n) asm volatile("s_waitcnt lgkmcnt(" #n ")" ::: "memory")
#define PG8_BAR __builtin_amdgcn_s_barrier()
#define PG8_SCHED __builtin_amdgcn_sched_barrier(0)
    Unit cur, nxt; int ui = 0;
    if (!S.next(0, cur)) return;
    f32x4 acc[2][2][4][2];
#pragma unroll
    for (int a = 0; a < 2; ++a)
#pragma unroll
        for (int b = 0; b < 2; ++b)
#pragma unroll
            for (int m = 0; m < 4; ++m)
#pragma unroll
                for (int n = 0; n < 2; ++n) acc[a][b][m][n] = (f32x4){0.f, 0.f, 0.f, 0.f};
    bf16x8 At[4][2], B0[2][2], B1[2][2];
    const char* cA = (const char*)g.A + (size_t)cur.pm * tstep; const char* cB = (const char*)g.Bt + (size_t)cur.pn * tstep;
    S.a_ready(cur);
    if constexpr (SP2) {
        PG8_STAGE(PG8_SB(0, 0), cB, voffB); PG8_STAGE(PG8_SB(0, 1), cB + hstep, voffB); PG8_STAGE(PG8_SA(0, 0), cA, voffA); PG8_STAGE(PG8_SA(0, 1), cA + hstep, voffA);
        if (wr == 1) PG8_BAR;
        PG8_WAIT_V(2); PG8_BAR;
        PG8_STAGE(PG8_SB(1, 0), cB + kstep, voffB); PG8_STAGE(PG8_SA(1, 0), cA + kstep, voffA); PG8_STAGE(PG8_SB(1, 1), cB + hstep + kstep, voffB);
        PG8_WAIT_V(6); PG8_BAR;
    } else {
        PG8_STAGE(PG8_SB(0, 0), cB, voffB); PG8_STAGE(PG8_SA(0, 0), cA, voffA); PG8_STAGE(PG8_SB(0, 1), cB + hstep, voffB); PG8_STAGE(PG8_SA(0, 1), cA + hstep, voffA);
        if (wr == 1) PG8_BAR;
        PG8_WAIT_V(4); PG8_BAR;
        PG8_STAGE(PG8_SB(1, 0), cB + kstep, voffB); PG8_STAGE(PG8_SA(1, 0), cA + kstep, voffA); PG8_STAGE(PG8_SB(1, 1), cB + hstep + kstep, voffB);
        PG8_WAIT_V(6); PG8_BAR;
    }
    for (;;) {
        const bool has_next = S.next(ui + 1, nxt);
        const char* nA = has_next ? (const char*)g.A + (size_t)nxt.pm * tstep : cA; const char* nB = has_next ? (const char*)g.Bt + (size_t)nxt.pn * tstep : cB;
        for (int t = 0; t < nt; t += 2) {
            const bool last = (t == nt - 2);
            const char* a1 = cA + (size_t)(t + 1) * kstep;
            const char* a2 = last ? nA : cA + (size_t)(t + 2) * kstep; const char* b2 = last ? nB : cB + (size_t)(t + 2) * kstep;
            const char* a3 = a2 + kstep; const char* b3 = b2 + kstep;
            if (last && has_next) S.a_ready(nxt);
            if constexpr (SP2) {
            PG8_LDB(B0, 0, 0); PG8_LDB(B1, 0, 1); PG8_SCHED; PG8_LDA(At, 0, 0); PG8_STAGE(PG8_SA(1, 1), a1 + hstep, voffA);
            PG8_WAIT_V(8); PG8_WAIT_L(0); PG8_BAR; PG8_MMA(0, 0, At, B0); PG8_MMA(0, 1, At, B1); PG8_BAR; PG8_SCHED;
            PG8_LDA(At, 0, 1); PG8_STAGE(PG8_SB(0, 0), b2, voffB); PG8_STAGE(PG8_SB(0, 1), b2 + hstep, voffB); PG8_STAGE(PG8_SA(0, 0), a2, voffA);
            PG8_WAIT_V(8); PG8_WAIT_L(0); PG8_BAR; PG8_MMA(1, 0, At, B0); PG8_MMA(1, 1, At, B1); PG8_BAR; PG8_SCHED;
            PG8_LDB(B0, 1, 0); PG8_LDB(B1, 1, 1); PG8_SCHED; PG8_LDA(At, 1, 0); PG8_STAGE(PG8_SA(0, 1), a2 + hstep, voffA);
            PG8_WAIT_V(8); PG8_WAIT_L(0); PG8_BAR; PG8_MMA(0, 0, At, B0); PG8_MMA(0, 1, At, B1); PG8_BAR; PG8_SCHED;
            PG8_LDA(At, 1, 1); PG8_STAGE(PG8_SB(1, 0), b3, voffB); PG8_STAGE(PG8_SB(1, 1), b3 + hstep, voffB); PG8_STAGE(PG8_SA(1, 0), a3, voffA);
            PG8_WAIT_V(8); PG8_WAIT_L(0); PG8_BAR; PG8_MMA(1, 0, At, B0); PG8_MMA(1, 1, At, B1); PG8_BAR; PG8_SCHED;
            } else {
            PG8_LDB(B0, 0, 0); PG8_SCHED; PG8_LDA(At, 0, 0); PG8_STAGE(PG8_SA(1, 1), a1 + hstep, voffA);
            PG8_WAIT_L(8); PG8_BAR; PG8_WAIT_L(0); PG8_MMA(0, 0, At, B0); PG8_BAR; PG8_SCHED;
            PG8_LDB(B1, 0, 1); PG8_STAGE(PG8_SB(0, 0), b2, voffB);
            PG8_BAR; PG8_WAIT_L(0); PG8_MMA(0, 1, At, B1); PG8_BAR;
            PG8_LDA(At, 0, 1); PG8_STAGE(PG8_SA(0, 0), a2, voffA);
            PG8_BAR; PG8_WAIT_L(0); PG8_MMA(1, 0, At, B0); PG8_BAR; PG8_SCHED;
            PG8_STAGE(PG8_SB(0, 1), b2 + hstep, voffB);
            PG8_WAIT_V(6); PG8_BAR; PG8_MMA(1, 1, At, B1); PG8_BAR;
            PG8_LDB(B0, 1, 0); PG8_SCHED; PG8_LDA(At, 1, 0); PG8_STAGE(PG8_SA(0, 1), a2 + hstep, voffA);
            PG8_WAIT_L(8); PG8_BAR; PG8_WAIT_L(0); PG8_MMA(0, 0, At, B0); PG8_BAR; PG8_SCHED;
            PG8_LDB(B1, 1, 1); PG8_STAGE(PG8_SB(1, 0), b3, voffB);
            PG8_BAR; PG8_WAIT_L(0); PG8_MMA(0, 1, At, B1); PG8_BAR;
            PG8_LDA(At, 1, 1); PG8_STAGE(PG8_SA(1, 0), a3, voffA);
            PG8_BAR; PG8_WAIT_L(0); PG8_MMA(1, 0, At, B0); PG8_BAR; PG8_SCHED;
            PG8_STAGE(PG8_SB(1, 1), b3 + hstep, voffB);
            PG8_WAIT_V(6); PG8_BAR; PG8_MMA(1, 1, At, B1); PG8_BAR;
            }
        }
        if constexpr (ALIGN_EPI) { if (wr == 0) PG8_BAR; }
        if constexpr (!Epi::AFTER_DRAIN) { E(acc, cur, wr, wc, fr, fq); S.done(cur); }
        if (!has_next) break;
#pragma unroll
        for (int a = 0; a < 2; ++a)
#pragma unroll
            for (int b = 0; b < 2; ++b)
#pragma unroll
                for (int m = 0; m < 4; ++m)
#pragma unroll
                    for (int n = 0; n < 2; ++n) acc[a][b][m][n] = (f32x4){0.f, 0.f, 0.f, 0.f};
        cur = nxt; cA = nA; cB = nB; ++ui;
        if constexpr (ALIGN_EPI) { if (wr == 1) PG8_BAR; }
    }
    PG8_WAIT_V(0);
    if constexpr (!ALIGN_EPI) { if (wr == 0) PG8_BAR; }
    PG8_BAR;
    if constexpr (Epi::AFTER_DRAIN) { E.fused(acc, cur, wr, wc, fr, fq, lds, wid, lane); S.done(cur); }
#undef PG8_SA
#undef PG8_SB
#undef PG8_STAGE
#undef PG8_LDA
#undef PG8_LDB
#undef PG8_MMA
#undef PG8_WAIT_V
#undef PG8_WAIT_L
#undef PG8_BAR
#undef PG8_SCHED
}
}

namespace pg8 {
struct EpiSwiglu {
    static constexpr bool PERM = false, AFTER_DRAIN = false;
    bf16_t* O; int ldo;
    __device__ __forceinline__ void operator()(const f32x4 (&acc)[2][2][4][2], const Unit& u, int wr, int wc, int fr, int fq) const {
        const int row0 = u.pm * BM + wr * 64 + fr;
#pragma unroll
        for (int ai = 0; ai < 2; ++ai)
#pragma unroll
            for (int m = 0; m < 4; ++m) {
                bf16_t* rowp = O + (size_t)(row0 + ai * HALF + m * 16) * ldo;
#pragma unroll
                for (int bj = 0; bj < 2; ++bj) {
                    const int grp = u.pn * 8 + bj * 4 + wc;
                    const f32x4 g = acc[ai][bj][m][0], up = acc[ai][bj][m][1];
                    const float h0 = fast_silu(g[0]) * up[0], h1 = fast_silu(g[1]) * up[1], h2 = fast_silu(g[2]) * up[2], h3 = fast_silu(g[3]) * up[3];
                    u32x2 w; w.x = cvt_pk_bf16(h0, h1); w.y = cvt_pk_bf16(h2, h3);
                    *(u32x2*)(rowp + grp * 16 + 4 * fq) = w;
                }
            }
    }
};
}

DEV void phase_prep_ffn(const FP& p, LAS unsigned char* lds, int gw, int ngw, int wave, int lane) {
    LAS float* scr = (LAS float*)(lds + wave * 16384);
    const float *wg = p.in[33], *wu = p.in[34], *wd = p.in[35];
    bf16_t* GU = (bf16_t*)(p.ws + WS_W_GU); bf16_t* DN = (bf16_t*)(p.ws + WS_W_DOWN);
    constexpr int I_G = 16 * 88, I_D = 44 * 32;
    for (int it = gw; it < 2 * I_G + I_D; it += ngw) {
        int r = it;
        if (r < I_G) { transpose_item(wg, 1024, 2816, GU, r, scr, lane, RmGU{0}); continue; } r -= I_G;
        if (r < I_G) { transpose_item(wu, 1024, 2816, GU, r, scr, lane, RmGU{1}); continue; } r -= I_G;
        transpose_item(wd, 2816, 1024, DN, r, scr, lane, RmPlain{0});
    }
}
DEV void phase_ffn_gu(const FP& p, LAS unsigned char* lds, int G, int bid) {
    pg8::Gemm g{(const bf16_t*)(p.ws + WS_XN), (const bf16_t*)(p.ws + WS_W_GU), MP, 5632, 1024};
    pg8::StaticOrder S; S.init(MP, 5632, G, bid);
    pg8::EpiSwiglu E{(bf16_t*)(p.ws + WS_HID), 2816};
    pg8::gemm_phase<pg8::EpiSwiglu, pg8::StaticOrder, true, true>(lds, g, S, E);
}
DEV void phase_ffn_down(const FP& p, LAS unsigned char* lds, int G, int bid) {
    pg8::Gemm g{(const bf16_t*)(p.ws + WS_HID), (const bf16_t*)(p.ws + WS_W_DOWN), MP, 1024, 2816};
    pg8::StaticOrder S; S.init(MP, 1024, G, bid);
    pg8::EpiBf16<0> E{(bf16_t*)(p.ws + WS_RAW), 1024, nullptr, 0, 0, 1.f};
    pg8::gemm_phase<pg8::EpiBf16<0>, pg8::StaticOrder, true, true>(lds, g, S, E);
}

typedef short v4i16_t __attribute__((ext_vector_type(4)));
typedef float f32x2_t __attribute__((ext_vector_type(2)));
typedef __bf16 bf16x2_t __attribute__((ext_vector_type(2)));
DEV unsigned cvtpk(float lo, float hi) { f32x2_t v = {lo, hi}; bf16x2_t b = __builtin_convertvector(v, bf16x2_t); return __builtin_bit_cast(unsigned, b); }
DEV f32x16 mfma32(bf16x8 a, bf16x8 b, f32x16 c) { return __builtin_amdgcn_mfma_f32_32x32x16_bf16(a, b, c, 0, 0, 0); }
DEV s16x4 tr_read(LAS const unsigned char* p) { return __builtin_bit_cast(s16x4, __builtin_amdgcn_ds_read_tr16_b64_v4i16((LAS v4i16_t*)p)); }
DEV bf16x8 cat8(s16x4 lo, s16x4 hi) { return (bf16x8){lo[0], lo[1], lo[2], lo[3], hi[0], hi[1], hi[2], hi[3]}; }
DEV float half_max(float v) { auto rr = __builtin_amdgcn_permlane32_swap(__float_as_uint(v), __float_as_uint(v), false, false); return fmaxf(__uint_as_float(rr[0]), __uint_as_float(rr[1])); }
DEV float half_sum(float v) { auto rr = __builtin_amdgcn_permlane32_swap(__float_as_uint(v), __float_as_uint(v), false, false); return __uint_as_float(rr[0]) + __uint_as_float(rr[1]); }
DEV bf16x8 pfrag(const f32x16& S, int s) {
    u32x4 w;
    if (s == 0) { w.x = cvtpk(S[0], S[1]); w.y = cvtpk(S[2], S[3]); w.z = cvtpk(S[4], S[5]); w.w = cvtpk(S[6], S[7]); }
    else { w.x = cvtpk(S[8], S[9]); w.y = cvtpk(S[10], S[11]); w.z = cvtpk(S[12], S[13]); w.w = cvtpk(S[14], S[15]); }
    return __builtin_bit_cast(bf16x8, w);
}
DEV float max16(const f32x16& S) {
    float a = fmaxf(fmaxf(S[0], S[1]), fmaxf(S[2], S[3])), b = fmaxf(fmaxf(S[4], S[5]), fmaxf(S[6], S[7]));
    float c = fmaxf(fmaxf(S[8], S[9]), fmaxf(S[10], S[11])), d = fmaxf(fmaxf(S[12], S[13]), fmaxf(S[14], S[15]));
    return fmaxf(fmaxf(a, b), fmaxf(c, d));
}

namespace pg8 {
struct EpiMemKV {
    static constexpr bool PERM = false, AFTER_DRAIN = false;
    float* ok; float* ov; bf16_t* bk; bf16_t* bv;
    __device__ __forceinline__ void operator()(const f32x4 (&acc)[2][2][4][2], const Unit& u, int wr, int wc, int fr, int fq) const {
        const int row0 = u.pm * BM + wr * 64 + fr; const bool isv = u.pn >= 4; const int colt = (u.pn & 3) * BM + wc * 32 + 4 * fq;
        float* of = isv ? ov : ok; bf16_t* ob = isv ? bv : bk;
#pragma unroll
        for (int ai = 0; ai < 2; ++ai)
#pragma unroll
            for (int m = 0; m < 4; ++m) {
                const size_t ro = (size_t)(row0 + ai * HALF + m * 16) * 1024;
#pragma unroll
                for (int bj = 0; bj < 2; ++bj)
#pragma unroll
                    for (int n = 0; n < 2; ++n) {
                        const f32x4 v = acc[ai][bj][m][n]; const int col = colt + bj * HALF + n * 16;
                        *(f32x4*)(of + ro + col) = v;
                        u32x2 w; w.x = cvt_pk_bf16(v[0], v[1]); w.y = cvt_pk_bf16(v[2], v[3]);
                        *(u32x2*)(ob + ro + col) = w;
                    }
            }
    }
};
}

DEV void phase_prep_x(const FP& p, LAS unsigned char* lds, int gw, int ngw, int wave, int lane) {
    LAS float* scr = (LAS float*)(lds + wave * 16384);
    constexpr int I_S = 16 * 32;
    for (int it = gw; it < 4 * I_S; it += ngw) {
        int r = it;
        if (r < I_S) { transpose_item(p.in[23], 1024, 1024, (bf16_t*)(p.ws + WS_W_Q), r, scr, lane, RmPlain{0}); continue; } r -= I_S;
        if (r < I_S) { transpose_item(p.in[24], 1024, 1024, (bf16_t*)(p.ws + WS_W_KV), r, scr, lane, RmPlain{0}); continue; } r -= I_S;
        if (r < I_S) { transpose_item(p.in[25], 1024, 1024, (bf16_t*)(p.ws + WS_W_KV), r, scr, lane, RmPlain{1024}); continue; } r -= I_S;
        transpose_item(p.in[26], 1024, 1024, (bf16_t*)(p.ws + WS_W_O), r, scr, lane, RmPlain{0});
    }
    row_phase(nullptr, p.in[8], nullptr, nullptr, p.in[22], (bf16_t*)(p.ws + WS_MN), 512, gw, ngw, lane);
}
DEV void phase_memkv(const FP& p, LAS unsigned char* lds, int G, int bid) {
    pg8::Gemm g{(const bf16_t*)(p.ws + WS_MN), (const bf16_t*)(p.ws + WS_W_KV), 512, 2048, 1024};
    pg8::StaticOrder S; S.init(512, 2048, G, bid);
    pg8::EpiMemKV E{p.out + 33822720, p.out + 34347008, (bf16_t*)(p.ws + WS_KM), (bf16_t*)(p.ws + WS_VM)};
    pg8::gemm_phase<pg8::EpiMemKV, pg8::StaticOrder, true, true>(lds, g, S, E);
}
namespace pg8 { struct OneUnit { int pm, pn;
    __device__ __forceinline__ bool next(int i, Unit& u) const { if (i) return false; u.pm = pm; u.pn = pn; return true; }
    __device__ __forceinline__ void a_ready(const Unit&) const {}
    __device__ __forceinline__ void done(const Unit&) const {} }; }
DEV void memkv_unit(const FP& p, LAS unsigned char* lds, int idx) {
    pg8::Gemm g{(const bf16_t*)(p.ws + WS_MN), (const bf16_t*)(p.ws + WS_W_KV), 512, 2048, 1024};
    pg8::OneUnit S{idx >> 3, idx & 7};
    pg8::EpiMemKV E{p.out + 33822720, p.out + 34347008, (bf16_t*)(p.ws + WS_KM), (bf16_t*)(p.ws + WS_VM)};
    pg8::gemm_phase<pg8::EpiMemKV, pg8::OneUnit, true, true>(lds, g, S, E);
}
DEV void phase_wq(const FP& p, LAS unsigned char* lds, int G, int bid) {
    pg8::Gemm g{(const bf16_t*)(p.ws + WS_XN), (const bf16_t*)(p.ws + WS_W_Q), MP, 1024, 1024};
    pg8::StaticOrder S; S.init(MP, 1024, G, bid);
    pg8::EpiBf16<0> E{(bf16_t*)(p.ws + WS_QX), 1024, nullptr, 1024, 0, 0.0625f * 1.4426950408889634f};
    pg8::gemm_phase<pg8::EpiBf16<0>, pg8::StaticOrder, true, true>(lds, g, S, E);
}
DEV void phase_wo(const FP& p, LAS unsigned char* lds, int G, int bid) {
    pg8::Gemm g{(const bf16_t*)(p.ws + WS_OX), (const bf16_t*)(p.ws + WS_W_O), MP, 1024, 1024};
    pg8::StaticOrder S; S.init(MP, 1024, G, bid);
    pg8::EpiBf16<0> E{(bf16_t*)(p.ws + WS_RAW), 1024, nullptr, 0, 0, 1.f};
    pg8::gemm_phase<pg8::EpiBf16<0>, pg8::StaticOrder, true, true>(lds, g, S, E);
}

DEV void phase_xattn(const FP& p, LAS unsigned char* lds, int G, int bid) {
    const int tid = threadIdx.x, lane = tid & 63, wave = __builtin_amdgcn_readfirstlane(tid >> 6), r = lane & 31, hh = lane >> 5, qb = wave & 3, eh = wave >> 2;
    const bf16_t* QX = (const bf16_t*)(p.ws + WS_QX); const bf16_t* KM = (const bf16_t*)(p.ws + WS_KM); const bf16_t* VM = (const bf16_t*)(p.ws + WS_VM);
    bf16_t* OX = (bf16_t*)(p.ws + WS_OX);
    constexpr int QOFF = 0, KOFF = 65536, VOFF = 98304;
    const int vlane = (4 * hh + ((lane & 15) >> 2)) * 64 + 32 * ((lane >> 4) & 1) + 8 * (lane & 3);
    for (int u = bid; u < 512; u += G) {
        const int bh = u & 7, b = bh >> 2, h = bh & 3, qblk = u >> 3;
        const size_t qrow0 = (size_t)b * 8192 + (size_t)qblk * 128;
#pragma unroll
        for (int j = 0; j < 8; ++j) {
            const int id = tid + 512 * j, row = id >> 5, ch = id & 31;
            const u32x4 v = *(const u32x4*)(QX + (qrow0 + row) * 1024 + h * 256 + ch * 8);
            *(LAS u32x4*)(lds + QOFF + row * 512 + ((ch ^ (row & 15)) << 4)) = v;
        }
        u32x4 kr[2], vr[2];
#pragma unroll
        for (int j = 0; j < 2; ++j) {
            const int id = tid + 512 * j, key = id >> 5, ch = id & 31;
            kr[j] = *(const u32x4*)(KM + ((size_t)b * 256 + key) * 1024 + h * 256 + ch * 8);
            vr[j] = *(const u32x4*)(VM + ((size_t)b * 256 + key) * 1024 + h * 256 + ch * 8);
        }
#pragma unroll
        for (int j = 0; j < 2; ++j) {
            const int id = tid + 512 * j, key = id >> 5, ch = id & 31;
            *(LAS u32x4*)(lds + KOFF + key * 512 + ((ch ^ (key & 15)) << 4)) = kr[j];
            *(LAS u32x4*)(lds + VOFF + (ch >> 2) * 2048 + key * 64 + (ch & 3) * 16) = vr[j];
        }
        __syncthreads();
        f32x16 O[4];
#pragma unroll
        for (int e = 0; e < 4; ++e)
#pragma unroll
            for (int i = 0; i < 16; ++i) O[e][i] = 0.f;
        float mrun = -1e30f, lsum = 0.f;
        const LAS unsigned char* qp = lds + QOFF + (32 * qb + r) * 512;
        for (int t = 0; t < 8; ++t) {
            const int buf = t & 1;
            if (t + 1 < 8) {
#pragma unroll
                for (int j = 0; j < 2; ++j) {
                    const int id = tid + 512 * j, key = id >> 5, ch = id & 31;
                    kr[j] = *(const u32x4*)(KM + ((size_t)b * 256 + 32 * (t + 1) + key) * 1024 + h * 256 + ch * 8);
                    vr[j] = *(const u32x4*)(VM + ((size_t)b * 256 + 32 * (t + 1) + key) * 1024 + h * 256 + ch * 8);
                }
            }
            const LAS unsigned char* kp = lds + KOFF + buf * 16384 + r * 512;
            const LAS unsigned char* vp = lds + VOFF + buf * 16384 + (4 * eh) * 2048 + vlane;
            f32x16 S;
#pragma unroll
            for (int i = 0; i < 16; ++i) S[i] = 0.f;
#pragma unroll 4
            for (int ks = 0; ks < 16; ++ks) {
                const int sl = ((2 * ks + hh) ^ (r & 15)) << 4;
                const bf16x8 a = *(const LAS bf16x8*)(kp + sl);
                const bf16x8 q = *(const LAS bf16x8*)(qp + sl);
                S = mfma32(a, q, S);
            }
            const float mx = half_max(max16(S));
            const float mnew = fmaxf(mrun, mx), alpha = __builtin_amdgcn_exp2f(mrun - mnew);
            mrun = mnew;
            float ps = 0.f;
#pragma unroll
            for (int i = 0; i < 16; ++i) { S[i] = __builtin_amdgcn_exp2f(S[i] - mnew); ps += S[i]; }
            lsum = lsum * alpha + ps;
#pragma unroll
            for (int e = 0; e < 4; ++e)
#pragma unroll
                for (int i = 0; i < 16; ++i) O[e][i] *= alpha;
            const bf16x8 P0 = pfrag(S, 0), P1 = pfrag(S, 1);
#pragma unroll
            for (int e = 0; e < 4; ++e) {
                const bf16x8 v0 = cat8(tr_read(vp + e * 2048), tr_read(vp + e * 2048 + 512));
                const bf16x8 v1 = cat8(tr_read(vp + e * 2048 + 1024), tr_read(vp + e * 2048 + 1536));
                O[e] = mfma32(v0, P0, O[e]);
                O[e] = mfma32(v1, P1, O[e]);
            }
            if (t + 1 < 8) {
#pragma unroll
                for (int j = 0; j < 2; ++j) {
                    const int id = tid + 512 * j, key = id >> 5, ch = id & 31;
                    *(LAS u32x4*)(lds + KOFF + (buf ^ 1) * 16384 + key * 512 + ((ch ^ (key & 15)) << 4)) = kr[j];
                    *(LAS u32x4*)(lds + VOFF + (buf ^ 1) * 16384 + (ch >> 2) * 2048 + key * 64 + (ch & 3) * 16) = vr[j];
                }
            }
            __syncthreads();
        }
        const float inv = 1.f / half_sum(lsum);
        LAS unsigned char* stg = lds + wave * 16384;
#pragma unroll
        for (int e = 0; e < 4; ++e)
#pragma unroll
            for (int g4 = 0; g4 < 4; ++g4) {
                u32x2 w; w.x = cvtpk(O[e][4 * g4 + 0] * inv, O[e][4 * g4 + 1] * inv); w.y = cvtpk(O[e][4 * g4 + 2] * inv, O[e][4 * g4 + 3] * inv);
                *(LAS u32x2*)(stg + r * 272 + (32 * e + 8 * g4 + 4 * hh) * 2) = w;
            }
        WAVE_SYNC();
#pragma unroll
        for (int i = 0; i < 8; ++i) {
            const int row = i * 4 + (lane >> 4), ch = lane & 15;
            const u32x4 v = *(const LAS u32x4*)(stg + row * 272 + ch * 16);
            *(u32x4*)(OX + (qrow0 + 32 * qb + row) * 1024 + h * 256 + 128 * eh + ch * 8) = v;
        }
        __syncthreads();
    }
}

constexpr float QSCALE = 0.125f * 1.4426950408889634f;
namespace pg8 {
struct EpiIn {
    static constexpr bool PERM = false, AFTER_DRAIN = false;
    bf16_t* ZX; bf16_t* Qb; bf16_t* Kb; bf16_t* Vb; float* okf; float* ovf; float* oconv;
    __device__ __forceinline__ void operator()(const f32x4 (&acc)[2][2][4][2], const Unit& u, int wr, int wc, int fr, int fq) const {
        const int row0 = u.pm * BM + wr * 64 + fr, pn = u.pn;
        if (pn < 6) {
#pragma unroll
            for (int ai = 0; ai < 2; ++ai)
#pragma unroll
                for (int m = 0; m < 4; ++m) {
                    const int row = row0 + ai * HALF + m * 16; const int t = row & 8191;
#pragma unroll
                    for (int bj = 0; bj < 2; ++bj)
#pragma unroll
                        for (int n = 0; n < 2; ++n) {
                            const f32x4 v = acc[ai][bj][m][n]; const int col = pn * BM + bj * HALF + wc * 32 + n * 16 + 4 * fq;
                            u32x2 w; w.x = cvt_pk_bf16(v[0], v[1]); w.y = cvt_pk_bf16(v[2], v[3]);
                            *(u32x2*)(ZX + (size_t)row * 1536 + col) = w;
                            if (pn >= 2 && t >= 8189) *(f32x4*)(oconv + (size_t)((row >> 13) * 3 + (t - 8189)) * 1024 + (col - 512)) = v;
                        }
                }
        } else if (pn < 10) {
            const bool isk = pn >= 8;
            const int g = wc & 1;
            float inv[4];
#pragma unroll
            for (int i = 0; i < 4; ++i) inv[i] = __builtin_amdgcn_exp2f(-(float)(16 * g + 4 * fq + i) * (13.287712379549449f / 32.f)) * 0.15915494309189535f;
#pragma unroll
            for (int ai = 0; ai < 2; ++ai)
#pragma unroll
                for (int m = 0; m < 4; ++m) {
                    const int row = row0 + ai * HALF + m * 16; const float pos = (float)(row & 8191);
                    float cs[4], sn[4];
#pragma unroll
                    for (int i = 0; i < 4; ++i) { float rev = pos * inv[i]; rev -= floorf(rev); sn[i] = __builtin_amdgcn_sinf(rev); cs[i] = __builtin_amdgcn_cosf(rev); }
#pragma unroll
                    for (int bj = 0; bj < 2; ++bj) {
                        const int cl = (pn & 1) * BM + bj * HALF + wc * 32;
                        const f32x4 x1 = acc[ai][bj][m][0], x2 = acc[ai][bj][m][1];
                        f32x4 o1, o2;
#pragma unroll
                        for (int i = 0; i < 4; ++i) { o1[i] = x1[i] * cs[i] - x2[i] * sn[i]; o2[i] = x2[i] * cs[i] + x1[i] * sn[i]; }
                        if (isk) {
                            float* kf = okf + (size_t)row * 512 + (cl >> 6) * 64 + 16 * g + 4 * fq;
                            *(f32x4*)kf = o1; *(f32x4*)(kf + 32) = o2;
                            u32x2 w; w.x = cvt_pk_bf16(o1[0], o1[1]); w.y = cvt_pk_bf16(o1[2], o1[3]);
                            *(u32x2*)(Kb + (size_t)row * 512 + cl + 4 * fq) = w;
                            w.x = cvt_pk_bf16(o2[0], o2[1]); w.y = cvt_pk_bf16(o2[2], o2[3]);
                            *(u32x2*)(Kb + (size_t)row * 512 + cl + 16 + 4 * fq) = w;
                        } else {
                            o1 = o1 * QSCALE; o2 = o2 * QSCALE;
                            u32x2 w; w.x = cvt_pk_bf16(o1[0], o1[1]); w.y = cvt_pk_bf16(o1[2], o1[3]);
                            *(u32x2*)(Qb + (size_t)row * 512 + cl + 4 * fq) = w;
                            w.x = cvt_pk_bf16(o2[0], o2[1]); w.y = cvt_pk_bf16(o2[2], o2[3]);
                            *(u32x2*)(Qb + (size_t)row * 512 + cl + 16 + 4 * fq) = w;
                        }
                    }
                }
        } else {
#pragma unroll
            for (int ai = 0; ai < 2; ++ai)
#pragma unroll
                for (int m = 0; m < 4; ++m) {
                    const int row = row0 + ai * HALF + m * 16;
#pragma unroll
                    for (int bj = 0; bj < 2; ++bj)
#pragma unroll
                        for (int n = 0; n < 2; ++n) {
                            const f32x4 v = acc[ai][bj][m][n]; const int col = (pn - 10) * BM + bj * HALF + wc * 32 + n * 16 + 4 * fq;
                            *(f32x4*)(ovf + (size_t)row * 512 + col) = v;
                            u32x2 w; w.x = cvt_pk_bf16(v[0], v[1]); w.y = cvt_pk_bf16(v[2], v[3]);
                            *(u32x2*)(Vb + (size_t)row * 512 + col) = w;
                        }
                }
        }
    }
};
}

DEV void phase_prep_mix(const FP& p, LAS unsigned char* lds, int gw, int ngw, int wave, int lane) {
    LAS float* scr = (LAS float*)(lds + wave * 16384);
    constexpr int I_IN = 16 * 97, I_OUT = 16 * 32;
    for (int it = gw; it < I_IN + I_OUT; it += ngw) {
        if (it < I_IN) transpose_item(p.in[9], 1024, 3080, (bf16_t*)(p.ws + WS_W_IN), it, scr, lane, RmIn{});
        else transpose_item(p.in[21], 1024, 1024, (bf16_t*)(p.ws + WS_W_OUT), it - I_IN, scr, lane, RmPlain{0});
    }
    __syncthreads();
    LAS float* wdt = (LAS float*)lds;
    for (int i = threadIdx.x; i < 8192; i += 512) wdt[i] = p.in[9][(size_t)(i >> 3) * 3080 + 1536 + (i & 7)];
    __syncthreads();
    const float* x = p.in[0]; const float* g = p.in[27]; bf16_t* xn = (bf16_t*)(p.ws + WS_XN); float* dtv = (float*)(p.ws + WS_DTV);
    const float bias = p.in[12][lane & 7];
    for (int r = gw; r < MP; r += ngw) {
        f32x4 h[4]; float ss = 0.f;
#pragma unroll
        for (int j = 0; j < 4; ++j) { h[j] = ((const f32x4*)(x + (size_t)r * 1024))[lane + 64 * j]; ss += h[j].x * h[j].x + h[j].y * h[j].y + h[j].z * h[j].z + h[j].w * h[j].w; }
        const float rs = rsqrtf(wave_sum(ss) * (1.f / 1024.f) + 1e-6f);
        float d[8];
#pragma unroll
        for (int k = 0; k < 8; ++k) d[k] = 0.f;
#pragma unroll
        for (int j = 0; j < 4; ++j) {
            const f32x4 gg = ((const f32x4*)g)[lane + 64 * j]; h[j] = h[j] * rs * gg;
            u32x2 w; w.x = pk2(h[j].x, h[j].y); w.y = pk2(h[j].z, h[j].w);
            ((u32x2*)(xn + (size_t)r * 1024))[lane + 64 * j] = w;
#pragma unroll
            for (int i = 0; i < 4; ++i) {
                const LAS f32x4* wp = (const LAS f32x4*)(wdt + (4 * (lane + 64 * j) + i) * 8);
                const f32x4 w0 = wp[0], w1 = wp[1]; const float hv = h[j][i];
                d[0] += hv * w0.x; d[1] += hv * w0.y; d[2] += hv * w0.z; d[3] += hv * w0.w; d[4] += hv * w1.x; d[5] += hv * w1.y; d[6] += hv * w1.z; d[7] += hv * w1.w;
            }
        }
#pragma unroll
        for (int k = 0; k < 8; ++k) d[k] = wave_sum(d[k]);
        float mine = d[0];
#pragma unroll
        for (int k = 1; k < 8; ++k) mine = ((lane & 7) == k) ? d[k] : mine;
        const float xx = mine + bias;
        if (lane < 8) dtv[(size_t)r * 8 + lane] = (xx > 20.f) ? xx : log1pf(expf(xx));
    }
    __syncthreads();
}
DEV void phase_inproj(const FP& p, LAS unsigned char* lds, int G, int bid) {
    pg8::Gemm g{(const bf16_t*)(p.ws + WS_XN), (const bf16_t*)(p.ws + WS_W_IN), MP, 3072, 1024};
    pg8::StaticOrder S; S.init(MP, 3072, G, bid);
    pg8::EpiIn E{(bf16_t*)(p.ws + WS_ZX), (bf16_t*)(p.ws + WS_Q), (bf16_t*)(p.ws + WS_K), (bf16_t*)(p.ws + WS_V), p.out + 16908288, p.out + 25296896, p.out + 33816576};
    pg8::gemm_phase<pg8::EpiIn, pg8::StaticOrder, true, true>(lds, g, S, E);
}
DEV void phase_outproj(const FP& p, LAS unsigned char* lds, int G, int bid) {
    pg8::Gemm g{(const bf16_t*)(p.ws + WS_CAT), (const bf16_t*)(p.ws + WS_W_OUT), MP, 1024, 1024};
    pg8::StaticOrder S; S.init(MP, 1024, G, bid);
    pg8::EpiBf16<0> E{(bf16_t*)(p.ws + WS_RAW), 1024, nullptr, 0, 0, 1.f};
    pg8::gemm_phase<pg8::EpiBf16<0>, pg8::StaticOrder, true, true>(lds, g, S, E);
}

DEV float ssd_tables(const FP& p, LAS float* tdt, LAS float* tac, size_t row0, int h, int lane) {
    const float dt = ((const float*)(p.ws + WS_DTV))[(row0 + lane) * 8 + h];
    const float a = -expf(p.in[13][h]);
    float v = dt * a;
#pragma unroll
    for (int o = 1; o < 64; o <<= 1) { const float t = __shfl_up(v, o); if (lane >= o) v += t; }
    tdt[lane * 8 + h] = dt; tac[lane * 8 + h] = v;
    return __shfl(v, 63);
}
template <class F> DEV void ssd_conv8(const FP& p, size_t row0, int col0, int l0, F emit) {
    const bf16_t* ZX = (const bf16_t*)(p.ws + WS_ZX);
    const float* cw = p.in[10]; const float* cb = p.in[11];
    f32x4 w[4][2], bias[2];
#pragma unroll
    for (int j = 0; j < 4; ++j) { w[j][0] = *(const f32x4*)(cw + j * 1024 + col0); w[j][1] = *(const f32x4*)(cw + j * 1024 + col0 + 4); }
    bias[0] = *(const f32x4*)(cb + col0); bias[1] = *(const f32x4*)(cb + col0 + 4);
    const int t0 = (int)(row0 & 8191);
    f32x4 u[4][2];
#pragma unroll
    for (int j = 0; j < 3; ++j) {
        const int l = l0 - 3 + j;
        if (t0 + l >= 0) {
            const u32x4 r = *(const u32x4*)(ZX + (row0 + l) * 1536 + 512 + col0);
            u[j][0] = (f32x4){bflo(r.x), bfhi(r.x), bflo(r.y), bfhi(r.y)}; u[j][1] = (f32x4){bflo(r.z), bfhi(r.z), bflo(r.w), bfhi(r.w)};
        } else { u[j][0] = (f32x4){0.f, 0.f, 0.f, 0.f}; u[j][1] = u[j][0]; }
    }
#pragma unroll
    for (int i = 0; i < 16; ++i) {
        const int l = l0 + i;
        const u32x4 r = *(const u32x4*)(ZX + (row0 + l) * 1536 + 512 + col0);
        u[3][0] = (f32x4){bflo(r.x), bfhi(r.x), bflo(r.y), bfhi(r.y)}; u[3][1] = (f32x4){bflo(r.z), bfhi(r.z), bflo(r.w), bfhi(r.w)};
        f32x4 a0 = bias[0] + w[0][0] * u[0][0] + w[1][0] * u[1][0] + w[2][0] * u[2][0] + w[3][0] * u[3][0];
        f32x4 a1 = bias[1] + w[0][1] * u[0][1] + w[1][1] * u[1][1] + w[2][1] * u[2][1] + w[3][1] * u[3][1];
#pragma unroll
        for (int k = 0; k < 4; ++k) { a0[k] = fast_silu(a0[k]); a1[k] = fast_silu(a1[k]); }
        emit(l, a0, a1);
        u[0][0] = u[1][0]; u[0][1] = u[1][1]; u[1][0] = u[2][0]; u[1][1] = u[2][1]; u[2][0] = u[3][0]; u[2][1] = u[3][1];
    }
}
constexpr int S_XS = 0, S_B = 65536, S_C = 98304, S_TDT = 131072, S_TAC = 133120, S_SSQ = 135168;
DEV int trlane(int lane) { return ((lane & 15) >> 2) * 64 + 32 * ((lane >> 4) & 1) + 8 * (lane & 3); }

DEV void phase_ssd1(const FP& p, LAS unsigned char* lds, int G, int bid) {
    const int tid = threadIdx.x, lane = tid & 63, wave = __builtin_amdgcn_readfirstlane(tid >> 6), hh = lane >> 5;
    LAS float* tdt = (LAS float*)(lds + S_TDT); LAS float* tac = (LAS float*)(lds + S_TAC);
    bf16_t* ST = (bf16_t*)(p.ws + WS_ST); float* cdec = (float*)(p.ws + WS_CDEC);
    for (int u = bid; u < 256; u += G) {
        const int b = u >> 7, c = u & 127; const size_t row0 = (size_t)b * 8192 + (size_t)c * 64;
        const float tot = ssd_tables(p, tdt, tac, row0, wave, lane);
        if (lane == 0) cdec[u * 8 + wave] = expf(tot);
        __syncthreads();
        { const int i = tid; const float t63 = tac[63 * 8 + (i & 7)]; const float s = tdt[i] * expf(t63 - tac[i]); __syncthreads(); tdt[i] = s; }
        __syncthreads();
        if (tid < 384) {
            const int cg = tid >> 2, tq = tid & 3, col0 = cg * 8;
            ssd_conv8(p, row0, col0, tq * 16, [&](int l, f32x4 a0, f32x4 a1) {
                u32x4 w;
                if (cg < 64) {
                    const int h = cg >> 3, pp = col0 & 63; const float s = tdt[l * 8 + h];
                    a0 = a0 * s; a1 = a1 * s;
                    w.x = pk2(a0[0], a0[1]); w.y = pk2(a0[2], a0[3]); w.z = pk2(a1[0], a1[1]); w.w = pk2(a1[2], a1[3]);
                    *(LAS u32x4*)(lds + S_XS + h * 8192 + (pp >> 5) * 4096 + l * 64 + (pp & 31) * 2) = w;
                } else {
                    const int n = col0 - 512, g = n >> 7, nn = n & 127;
                    w.x = pk2(a0[0], a0[1]); w.y = pk2(a0[2], a0[3]); w.z = pk2(a1[0], a1[1]); w.w = pk2(a1[2], a1[3]);
                    *(LAS u32x4*)(lds + S_B + g * 16384 + (nn >> 5) * 4096 + l * 64 + (nn & 31) * 2) = w;
                }
            });
        }
        __syncthreads();
        const int h = wave, g = h >> 2;
        const LAS unsigned char* xa = lds + S_XS + h * 8192 + hh * 512 + trlane(lane);
        const LAS unsigned char* ba = lds + S_B + g * 16384 + hh * 512 + trlane(lane);
        bf16_t* sp = ST + ((size_t)u * 8 + h) * 8192;
#pragma unroll 1
        for (int nh = 0; nh < 2; ++nh) {
            f32x16 acc[2][2];
#pragma unroll
            for (int a = 0; a < 2; ++a)
#pragma unroll
                for (int n = 0; n < 2; ++n)
#pragma unroll
                    for (int i = 0; i < 16; ++i) acc[a][n][i] = 0.f;
#pragma unroll 2
            for (int s = 0; s < 4; ++s) {
                bf16x8 af[2], bfr[2];
#pragma unroll
                for (int a = 0; a < 2; ++a) af[a] = cat8(tr_read(xa + a * 4096 + s * 1024), tr_read(xa + a * 4096 + s * 1024 + 256));
#pragma unroll
                for (int n = 0; n < 2; ++n) bfr[n] = cat8(tr_read(ba + (2 * nh + n) * 4096 + s * 1024), tr_read(ba + (2 * nh + n) * 4096 + s * 1024 + 256));
#pragma unroll
                for (int a = 0; a < 2; ++a)
#pragma unroll
                    for (int n = 0; n < 2; ++n) acc[a][n] = mfma32(af[a], bfr[n], acc[a][n]);
            }
#pragma unroll
            for (int a = 0; a < 2; ++a)
#pragma unroll
                for (int n = 0; n < 2; ++n)
#pragma unroll
                    for (int i = 0; i < 16; ++i) {
                        const int pr = 32 * a + (i & 3) + 8 * (i >> 2) + 4 * hh;
                        sp[pr * 128 + 32 * (2 * nh + n) + (lane & 31)] = (bf16_t)f2bf(acc[a][n][i]);
                    }
        }
        __syncthreads();
    }
}

DEV void ssd2_item(const FP& p, int blk) {
    const int tid = threadIdx.x;
    unsigned* ST = (unsigned*)(p.ws + WS_ST); const float* cdec = (const float*)(p.ws + WS_CDEC); float* pssm = p.out + 33685504;
    const int idx = blk * 512 + tid;
    const int n2 = idx & 63, pr = (idx >> 6) & 63, h = (idx >> 12) & 7, b = idx >> 15;
    float s0 = 0.f, s1 = 0.f;
    for (int c0 = 0; c0 < 128; c0 += 32) {
        unsigned v[32];
#pragma unroll
        for (int j = 0; j < 32; ++j) v[j] = ST[(((size_t)(b * 128 + c0 + j) * 8 + h) * 64 + pr) * 64 + n2];
#pragma unroll
        for (int j = 0; j < 32; ++j) {
            const float dc = cdec[(b * 128 + c0 + j) * 8 + h];
            ST[(((size_t)(b * 128 + c0 + j) * 8 + h) * 64 + pr) * 64 + n2] = pk2(s0, s1);
            s0 = s0 * dc + bflo(v[j]); s1 = s1 * dc + bfhi(v[j]);
        }
    }
    float2 o; o.x = s0; o.y = s1;
    ((float2*)pssm)[(((size_t)b * 8 + h) * 64 + pr) * 64 + n2] = o;
}
DEV void phase_ssd2(const FP& p, int G, int bid) { for (int blk = bid; blk < 128; blk += G) ssd2_item(p, blk); }

DEV void phase_ssd3(const FP& p, LAS unsigned char* lds, int G, int bid) {
    LAS float* tdt = (LAS float*)(lds + S_TDT); LAS float* tac = (LAS float*)(lds + S_TAC); LAS float* ssq = (LAS float*)(lds + S_SSQ);
    const bf16_t* ST = (const bf16_t*)(p.ws + WS_ST); const bf16_t* ZX = (const bf16_t*)(p.ws + WS_ZX); bf16_t* CAT = (bf16_t*)(p.ws + WS_CAT);
    for (int u = bid; u < 256; u += G) {
        int tid = threadIdx.x; asm volatile("" : "+v"(tid));
        const int lane = tid & 63, wave = __builtin_amdgcn_readfirstlane(tid >> 6), r = lane & 31, hh = lane >> 5;
        const int b = u >> 7, c = u & 127; const size_t row0 = (size_t)b * 8192 + (size_t)c * 64;
        (void)ssd_tables(p, tdt, tac, row0, wave, lane);
        {
            const int cg = tid >> 2, tq = tid & 3, col0 = cg * 8;
            ssd_conv8(p, row0, col0, tq * 16, [&](int l, f32x4 a0, f32x4 a1) {
                u32x4 w; w.x = pk2(a0[0], a0[1]); w.y = pk2(a0[2], a0[3]); w.z = pk2(a1[0], a1[1]); w.w = pk2(a1[2], a1[3]);
                if (cg < 64) {
                    const int h = cg >> 3, pp = col0 & 63;
                    *(LAS u32x4*)(lds + S_XS + h * 8192 + (pp >> 5) * 4096 + l * 64 + (pp & 31) * 2) = w;
                } else {
                    const int n = (col0 - 512) & 255, g = n >> 7, ch = (n & 127) >> 3;
                    *(LAS u32x4*)(lds + (col0 < 768 ? S_B : S_C) + g * 16384 + l * 256 + ((ch ^ (l & 15)) << 4)) = w;
                }
            });
        }
        __syncthreads();
        const int h = wave, g = h >> 2;
        f32x16 Y[2][2];
#pragma unroll
        for (int a = 0; a < 2; ++a)
#pragma unroll
            for (int l2 = 0; l2 < 2; ++l2)
#pragma unroll
                for (int i = 0; i < 16; ++i) Y[a][l2][i] = 0.f;
        const LAS unsigned char* cp = lds + S_C + g * 16384 + r * 256;
        const LAS unsigned char* bp = lds + S_B + g * 16384 + r * 256;
        const bf16_t* pv = ST + ((size_t)u * 8 + h) * 8192 + (size_t)r * 128 + 8 * hh;
#pragma unroll 2
        for (int ks = 0; ks < 8; ++ks) {
            const int sl = ((2 * ks + hh) ^ (r & 15)) << 4;
            const bf16x8 c0 = *(const LAS bf16x8*)(cp + sl), c1 = *(const LAS bf16x8*)(cp + 32 * 256 + sl);
            const bf16x8 p0 = *(const bf16x8*)(pv + 16 * ks), p1 = *(const bf16x8*)(pv + 32 * 128 + 16 * ks);
            Y[0][0] = mfma32(p0, c0, Y[0][0]); Y[0][1] = mfma32(p0, c1, Y[0][1]);
            Y[1][0] = mfma32(p1, c0, Y[1][0]); Y[1][1] = mfma32(p1, c1, Y[1][1]);
        }
        float acl[2];
#pragma unroll
        for (int l2 = 0; l2 < 2; ++l2) {
            acl[l2] = tac[(32 * l2 + r) * 8 + h]; const float e = expf(acl[l2]);
#pragma unroll
            for (int a = 0; a < 2; ++a)
#pragma unroll
                for (int i = 0; i < 16; ++i) Y[a][l2][i] *= e;
        }
        __builtin_amdgcn_sched_barrier(0);
        const LAS unsigned char* xa = lds + S_XS + h * 8192 + hh * 256 + trlane(lane);
#pragma unroll
        for (int lb = 0; lb < 2; ++lb)
#pragma unroll
            for (int sb = 0; sb <= lb; ++sb) {
                f32x16 T;
#pragma unroll
                for (int i = 0; i < 16; ++i) T[i] = 0.f;
#pragma unroll 2
                for (int ks = 0; ks < 8; ++ks) {
                    const int sl = ((2 * ks + hh) ^ (r & 15)) << 4;
                    const bf16x8 bb = *(const LAS bf16x8*)(bp + sb * 32 * 256 + sl), cc = *(const LAS bf16x8*)(cp + lb * 32 * 256 + sl);
                    T = mfma32(bb, cc, T);
                }
#pragma unroll
                for (int i = 0; i < 16; ++i) {
                    const int s = 32 * sb + (i & 3) + 8 * (i >> 2) + 4 * hh;
                    const float f = tdt[s * 8 + h] * __builtin_amdgcn_exp2f(1.4426950408889634f * fminf(acl[lb] - tac[s * 8 + h], 0.f));
                    T[i] = (s <= 32 * lb + r) ? T[i] * f : 0.f;
                }
                const bf16x8 P0 = pfrag(T, 0), P1 = pfrag(T, 1);
#pragma unroll
                for (int a = 0; a < 2; ++a) {
                    const bf16x8 x0 = cat8(tr_read(xa + a * 4096 + (2 * sb) * 1024), tr_read(xa + a * 4096 + (2 * sb) * 1024 + 512));
                    const bf16x8 x1 = cat8(tr_read(xa + a * 4096 + (2 * sb + 1) * 1024), tr_read(xa + a * 4096 + (2 * sb + 1) * 1024 + 512));
                    Y[a][lb] = mfma32(x0, P0, Y[a][lb]);
                    Y[a][lb] = mfma32(x1, P1, Y[a][lb]);
                }
            }
        __builtin_amdgcn_sched_barrier(0);
        const float Dh = p.in[14][h];
        float sq[2] = {0.f, 0.f};
#pragma unroll
        for (int a = 0; a < 2; ++a)
#pragma unroll
            for (int l2 = 0; l2 < 2; ++l2) {
                const int l = 32 * l2 + r;
#pragma unroll
                for (int g4 = 0; g4 < 4; ++g4) {
                    const int pp = 8 * g4 + 4 * hh;
                    const u32x2 xw = *(const LAS u32x2*)(lds + S_XS + h * 8192 + a * 4096 + l * 64 + pp * 2);
                    const u32x2 zw = *(const u32x2*)(ZX + (row0 + l) * 1536 + h * 64 + 32 * a + pp);
                    const float xv[4] = {bflo(xw.x), bfhi(xw.x), bflo(xw.y), bfhi(xw.y)}, zv[4] = {bflo(zw.x), bfhi(zw.x), bflo(zw.y), bfhi(zw.y)};
#pragma unroll
                    for (int i = 0; i < 4; ++i) { const float v = (Y[a][l2][4 * g4 + i] + Dh * xv[i]) * fast_silu(zv[i]); Y[a][l2][4 * g4 + i] = v; sq[l2] += v * v; }
                }
            }
#pragma unroll
        for (int l2 = 0; l2 < 2; ++l2) { sq[l2] = half_sum(sq[l2]); if (hh == 0) ssq[(h * 2 + l2) * 32 + r] = sq[l2]; }
        __syncthreads();
        float rs[2];
#pragma unroll
        for (int l2 = 0; l2 < 2; ++l2) {
            float t = 0.f;
#pragma unroll
            for (int k = 0; k < 4; ++k) t += ssq[((4 * g + k) * 2 + l2) * 32 + r];
            rs[l2] = rsqrtf(t * (1.f / 256.f) + 1e-5f);
        }
#pragma unroll
        for (int a = 0; a < 2; ++a)
#pragma unroll
            for (int g4 = 0; g4 < 4; ++g4) {
                const int pcol = h * 64 + 32 * a + 8 * g4 + 4 * hh;
                const f32x4 w = *(const f32x4*)(p.in[15] + pcol);
#pragma unroll
                for (int l2 = 0; l2 < 2; ++l2) {
                    u32x2 o; o.x = cvtpk(Y[a][l2][4 * g4 + 0] * rs[l2] * w[0], Y[a][l2][4 * g4 + 1] * rs[l2] * w[1]);
                    o.y = cvtpk(Y[a][l2][4 * g4 + 2] * rs[l2] * w[2], Y[a][l2][4 * g4 + 3] * rs[l2] * w[3]);
                    *(u32x2*)(CAT + (row0 + 32 * l2 + r) * 1024 + pcol) = o;
                }
            }
        __syncthreads();
    }
}

struct AttnCtx { unsigned lam_bits; };
DEV AttnCtx attn_setup(const FP& p, LAS unsigned char* lds) {
    const int tid0 = threadIdx.x, lane0 = tid0 & 63;
    AttnCtx c; float lamv = expf(wave_sum(p.in[16][lane0] * p.in[17][lane0])) - expf(wave_sum(p.in[18][lane0] * p.in[19][lane0])) + 0.2f;
    asm volatile("" : "+v"(lamv));
    c.lam_bits = __builtin_amdgcn_readfirstlane(__float_as_uint(lamv));
    LAS float* subw = (LAS float*)(lds + 131072);
    if (tid0 < 128) subw[tid0] = p.in[20][tid0];
    return c;
}
DEV void attn_unit(const FP& p, LAS unsigned char* lds, const AttnCtx& ctx, int bh, int jq) {
    const bf16_t* Qg = (const bf16_t*)(p.ws + WS_Q); const bf16_t* Kg = (const bf16_t*)(p.ws + WS_K); const bf16_t* Vg = (const bf16_t*)(p.ws + WS_V);
    bf16_t* CAT = (bf16_t*)(p.ws + WS_CAT);
    const float lam_init = 0.2f, lam = __uint_as_float(ctx.lam_bits);
    LAS float* subw = (LAS float*)(lds + 131072);
    const int b = bh >> 2, h = bh & 3;
    int tid = threadIdx.x; asm volatile("" : "+v"(tid));
    const int lane = tid & 63, wave = __builtin_amdgcn_readfirstlane(tid >> 6), r = lane & 31, hh = lane >> 5, qb = wave & 3, c = wave >> 2;
    const int vlane = (4 * hh) * 64 + trlane(lane);
    const size_t rowb = (size_t)b * 8192; const int q0 = jq * 128;
    const int ntb = 2 * jq + 2, myn = 2 * jq + (qb >> 1) + 1;
    constexpr int KOFF = 0, VOFF = 32768;
    bf16x8 qf[4];
#pragma unroll
    for (int ks = 0; ks < 4; ++ks) qf[ks] = *(const bf16x8*)(Qg + (rowb + q0 + 32 * qb + r) * 512 + h * 128 + c * 64 + 16 * ks + 8 * hh);
#pragma unroll
    for (int ks = 0; ks < 4; ++ks) asm volatile("" : "+v"(qf[ks]));
    const bf16_t* ksrc[2]; const bf16_t* vsrc[2]; int kdst[2], vdst[2];
#pragma unroll
    for (int j = 0; j < 2; ++j) {
        const int pc = wave + 8 * j;
        { const int comp = pc >> 3, kb8 = pc & 7, key = 8 * kb8 + (lane >> 3), ch = (lane & 7) ^ ((key >> 1) & 7);
          ksrc[j] = Kg + (rowb + key) * 512 + h * 128 + comp * 64 + ch * 8; kdst[j] = KOFF + comp * 8192 + kb8 * 1024; }
        { const int eb = pc >> 2, kb16 = pc & 3, key = 16 * kb16 + (lane >> 2);
          vsrc[j] = Vg + (rowb + key) * 512 + h * 128 + eb * 32 + (lane & 3) * 8; vdst[j] = VOFF + eb * 4096 + kb16 * 1024; }
    }
#define ATT_DMA(tt, bufo) do { _Pragma("unroll") for (int s_ = 0; s_ < 2; ++s_) _Pragma("unroll") for (int j_ = 0; j_ < 2; ++j_) { \
        __builtin_amdgcn_global_load_lds((const unsigned*)(ksrc[j_] + (size_t)(128 * (tt) + 64 * s_) * 512), (LAS unsigned*)(lds + kdst[j_] + (bufo) + 16384 * s_), 16, 0, 0); \
        __builtin_amdgcn_global_load_lds((const unsigned*)(vsrc[j_] + (size_t)(128 * (tt) + 64 * s_) * 512), (LAS unsigned*)(lds + vdst[j_] + (bufo) + 16384 * s_), 16, 0, 0); } } while (0)
#define ATT_BAR_L() do { asm volatile("s_waitcnt lgkmcnt(0)" ::: "memory"); __builtin_amdgcn_s_barrier(); asm volatile("" ::: "memory"); } while (0)
#define ATT_BAR_VL() do { asm volatile("s_waitcnt vmcnt(0) lgkmcnt(0)" ::: "memory"); __builtin_amdgcn_s_barrier(); asm volatile("" ::: "memory"); } while (0)
    asm volatile("s_waitcnt vmcnt(0) lgkmcnt(0)" ::: "memory");
    ATT_DMA(0, 0);
    ATT_BAR_VL();
    f32x16 O[4];
#pragma unroll
    for (int e = 0; e < 4; ++e)
#pragma unroll
        for (int i = 0; i < 16; ++i) O[e][i] = 0.f;
    float mrun = -1e30f, lsum = 0.f;
    const int nst = jq + 1;
    for (int tt = 0; tt < nst; ++tt) {
        const int bufo = (tt & 1) * 65536;
        if (tt + 1 < nst) ATT_DMA(tt + 1, 65536 - bufo);
#pragma unroll
        for (int sub = 0; sub < 2; ++sub) {
            if (2 * tt + sub < myn) {
                const LAS unsigned char* kp = lds + bufo + sub * 16384 + KOFF + c * 8192 + r * 128;
                const LAS unsigned char* vp = lds + bufo + sub * 16384 + VOFF + vlane;
                f32x16 S0, S1;
#pragma unroll
                for (int i = 0; i < 16; ++i) { S0[i] = 0.f; S1[i] = 0.f; }
#pragma unroll
                for (int ks = 0; ks < 4; ++ks) {
                    const int sl = ((2 * ks + hh) ^ ((r >> 1) & 7)) << 4;
                    const bf16x8 a0 = *(const LAS bf16x8*)(kp + sl), a1 = *(const LAS bf16x8*)(kp + 32 * 128 + sl);
                    S0 = mfma32(a0, qf[ks], S0); S1 = mfma32(a1, qf[ks], S1);
                }
                const float mx = half_max(fmaxf(max16(S0), max16(S1)));
                const float mnew = fmaxf(mrun, mx);
                if (__any(mnew > mrun)) {
                    const float alpha = __builtin_amdgcn_exp2f(mrun - mnew);
                    lsum *= alpha;
#pragma unroll
                    for (int e = 0; e < 4; ++e)
#pragma unroll
                        for (int i = 0; i < 16; ++i) O[e][i] *= alpha;
                    mrun = mnew;
                }
                float ps = 0.f;
#pragma unroll
                for (int i = 0; i < 16; ++i) { S0[i] = __builtin_amdgcn_exp2f(S0[i] - mrun); S1[i] = __builtin_amdgcn_exp2f(S1[i] - mrun); ps += S0[i] + S1[i]; }
                lsum += ps;
                const bf16x8 P0 = pfrag(S0, 0), P1 = pfrag(S0, 1), P2 = pfrag(S1, 0), P3 = pfrag(S1, 1);
#pragma unroll
                for (int e = 0; e < 4; ++e) {
                    const bf16x8 v0 = cat8(tr_read(vp + e * 4096), tr_read(vp + e * 4096 + 512));
                    const bf16x8 v1 = cat8(tr_read(vp + e * 4096 + 1024), tr_read(vp + e * 4096 + 1536));
                    const bf16x8 v2 = cat8(tr_read(vp + e * 4096 + 2048), tr_read(vp + e * 4096 + 2560));
                    const bf16x8 v3 = cat8(tr_read(vp + e * 4096 + 3072), tr_read(vp + e * 4096 + 3584));
                    O[e] = mfma32(v0, P0, O[e]); O[e] = mfma32(v1, P1, O[e]); O[e] = mfma32(v2, P2, O[e]); O[e] = mfma32(v3, P3, O[e]);
                }
            }
        }
        ATT_BAR_VL();
    }
#undef ATT_DMA
    const float inv = 1.f / half_sum(lsum);
    LAS float* xch = (LAS float*)(lds + qb * 16384);
    if (c == 1) {
        const float f = -lam * inv;
#pragma unroll
        for (int e = 0; e < 4; ++e)
#pragma unroll
            for (int i = 0; i < 16; ++i) xch[(e * 16 + i) * 64 + lane] = O[e][i] * f;
    }
    __syncthreads();
    if (c == 0) {
        float ss = 0.f;
#pragma unroll
        for (int e = 0; e < 4; ++e)
#pragma unroll
            for (int i = 0; i < 16; ++i) { const float v = O[e][i] * inv + xch[(e * 16 + i) * 64 + lane]; O[e][i] = v; ss += v * v; }
        ss = half_sum(ss);
        const float rs = rsqrtf(ss * (1.f / 128.f) + 1e-5f) * (1.f - lam_init);
        WAVE_SYNC();
        LAS unsigned char* stg = lds + qb * 16384;
#pragma unroll
        for (int e = 0; e < 4; ++e)
#pragma unroll
            for (int g4 = 0; g4 < 4; ++g4) {
                const int e0 = 32 * e + 8 * g4 + 4 * hh;
                const f32x4 w = *(const LAS f32x4*)(subw + e0);
                u32x2 o; o.x = cvtpk(O[e][4 * g4 + 0] * rs * w[0], O[e][4 * g4 + 1] * rs * w[1]); o.y = cvtpk(O[e][4 * g4 + 2] * rs * w[2], O[e][4 * g4 + 3] * rs * w[3]);
                *(LAS u32x2*)(stg + r * 272 + e0 * 2) = o;
            }
        WAVE_SYNC();
#pragma unroll
        for (int i = 0; i < 8; ++i) {
            const int row = i * 4 + (lane >> 4), ch = lane & 15;
            const u32x4 v = *(const LAS u32x4*)(stg + row * 272 + ch * 16);
            *(u32x4*)(CAT + (rowb + q0 + 32 * qb + row) * 1024 + 512 + h * 128 + ch * 8) = v;
        }
    }
    __syncthreads();
#undef ATT_BAR_L
#undef ATT_BAR_VL
}
DEV void phase_attn(const FP& p, LAS unsigned char* lds, int G, int bid) {
    const AttnCtx ctx = attn_setup(p, lds);
    for (int pu = bid; pu < 256; pu += G) {
        const int bh = pu & 7, pr = pu >> 3;
        attn_unit(p, lds, ctx, bh, pr);
        attn_unit(p, lds, ctx, bh, 63 - pr);
    }
}

constexpr int NS = 128;
constexpr size_t SB_XN = 0, SB_Z = 256 * 1024, SB_XBC = 512 * 1024, SB_Q = 1024 * 1024, SB_DTV = 1280 * 1024, SB_YPRE = 1536 * 1024, SB_CAT = 1792 * 1024, SB_MIX = 2048 * 1024,
                 SB_QX = 2560 * 1024, SB_OX = 3072 * 1024, SB_HID = 3328 * 1024, SB_AML = 4096 * 1024, SB_XML = 4608 * 1024, SB_XO = 5 * MiB, SB_AO = 8 * MiB;
constexpr int N_ATILE = 33;

template <class Epi>
DEV void s_gemm(const bf16_t* A, const bf16_t* Bt, int N, int K, LAS unsigned char* lds, int bid, int G, int rot, const Epi& E) {
    int tid = threadIdx.x; asm volatile("" : "+v"(tid));
    const int lane = tid & 63, wave = __builtin_amdgcn_readfirstlane(tid >> 6), r = lane & 31, hh = lane >> 5;
    const int nun = 4 * (N >> 5), kw = K >> 3, nit = kw >> 5;
    for (int u = (bid + G - rot) % G; u < nun; u += G) {
        const int mb = u & 3, n0 = (u >> 2) * 32;
        const bf16_t* ap = A + (size_t)(32 * mb + r) * K + wave * kw + 16 * hh;
        const bf16_t* bp = Bt + (size_t)(n0 + r) * K + wave * kw + 16 * hh;
        f32x16 acc;
#pragma unroll
        for (int i = 0; i < 16; ++i) acc[i] = 0.f;
#pragma unroll 4
        for (int j = 0; j < nit; ++j) {
            const bf16x8 a0 = *(const bf16x8*)(ap + 32 * j), a1 = *(const bf16x8*)(ap + 32 * j + 8);
            const bf16x8 b0 = *(const bf16x8*)(bp + 32 * j), b1 = *(const bf16x8*)(bp + 32 * j + 8);
            acc = mfma32(b0, a0, acc); acc = mfma32(b1, a1, acc);
        }
        LAS float* red = (LAS float*)lds;
        if (wave != 0) {
#pragma unroll
            for (int i = 0; i < 16; ++i) red[wave * 1024 + i * 64 + lane] = acc[i];
        }
        __syncthreads();
        if (wave == 0) {
#pragma unroll
            for (int w = 1; w < 8; ++w)
#pragma unroll
                for (int i = 0; i < 16; ++i) acc[i] += red[w * 1024 + i * 64 + lane];
            E(acc, 32 * mb + r, n0, hh);
        }
        __syncthreads();
    }
}
struct EpiSF32 {
    float* C; int ldc; float scale;
    __device__ __forceinline__ void operator()(const f32x16& acc, int m, int n0, int hh) const {
#pragma unroll
        for (int g4 = 0; g4 < 4; ++g4) { f32x4 v = {acc[4 * g4] * scale, acc[4 * g4 + 1] * scale, acc[4 * g4 + 2] * scale, acc[4 * g4 + 3] * scale}; *(f32x4*)(C + (size_t)m * ldc + n0 + 8 * g4 + 4 * hh) = v; }
    }
};
struct EpiSSwiglu {
    bf16_t* H;
    __device__ __forceinline__ void operator()(const f32x16& acc, int m, int n0, int hh) const {
#pragma unroll
        for (int g4 = 0; g4 < 2; ++g4) {
            u32x2 w; w.x = cvtpk(fast_silu(acc[4 * g4]) * acc[4 * g4 + 8], fast_silu(acc[4 * g4 + 1]) * acc[4 * g4 + 9]);
            w.y = cvtpk(fast_silu(acc[4 * g4 + 2]) * acc[4 * g4 + 10], fast_silu(acc[4 * g4 + 3]) * acc[4 * g4 + 11]);
            *(u32x2*)(H + (size_t)m * 2816 + 16 * (n0 >> 5) + 8 * g4 + 4 * hh) = w;
        }
    }
};
struct EpiSIn {
    float *z, *xbc, *q, *ok, *ov, *oconv;
    __device__ __forceinline__ void operator()(const f32x16& acc, int m, int n0, int hh) const {
        const int t = m & 15, b = m >> 4;
        if (n0 < 1536) {
#pragma unroll
            for (int g4 = 0; g4 < 4; ++g4) {
                const f32x4 v = {acc[4 * g4], acc[4 * g4 + 1], acc[4 * g4 + 2], acc[4 * g4 + 3]}; const int col = n0 + 8 * g4 + 4 * hh;
                if (n0 < 512) *(f32x4*)(z + (size_t)m * 512 + col) = v;
                else { *(f32x4*)(xbc + (size_t)m * 1024 + col - 512) = v; if (t >= 13) *(f32x4*)(oconv + (size_t)(b * 3 + t - 13) * 1024 + col - 512) = v; }
            }
        } else if (n0 < 2560) {
            const bool isk = n0 >= 2048; const int cl = (n0 - (isk ? 2048 : 1536)), u64 = cl >> 6, g = (cl >> 5) & 1;
            const float pos = (float)(2048 + t);
            float* dst = (isk ? ok : q) + (size_t)m * 512 + u64 * 64;
#pragma unroll
            for (int g4 = 0; g4 < 2; ++g4) {
                f32x4 o1, o2;
#pragma unroll
                for (int i = 0; i < 4; ++i) {
                    const int d0 = 16 * g + 8 * g4 + 4 * hh + i;
                    float rev = pos * (__builtin_amdgcn_exp2f(-(float)d0 * (13.287712379549449f / 32.f)) * 0.15915494309189535f); rev -= floorf(rev);
                    const float sn = __builtin_amdgcn_sinf(rev), cs = __builtin_amdgcn_cosf(rev);
                    const float x1 = acc[4 * g4 + i], x2 = acc[4 * g4 + 8 + i];
                    o1[i] = x1 * cs - x2 * sn; o2[i] = x2 * cs + x1 * sn;
                }
                const int d0 = 16 * g + 8 * g4 + 4 * hh;
                *(f32x4*)(dst + d0) = o1; *(f32x4*)(dst + d0 + 32) = o2;
            }
        } else {
#pragma unroll
            for (int g4 = 0; g4 < 4; ++g4) { const f32x4 v = {acc[4 * g4], acc[4 * g4 + 1], acc[4 * g4 + 2], acc[4 * g4 + 3]}; *(f32x4*)(ov + (size_t)m * 512 + n0 - 2560 + 8 * g4 + 4 * hh) = v; }
        }
    }
};

DEV void s_row(const FP& p, const float* raw, const float* hin, const float* gpost, float* hout, const float* gpre, bf16_t* xn, float* dtv, int bid, int G, int rot) {
    const int lane = threadIdx.x & 63, wave = __builtin_amdgcn_readfirstlane(threadIdx.x >> 6);
    const int blk = (bid + G - rot) % G;
    for (int r = blk + G * wave; r < NS; r += 8 * G) {
        f32x4 h[4];
#pragma unroll
        for (int j = 0; j < 4; ++j) h[j] = ((const f32x4*)(hin + (size_t)r * 1024))[lane + 64 * j];
        if (raw) {
            f32x4 v[4]; float ss = 0.f;
#pragma unroll
            for (int j = 0; j < 4; ++j) { v[j] = ((const f32x4*)(raw + (size_t)r * 1024))[lane + 64 * j]; ss += v[j].x * v[j].x + v[j].y * v[j].y + v[j].z * v[j].z + v[j].w * v[j].w; }
            const float rs = rsqrtf(wave_sum(ss) * (1.f / 1024.f) + 1e-6f);
#pragma unroll
            for (int j = 0; j < 4; ++j) { const f32x4 g = ((const f32x4*)gpost)[lane + 64 * j]; h[j] += v[j] * rs * g; }
        }
        if (hout) {
#pragma unroll
            for (int j = 0; j < 4; ++j) ((f32x4*)(hout + (size_t)r * 1024))[lane + 64 * j] = h[j];
        }
        if (gpre) {
            float ss = 0.f;
#pragma unroll
            for (int j = 0; j < 4; ++j) ss += h[j].x * h[j].x + h[j].y * h[j].y + h[j].z * h[j].z + h[j].w * h[j].w;
            const float rs = rsqrtf(wave_sum(ss) * (1.f / 1024.f) + 1e-6f);
            float d[8];
#pragma unroll
            for (int k = 0; k < 8; ++k) d[k] = 0.f;
#pragma unroll
            for (int j = 0; j < 4; ++j) {
                const f32x4 g = ((const f32x4*)gpre)[lane + 64 * j]; const f32x4 o = h[j] * rs * g;
                u32x2 w; w.x = pk2(o.x, o.y); w.y = pk2(o.z, o.w);
                ((u32x2*)(xn + (size_t)r * 1024))[lane + 64 * j] = w;
                if (dtv) {
#pragma unroll
                    for (int i = 0; i < 4; ++i) {
                        const float* wp = p.in[9] + (size_t)(4 * (lane + 64 * j) + i) * 3080 + 1536;
                        const f32x4 w0 = *(const f32x4*)wp, w1 = *(const f32x4*)(wp + 4); const float hv = o[i];
                        d[0] += hv * w0.x; d[1] += hv * w0.y; d[2] += hv * w0.z; d[3] += hv * w0.w; d[4] += hv * w1.x; d[5] += hv * w1.y; d[6] += hv * w1.z; d[7] += hv * w1.w;
                    }
                }
            }
            if (dtv) {
#pragma unroll
                for (int k = 0; k < 8; ++k) d[k] = wave_sum(d[k]);
                float mine = d[0];
#pragma unroll
                for (int k = 1; k < 8; ++k) mine = ((lane & 7) == k) ? d[k] : mine;
                const float xx = mine + p.in[12][lane & 7];
                if (lane < 8) dtv[(size_t)r * 8 + lane] = (xx > 20.f) ? xx : log1pf(expf(xx));
            }
        }
    }
}

DEV void s_ssd(const FP& p, LAS unsigned char* lds, int bid, int G, int rot) {
    const int tid = threadIdx.x;
    const float* xbc = (const float*)(p.ws + WS_SMP + SB_XBC); const float* zb = (const float*)(p.ws + WS_SMP + SB_Z); const float* dtv = (const float*)(p.ws + WS_SMP + SB_DTV);
    float* ypre = (float*)(p.ws + WS_SMP + SB_YPRE); float* s_ssm = p.out + 35002368;
    const float* cbuf = p.in[5]; const float* cw = p.in[10]; const float* cb = p.in[11];
    LAS float* act = (LAS float*)lds;
    for (int item = (bid + G - rot) % G; item < 64; item += G) {
        const int b = item >> 3, h = item & 7, g = h >> 2;
        for (int e = tid; e < 16 * 320; e += 512) {
            const int t = e / 320, cc = e % 320;
            const int col = (cc < 64) ? h * 64 + cc : (cc < 192 ? 512 + g * 128 + (cc - 64) : 768 + g * 128 + (cc - 192));
            float a = cb[col];
#pragma unroll
            for (int j = 0; j < 4; ++j) {
                const int tt = t - 3 + j;
                const float u = (tt >= 0) ? xbc[(size_t)(b * 16 + tt) * 1024 + col] : cbuf[(size_t)(b * 3 + tt + 3) * 1024 + col];
                a += cw[j * 1024 + col] * u;
            }
            act[e] = a / (1.f + expf(-a));
        }
        __syncthreads();
        const int pp = tid >> 3, seg = tid & 7;
        float hs[16];
        const size_t sbase = ((size_t)(b * 8 + h) * 64 + pp) * 128 + seg * 16;
#pragma unroll
        for (int i = 0; i < 16; ++i) hs[i] = p.in[4][sbase + i];
        const float a = -expf(p.in[13][h]), D = p.in[14][h];
#pragma unroll 1
        for (int t = 0; t < 16; ++t) {
            const float dt = dtv[(b * 16 + t) * 8 + h];
            const float zz = zb[(size_t)(b * 16 + t) * 512 + h * 64 + pp];
            const float x = act[t * 320 + pp];
            const float dA = expf(dt * a), coef = dt * x;
            float y = 0.f;
#pragma unroll
            for (int i = 0; i < 16; ++i) { hs[i] = dA * hs[i] + coef * act[t * 320 + 64 + seg * 16 + i]; y += act[t * 320 + 192 + seg * 16 + i] * hs[i]; }
            y += __shfl_xor(y, 1); y += __shfl_xor(y, 2); y += __shfl_xor(y, 4);
            if (seg == 0) ypre[(size_t)(b * 16 + t) * 512 + h * 64 + pp] = (y + D * x) * (zz / (1.f + expf(-zz)));
        }
#pragma unroll
        for (int i = 0; i < 16; ++i) s_ssm[sbase + i] = hs[i];
        __syncthreads();
    }
}

DEV bf16x8 cvt8(const float* p, float sc) {
    const f32x4 a = *(const f32x4*)p, b = *(const f32x4*)(p + 4);
    u32x4 w; w.x = cvtpk(a.x * sc, a.y * sc); w.y = cvtpk(a.z * sc, a.w * sc); w.z = cvtpk(b.x * sc, b.y * sc); w.w = cvtpk(b.z * sc, b.w * sc);
    return __builtin_bit_cast(bf16x8, w);
}
DEV void s_attn_part(const FP& p, LAS unsigned char* lds, int bid, int G) {
    const int lane = threadIdx.x & 63, wave = __builtin_amdgcn_readfirstlane(threadIdx.x >> 6), r = lane & 31, hh = lane >> 5;
    const float* q = (const float*)(p.ws + WS_SMP + SB_Q); const float* kn = p.out + 34871296; const float* vn = p.out + 34936832; const float* kp = p.in[2]; const float* vp = p.in[3];
    float* aml = (float*)(p.ws + WS_SMP + SB_AML); float* ao = (float*)(p.ws + WS_SMP + SB_AO);
    for (int it = bid + G * wave; it < 32 * N_ATILE; it += 8 * G) {
        const int bh = it / N_ATILE, tile = it % N_ATILE, b = bh >> 2, h = bh & 3;
        f32x16 S[2][2];
#pragma unroll
        for (int c = 0; c < 2; ++c)
#pragma unroll
            for (int sub = 0; sub < 2; ++sub)
#pragma unroll
                for (int i = 0; i < 16; ++i) S[c][sub][i] = 0.f;
        const float* qrow = q + (size_t)(b * 16 + (r & 15)) * 512 + h * 128 + 8 * hh;
#pragma unroll
        for (int sub = 0; sub < 2; ++sub) {
            int kk = tile * 64 + sub * 32 + r; if (kk > 2063) kk = 2063;
            const float* krow = ((kk < 2048) ? kp + (((size_t)b * 2048 + kk) * 4 + h) * 128 : kn + (((size_t)b * 16 + (kk - 2048)) * 4 + h) * 128) + 8 * hh;
#pragma unroll
            for (int c = 0; c < 2; ++c)
#pragma unroll
                for (int ks = 0; ks < 4; ++ks) S[c][sub] = mfma32(cvt8(krow + c * 64 + 16 * ks, 1.f), cvt8(qrow + c * 64 + 16 * ks, QSCALE), S[c][sub]);
        }
        bf16x8 P[2][4];
#pragma unroll
        for (int c = 0; c < 2; ++c) {
            float mx = -1e30f;
#pragma unroll
            for (int sub = 0; sub < 2; ++sub)
#pragma unroll
                for (int i = 0; i < 16; ++i) {
                    const int key = tile * 64 + sub * 32 + (i & 3) + 8 * (i >> 2) + 4 * hh;
                    if (key > 2063) S[c][sub][i] = -1e30f;
                    mx = fmaxf(mx, S[c][sub][i]);
                }
            mx = half_max(mx);
            float l = 0.f;
#pragma unroll
            for (int sub = 0; sub < 2; ++sub)
#pragma unroll
                for (int i = 0; i < 16; ++i) { S[c][sub][i] = __builtin_amdgcn_exp2f(S[c][sub][i] - mx); l += S[c][sub][i]; }
            l = half_sum(l);
            if (lane < 16) { aml[((size_t)it * 32 + lane * 2 + c) * 2] = mx * 0.6931471805599453f; aml[((size_t)it * 32 + lane * 2 + c) * 2 + 1] = l; }
            P[c][0] = pfrag(S[c][0], 0); P[c][1] = pfrag(S[c][0], 1); P[c][2] = pfrag(S[c][1], 0); P[c][3] = pfrag(S[c][1], 1);
        }
#pragma unroll 1
        for (int eb = 0; eb < 4; ++eb) {
            f32x16 O0, O1;
#pragma unroll
            for (int i = 0; i < 16; ++i) { O0[i] = 0.f; O1[i] = 0.f; }
#pragma unroll
            for (int st = 0; st < 4; ++st) {
                float vv[8];
#pragma unroll
                for (int jj = 0; jj < 8; ++jj) {
                    int kj = tile * 64 + 16 * st + 8 * (jj >> 2) + 4 * hh + (jj & 3); if (kj > 2063) kj = 2063;
                    const float* vrow = (kj < 2048) ? vp + (((size_t)b * 2048 + kj) * 4 + h) * 128 : vn + (((size_t)b * 16 + (kj - 2048)) * 4 + h) * 128;
                    vv[jj] = vrow[eb * 32 + r];
                }
                u32x4 w; w.x = cvtpk(vv[0], vv[1]); w.y = cvtpk(vv[2], vv[3]); w.z = cvtpk(vv[4], vv[5]); w.w = cvtpk(vv[6], vv[7]);
                const bf16x8 vf = __builtin_bit_cast(bf16x8, w);
                O0 = mfma32(vf, P[0][st], O0); O1 = mfma32(vf, P[1][st], O1);
            }
            if (r < 16) {
#pragma unroll
                for (int g4 = 0; g4 < 4; ++g4) {
                    const int e0 = eb * 32 + 8 * g4 + 4 * hh;
                    *(f32x4*)(ao + ((size_t)it * 32 + r * 2 + 0) * 128 + e0) = (f32x4){O0[4 * g4], O0[4 * g4 + 1], O0[4 * g4 + 2], O0[4 * g4 + 3]};
                    *(f32x4*)(ao + ((size_t)it * 32 + r * 2 + 1) * 128 + e0) = (f32x4){O1[4 * g4], O1[4 * g4 + 1], O1[4 * g4 + 2], O1[4 * g4 + 3]};
                }
            }
        }
    }
}
DEV void s_attn_comb(const FP& p, int bid, int G, int rot) {
    const int lane = threadIdx.x & 63, wave = __builtin_amdgcn_readfirstlane(threadIdx.x >> 6);
    const float* aml = (const float*)(p.ws + WS_SMP + SB_AML); const float* ao = (const float*)(p.ws + WS_SMP + SB_AO); const float* ypre = (const float*)(p.ws + WS_SMP + SB_YPRE);
    bf16_t* cat = (bf16_t*)(p.ws + WS_SMP + SB_CAT);
    const float lam_init = 0.2f;
    const float lam = expf(wave_sum(p.in[16][lane] * p.in[17][lane])) - expf(wave_sum(p.in[18][lane] * p.in[19][lane])) + lam_init;
    const int blk = (bid + G - rot) % G;
    for (int it = blk + G * wave; it < 512 + 256; it += 8 * G) {
        if (it < 512) {
            const int bh = it >> 4, qi = it & 15, b = bh >> 2, h = bh & 3;
            float o[2][2];
#pragma unroll
            for (int c = 0; c < 2; ++c) {
                const float mj = (lane < N_ATILE) ? aml[((size_t)(bh * N_ATILE + lane) * 32 + qi * 2 + c) * 2] : -1e30f;
                const float lj = (lane < N_ATILE) ? aml[((size_t)(bh * N_ATILE + lane) * 32 + qi * 2 + c) * 2 + 1] : 0.f;
                const float M = wave_max(mj), wj = expf(mj - M), L = wave_sum(lj * wj);
                float ax = 0.f, ay = 0.f;
#pragma unroll 11
                for (int j = 0; j < N_ATILE; ++j) {
                    const float w = __shfl(wj, j);
                    const float2 v = ((const float2*)(ao + ((size_t)(bh * N_ATILE + j) * 32 + qi * 2 + c) * 128))[lane];
                    ax += w * v.x; ay += w * v.y;
                }
                o[c][0] = ax / L; o[c][1] = ay / L;
            }
            const float ox = o[0][0] - lam * o[1][0], oy = o[0][1] - lam * o[1][1];
            const float ms = wave_sum(ox * ox + oy * oy) * (1.f / 128.f);
            const float rs = rsqrtf(ms + 1e-5f) * (1.f - lam_init);
            const float2 w = ((const float2*)p.in[20])[lane];
            ((unsigned*)(cat + (size_t)(b * 16 + qi) * 1024 + 512 + h * 128))[lane] = pk2(ox * rs * w.x, oy * rs * w.y);
        } else {
            const int i2 = it - 512, row = i2 >> 1, g = i2 & 1;
            const f32x4 v = ((const f32x4*)(ypre + (size_t)row * 512 + g * 256))[lane];
            const float rs = rsqrtf(wave_sum(v.x * v.x + v.y * v.y + v.z * v.z + v.w * v.w) * (1.f / 256.f) + 1e-5f);
            const f32x4 ww = ((const f32x4*)(p.in[15] + g * 256))[lane];
            u32x2 o; o.x = pk2(v.x * rs * ww.x, v.y * rs * ww.y); o.y = pk2(v.z * rs * ww.z, v.w * rs * ww.w);
            ((u32x2*)(cat + (size_t)row * 1024 + g * 256))[lane] = o;
        }
    }
}
DEV void s_xattn_part(const FP& p, LAS unsigned char* lds, int bid, int G, int rot) {
    const int lane = threadIdx.x & 63, wave = __builtin_amdgcn_readfirstlane(threadIdx.x >> 6), r = lane & 31, hh = lane >> 5;
    const float* qx = (const float*)(p.ws + WS_SMP + SB_QX); const float* mk = p.in[6]; const float* mv = p.in[7];
    float* xml = (float*)(p.ws + WS_SMP + SB_XML); float* xo = (float*)(p.ws + WS_SMP + SB_XO);
    const int blk = (bid + G - rot) % G;
    for (int it = blk + G * wave; it < 128; it += 8 * G) {
        const int bh = it >> 2, tile = it & 3, b = bh >> 2, h = bh & 3;
        f32x16 S[2];
#pragma unroll
        for (int sub = 0; sub < 2; ++sub)
#pragma unroll
            for (int i = 0; i < 16; ++i) S[sub][i] = 0.f;
        const float* qrow = qx + (size_t)(b * 16 + (r & 15)) * 1024 + h * 256 + 8 * hh;
#pragma unroll 4
        for (int ks = 0; ks < 16; ++ks) {
            const bf16x8 qf = cvt8(qrow + 16 * ks, 0.0625f * 1.4426950408889634f);
#pragma unroll
            for (int sub = 0; sub < 2; ++sub) {
                const float* krow = mk + (((size_t)b * 256 + tile * 64 + sub * 32 + r) * 4 + h) * 256 + 8 * hh;
                S[sub] = mfma32(cvt8(krow + 16 * ks, 1.f), qf, S[sub]);
            }
        }
        float mx = half_max(fmaxf(max16(S[0]), max16(S[1])));
        float l = 0.f;
#pragma unroll
        for (int sub = 0; sub < 2; ++sub)
#pragma unroll
            for (int i = 0; i < 16; ++i) { S[sub][i] = __builtin_amdgcn_exp2f(S[sub][i] - mx); l += S[sub][i]; }
        l = half_sum(l);
        if (lane < 16) { xml[((size_t)it * 16 + lane) * 2] = mx * 0.6931471805599453f; xml[((size_t)it * 16 + lane) * 2 + 1] = l; }
        bf16x8 P[4];
        P[0] = pfrag(S[0], 0); P[1] = pfrag(S[0], 1); P[2] = pfrag(S[1], 0); P[3] = pfrag(S[1], 1);
#pragma unroll 1
        for (int eb = 0; eb < 8; ++eb) {
            f32x16 O;
#pragma unroll
            for (int i = 0; i < 16; ++i) O[i] = 0.f;
#pragma unroll
            for (int st = 0; st < 4; ++st) {
                float vv[8];
#pragma unroll
                for (int jj = 0; jj < 8; ++jj) {
                    const int kj = tile * 64 + 16 * st + 8 * (jj >> 2) + 4 * hh + (jj & 3);
                    vv[jj] = mv[(((size_t)b * 256 + kj) * 4 + h) * 256 + eb * 32 + r];
                }
                u32x4 w; w.x = cvtpk(vv[0], vv[1]); w.y = cvtpk(vv[2], vv[3]); w.z = cvtpk(vv[4], vv[5]); w.w = cvtpk(vv[6], vv[7]);
                O = mfma32(__builtin_bit_cast(bf16x8, w), P[st], O);
            }
            if (r < 16) {
#pragma unroll
                for (int g4 = 0; g4 < 4; ++g4) *(f32x4*)(xo + ((size_t)it * 16 + r) * 256 + eb * 32 + 8 * g4 + 4 * hh) = (f32x4){O[4 * g4], O[4 * g4 + 1], O[4 * g4 + 2], O[4 * g4 + 3]};
            }
        }
    }
}
DEV void s_xattn_comb(const FP& p, int bid, int G, int rot) {
    const int lane = threadIdx.x & 63, wave = __builtin_amdgcn_readfirstlane(threadIdx.x >> 6);
    const float* xml = (const float*)(p.ws + WS_SMP + SB_XML); const float* xo = (const float*)(p.ws + WS_SMP + SB_XO);
    bf16_t* ox = (bf16_t*)(p.ws + WS_SMP + SB_OX);
    const int blk = (bid + G - rot) % G;
    for (int it = blk + G * wave; it < 512; it += 8 * G) {
        const int bh = it >> 4, qi = it & 15, b = bh >> 2, h = bh & 3;
        float m[4], l[4];
#pragma unroll
        for (int j = 0; j < 4; ++j) { m[j] = xml[((size_t)(bh * 4 + j) * 16 + qi) * 2]; l[j] = xml[((size_t)(bh * 4 + j) * 16 + qi) * 2 + 1]; }
        const float M = fmaxf(fmaxf(m[0], m[1]), fmaxf(m[2], m[3]));
        float L = 0.f; f32x4 acc = {0.f, 0.f, 0.f, 0.f};
#pragma unroll
        for (int j = 0; j < 4; ++j) { const float w = expf(m[j] - M); L += l[j] * w; acc += ((const f32x4*)(xo + ((size_t)(bh * 4 + j) * 16 + qi) * 256))[lane] * w; }
        const float il = 1.f / L;
        u32x2 o; o.x = pk2(acc.x * il, acc.y * il); o.y = pk2(acc.z * il, acc.w * il);
        ((u32x2*)(ox + (size_t)(b * 16 + qi) * 1024 + h * 256))[lane] = o;
    }
}

namespace cg = cooperative_groups;


DEV unsigned long long rf64(unsigned long long v) {
    const unsigned lo = __builtin_amdgcn_readfirstlane((unsigned)v), hi = __builtin_amdgcn_readfirstlane((unsigned)(v >> 32));
    return ((unsigned long long)hi << 32) | lo;
}
DEV FP fp_from_lds(const LAS unsigned long long* tab) {
    asm volatile("" ::: "memory");
    FP q;
#pragma unroll
    for (int i = 0; i < 36; ++i) q.in[i] = (const float*)rf64(tab[i]);
    q.out = (float*)rf64(tab[36]); q.ws = (unsigned char*)rf64(tab[37]);
    return q;
}

constexpr int CW_TEAM = 8192, CW_QUEUE = 4160;
constexpr int TEAM = 64;
DEV void sample_chain(const FP& p, LAS unsigned char* lds, int tb, int T, const XcdBarrier& tbar) {
    unsigned char* sb = p.ws + WS_SMP;
    float* ys = p.out + 16777216; const float* xs = p.in[1];
    s_gemm((const bf16_t*)(sb + SB_XN), (const bf16_t*)(p.ws + WS_W_IN), 3072, 1024, lds, tb, T, 0,
           EpiSIn{(float*)(sb + SB_Z), (float*)(sb + SB_XBC), (float*)(sb + SB_Q), p.out + 34871296, p.out + 34936832, p.out + 35526656});
    xcd_barrier(tbar);
    s_ssd(p, lds, tb, T, 0);
    s_attn_part(p, lds, tb, T);
    xcd_barrier(tbar);
    s_attn_comb(p, tb, T, 0);
    xcd_barrier(tbar);
    s_gemm((const bf16_t*)(sb + SB_CAT), (const bf16_t*)(p.ws + WS_W_OUT), 1024, 1024, lds, tb, T, 0, EpiSF32{(float*)(sb + SB_MIX), 1024, 1.f});
    xcd_barrier(tbar);
    s_row(p, (const float*)(sb + SB_MIX), xs, p.in[28], ys, p.in[29], (bf16_t*)(sb + SB_XN), nullptr, tb, T, 0);
    xcd_barrier(tbar);
    s_gemm((const bf16_t*)(sb + SB_XN), (const bf16_t*)(p.ws + WS_W_Q), 1024, 1024, lds, tb, T, 0, EpiSF32{(float*)(sb + SB_QX), 1024, 1.f});
    xcd_barrier(tbar);
    s_xattn_part(p, lds, tb, T, 0);
    xcd_barrier(tbar);
    s_xattn_comb(p, tb, T, 0);
    xcd_barrier(tbar);
    s_gemm((const bf16_t*)(sb + SB_OX), (const bf16_t*)(p.ws + WS_W_O), 1024, 1024, lds, tb, T, 0, EpiSF32{(float*)(sb + SB_MIX), 1024, 1.f});
    xcd_barrier(tbar);
    s_row(p, (const float*)(sb + SB_MIX), ys, p.in[30], ys, p.in[31], (bf16_t*)(sb + SB_XN), nullptr, tb, T, 0);
    xcd_barrier(tbar);
    s_gemm((const bf16_t*)(sb + SB_XN), (const bf16_t*)(p.ws + WS_W_GU), 5632, 1024, lds, tb, T, 0, EpiSSwiglu{(bf16_t*)(sb + SB_HID)});
    xcd_barrier(tbar);
    s_gemm((const bf16_t*)(sb + SB_HID), (const bf16_t*)(p.ws + WS_W_DOWN), 1024, 2816, lds, tb, T, 0, EpiSF32{(float*)(sb + SB_MIX), 1024, 1.f});
    xcd_barrier(tbar);
    s_row(p, (const float*)(sb + SB_MIX), ys, p.in[32], ys, nullptr, nullptr, nullptr, tb, T, 0);
    __syncthreads();
}
DEV void p3_queue(const FP& p, LAS unsigned char* lds, int bid) {
    unsigned* qh = (unsigned*)(p.ws + WS_CTL) + CW_QUEUE;
    volatile LAS int* slot = (volatile LAS int*)(lds + LDS_BYTES - 32);
    const AttnCtx ctx = attn_setup(p, lds);
    for (;;) {
        __syncthreads();
        if (threadIdx.x == 0) {
            int u = -1;
            for (int k = 0; k < 8 && u < 0; ++k) {
                const int q = (bid + k) & 7;
                const unsigned v = __hip_atomic_fetch_add(qh + 64 * q, 1u, __ATOMIC_RELAXED, __HIP_MEMORY_SCOPE_AGENT);
                if (v < 82u) u = q * 82 + (int)v;
            }
            slot[0] = u;
        }
        __syncthreads();
        const int u = slot[0];
        if (u < 0) break;
        const int q = u / 82, v = u % 82;
        if (v < 57) attn_unit(p, lds, ctx, q, 63 - v);
        else if (v < 73) ssd2_item(p, q * 16 + (v - 57));
        else if (v < 75) memkv_unit(p, lds, q * 2 + (v - 73));
        else attn_unit(p, lds, ctx, q, 81 - v);
    }
}
__global__ void __launch_bounds__(512, 2) k_mega(FP p0) {
    extern __shared__ __attribute__((aligned(16))) unsigned char lds_raw[];
    LAS unsigned char* lds = (LAS unsigned char*)lds_raw;
    const int G = gridDim.x, bid = blockIdx.x, ngw = G * 8;
#define IDS() int tid_ = threadIdx.x; asm volatile("" : "+v"(tid_)); const int lane = tid_ & 63, wave = __builtin_amdgcn_readfirstlane(tid_ >> 6), gw = bid * 8 + wave; (void)lane; (void)gw
    LAS unsigned long long* tab = (LAS unsigned long long*)(lds + LDS_BYTES - 512);
    if (threadIdx.x < 36) tab[threadIdx.x] = (unsigned long long)p0.in[threadIdx.x];
    if (threadIdx.x == 36) tab[36] = (unsigned long long)p0.out;
    if (threadIdx.x == 37) tab[37] = (unsigned long long)p0.ws;
#define PH(...) do { const FP p = fp_from_lds(tab); float* y = p.out; unsigned char* sb = p.ws + WS_SMP; (void)y; (void)sb; __VA_ARGS__ } while (0)
    volatile LAS unsigned* MISC = (volatile LAS unsigned*)(lds + LDS_BYTES - 64);
    if (threadIdx.x < 16) MISC[threadIdx.x] = 0u;
    __syncthreads();
    XcdBarrier bar = xcd_barrier_post((unsigned*)(p0.ws + WS_CTL), MISC);
    PH( { IDS(); phase_prep_x(p, lds, gw, ngw, wave, lane); phase_prep_ffn(p, lds, gw, ngw, wave, lane); phase_prep_mix(p, lds, gw, ngw, wave, lane); } );
    PH( s_row(p, nullptr, p.in[1], nullptr, nullptr, p.in[27], (bf16_t*)(sb + SB_XN), (float*)(sb + SB_DTV), bid, G, 0); );
    xcd_barrier(bar);
    PH( phase_inproj(p, lds, G, bid); );
    xcd_barrier(bar);
    PH( phase_ssd1(p, lds, G, bid); );
    xcd_barrier(bar);
    PH( { const int T = (G >= 2 * TEAM) ? TEAM : 1; if (bid >= G - T) { XcdBarrier tbar = xcd_barrier_post((unsigned*)(p.ws + WS_CTL) + CW_TEAM, (volatile LAS unsigned*)(lds + LDS_BYTES - 48), (unsigned)T); sample_chain(p, lds, bid - (G - T), T, tbar); } } );
    PH( p3_queue(p, lds, bid); );
    xcd_barrier(bar);
    PH( phase_ssd3(p, lds, G, bid); );
    xcd_barrier(bar);
    PH( phase_outproj(p, lds, G, bid); );
    xcd_barrier(bar);
    PH( { IDS(); row_phase((const bf16_t*)(p.ws + WS_RAW), p.in[0], p.in[28], y, p.in[29], (bf16_t*)(p.ws + WS_XN), MP, gw, ngw, lane); } );
    xcd_barrier(bar);
    PH( phase_wq(p, lds, G, bid); );
    xcd_barrier(bar);
    PH( phase_xattn(p, lds, G, bid); );
    xcd_barrier(bar);
    PH( phase_wo(p, lds, G, bid); );
    xcd_barrier(bar);
    PH( { IDS(); row_phase((const bf16_t*)(p.ws + WS_RAW), y, p.in[30], y, p.in[31], (bf16_t*)(p.ws + WS_XN), MP, gw, ngw, lane); } );
    xcd_barrier(bar);
    PH( phase_ffn_gu(p, lds, G, bid); );
    xcd_barrier(bar);
    PH( phase_ffn_down(p, lds, G, bid); );
    xcd_barrier(bar);
    PH( { IDS(); row_phase((const bf16_t*)(p.ws + WS_RAW), y, p.in[32], y, nullptr, nullptr, MP, gw, ngw, lane); } );
}

extern "C" void kernel_launch(void* const* d_in, const int* in_sizes, int n_in, void* d_out, int out_size, void* d_ws, size_t ws_size, hipStream_t stream) {
    static int grid = 0;
    if (!grid) {
        int dev = 0, cus = 0, per_cu = 0;
        (void)hipGetDevice(&dev);
        (void)hipDeviceGetAttribute(&cus, hipDeviceAttributeMultiprocessorCount, dev);
        (void)hipFuncSetAttribute((const void*)k_mega, hipFuncAttributeMaxDynamicSharedMemorySize, LDS_BYTES);
        (void)hipOccupancyMaxActiveBlocksPerMultiprocessor(&per_cu, (const void*)k_mega, 512, LDS_BYTES);
        if (per_cu < 1) per_cu = 1;
        grid = cus * per_cu;
        if (grid > 256) grid = 256;
        if (n_in != 36 || ws_size < 256 * MiB) fprintf(stderr, "kernel_launch: unexpected n_in %d / ws_size %zu\n", n_in, ws_size);
    }
    (void)hipMemsetAsync((unsigned char*)d_ws + WS_CTL, 0, 65536, stream);
    FP p{};
    for (int i = 0; i < 36; ++i) p.in[i] = (const float*)d_in[i];
    p.out = (float*)d_out; p.ws = (unsigned char*)d_ws;
    void* args[] = {&p};
    hipError_t e = hipLaunchCooperativeKernel((const void*)k_mega, dim3(grid), dim3(512), args, LDS_BYTES, stream);
    if (e != hipSuccess) fprintf(stderr, "cooperative launch failed: %s (grid %d)\n", hipGetErrorString(e), grid);
}
```
